# Optimizing an MI355X kernel written in HIP

```python
import jax, jax.numpy as jnp
from jax import lax
import numpy as np

D_MODEL = 1024
BATCH = 16
SEQ = 2048
DEPTH = 1

CHUNK = 64
MIX_WIDTH = 2 * D_MODEL
SSM_WIDTH = D_MODEL
SSM_HEAD_DIM = 64
SSM_HEADS = SSM_WIDTH // SSM_HEAD_DIM
SSM_GROUPS = 2
SSM_STATE = 128
CONV_WIDTH = 4
CONV_DIM = SSM_WIDTH + 2 * SSM_GROUPS * SSM_STATE
LSTM_WIDTH = MIX_WIDTH - SSM_WIDTH
LSTM_HEAD_DIM = 128
LSTM_HEADS = LSTM_WIDTH // LSTM_HEAD_DIM
N_EXPERTS = 32
TOP_K = 4
D_FF = D_MODEL
SWIGLU_LIMIT = 7.0
SWIGLU_ALPHA = 1.702
MOE_BLOCK = 256
RMS_EPS = 1e-6
IN_SIZES = (SSM_WIDTH, CONV_DIM, SSM_HEADS,
            LSTM_WIDTH, LSTM_WIDTH, LSTM_WIDTH, LSTM_WIDTH, LSTM_HEADS, LSTM_HEADS)
IN_PROJ_DIM = SSM_WIDTH + CONV_DIM + SSM_HEADS + 4 * LSTM_WIDTH + 2 * LSTM_HEADS

kernel_name = 'hybrid_ssd_mlstm_moe_block'


def _rms_norm(x, w):
    xf = x.astype(jnp.float32)
    y = xf * lax.rsqrt(jnp.mean(xf * xf, axis=-1, keepdims=True) + RMS_EPS)
    return (y * w.astype(jnp.float32)).astype(x.dtype)


def _segsum(a):
    t = a.shape[-1]
    cs = jnp.cumsum(a, axis=-1)
    diff = cs[..., :, None] - cs[..., None, :]
    mask = jnp.tril(jnp.ones((t, t), dtype=bool))
    return jnp.where(mask, diff, -jnp.inf)


def _causal_conv(u, w, b):
    ch = u.shape[-1]
    y = lax.conv_general_dilated(u, w[:, None, :], window_strides=(1,),
                                 padding=[(w.shape[0] - 1, 0)],
                                 dimension_numbers=('NWC', 'WIO', 'NWC'),
                                 feature_group_count=ch)
    return y + b


def _ssd(xs, dt, a_neg, bm, cm):
    b, s, h, p = xs.shape
    g, n = bm.shape[2], bm.shape[3]
    e, c, l = h // g, s // CHUNK, CHUNK
    xd = (xs * dt[..., None]).reshape(b, c, l, g, e, p)
    a = jnp.transpose((dt * a_neg).reshape(b, c, l, g, e), (0, 3, 4, 1, 2))
    bc = bm.reshape(b, c, l, g, n)
    cc = cm.reshape(b, c, l, g, n)
    a_cs = jnp.cumsum(a, axis=-1)
    decay_in = jnp.exp(_segsum(a))
    cb = jnp.einsum('bclgn,bcsgn->bgcls', cc, bc)
    y_diag = jnp.einsum('bgecls,bcsgep->bclgep', cb[:, :, None] * decay_in, xd)
    decay_to_end = jnp.exp(a_cs[..., -1:] - a_cs)
    states = jnp.einsum('bcsgn,bgecs,bcsgep->bcgepn', bc, decay_to_end, xd)
    states = jnp.concatenate([jnp.zeros_like(states[:, :1]), states], axis=1)
    chunk_decay = jnp.exp(_segsum(jnp.pad(a_cs[..., -1], ((0, 0), (0, 0), (0, 0), (1, 0)))))
    states = jnp.einsum('bgezc,bcgepn->bzgepn', chunk_decay, states)[:, :-1]
    y_off = jnp.einsum('bclgn,bcgepn,bgecl->bclgep', cc, states, jnp.exp(a_cs))
    return (y_diag + y_off).reshape(b, s, h, p)


def _mlstm(q, k, v, i_pre, f_pre):
    b, s, h, dh = q.shape
    c, l = s // CHUNK, CHUNK
    q = q.reshape(b, c, l, h, dh)
    k = k.reshape(b, c, l, h, dh) * (dh ** -0.5)
    v = v.reshape(b, c, l, h, dh)
    log_f = jnp.transpose(jax.nn.log_sigmoid(f_pre).reshape(b, c, l, h), (0, 3, 1, 2))
    log_i = jnp.transpose(i_pre.reshape(b, c, l, h), (0, 3, 1, 2))
    cum_f = jnp.cumsum(log_f, axis=-1)
    chunk_f = cum_f[..., -1]
    a_end = chunk_f[..., None] - cum_f + log_i
    m_loc = jnp.max(a_end, axis=-1)
    w_end = jnp.exp(a_end - m_loc[..., None])
    c_loc = jnp.einsum('bhcl,bclhk,bclhv->bhckv', w_end, k, v)
    n_loc = jnp.einsum('bhcl,bclhk->bhck', w_end, k)

    def step(carry, inp):
        c_st, n_st, m_st = carry
        f_c, m_c, c_c, n_c = inp
        m_new = jnp.maximum(f_c + m_st, m_c)
        s_old = jnp.exp(f_c + m_st - m_new)
        s_new = jnp.exp(m_c - m_new)
        c_next = s_old[..., None, None] * c_st + s_new[..., None, None] * c_c
        n_next = s_old[..., None] * n_st + s_new[..., None] * n_c
        return (c_next, n_next, m_new), (c_st, n_st, m_st)

    init = (jnp.zeros((b, h, dh, dh), q.dtype), jnp.zeros((b, h, dh), q.dtype),
            jnp.zeros((b, h), q.dtype))
    _, (c_prev, n_prev, m_prev) = lax.scan(
        step, init, (jnp.moveaxis(chunk_f, 2, 0), jnp.moveaxis(m_loc, 2, 0),
                     jnp.moveaxis(c_loc, 2, 0), jnp.moveaxis(n_loc, 2, 0)))
    c_prev = jnp.moveaxis(c_prev, 0, 2)
    n_prev = jnp.moveaxis(n_prev, 0, 2)
    m_prev = jnp.moveaxis(m_prev, 0, 2)
    causal = jnp.tril(jnp.ones((l, l), dtype=bool))
    log_d = jnp.where(causal, cum_f[..., :, None] - cum_f[..., None, :] + log_i[..., None, :],
                      -jnp.inf)
    log_inter = cum_f + m_prev[..., None]
    m_row = jnp.maximum(log_inter, jnp.max(log_d, axis=-1))
    sc = jnp.einsum('bclhk,bcjhk->bhclj', q, k) * jnp.exp(log_d - m_row[..., None])
    w_inter = jnp.exp(log_inter - m_row)
    num = (jnp.einsum('bhclj,bcjhv->bclhv', sc, v)
           + jnp.einsum('bclhk,bhckv->bclhv', q, c_prev) * jnp.transpose(w_inter, (0, 2, 3, 1))[..., None])
    den = jnp.sum(sc, axis=-1) + jnp.einsum('bclhk,bhck->bhcl', q, n_prev) * w_inter
    den = jnp.maximum(jnp.abs(den), jnp.exp(-m_row))
    hout = num / jnp.transpose(den, (0, 2, 3, 1))[..., None]
    return hout.reshape(b, s, h, dh)


def _moe(xn, w_router, b_router, w_gu, b_gu, w_dn, b_dn):
    bsz, s, d = xn.shape
    t = bsz * s
    xf = xn.reshape(t, d)
    logits = (xf @ w_router + b_router).astype(jnp.float32)
    top_val, top_idx = lax.top_k(logits, TOP_K)
    gates = jax.nn.softmax(top_val, axis=-1)
    n_assign = t * TOP_K
    n_blocks = -(-n_assign // MOE_BLOCK) + N_EXPERTS
    n_rows = n_blocks * MOE_BLOCK
    flat_e = top_idx.reshape(n_assign)
    flat_tok = jnp.arange(n_assign, dtype=jnp.int32) // TOP_K
    flat_gate = gates.reshape(n_assign)
    order = jnp.argsort(flat_e)
    sorted_e = flat_e[order]
    counts = jnp.bincount(flat_e, length=N_EXPERTS)
    starts = jnp.cumsum(counts) - counts
    padded = (counts + MOE_BLOCK - 1) // MOE_BLOCK * MOE_BLOCK
    padded_ends = jnp.cumsum(padded)
    padded_starts = padded_ends - padded
    dest = padded_starts[sorted_e] + jnp.arange(n_assign, dtype=jnp.int32) - starts[sorted_e]
    row_tok = jnp.zeros((n_rows,), jnp.int32).at[dest].set(flat_tok[order])
    row_gate = jnp.zeros((n_rows,), jnp.float32).at[dest].set(flat_gate[order])
    block_expert = jnp.minimum(
        jnp.searchsorted(padded_ends, jnp.arange(n_blocks, dtype=jnp.int32) * MOE_BLOCK, side='right'),
        N_EXPERTS - 1).astype(jnp.int32)

    def expert_block(args):
        tok, gate, e = args
        xb = xf[tok]
        hh = xb @ w_gu[e] + b_gu[e]
        g_h = jnp.minimum(hh[:, :D_FF], SWIGLU_LIMIT)
        u_h = jnp.clip(hh[:, D_FF:], -SWIGLU_LIMIT, SWIGLU_LIMIT)
        act = (u_h + 1.0) * (g_h * jax.nn.sigmoid(SWIGLU_ALPHA * g_h))
        out = act @ w_dn[e] + b_dn[e]
        return out * gate.astype(out.dtype)[:, None]

    outs = lax.map(expert_block, (row_tok.reshape(n_blocks, MOE_BLOCK),
                                  row_gate.reshape(n_blocks, MOE_BLOCK), block_expert))
    y = jax.ops.segment_sum(outs.reshape(n_rows, d), row_tok, num_segments=t)
    return y.reshape(bsz, s, d).astype(xn.dtype)


def setup_inputs(seed: int = 0) -> dict:
    key = jax.random.key(seed)
    ks = jax.random.split(key, 24)
    f32 = jnp.float32
    nrm = lambda k, shape, scale: jax.random.normal(k, shape, f32) * scale
    dt0 = jnp.exp(jax.random.uniform(ks[5], (DEPTH, SSM_HEADS), f32, np.log(1e-3), np.log(1e-1)))
    return {
        'x': jax.random.normal(ks[0], (BATCH, SEQ, D_MODEL), f32),
        'norm_mix_w': 1.0 + nrm(ks[1], (DEPTH, D_MODEL), 0.02),
        'w_in': nrm(ks[2], (DEPTH, D_MODEL, IN_PROJ_DIM), D_MODEL ** -0.5),
        'conv_w': nrm(ks[3], (DEPTH, CONV_WIDTH, CONV_DIM), CONV_WIDTH ** -0.5),
        'conv_b': nrm(ks[4], (DEPTH, CONV_DIM), 0.02),
        'dt_bias': dt0 + jnp.log(-jnp.expm1(-dt0)),
        'a_log': jnp.log(jax.random.uniform(ks[6], (DEPTH, SSM_HEADS), f32, 1.0, 16.0)),
        'd_skip': 1.0 + nrm(ks[7], (DEPTH, SSM_HEADS), 0.1),
        'ssm_norm_w': 1.0 + nrm(ks[8], (DEPTH, SSM_WIDTH), 0.02),
        'lstm_i_bias': nrm(ks[9], (DEPTH, LSTM_HEADS), 0.1),
        'lstm_f_bias': 3.0 + 3.0 * jax.random.uniform(ks[10], (DEPTH, LSTM_HEADS), f32),
        'lstm_norm_w': 1.0 + nrm(ks[11], (DEPTH, LSTM_WIDTH), 0.02),
        'w_out': nrm(ks[12], (DEPTH, MIX_WIDTH, D_MODEL), MIX_WIDTH ** -0.5),
        'norm_ffn_w': 1.0 + nrm(ks[13], (DEPTH, D_MODEL), 0.02),
        'w_router': nrm(ks[14], (DEPTH, D_MODEL, N_EXPERTS), D_MODEL ** -0.5),
        'b_router': nrm(ks[15], (DEPTH, N_EXPERTS), 0.01),
        'w_gate_up': nrm(ks[16], (DEPTH, N_EXPERTS, D_MODEL, 2 * D_FF), D_MODEL ** -0.5),
        'b_gate_up': nrm(ks[17], (DEPTH, N_EXPERTS, 2 * D_FF), 0.02),
        'w_down': nrm(ks[18], (DEPTH, N_EXPERTS, D_FF, D_MODEL), D_FF ** -0.5),
        'b_down': nrm(ks[19], (DEPTH, N_EXPERTS, D_MODEL), 0.02),
        'norm_final_w': 1.0 + nrm(ks[20], (D_MODEL,), 0.02),
    }


def reference(x, norm_mix_w, w_in, conv_w, conv_b, dt_bias, a_log, d_skip, ssm_norm_w,
              lstm_i_bias, lstm_f_bias, lstm_norm_w, w_out, norm_ffn_w, w_router, b_router,
              w_gate_up, b_gate_up, w_down, b_down, norm_final_w):
    f32 = jnp.float32
    b, s = x.shape[0], x.shape[1]
    splits = np.cumsum(IN_SIZES)[:-1].tolist()
    for layer in range(DEPTH):
        xn = _rms_norm(x, norm_mix_w[layer])
        proj = (xn @ w_in[layer]).astype(f32)
        z, xbc, dt_raw, q, k, v, o_pre, i_pre, f_pre = jnp.split(proj, splits, axis=-1)
        xbc = jax.nn.silu(_causal_conv(xbc, conv_w[layer].astype(f32), conv_b[layer].astype(f32)))
        xs, bm, cm = jnp.split(xbc, [SSM_WIDTH, SSM_WIDTH + SSM_GROUPS * SSM_STATE], axis=-1)
        xs = xs.reshape(b, s, SSM_HEADS, SSM_HEAD_DIM)
        bm = bm.reshape(b, s, SSM_GROUPS, SSM_STATE)
        cm = cm.reshape(b, s, SSM_GROUPS, SSM_STATE)
        dt = jax.nn.softplus(dt_raw + dt_bias[layer].astype(f32))
        a_neg = -jnp.exp(a_log[layer].astype(f32))
        y_ssm = _ssd(xs, dt, a_neg, bm, cm) + d_skip[layer].astype(f32)[:, None] * xs
        y_ssm = _rms_norm(y_ssm.reshape(b, s, SSM_WIDTH) * jax.nn.silu(z), ssm_norm_w[layer])
        h_l = _mlstm(q.reshape(b, s, LSTM_HEADS, LSTM_HEAD_DIM),
                     k.reshape(b, s, LSTM_HEADS, LSTM_HEAD_DIM),
                     v.reshape(b, s, LSTM_HEADS, LSTM_HEAD_DIM),
                     i_pre + lstm_i_bias[layer].astype(f32),
                     f_pre + lstm_f_bias[layer].astype(f32))
        h_l = _rms_norm(h_l, lstm_norm_w[layer].reshape(LSTM_HEADS, LSTM_HEAD_DIM))
        y_lstm = jax.nn.sigmoid(o_pre) * h_l.reshape(b, s, LSTM_WIDTH)
        mixed = jnp.concatenate([y_ssm, y_lstm], axis=-1).astype(x.dtype)
        x = x + mixed @ w_out[layer]
        x = x + _moe(_rms_norm(x, norm_ffn_w[layer]), w_router[layer], b_router[layer],
                     w_gate_up[layer], b_gate_up[layer], w_down[layer], b_down[layer])
    return _rms_norm(x, norm_final_w)
```

```cpp
#include <hip/hip_runtime.h>
#include <cstdio>
#include <cstdint>

__device__ __forceinline__ int lane_id() { int l; asm volatile("v_mbcnt_lo_u32_b32 %0, -1, 0\n\tv_mbcnt_hi_u32_b32 %0, -1, %0" : "=v"(l)); return l; }
namespace pg8 {
#define PG8_LAS __attribute__((address_space(3)))
typedef unsigned short bf16_t;
typedef short bf16x8 __attribute__((ext_vector_type(8)));
typedef float f32x4 __attribute__((ext_vector_type(4)));
typedef unsigned u32x4 __attribute__((ext_vector_type(4)));
constexpr int BM = 256, BK = 64, HALF = 128, HTB = HALF * BK * 2, STAGE_BYTES = 8 * HTB, NXCD = 8, WGM = 8;

__host__ __device__ __forceinline__ int lds_byte(int r, int c) { const int st = (r >> 4) * 2 + (c >> 5), rr = r & 15, cc = c & 31, ob = rr * 64 + cc * 2; return st * 1024 + (ob ^ (((ob >> 9) & 1) << 5)); }
__host__ __device__ __forceinline__ void stage_rc(int b, int& R, int& C) { const int st = b / 1024, sb = b % 1024, swz = sb ^ (((sb >> 9) & 1) << 5); R = (st >> 1) * 16 + swz / 64; C = (st & 1) * 32 + (swz % 64) / 2; }
__host__ __device__ __forceinline__ int perm32(int rho) { const int n = rho >> 4, i = rho & 15; return 8 * (i >> 2) + 4 * n + (i & 3); }

__device__ __forceinline__ const char* uni_ptr(const void* p) { const unsigned long long v = (unsigned long long)p; const unsigned lo = __builtin_amdgcn_readfirstlane((unsigned)v), hi = __builtin_amdgcn_readfirstlane((unsigned)(v >> 32)); return (const char*)(((unsigned long long)hi << 32) | lo); }
struct Unit { int pm, pn, pb, e; };
struct Gemm { const bf16_t* A; const bf16_t* Bt; int M, N, K; };

struct StaticOrder {
    int nM, nN, nwg, G, c;
    __host__ __device__ void init(int M, int N, int G_, int c_) { nM = M / BM; nN = N / BM; nwg = nM * nN; G = G_; c = c_; }
    __host__ __device__ bool next(int i, Unit& u) const {
        const long L = (long)i * G + c; if (L >= nwg) return false;
        int wgid = (int)L; { const int q = nwg / NXCD, r = nwg % NXCD, xcd = wgid % NXCD, off = wgid / NXCD; wgid = (xcd < r ? xcd * (q + 1) : r * (q + 1) + (xcd - r) * q) + off; }
        const int nig = WGM * nN, gid = wgid / nig, fm = gid * WGM, gsz = (nM - fm) < WGM ? (nM - fm) : WGM;
        u.pm = fm + ((wgid % nig) % gsz); u.pn = (wgid % nig) / gsz; u.pb = u.pn; u.e = 0; return true;
    }
};
struct MoeOrder {
    const int* blk_expert; int nblk, ntn, G, c;
    __device__ bool next(int i, Unit& u) const {
        const int xcd = c % NXCD, s = i * (G / NXCD) + c / NXCD;
        const int rb = (s / ntn) * NXCD + xcd; if (rb >= nblk) return false;
        u.pm = rb; u.pn = s % ntn; u.e = __builtin_amdgcn_readfirstlane(blk_expert[rb]); u.pb = u.e * ntn + u.pn; return true;
    }
};

__device__ __forceinline__ unsigned cvt_pk_bf16(float lo, float hi) { unsigned r; asm volatile("v_cvt_pk_bf16_f32 %0, %1, %2" : "=v"(r) : "v"(lo), "v"(hi)); return r; }

struct EpiBf16 {
    static constexpr bool PERM = true; static constexpr int MIDT = -1;
    __device__ __forceinline__ void mid(f32x4 (&)[2][2][4][2], const Unit&, int, int) const {}
    bf16_t* O; int ldc;
    __device__ __forceinline__ void operator()(const f32x4 (&acc)[2][2][4][2], const Unit& u, int wr, int wc, int fr, int fq) const {
        const int row0 = u.pm * BM + wr * 64 + fr, col0 = u.pn * BM + wc * 32 + 8 * fq;
#pragma unroll
        for (int ai = 0; ai < 2; ++ai)
#pragma unroll
            for (int m = 0; m < 4; ++m) { bf16_t* rowp = O + (size_t)(row0 + ai * HALF + m * 16) * ldc + col0;
#pragma unroll
                for (int bj = 0; bj < 2; ++bj) { const f32x4 v0 = acc[ai][bj][m][0], v1 = acc[ai][bj][m][1];
                    u32x4 w; w.x = cvt_pk_bf16(v0[0], v0[1]); w.y = cvt_pk_bf16(v0[2], v0[3]); w.z = cvt_pk_bf16(v1[0], v1[1]); w.w = cvt_pk_bf16(v1[2], v1[3]);
                    *(u32x4*)(rowp + bj * HALF) = w; } }
    }
};
struct EpiResF32 {
    static constexpr bool PERM = false; static constexpr int MIDT = 16;
    const float* base; float* C; int ldc; const float* ssq;
    __device__ __forceinline__ void mid(f32x4 (&acc)[2][2][4][2], const Unit& u, int wr, int fr) const {
#pragma unroll
        for (int ai = 0; ai < 2; ++ai)
#pragma unroll
            for (int m = 0; m < 4; ++m) { const int row = u.pm * BM + ai * HALF + wr * 64 + m * 16 + fr; const f32x4 a = *(const f32x4*)(ssq + (size_t)row * 8), b = *(const f32x4*)(ssq + (size_t)row * 8 + 4);
                const float rs = 1.0f / sqrtf(((a[0] + a[1]) + (a[2] + a[3]) + (b[0] + b[1]) + (b[2] + b[3])) * (1.0f / 1024.0f) + 1e-6f);
#pragma unroll
                for (int bj = 0; bj < 2; ++bj)
#pragma unroll
                    for (int n = 0; n < 2; ++n) acc[ai][bj][m][n] = acc[ai][bj][m][n] * rs;
                asm volatile("" ::: "memory"); }
    }
    __device__ __forceinline__ void operator()(const f32x4 (&acc)[2][2][4][2], const Unit& u, int wr, int wc, int fr, int fq) const {
        const int row0 = u.pm * BM + wr * 64 + fr, col0 = u.pn * BM + wc * 32 + 4 * fq;
#pragma unroll
        for (int ai = 0; ai < 2; ++ai)
#pragma unroll
            for (int m = 0; m < 4; ++m) { const size_t off = (size_t)(row0 + ai * HALF + m * 16) * ldc + col0;
#pragma unroll
                for (int bj = 0; bj < 2; ++bj)
#pragma unroll
                    for (int n = 0; n < 2; ++n) { const f32x4 b = *(const f32x4*)(base + off + bj * HALF + n * 16); *(f32x4*)(C + off + bj * HALF + n * 16) = acc[ai][bj][m][n] + b; } }
    }
};
struct EpiSwiglu {
    static constexpr bool PERM = true; static constexpr int MIDT = -1;
    __device__ __forceinline__ void mid(f32x4 (&)[2][2][4][2], const Unit&, int, int) const {}
    unsigned char* act; const float* bgu;
    __device__ __forceinline__ void operator()(const f32x4 (&acc)[2][2][4][2], const Unit& u, int wr, int wc, int fr, int fq) const {
        const int row0 = u.pm * BM + wr * 64 + fr, col0 = u.pn * HALF + wc * 32 + 8 * fq;
        const float* bg = bgu + (size_t)u.e * 2048 + col0;
        f32x4 bgv[2], buv[2];
#pragma unroll
        for (int n = 0; n < 2; ++n) { bgv[n] = *(const f32x4*)(bg + 4 * n); buv[n] = *(const f32x4*)(bg + 1024 + 4 * n); }
#pragma unroll
        for (int ai = 0; ai < 2; ++ai)
#pragma unroll
            for (int m = 0; m < 4; ++m) { unsigned char* rowp = act + (size_t)(row0 + ai * HALF + m * 16) * 1024 + col0;
                float o[8];
#pragma unroll
                for (int n = 0; n < 2; ++n) { const f32x4 gv = acc[ai][0][m][n] + bgv[n], uv = acc[ai][1][m][n] + buv[n];
#pragma unroll
                    for (int i = 0; i < 4; ++i) { const float g = fminf(gv[i], 7.0f), uu = fminf(fmaxf(uv[i], -7.0f), 7.0f);
                        o[4 * n + i] = (uu + 1.0f) * g * __builtin_amdgcn_rcpf(1.0f + __expf(-1.702f * g)); } }
                int w0 = 0, w1 = 0; w0 = __builtin_amdgcn_cvt_pk_fp8_f32(o[0], o[1], w0, false); w0 = __builtin_amdgcn_cvt_pk_fp8_f32(o[2], o[3], w0, true); w1 = __builtin_amdgcn_cvt_pk_fp8_f32(o[4], o[5], w1, false); w1 = __builtin_amdgcn_cvt_pk_fp8_f32(o[6], o[7], w1, true);
                typedef int i2v __attribute__((ext_vector_type(2))); *(i2v*)rowp = (i2v){w0, w1}; }
    }
};
struct EpiDown {
    static constexpr bool PERM = true; static constexpr int MIDT = -1;
    __device__ __forceinline__ void mid(f32x4 (&)[2][2][4][2], const Unit&, int, int) const {}
    bf16_t* eo; const float* bdn; const float* row_gate;
    __device__ __forceinline__ void operator()(const f32x4 (&acc)[2][2][4][2], const Unit& u, int wr, int wc, int fr, int fq) const {
        const int row0 = u.pm * BM + wr * 64 + fr, col0 = u.pn * BM + wc * 32 + 8 * fq;
        const float* bb = bdn + (size_t)u.e * 1024 + col0;
        f32x4 bv[2][2];
#pragma unroll
        for (int bj = 0; bj < 2; ++bj)
#pragma unroll
            for (int n = 0; n < 2; ++n) bv[bj][n] = *(const f32x4*)(bb + bj * HALF + 4 * n);
#pragma unroll
        for (int ai = 0; ai < 2; ++ai)
#pragma unroll
            for (int m = 0; m < 4; ++m) { const int row = row0 + ai * HALF + m * 16; const float gt = row_gate[row]; bf16_t* rowp = eo + (size_t)row * 1024 + col0;
#pragma unroll
                for (int bj = 0; bj < 2; ++bj) { const f32x4 v0 = (acc[ai][bj][m][0] + bv[bj][0]) * gt, v1 = (acc[ai][bj][m][1] + bv[bj][1]) * gt;
                    u32x4 w; w.x = cvt_pk_bf16(v0[0], v0[1]); w.y = cvt_pk_bf16(v0[2], v0[3]); w.z = cvt_pk_bf16(v1[0], v1[1]); w.w = cvt_pk_bf16(v1[2], v1[3]);
                    *(u32x4*)(rowp + bj * HALF) = w; } }
    }
};

typedef int v8i_t __attribute__((ext_vector_type(8)));
typedef int v4i_t __attribute__((ext_vector_type(4)));
template <class Epi, class Sched>
__device__ __forceinline__ void gemm_phase(PG8_LAS unsigned char* lds, const Gemm g, const Sched& S, const Epi& E, int wid) {
    const int lane = lane_id(), tid = wid * 64 + lane, wr = wid >> 2, wc = wid & 3, fr = lane & 15, fq = lane >> 4;
    const int K = g.K, nt = K / BK;
    unsigned voffA[2], voffB[2];
#pragma unroll
    for (int i = 0; i < 2; ++i) { int R, C; stage_rc(tid * 16 + i * 8192, R, C); const int Rb = Epi::PERM ? ((R & ~31) + perm32(R & 31)) : R;
        voffA[i] = (unsigned)(R * K + C) * 2u; voffB[i] = (unsigned)(Rb * K + C) * 2u; }
    const size_t kstep = (size_t)(BK * 2);
    const size_t hstep = (size_t)HALF * K * 2;
    const size_t tstep = 2 * hstep;
    const unsigned ldsw = (unsigned)wid * 1024u;
    const int aoff = lds_byte(wr * 64 + fr, fq * 8), boff = lds_byte(wc * 32 + fr, fq * 8);
#define PG8_SA(b, h) (((b) * 2 + (h)) * HTB)
#define PG8_SB(b, h) ((4 + (b) * 2 + (h)) * HTB)
#define PG8_STAGE(bufoff, gbase, voff) do { _Pragma("unroll") for (int _i = 0; _i < 2; ++_i) \
        __builtin_amdgcn_global_load_lds((const unsigned*)((const char*)(gbase) + (voff)[_i]), (PG8_LAS unsigned*)(lds + (bufoff) + ldsw + _i * 8192), 16, 0, 0); } while (0)
#define PG8_LDA(dst, b, h) do { _Pragma("unroll") for (int m = 0; m < 4; ++m) _Pragma("unroll") for (int k = 0; k < 2; ++k) dst[m][k] = *(const PG8_LAS bf16x8*)(lds + PG8_SA(b, h) + aoff + m * 2048 + k * 1024); } while (0)
#define PG8_LDB(dst, b, h) do { _Pragma("unroll") for (int n = 0; n < 2; ++n) _Pragma("unroll") for (int k = 0; k < 2; ++k) dst[n][k] = *(const PG8_LAS bf16x8*)(lds + PG8_SB(b, h) + boff + n * 2048 + k * 1024); } while (0)
#define PG8_MMA(ai, bj, At, Bt) do { __builtin_amdgcn_s_setprio(1); _Pragma("unroll") for (int m = 0; m < 4; ++m) _Pragma("unroll") for (int n = 0; n < 2; ++n) _Pragma("unroll") for (int k = 0; k < 2; ++k) \
        acc[ai][bj][m][n] = __builtin_amdgcn_mfma_f32_16x16x32_bf16(Bt[n][k], At[m][k], acc[ai][bj][m][n], 0, 0, 0); __builtin_amdgcn_s_setprio(0); } while (0)
#define PG8_WAIT_V(n) asm volatile("s_waitcnt vmcnt(" #n ")" ::: "memory")
#define PG8_WAIT_L(n) asm volatile("s_waitcnt lgkmcnt(" #n ")" ::: "memory")
#define PG8_BAR __builtin_amdgcn_s_barrier()
#define PG8_SCHED __builtin_amdgcn_sched_barrier(0)
    Unit cur, nxt; int ui = 0;
    if (!S.next(0, cur)) return;
    f32x4 acc[2][2][4][2];
#pragma unroll
    for (int a = 0; a < 2; ++a)
#pragma unroll
        for (int b = 0; b < 2; ++b)
#pragma unroll
            for (int m = 0; m < 4; ++m)
#pragma unroll
                for (int n = 0; n < 2; ++n) acc[a][b][m][n] = (f32x4){0.f, 0.f, 0.f, 0.f};
    bf16x8 At[4][2], B0[2][2], B1[2][2];
    const char* cA = uni_ptr((const char*)g.A + (size_t)cur.pm * tstep); const char* cB = uni_ptr((const char*)g.Bt + (size_t)cur.pb * tstep);
    PG8_STAGE(PG8_SB(0, 0), cB, voffB); PG8_STAGE(PG8_SB(0, 1), cB + hstep, voffB); PG8_STAGE(PG8_SA(0, 0), cA, voffA); PG8_STAGE(PG8_SA(0, 1), cA + hstep, voffA);
    if (wr == 1) PG8_BAR;
    PG8_WAIT_V(2); PG8_BAR;
    PG8_STAGE(PG8_SB(1, 0), cB + kstep, voffB); PG8_STAGE(PG8_SA(1, 0), cA + kstep, voffA); PG8_STAGE(PG8_SB(1, 1), cB + hstep + kstep, voffB);
    PG8_WAIT_V(6); PG8_BAR;
    for (;;) {
        const bool has_next = S.next(ui + 1, nxt);
        const char* nA = uni_ptr(has_next ? (const char*)g.A + (size_t)nxt.pm * tstep : cA); const char* nB = uni_ptr(has_next ? (const char*)g.Bt + (size_t)nxt.pb * tstep : cB);
        for (int t = 0; t < nt; t += 2) {
            const bool last = (t == nt - 2);
            const char* a1 = cA + (size_t)(t + 1) * kstep;
            const char* a2 = last ? nA : cA + (size_t)(t + 2) * kstep; const char* b2 = last ? nB : cB + (size_t)(t + 2) * kstep;
            const char* a3 = a2 + kstep; const char* b3 = b2 + kstep;
            if constexpr (Epi::MIDT >= 0) { if (t == Epi::MIDT) E.mid(acc, cur, wr, fr); }
            PG8_LDB(B0, 0, 0); PG8_LDB(B1, 0, 1); PG8_SCHED; PG8_LDA(At, 0, 0); PG8_STAGE(PG8_SA(1, 1), a1 + hstep, voffA);
            PG8_WAIT_V(8); PG8_WAIT_L(0); PG8_BAR; PG8_MMA(0, 0, At, B0); PG8_MMA(0, 1, At, B1); PG8_BAR; PG8_SCHED;
            PG8_LDA(At, 0, 1); PG8_STAGE(PG8_SB(0, 0), b2, voffB); PG8_STAGE(PG8_SB(0, 1), b2 + hstep, voffB); PG8_STAGE(PG8_SA(0, 0), a2, voffA);
            PG8_WAIT_V(8); PG8_WAIT_L(0); PG8_BAR; PG8_MMA(1, 0, At, B0); PG8_MMA(1, 1, At, B1); PG8_BAR; PG8_SCHED;
            PG8_LDB(B0, 1, 0); PG8_LDB(B1, 1, 1); PG8_SCHED; PG8_LDA(At, 1, 0); PG8_STAGE(PG8_SA(0, 1), a2 + hstep, voffA);
            PG8_WAIT_V(8); PG8_WAIT_L(0); PG8_BAR; PG8_MMA(0, 0, At, B0); PG8_MMA(0, 1, At, B1); PG8_BAR; PG8_SCHED;
            PG8_LDA(At, 1, 1); PG8_STAGE(PG8_SB(1, 0), b3, voffB); PG8_STAGE(PG8_SB(1, 1), b3 + hstep, voffB); PG8_STAGE(PG8_SA(1, 0), a3, voffA);
            PG8_WAIT_V(8); PG8_WAIT_L(0); PG8_BAR; PG8_MMA(1, 0, At, B0); PG8_MMA(1, 1, At, B1); PG8_BAR; PG8_SCHED;
        }
        if (wr == 0) PG8_BAR;
        E(acc, cur, wr, wc, fr, fq);
        if (!has_next) break;
#pragma unroll
        for (int a = 0; a < 2; ++a)
#pragma unroll
            for (int b = 0; b < 2; ++b)
#pragma unroll
                for (int m = 0; m < 4; ++m)
#pragma unroll
                    for (int n = 0; n < 2; ++n) acc[a][b][m][n] = (f32x4){0.f, 0.f, 0.f, 0.f};
        cur = nxt; cA = nA; cB = nB; ++ui;
        if (wr == 1) PG8_BAR;
    }
    PG8_WAIT_V(0);
    PG8_BAR;
#undef PG8_SA
#undef PG8_SB
#undef PG8_STAGE
#undef PG8_LDA
#undef PG8_LDB
#undef PG8_MMA
#undef PG8_WAIT_V
#undef PG8_WAIT_L
#undef PG8_BAR
#undef PG8_SCHED
}
template <class Epi, class Sched>
__device__ __forceinline__ void gemm_phase_f8(PG8_LAS unsigned char* lds, const Gemm g, const Sched& S, const Epi& E, int wid) {
    const int lane = lane_id(), tid = wid * 64 + lane, wr = wid >> 2, wc = wid & 3, fr = lane & 15, fq = lane >> 4;
    int Kq = g.K; asm volatile("" : "+s"(Kq));
    const int K = Kq, nt = K / BK;
    unsigned voffA[2], voffB[2];
#pragma unroll
    for (int i = 0; i < 2; ++i) { int R, C; stage_rc(tid * 16 + i * 8192, R, C); const int Rb = Epi::PERM ? ((R & ~31) + perm32(R & 31)) : R;
        voffA[i] = (unsigned)(R * K + C) * 2u; voffB[i] = (unsigned)(Rb * K + C) * 2u; }
    const size_t kstep = (size_t)(BK * 2);
    const size_t hstep = (size_t)HALF * K * 2;
    const size_t tstep = 2 * hstep;
    const unsigned ldsw = (unsigned)wid * 1024u;
    const unsigned ldsb = (unsigned)__builtin_amdgcn_readfirstlane((int)((unsigned)(size_t)lds + ldsw));
    const int aoff = lds_byte(wr * 64 + fr, fq * 8), boff = lds_byte(wc * 32 + fr, fq * 8);
#define PG8_SA(b, h) (((b) * 2 + (h)) * HTB)
#define PG8_SB(b, h) ((4 + (b) * 2 + (h)) * HTB)
#define PG8_STAGE(bufoff, gbase, voff) do { _Pragma("unroll") for (int _i = 0; _i < 2; ++_i) { unsigned _keep; \
        asm volatile("s_mov_b32 %0, m0\n\ts_mov_b32 m0, %3\n\ts_nop 0\n\tglobal_load_lds_dwordx4 %1, %2\n\ts_mov_b32 m0, %0" : "=&s"(_keep) : "v"((voff)[_i]), "s"((const char*)(gbase)), "s"(ldsb + (unsigned)((bufoff) + _i * 8192)) : "memory"); } } while (0)
#define PG8_LDA(dst, b, h) do { _Pragma("unroll") for (int m = 0; m < 4; ++m) { const v4i_t _lo = *(const PG8_LAS v4i_t*)(lds + PG8_SA(b, h) + aoff + m * 2048), _hi = *(const PG8_LAS v4i_t*)(lds + PG8_SA(b, h) + aoff + m * 2048 + 1024); dst[m] = __builtin_shufflevector(_lo, _hi, 0, 1, 2, 3, 4, 5, 6, 7); } } while (0)
#define PG8_LDB(dst, b, h) do { _Pragma("unroll") for (int n = 0; n < 2; ++n) { const v4i_t _lo = *(const PG8_LAS v4i_t*)(lds + PG8_SB(b, h) + boff + n * 2048), _hi = *(const PG8_LAS v4i_t*)(lds + PG8_SB(b, h) + boff + n * 2048 + 1024); dst[n] = __builtin_shufflevector(_lo, _hi, 0, 1, 2, 3, 4, 5, 6, 7); } } while (0)
#define PG8_MMA(ai, bj, At, Bt) do { __builtin_amdgcn_s_setprio(1); _Pragma("unroll") for (int m = 0; m < 4; ++m) _Pragma("unroll") for (int n = 0; n < 2; ++n) \
        acc[ai][bj][m][n] = __builtin_amdgcn_mfma_scale_f32_16x16x128_f8f6f4(Bt[n], At[m], acc[ai][bj][m][n], 0, 0, 0, 0x79797979, 0, 0x7f7f7f7f); __builtin_amdgcn_s_setprio(0); } while (0)
#define PG8_WAIT_V(n) asm volatile("s_waitcnt vmcnt(" #n ")" ::: "memory")
#define PG8_WAIT_L(n) asm volatile("s_waitcnt lgkmcnt(" #n ")" ::: "memory")
#define PG8_BAR __builtin_amdgcn_s_barrier()
#define PG8_SCHED __builtin_amdgcn_sched_barrier(0)
    Unit cur, nxt; int ui = 0;
    if (!S.next(0, cur)) return;
    f32x4 acc[2][2][4][2];
#pragma unroll
    for (int a = 0; a < 2; ++a)
#pragma unroll
        for (int b = 0; b < 2; ++b)
#pragma unroll
            for (int m = 0; m < 4; ++m)
#pragma unroll
                for (int n = 0; n < 2; ++n) acc[a][b][m][n] = (f32x4){0.f, 0.f, 0.f, 0.f};
    v8i_t At[4], B0[2], B1[2];
    const char* cA = uni_ptr((const char*)g.A + (size_t)cur.pm * tstep); const char* cB = uni_ptr((const char*)g.Bt + (size_t)cur.pb * tstep);
    PG8_STAGE(PG8_SB(0, 0), cB, voffB); PG8_STAGE(PG8_SB(0, 1), cB + hstep, voffB); PG8_STAGE(PG8_SA(0, 0), cA, voffA); PG8_STAGE(PG8_SA(0, 1), cA + hstep, voffA);
    if (wr == 1) PG8_BAR;
    PG8_WAIT_V(2); PG8_BAR;
    PG8_STAGE(PG8_SB(1, 0), cB + kstep, voffB); PG8_STAGE(PG8_SA(1, 0), cA + kstep, voffA); PG8_STAGE(PG8_SB(1, 1), cB + hstep + kstep, voffB);
    PG8_WAIT_V(6); PG8_BAR;
    for (;;) {
        const bool has_next = S.next(ui + 1, nxt);
        const char* nA = uni_ptr(has_next ? (const char*)g.A + (size_t)nxt.pm * tstep : cA); const char* nB = uni_ptr(has_next ? (const char*)g.Bt + (size_t)nxt.pb * tstep : cB);
        for (int t = 0; t < nt; t += 2) {
            const bool last = (t == nt - 2);
            const char* a1 = cA + (size_t)(t + 1) * kstep;
            const char* a2 = last ? nA : cA + (size_t)(t + 2) * kstep; const char* b2 = last ? nB : cB + (size_t)(t + 2) * kstep;
            const char* a3 = a2 + kstep; const char* b3 = b2 + kstep;
            if constexpr (Epi::MIDT >= 0) { if (t == Epi::MIDT) E.mid(acc, cur, wr, fr); }
            PG8_LDB(B0, 0, 0); PG8_LDB(B1, 0, 1); PG8_SCHED; PG8_LDA(At, 0, 0); PG8_STAGE(PG8_SA(1, 1), a1 + hstep, voffA);
            PG8_WAIT_V(8); PG8_WAIT_L(0); PG8_BAR; PG8_MMA(0, 0, At, B0); PG8_MMA(0, 1, At, B1); PG8_BAR; PG8_SCHED;
            PG8_LDA(At, 0, 1); PG8_STAGE(PG8_SB(0, 0), b2, voffB); PG8_STAGE(PG8_SB(0, 1), b2 + hstep, voffB); PG8_STAGE(PG8_SA(0, 0), a2, voffA);
            PG8_WAIT_V(8); PG8_WAIT_L(0); PG8_BAR; PG8_MMA(1, 0, At, B0); PG8_MMA(1, 1, At, B1); PG8_BAR; PG8_SCHED;
            PG8_LDB(B0, 1, 0); PG8_LDB(B1, 1, 1); PG8_SCHED; PG8_LDA(At, 1, 0); PG8_STAGE(PG8_SA(0, 1), a2 + hstep, voffA);
            PG8_WAIT_V(8); PG8_WAIT_L(0); PG8_BAR; PG8_MMA(0, 0, At, B0); PG8_MMA(0, 1, At, B1); PG8_BAR; PG8_SCHED;
            PG8_LDA(At, 1, 1); PG8_STAGE(PG8_SB(1, 0), b3, voffB); PG8_STAGE(PG8_SB(1, 1), b3 + hstep, voffB); PG8_STAGE(PG8_SA(1, 0), a3, voffA);
            PG8_WAIT_V(8); PG8_WAIT_L(0); PG8_BAR; PG8_MMA(1, 0, At, B0); PG8_MMA(1, 1, At, B1); PG8_BAR; PG8_SCHED;
        }
        if (wr == 0) PG8_BAR;
        E(acc, cur, wr, wc, fr, fq);
        if (!has_next) break;
#pragma unroll
        for (int a = 0; a < 2; ++a)
#pragma unroll
            for (int b = 0; b < 2; ++b)
#pragma unroll
                for (int m = 0; m < 4; ++m)
#pragma unroll
                    for (int n = 0; n < 2; ++n) acc[a][b][m][n] = (f32x4){0.f, 0.f, 0.f, 0.f};
        cur = nxt; cA = nA; cB = nB; ++ui;
        if (wr == 1) PG8_BAR;
    }
    PG8_WAIT_V(0);
    PG8_BAR;
#undef PG8_SA
#undef PG8_SB
#undef PG8_STAGE
#undef PG8_LDA
#undef PG8_LDB
#undef PG8_MMA
#undef PG8_WAIT_V
#undef PG8_WAIT_L
#undef PG8_BAR
#undef PG8_SCHED
}
}

constexpr int BATCH = 16, SEQ = 2048, T = BATCH * SEQ, D = 1024;
constexpr int NPROJ = 6656;
constexpr int C_Z = 0, C_XBC = 1024, C_Q = 2560, C_K = 3584, C_V = 4608, C_O = 5632;
constexpr int WIN_LD = 6688;
constexpr int NE = 32, TOPK = 4;
constexpr int NASSIGN = T * TOPK, MAXBLK = NASSIGN / 256 + NE, MAXROWS = MAXBLK * 256;
constexpr float RMS_EPS = 1e-6f;
constexpr int NWAVES = 8, NTHR = 512;

constexpr size_t MiB = 1u << 20;
constexpr size_t WS_CTL = 0, CTL_ZERO_BYTES = 1 * MiB;
constexpr size_t WS_WIN = 1 * MiB, WS_WOUT = 14 * MiB, WS_WGU = 18 * MiB, WS_WDN = 146 * MiB;
constexpr size_t WS_XN = 210 * MiB, WS_H = 274 * MiB, WS_GATES = 402 * MiB, WS_ROUTE = 406 * MiB, WS_PROJ = 412 * MiB, WS_MIX = 828 * MiB, WS_END = 956 * MiB;
constexpr size_t WS_XBC = WS_H;
constexpr size_t WS_SSQ = WS_ROUTE + 3 * MiB;
constexpr size_t WS_XG = WS_PROJ, WS_ACT = WS_PROJ + 272 * MiB;
static_assert((size_t)MAXROWS * 1024 * 2 == 272 * MiB && WS_ACT + 272 * MiB == WS_END, "overlay map");
constexpr size_t R_TOPI = 0, R_TOPG = 512 * 1024, R_TOKROW = 1024 * 1024, R_ROWTOK = 1536 * 1024, R_ROWGATE = 2176 * 1024, R_BLKCNT = 2816 * 1024, R_BLKEXP = 2880 * 1024, R_NBLK = 2944 * 1024;
constexpr int CW_BAR = 4096;

constexpr int WL_LD = 36;
constexpr int WL_BYTES = 1024 * WL_LD * 4;
constexpr int MISC_OFF = 150528, LDS_BYTES = MISC_OFF + 1024;

#define GAS __attribute__((address_space(1)))
#define LAS __attribute__((address_space(3)))
typedef unsigned short bf16;
typedef unsigned v4u __attribute__((ext_vector_type(4)));
typedef unsigned v2u __attribute__((ext_vector_type(2)));
typedef float f32x4 __attribute__((ext_vector_type(4)));
#define LDS_WAIT() asm volatile("s_waitcnt lgkmcnt(0)" ::: "memory")
__device__ __forceinline__ unsigned f2bf(float f) { return (unsigned)__builtin_bit_cast(unsigned short, (__bf16)f); }
typedef __bf16 bf2_t __attribute__((ext_vector_type(2)));
__device__ __forceinline__ unsigned pk2(float lo, float hi) { const bf2_t v = {(__bf16)lo, (__bf16)hi}; return __builtin_bit_cast(unsigned, v); }
__device__ __forceinline__ float bf2f(unsigned short b) { return __builtin_bit_cast(float, (unsigned)b << 16); }
__device__ __forceinline__ float bflo(unsigned w) { return __builtin_bit_cast(float, w << 16); }
__device__ __forceinline__ float bfhi(unsigned w) { return __builtin_bit_cast(float, w & 0xffff0000u); }
__device__ __forceinline__ float wave_sum(float v) {
#pragma unroll
    for (int o = 1; o < 64; o <<= 1) v += __shfl_xor(v, o);
    return v;
}
__device__ __forceinline__ float silu_f(float x) { return x * __builtin_amdgcn_rcpf(1.0f + __expf(-x)); }
__device__ __forceinline__ float sigmoid_f(float x) { return __builtin_amdgcn_rcpf(1.0f + __expf(-x)); }
__device__ __forceinline__ float rsqrt_f(float x) { return __builtin_amdgcn_rsqf(x); }
__device__ __forceinline__ float softplus_f(float x) { return x > 20.0f ? x : log1pf(__expf(x)); }


#define XB_TMO      128
#define XB_XCNT(j)  (256  + 64 * (j))
#define XB_XSUB(j)  (1280 + 64 * (j))
#define XB_XGEN(j)  (2304 + 64 * (j))
#define XB_TOP      3328
#define XB_TOPGEN   3392
#define XCD_BAR_WORDS 3456
#define XB_SPIN_CAP (1u << 18)
__device__ __forceinline__ unsigned xb_ld(unsigned* p)              { return __hip_atomic_load(p, __ATOMIC_RELAXED, __HIP_MEMORY_SCOPE_AGENT); }
__device__ __forceinline__ unsigned xb_add(unsigned* p, unsigned v) { return __hip_atomic_fetch_add(p, v, __ATOMIC_RELAXED, __HIP_MEMORY_SCOPE_AGENT); }
__device__ __forceinline__ unsigned xb_xcc_id() { return (unsigned)__builtin_amdgcn_s_getreg((3 << 11) | 20) & 0xFu; }
#define XB_SPIN(cond, bar) do { unsigned _sp = 0; while (cond) { __builtin_amdgcn_s_sleep(1); \
    if ((++_sp & 255u) == 0u) { if (xb_ld(&(bar)[XB_TMO])) break; if (_sp > XB_SPIN_CAP) { atomicAdd(&(bar)[XB_TMO], 1u); break; } } } } while (0)
struct XcdBarrier { unsigned* bar; unsigned x; volatile LAS unsigned* st; };
__device__ __forceinline__ XcdBarrier xcd_barrier_post(unsigned* bar, volatile LAS unsigned* st, bool t0  ) {
    XcdBarrier b; b.bar = bar; b.x = xb_xcc_id(); b.st = st;
    if (t0) (void)xb_add(&bar[XB_XCNT(b.x)], 1u);
    return b;
}
__device__ __forceinline__ void xcd_barrier_complete(unsigned* bar, unsigned x, unsigned& nloc, unsigned& nx) {
    const unsigned G = gridDim.x * gridDim.y * gridDim.z;
    unsigned sum, cnt, mine, sp = 0u;
    for (;;) {
        sum = 0u; cnt = 0u; mine = 0u;
#pragma unroll
        for (unsigned j = 0; j < 16; ++j) { const unsigned c = xb_ld(&bar[XB_XCNT(j)]); sum += c; cnt += (c > 0u) ? 1u : 0u; mine = (j == x) ? c : mine; }
        if (sum == G) break;
        __builtin_amdgcn_s_sleep(1);
        if ((++sp & 255u) == 0u) { if (xb_ld(&bar[XB_TMO])) break; if (sp > XB_SPIN_CAP) { atomicAdd(&bar[XB_TMO], 1u); break; } }
    }
    nloc = mine > 0u ? mine : 1u; nx = cnt > 0u ? cnt : 1u;
}
__device__ __forceinline__ void xcd_barrier(const XcdBarrier& b, bool t0  ) {
    asm volatile("s_waitcnt vmcnt(0)" ::: "memory");
    __syncthreads();
    if (t0) {
        unsigned* bar = b.bar;
        __builtin_amdgcn_s_waitcnt(0);
        unsigned nloc = b.st[0], nx = b.st[1];
        if (nloc == 0u) { xcd_barrier_complete(bar, b.x, nloc, nx); b.st[0] = nloc; b.st[1] = nx; }
        const unsigned old = xb_add(&bar[XB_XSUB(b.x)], 1u);
        const unsigned gen = old / nloc;
        if (old + 1u == (gen + 1u) * nloc) {
            __builtin_amdgcn_fence(__ATOMIC_RELEASE, "agent");
            asm volatile("s_waitcnt vmcnt(0)" ::: "memory");
            const unsigned og = xb_add(&bar[XB_TOP], 1u);
            const unsigned tg = og / nx;
            if (og + 1u == (tg + 1u) * nx) xb_add(&bar[XB_TOPGEN], 1u);
            else XB_SPIN(xb_ld(&bar[XB_TOPGEN]) == tg, bar);
            __builtin_amdgcn_fence(__ATOMIC_ACQUIRE, "agent");
            xb_add(&bar[XB_XGEN(b.x)], 1u);
            asm volatile("s_waitcnt vmcnt(0)" ::: "memory");
        } else {
            XB_SPIN(xb_ld(&bar[XB_XGEN(b.x)]) == gen, bar);
            __builtin_amdgcn_fence(__ATOMIC_ACQUIRE, "agent");
            asm volatile("s_waitcnt vmcnt(0)" ::: "memory");
        }
    }
    __syncthreads();
}

__device__ __forceinline__ int fresh_tid(int wave) { int t = wave * 64 + lane_id(); asm volatile("" : "+v"(t)); return t; }
struct Args { const float* in[21]; float* out; unsigned char* ws; int ph_lo, ph_hi, variant, pad; };

__device__ __forceinline__ void transpose_item(const float* W, int ld_src, int n0s, int k0, bf16* WT, int K, int n0d, float cscale, const float* kscale, LAS float* scr, int lane) {
#pragma unroll 8
    for (int i = 0; i < 32; ++i) { const int kk = 2 * i + (lane >> 5); float v = W[(size_t)(k0 + kk) * ld_src + n0s + (lane & 31)] * cscale; if (kscale) v *= kscale[k0 + kk]; scr[kk * 33 + (lane & 31)] = v; }
    LDS_WAIT(); asm volatile("" ::: "memory");
    const int c = lane & 7;
#pragma unroll
    for (int j = 0; j < 4; ++j) { const int n = (lane >> 3) + 8 * j; const LAS float* s = scr + (8 * c) * 33 + n;
        v4u o; o.x = pk2(s[0 * 33], s[1 * 33]); o.y = pk2(s[2 * 33], s[3 * 33]); o.z = pk2(s[4 * 33], s[5 * 33]); o.w = pk2(s[6 * 33], s[7 * 33]);
        *(v4u*)(WT + (size_t)(n0d + n) * K + k0 + 8 * c) = o; }
    LDS_WAIT(); asm volatile("" ::: "memory");
}

__device__ __forceinline__ int pk4_fp8(float a, float b, float c, float d) { int w = 0; w = __builtin_amdgcn_cvt_pk_fp8_f32(a, b, w, false); w = __builtin_amdgcn_cvt_pk_fp8_f32(c, d, w, true); return w; }
__device__ __forceinline__ void transpose_item_f8(const float* W, int ld_src, int n0s, int k0, unsigned char* WT, int K, int n0d, float cscale, LAS float* scr, int lane) {
#pragma unroll 8
    for (int i = 0; i < 32; ++i) { const int kk = 2 * i + (lane >> 5); scr[kk * 33 + (lane & 31)] = W[(size_t)(k0 + kk) * ld_src + n0s + (lane & 31)] * cscale; }
    LDS_WAIT(); asm volatile("" ::: "memory");
    const int c = lane & 3;
#pragma unroll
    for (int j = 0; j < 2; ++j) { const int n = (lane >> 2) + 16 * j; const LAS float* s = scr + (16 * c) * 33 + n;
        v4u o; o.x = (unsigned)pk4_fp8(s[0 * 33], s[1 * 33], s[2 * 33], s[3 * 33]); o.y = (unsigned)pk4_fp8(s[4 * 33], s[5 * 33], s[6 * 33], s[7 * 33]);
        o.z = (unsigned)pk4_fp8(s[8 * 33], s[9 * 33], s[10 * 33], s[11 * 33]); o.w = (unsigned)pk4_fp8(s[12 * 33], s[13 * 33], s[14 * 33], s[15 * 33]);
        *(v4u*)(WT + (size_t)(n0d + n) * K + k0 + 16 * c) = o; }
    LDS_WAIT(); asm volatile("" ::: "memory");
}

template <int R, bool OUT_F8>
__device__ __forceinline__ void rownorm_proj(const float* src, const f32x4 (&wn)[4], const LAS float* Wl, void* dst, int lane, float (&res)[R]) {
    float xv[R][16];
#pragma unroll
    for (int r = 0; r < R; ++r) {
        float ss = 0.f; f32x4 v[4];
#pragma unroll
        for (int j = 0; j < 4; ++j) { v[j] = *(const f32x4*)(src + (size_t)r * 1024 + 4 * lane + 256 * j); ss += (v[j][0] * v[j][0] + v[j][1] * v[j][1]) + (v[j][2] * v[j][2] + v[j][3] * v[j][3]); }
        ss = wave_sum(ss);
        const float rs = 1.0f / sqrtf(ss * (1.0f / 1024.0f) + RMS_EPS);
#pragma unroll
        for (int j = 0; j < 4; ++j) { v[j] = v[j] * rs * wn[j];
#pragma unroll
            for (int i = 0; i < 4; ++i) xv[r][4 * j + i] = v[j][i];
            if constexpr (OUT_F8) *(int*)((unsigned char*)dst + (size_t)r * 1024 + 4 * lane + 256 * j) = pk4_fp8(v[j][0], v[j][1], v[j][2], v[j][3]);
            else { v2u w; w.x = pk2(v[j][0], v[j][1]); w.y = pk2(v[j][2], v[j][3]); *(v2u*)((bf16*)dst + (size_t)r * 1024 + 4 * lane + 256 * j) = w; } }
    }
    float acc[R][32];
#pragma unroll
    for (int r = 0; r < R; ++r)
#pragma unroll
        for (int c = 0; c < 32; ++c) acc[r][c] = 0.f;
#pragma unroll
    for (int j = 0; j < 16; ++j) {
        const LAS float* wrow = Wl + (lane + 64 * j) * WL_LD; asm volatile("" ::: "memory");
#pragma unroll
        for (int c4 = 0; c4 < 8; ++c4) { const f32x4 w = *(const LAS f32x4*)(wrow + 4 * c4);
#pragma unroll
            for (int r = 0; r < R; ++r) { acc[r][4 * c4 + 0] += xv[r][j] * w[0]; acc[r][4 * c4 + 1] += xv[r][j] * w[1]; acc[r][4 * c4 + 2] += xv[r][j] * w[2]; acc[r][4 * c4 + 3] += xv[r][j] * w[3]; } }
    }
#pragma unroll
    for (int r = 0; r < R; ++r) {
#pragma unroll
        for (int i = 0; i < 16; ++i) { const bool up = lane & 16; const float keep = up ? acc[r][i + 16] : acc[r][i], send = up ? acc[r][i] : acc[r][i + 16]; acc[r][i] = keep + __shfl_xor(send, 16); }
#pragma unroll
        for (int i = 0; i < 8; ++i) { const bool up = lane & 8; const float keep = up ? acc[r][i + 8] : acc[r][i], send = up ? acc[r][i] : acc[r][i + 8]; acc[r][i] = keep + __shfl_xor(send, 8); }
#pragma unroll
        for (int i = 0; i < 4; ++i) { const bool up = lane & 4; const float keep = up ? acc[r][i + 4] : acc[r][i], send = up ? acc[r][i] : acc[r][i + 4]; acc[r][i] = keep + __shfl_xor(send, 4); }
#pragma unroll
        for (int i = 0; i < 2; ++i) { const bool up = lane & 2; const float keep = up ? acc[r][i + 2] : acc[r][i], send = up ? acc[r][i] : acc[r][i + 2]; acc[r][i] = keep + __shfl_xor(send, 2); }
        { const bool up = lane & 1; const float keep = up ? acc[r][1] : acc[r][0], send = up ? acc[r][0] : acc[r][1]; acc[r][0] = keep + __shfl_xor(send, 1); }
        res[r] = acc[r][0] + __shfl_xor(acc[r][0], 32);
    }
}

namespace mx {
typedef short s8v __attribute__((ext_vector_type(8)));
typedef short s4v __attribute__((ext_vector_type(4)));
#define MX_MFMA(a, b, c) __builtin_amdgcn_mfma_f32_16x16x32_bf16(a, b, c, 0, 0, 0)
#define MX_SB() __builtin_amdgcn_sched_barrier(0)
#define MX_BAR() do { MX_SB(); asm volatile("s_waitcnt lgkmcnt(0)" ::: "memory"); __builtin_amdgcn_s_barrier(); asm volatile("" ::: "memory"); } while (0)
constexpr int TS = 288, TILE = 64 * TS, PS = 144, PTILE = 64 * PS, BUF = 3 * TILE;
struct LaneBase { unsigned row, perm, tr, prow; };
__device__ __forceinline__ LaneBase lane_base(int lane) { LaneBase L; const unsigned g = lane >> 4, i = lane & 15, q = i >> 2, p = lane & 3;
    L.row = i * TS + g * 16; L.perm = i * TS + g * 8; L.tr = (8 * g + q) * TS + p * 8; L.prow = i * PS + g * 16; return L; }
#define LD_ROW(t, L, rb, s) (*(const LAS mx::s8v*)((t) + (L).row + (rb) * 16 * mx::TS + (s) * 64))
#define LD_ROWP(t, L, rb, s) (*(const LAS mx::s8v*)((t) + (L).prow + (rb) * 16 * mx::PS + (s) * 64))
__device__ __forceinline__ s8v ld_perm2(const LAS unsigned char* p) { const s4v lo = *(const LAS s4v*)p, hi = *(const LAS s4v*)(p + 32); return (s8v){lo[0], lo[1], lo[2], lo[3], hi[0], hi[1], hi[2], hi[3]}; }
#define LD_PERM(t, L, rb, s) mx::ld_perm2((t) + (L).perm + (rb) * 16 * mx::TS + (s) * 64)
__device__ __forceinline__ s8v ld_tr2(const LAS unsigned char* p) {
    const s4v a = __builtin_amdgcn_ds_read_tr16_b64_v4i16((LAS s4v*)p), b = __builtin_amdgcn_ds_read_tr16_b64_v4i16((LAS s4v*)(p + 4 * TS));
    return (s8v){a[0], a[1], a[2], a[3], b[0], b[1], b[2], b[3]}; }
#define LD_TR(t, L, c, ks) mx::ld_tr2((t) + (L).tr + (ks) * 32 * mx::TS + (c) * 32)
struct DmaOff { unsigned o[7]; };
__device__ __forceinline__ DmaOff dma_offsets(int gstride, int co0, int co1, int co2, int wave, int lane) { DmaOff D;
#pragma unroll
    for (int pp = 0; pp < 7; ++pp) { const int piece = wave + 8 * pp; const unsigned o = piece * 1024 + lane * 16, tl = o / TILE, ot = o - tl * TILE, row = ot / TS, wb = ot - row * TS;
        const int co = tl == 0 ? co0 : (tl == 1 ? co1 : co2); D.o[pp] = piece < 54 ? (unsigned)((row * gstride + co + (wb < 256 ? wb >> 1 : 0)) * 2) : 0u; }
    return D; }
__device__ __forceinline__ void dma_issue(LAS unsigned char* buf, const bf16* gbase, const DmaOff& D, int wave) {
    const unsigned lb = (unsigned)(size_t)buf;
#pragma unroll
    for (int pp = 0; pp < 7; ++pp) { const int piece = wave + 8 * pp; if (piece < 54) { unsigned keep;
        asm volatile("s_mov_b32 %0, m0\n\ts_mov_b32 m0, %3\n\ts_nop 0\n\tglobal_load_lds_dwordx4 %1, %2\n\ts_mov_b32 m0, %0" : "=&s"(keep) : "v"(D.o[pp]), "s"(gbase), "s"(lb + (unsigned)piece * 1024u) : "memory"); } }
}
#define MX_DPPF(old, src, ctrl, rm) __builtin_bit_cast(float, __builtin_amdgcn_update_dpp(__builtin_bit_cast(int, (float)(old)), __builtin_bit_cast(int, (float)(src)), ctrl, rm, 0xf, false))
__device__ __forceinline__ float scan_add(float x) {
    x += MX_DPPF(0.f, x, 0x111, 0xf); x += MX_DPPF(0.f, x, 0x112, 0xf); x += MX_DPPF(0.f, x, 0x114, 0xf); x += MX_DPPF(0.f, x, 0x118, 0xf);
    x += MX_DPPF(0.f, x, 0x142, 0xa); x += MX_DPPF(0.f, x, 0x143, 0xc); return x; }
__device__ __forceinline__ float scan_max(float x) { const float ninf = -INFINITY;
    x = fmaxf(x, MX_DPPF(ninf, x, 0x111, 0xf)); x = fmaxf(x, MX_DPPF(ninf, x, 0x112, 0xf)); x = fmaxf(x, MX_DPPF(ninf, x, 0x114, 0xf)); x = fmaxf(x, MX_DPPF(ninf, x, 0x118, 0xf));
    x = fmaxf(x, MX_DPPF(ninf, x, 0x142, 0xa)); x = fmaxf(x, MX_DPPF(ninf, x, 0x143, 0xc)); return x; }
__device__ __forceinline__ float lane63(float x) { return __builtin_bit_cast(float, __builtin_amdgcn_readlane(__builtin_bit_cast(int, x), 63)); }
__device__ __forceinline__ float softplus_fast(float x) { return fmaxf(x, 0.f) + __logf(1.0f + __expf(-fabsf(x))); }
__device__ __forceinline__ s8v pack_acc(const f32x4& a, const f32x4& b) {
    const unsigned w0 = pk2(a[0], a[1]), w1 = pk2(a[2], a[3]), w2 = pk2(b[0], b[1]), w3 = pk2(b[2], b[3]);
    v4u w = {w0, w1, w2, w3}; return __builtin_bit_cast(s8v, w);
}
__device__ __forceinline__ void unpack8(const v4u& w, float (&f)[8]) { f[0] = bflo(w.x); f[1] = bfhi(w.x); f[2] = bflo(w.y); f[3] = bfhi(w.y); f[4] = bflo(w.z); f[5] = bfhi(w.z); f[6] = bflo(w.w); f[7] = bfhi(w.w); }

__device__ __forceinline__ void mlstm_item(LAS unsigned char* lds, int item, int var, int wave, const bf16* __restrict__ PROJ, const float* __restrict__ GATES, const float* __restrict__ lnw, bf16* __restrict__ MIX) {
    const int lane = lane_id(), tid = wave * 64 + lane, g = lane >> 4, c16 = lane & 15;
    const int b = item >> 3, h = item & 7;
    const LaneBase L = lane_base(lane);
    LAS unsigned char* TP = lds + 2 * BUF; LAS unsigned char* TO = TP + PTILE;
    LAS float* denP = (LAS float*)(TO + TILE); LAS float* qnp = denP + 128; LAS float* nsh = qnp + 512;
    LAS float* Au = nsh + 128; LAS float* Avv = Au + 64; LAS float* Awi = Avv + 64; LAS float* Akw = Awi + 64; LAS float* Aid = Akw + 64;
    f32x4 Cst[8];
#pragma unroll
    for (int i = 0; i < 8; ++i) Cst[i] = (f32x4){0.f, 0.f, 0.f, 0.f};
    float nreg = 0.f, m_prev = 0.f;
    if (lane < 16) nsh[wave * 16 + lane] = 0.f;
    const int srow = tid >> 3, sch = tid & 7;
    const bf16* qbase = PROJ + (size_t)(b * SEQ) * NPROJ + h * 128;
    const DmaOff DO = dma_offsets(NPROJ, C_Q, C_K, C_V, wave, lane);
    dma_issue(lds, qbase, DO, wave);
    float fnext = GATES[(size_t)(b * SEQ + lane) * 32 + 24 + h], inext = GATES[(size_t)(b * SEQ + lane) * 32 + 16 + h];
    asm volatile("s_waitcnt vmcnt(0)" ::: "memory"); MX_BAR();
#pragma unroll 1
    for (int c = 0; c < SEQ / 64; ++c) {
        const int cur = c & 1; const int t0 = b * SEQ + c * 64;
        LAS unsigned char* TQ = lds + cur * BUF; LAS unsigned char* TK = TQ + TILE; LAS unsigned char* TV = TQ + 2 * TILE;
        float fraw = fnext, iraw = inext; asm volatile("" : "+v"(fraw), "+v"(iraw));
        MX_SB();
        const v4u ov0 = *(const v4u*)(PROJ + (size_t)(t0 + srow) * NPROJ + C_O + h * 128 + 8 * sch), ov1 = *(const v4u*)(PROJ + (size_t)(t0 + srow) * NPROJ + C_O + h * 128 + 64 + 8 * sch);
        { const int tn = (c + 1 < SEQ / 64 ? t0 + 64 : t0) + lane; fnext = GATES[(size_t)tn * 32 + 24 + h]; inext = GATES[(size_t)tn * 32 + 16 + h]; }
        if (c + 1 < SEQ / 64 && !(var & 1)) dma_issue(lds + (cur ^ 1) * BUF, qbase + (size_t)(c + 1) * 64 * NPROJ, DO, wave);
        MX_SB();
        const float lf = -softplus_fast(-fraw), cf = scan_add(lf), chunk_f = lane63(cf);
        const float u = iraw - cf, Mx = scan_max(u);
        const float m_row = cf + fmaxf(m_prev, Mx), vv = cf - m_row;
        const float m_loc = chunk_f + lane63(Mx), m_new = fmaxf(chunk_f + m_prev, m_loc);
        const float w_inter = __expf(vv + m_prev), floorv = __expf(-m_row), kw = __expf(chunk_f + u - m_new), s_old = __expf(chunk_f + m_prev - m_new);
        Au[lane] = u; Avv[lane] = vv; Awi[lane] = w_inter; Akw[lane] = kw;
        if (!(var & 2)) { const int lt = wave & 3, jt0 = 2 * (wave >> 2); const float vv_l = Avv[16 * lt + c16]; float rsum = 0.f;
#pragma unroll
          for (int jj = 0; jj < 2; ++jj) { const int jt = jt0 + jj; float pv[4] = {0.f, 0.f, 0.f, 0.f};
            if (jt <= lt) { f32x4 acc = {0.f, 0.f, 0.f, 0.f};
#pragma unroll
                for (int ks = 0; ks < 4; ++ks) acc = MX_MFMA(LD_ROW(TK, L, jt, ks), LD_ROW(TQ, L, lt, ks), acc);
                const f32x4 uj = *(const LAS f32x4*)(Au + 16 * jt + 4 * g);
#pragma unroll
                for (int r = 0; r < 4; ++r) { const int j = 16 * jt + 4 * g + r, l = 16 * lt + c16; const float val = (j <= l) ? acc[r] * __expf(vv_l + uj[r]) : 0.f; rsum += val; pv[r] = val; } }
            v2u w; w.x = pk2(pv[0], pv[1]); w.y = pk2(pv[2], pv[3]);
            *(LAS v2u*)(TP + (16 * lt + c16) * PS + (16 * jt + 4 * g) * 2) = w; }
          rsum += __shfl_xor(rsum, 16); rsum += __shfl_xor(rsum, 32);
          if (g == 0) denP[(wave >> 2) * 64 + 16 * lt + c16] = rsum;
          v4u q0 = *(const LAS v4u*)(TQ + lane * TS + wave * 32), q1 = *(const LAS v4u*)(TQ + lane * TS + wave * 32 + 16); float qf[16]; { float t8[8]; unpack8(q0, t8);
#pragma unroll
            for (int e = 0; e < 8; ++e) qf[e] = t8[e]; unpack8(q1, t8);
#pragma unroll
            for (int e = 0; e < 8; ++e) qf[8 + e] = t8[e]; }
          float part = 0.f;
#pragma unroll
          for (int e4 = 0; e4 < 4; ++e4) { const f32x4 nv = *(const LAS f32x4*)(nsh + wave * 16 + 4 * e4); part += qf[4 * e4] * nv[0] + qf[4 * e4 + 1] * nv[1] + qf[4 * e4 + 2] * nv[2] + qf[4 * e4 + 3] * nv[3]; }
          qnp[wave * 64 + lane] = part; }
        MX_BAR();
        float inv_den; { float qn = 0.f;
#pragma unroll
          for (int w = 0; w < 8; ++w) qn += qnp[w * 64 + lane];
          float den = denP[lane] + denP[64 + lane] + w_inter * qn; den = fmaxf(fabsf(den), floorv); inv_den = __builtin_amdgcn_rcpf(den); Aid[lane] = inv_den; }
        { s8v sf[4];
#pragma unroll
          for (int ks = 0; ks < 4; ++ks) sf[ks] = pack_acc(Cst[2 * ks], Cst[2 * ks + 1]);
          const s8v vf0 = LD_TR(TV + wave * 32, L, 0, 0), vf1 = LD_TR(TV + wave * 32, L, 0, 1);
          if (!(var & 4))
#pragma unroll
          for (int lt = 0; lt < 4; ++lt) { f32x4 acc = {0.f, 0.f, 0.f, 0.f};
#pragma unroll
            for (int ks = 0; ks < 4; ++ks) acc = MX_MFMA(sf[ks], LD_PERM(TQ, L, lt, ks), acc);
            acc = acc * Awi[16 * lt + c16];
            acc = MX_MFMA(vf0, LD_ROWP(TP, L, lt, 0), acc);
            if (lt >= 2) acc = MX_MFMA(vf1, LD_ROWP(TP, L, lt, 1), acc);
            acc = acc * Aid[16 * lt + c16];
            v2u w; w.x = pk2(acc[0], acc[1]); w.y = pk2(acc[2], acc[3]);
            *(LAS v2u*)(TO + (16 * lt + c16) * TS + (16 * wave + 4 * g) * 2) = w; }
#pragma unroll
          for (int i = 0; i < 8; ++i) Cst[i] = Cst[i] * s_old;
          if (!(var & 8))
#pragma unroll
          for (int ks = 0; ks < 2; ++ks) { const s8v vf = ks ? vf1 : vf0; const v4u vw = __builtin_bit_cast(v4u, vf); float f[8]; unpack8(vw, f);
            { const f32x4 k0 = *(const LAS f32x4*)(Akw + 32 * ks + 8 * g), k1 = *(const LAS f32x4*)(Akw + 32 * ks + 8 * g + 4);
#pragma unroll
              for (int e = 0; e < 4; ++e) { f[e] *= k0[e]; f[4 + e] *= k1[e]; } }
            v4u pw = {pk2(f[0], f[1]), pk2(f[2], f[3]), pk2(f[4], f[5]), pk2(f[6], f[7])}; const s8v vwf = __builtin_bit_cast(s8v, pw);
#pragma unroll
            for (int dkt = 0; dkt < 8; ++dkt) Cst[dkt] = MX_MFMA(LD_TR(TK, L, dkt, ks), vwf, Cst[dkt]); }
          float part = 0.f;
#pragma unroll
          for (int e4 = 0; e4 < 4; ++e4) { const f32x4 kk = *(const LAS f32x4*)(Akw + 16 * g + 4 * e4);
#pragma unroll
            for (int e = 0; e < 4; ++e) { const int j = 16 * g + 4 * e4 + e; part += bf2f(*(const LAS unsigned short*)(TK + j * TS + (16 * wave + c16) * 2)) * kk[e]; } }
          part += __shfl_xor(part, 16); part += __shfl_xor(part, 32);
          nreg = s_old * nreg + part; if (g == 0) nsh[wave * 16 + c16] = nreg;
          m_prev = m_new; }
        asm volatile("s_waitcnt vmcnt(0)" ::: "memory"); MX_BAR();
        if (!(var & 16)) { const v4u a = *(const LAS v4u*)(TO + srow * TS + sch * 16), bq = *(const LAS v4u*)(TO + srow * TS + sch * 16 + 128); float f[16], of[16]; { float t8[8]; unpack8(a, t8);
#pragma unroll
            for (int e = 0; e < 8; ++e) f[e] = t8[e]; unpack8(bq, t8);
#pragma unroll
            for (int e = 0; e < 8; ++e) f[8 + e] = t8[e]; unpack8(ov0, t8);
#pragma unroll
            for (int e = 0; e < 8; ++e) of[e] = t8[e]; unpack8(ov1, t8);
#pragma unroll
            for (int e = 0; e < 8; ++e) of[8 + e] = t8[e]; }
          float ss = 0.f;
#pragma unroll
          for (int e = 0; e < 16; ++e) ss += f[e] * f[e];
          ss += __shfl_xor(ss, 1); ss += __shfl_xor(ss, 2); ss += __shfl_xor(ss, 4);
          const float rs = rsqrt_f(ss * (1.0f / 128.0f) + RMS_EPS);
          float wn[16]; { const f32x4 w0 = *(const f32x4*)(lnw + h * 128 + 8 * sch), w1 = *(const f32x4*)(lnw + h * 128 + 8 * sch + 4), w2 = *(const f32x4*)(lnw + h * 128 + 64 + 8 * sch), w3 = *(const f32x4*)(lnw + h * 128 + 64 + 8 * sch + 4);
#pragma unroll
            for (int e = 0; e < 4; ++e) { wn[e] = w0[e]; wn[4 + e] = w1[e]; wn[8 + e] = w2[e]; wn[12 + e] = w3[e]; } }
#pragma unroll
          for (int e = 0; e < 16; ++e) f[e] = f[e] * rs * wn[e] * sigmoid_f(of[e]);
          v4u o0 = {pk2(f[0], f[1]), pk2(f[2], f[3]), pk2(f[4], f[5]), pk2(f[6], f[7])}, o1 = {pk2(f[8], f[9]), pk2(f[10], f[11]), pk2(f[12], f[13]), pk2(f[14], f[15])};
          bf16* mp = MIX + (size_t)(t0 + srow) * 2048 + 1024 + h * 128 + 8 * sch; *(v4u*)mp = o0; *(v4u*)(mp + 64) = o1; }
    }
    MX_BAR();
}

__device__ __forceinline__ void ssd_item(LAS unsigned char* lds, int item, int var, int wave, const bf16* __restrict__ XBC, const bf16* __restrict__ PROJ, const float* __restrict__ GATES, const float* __restrict__ a_log,
                                         const float* __restrict__ d_skip, bf16* __restrict__ MIX, float* __restrict__ SSQ) {
    const int lane = lane_id(), tid = wave * 64 + lane, g = lane >> 4, c16 = lane & 15;
    const int b = item >> 3, hp = item & 7, grp = hp >> 2, hh = wave >> 2, ps = wave & 3;
    const LaneBase L = lane_base(lane);
    LAS unsigned char* TG = lds + 2 * BUF;
    LAS unsigned char* TO = TG + 2 * PTILE;
    LAS float* Aacs = (LAS float*)(TO + TILE); LAS float* Adinv = Aacs + 128; LAS float* Adt = Adinv + 128; LAS float* Awd = Adt + 128; LAS float* Aea = Awd + 128;
    f32x4 RT[8];
#pragma unroll
    for (int i = 0; i < 8; ++i) RT[i] = (f32x4){0.f, 0.f, 0.f, 0.f};
    const float an0 = -__expf(a_log[2 * hp]), an1 = -__expf(a_log[2 * hp + 1]), dk0 = d_skip[2 * hp], dk1 = d_skip[2 * hp + 1];
    const int srow = tid >> 3, sch = tid & 7;
    const bf16* xb = XBC + (size_t)(b * SEQ) * 1536;
    const DmaOff DO = dma_offsets(1536, 1280 + grp * 128, 1024 + grp * 128, hp * 128, wave, lane);
    dma_issue(lds, xb, DO, wave);
    float dn0 = GATES[(size_t)(b * SEQ + lane) * 32 + 2 * hp], dn1 = GATES[(size_t)(b * SEQ + lane) * 32 + 2 * hp + 1];
    asm volatile("s_waitcnt vmcnt(0)" ::: "memory"); MX_BAR();
#pragma unroll 1
    for (int c = 0; c < SEQ / 64; ++c) {
        const int cur = c & 1; const int t0 = b * SEQ + c * 64;
        LAS unsigned char* TC = lds + cur * BUF; LAS unsigned char* TB = TC + TILE; LAS unsigned char* TX = TC + 2 * TILE;
        float dr0 = dn0, dr1 = dn1; asm volatile("" : "+v"(dr0), "+v"(dr1));
        MX_SB();
        const v4u zv0 = *(const v4u*)(PROJ + (size_t)(t0 + srow) * NPROJ + C_Z + hp * 128 + 8 * sch), zv1 = *(const v4u*)(PROJ + (size_t)(t0 + srow) * NPROJ + C_Z + hp * 128 + 64 + 8 * sch);
        { const int tn = (c + 1 < SEQ / 64 ? t0 + 64 : t0) + lane; dn0 = GATES[(size_t)tn * 32 + 2 * hp]; dn1 = GATES[(size_t)tn * 32 + 2 * hp + 1]; }
        if (c + 1 < SEQ / 64 && !(var & 1)) dma_issue(lds + (cur ^ 1) * BUF, xb + (size_t)(c + 1) * 64 * 1536, DO, wave);
        MX_SB();
        const float dt0 = softplus_fast(dr0), dt1 = softplus_fast(dr1);
        const float acs0 = scan_add(dt0 * an0), acs1 = scan_add(dt1 * an1);
        const float aend0 = lane63(acs0), aend1 = lane63(acs1);
        Aacs[lane] = acs0; Aacs[64 + lane] = acs1; Adinv[lane] = dk0 * __builtin_amdgcn_rcpf(dt0); Adinv[64 + lane] = dk1 * __builtin_amdgcn_rcpf(dt1); Adt[lane] = dt0; Adt[64 + lane] = dt1;
        Awd[lane] = __expf(aend0 - acs0); Awd[64 + lane] = __expf(aend1 - acs1); Aea[lane] = __expf(acs0); Aea[64 + lane] = __expf(acs1);
        const float aend = hh ? aend1 : aend0;
        if (!(var & 2)) { const int lt = wave & 3, st0 = 2 * (wave >> 2); const int l = 16 * lt + c16;
          const float al0 = Aacs[l], al1 = Aacs[64 + l], di0 = Adinv[l], di1 = Adinv[64 + l];
#pragma unroll
          for (int ss = 0; ss < 2; ++ss) { const int st = st0 + ss; float p0[4] = {0.f, 0.f, 0.f, 0.f}, p1[4] = {0.f, 0.f, 0.f, 0.f};
            if (st <= lt) { f32x4 acc = {0.f, 0.f, 0.f, 0.f};
#pragma unroll
                for (int ks = 0; ks < 4; ++ks) acc = MX_MFMA(LD_ROW(TB, L, st, ks), LD_ROW(TC, L, lt, ks), acc);
                const f32x4 as0 = *(const LAS f32x4*)(Aacs + 16 * st + 4 * g), as1 = *(const LAS f32x4*)(Aacs + 64 + 16 * st + 4 * g);
#pragma unroll
                for (int r = 0; r < 4; ++r) { const int sidx = 16 * st + 4 * g + r;
                    float v0 = (sidx <= l) ? acc[r] * __expf(al0 - as0[r]) : 0.f, v1 = (sidx <= l) ? acc[r] * __expf(al1 - as1[r]) : 0.f;
                    if (sidx == l) { v0 += di0; v1 += di1; } p0[r] = v0; p1[r] = v1; } }
            v2u w0, w1; w0.x = pk2(p0[0], p0[1]); w0.y = pk2(p0[2], p0[3]); w1.x = pk2(p1[0], p1[1]); w1.y = pk2(p1[2], p1[3]);
            const unsigned o = l * PS + (16 * st + 4 * g) * 2;
            *(LAS v2u*)(TG + o) = w0; *(LAS v2u*)(TG + PTILE + o) = w1; } }
        MX_BAR();
        { s8v sf[4];
#pragma unroll
          for (int ks = 0; ks < 4; ++ks) sf[ks] = pack_acc(RT[2 * ks], RT[2 * ks + 1]);
          s8v xd[2], xw[2];
#pragma unroll
          for (int ks = 0; ks < 2; ++ks) { const s8v xf = LD_TR(TX + (4 * hh + ps) * 32, L, 0, ks); const v4u xv = __builtin_bit_cast(v4u, xf); float f[8], fw[8]; unpack8(xv, f);
            { const LAS float* pd = Adt + 64 * hh + 32 * ks + 8 * g; const LAS float* pw = Awd + 64 * hh + 32 * ks + 8 * g; const f32x4 d0 = *(const LAS f32x4*)pd, d1 = *(const LAS f32x4*)(pd + 4), w0 = *(const LAS f32x4*)pw, w1 = *(const LAS f32x4*)(pw + 4);
#pragma unroll
              for (int e = 0; e < 4; ++e) { f[e] *= d0[e]; fw[e] = f[e] * w0[e]; f[4 + e] *= d1[e]; fw[4 + e] = f[4 + e] * w1[e]; } }
            v4u a = {pk2(f[0], f[1]), pk2(f[2], f[3]), pk2(f[4], f[5]), pk2(f[6], f[7])}, bw = {pk2(fw[0], fw[1]), pk2(fw[2], fw[3]), pk2(fw[4], fw[5]), pk2(fw[6], fw[7])};
            xd[ks] = __builtin_bit_cast(s8v, a); xw[ks] = __builtin_bit_cast(s8v, bw); }
          const LAS unsigned char* TGm = TG + hh * PTILE;
          if (!(var & 4))
#pragma unroll
          for (int lt = 0; lt < 4; ++lt) { f32x4 acc = {0.f, 0.f, 0.f, 0.f};
#pragma unroll
            for (int ks = 0; ks < 4; ++ks) acc = MX_MFMA(sf[ks], LD_PERM(TC, L, lt, ks), acc);
            acc = acc * Aea[64 * hh + 16 * lt + c16];
            acc = MX_MFMA(xd[0], LD_ROWP(TGm, L, lt, 0), acc);
            if (lt >= 2) acc = MX_MFMA(xd[1], LD_ROWP(TGm, L, lt, 1), acc);
            v2u w; w.x = pk2(acc[0], acc[1]); w.y = pk2(acc[2], acc[3]);
            *(LAS v2u*)(TO + (16 * lt + c16) * TS + (64 * hh + 16 * ps + 4 * g) * 2) = w; }
          const float ea = __expf(aend);
#pragma unroll
          for (int i = 0; i < 8; ++i) RT[i] = RT[i] * ea;
          if (!(var & 8))
#pragma unroll
          for (int ks = 0; ks < 2; ++ks)
#pragma unroll
            for (int nt = 0; nt < 8; ++nt) RT[nt] = MX_MFMA(LD_TR(TB, L, nt, ks), xw[ks], RT[nt]); }
        asm volatile("s_waitcnt vmcnt(0)" ::: "memory"); MX_BAR();
        if (!(var & 16)) { const v4u a = *(const LAS v4u*)(TO + srow * TS + sch * 16), bq = *(const LAS v4u*)(TO + srow * TS + sch * 16 + 128); float f[16], zf[16]; { float t8[8]; unpack8(a, t8);
#pragma unroll
            for (int e = 0; e < 8; ++e) f[e] = t8[e]; unpack8(bq, t8);
#pragma unroll
            for (int e = 0; e < 8; ++e) f[8 + e] = t8[e]; unpack8(zv0, t8);
#pragma unroll
            for (int e = 0; e < 8; ++e) zf[e] = t8[e]; unpack8(zv1, t8);
#pragma unroll
            for (int e = 0; e < 8; ++e) zf[8 + e] = t8[e]; }
          float ss = 0.f;
#pragma unroll
          for (int e = 0; e < 16; ++e) { f[e] = f[e] * silu_f(zf[e]); ss += f[e] * f[e]; }
          ss += __shfl_xor(ss, 1); ss += __shfl_xor(ss, 2); ss += __shfl_xor(ss, 4);
          if (sch == 0) SSQ[(size_t)(t0 + srow) * 8 + hp] = ss;
          v4u o0 = {pk2(f[0], f[1]), pk2(f[2], f[3]), pk2(f[4], f[5]), pk2(f[6], f[7])}, o1 = {pk2(f[8], f[9]), pk2(f[10], f[11]), pk2(f[12], f[13]), pk2(f[14], f[15])};
          bf16* mp = MIX + (size_t)(t0 + srow) * 2048 + hp * 128 + 8 * sch; *(v4u*)mp = o0; *(v4u*)(mp + 64) = o1; }
    }
    MX_BAR();
}
}

__device__ __forceinline__ int wl_k(int p) { return 4 * (p & 63) + 256 * (p >> 8) + ((p >> 6) & 3); }
constexpr int RN = 2;

__global__ void __launch_bounds__(NTHR, 2) mega(Args args) {
    extern __shared__ __attribute__((aligned(16))) unsigned char lds_raw[];
    LAS unsigned char* lds = (LAS unsigned char*)lds_raw;
    const int wave = __builtin_amdgcn_readfirstlane((int)threadIdx.x >> 6);
    const int lane = lane_id(), tid = wave * 64 + lane;
    const int G = gridDim.x, bx = blockIdx.x;
    unsigned char* ws = args.ws;
#define INP(k) ({ int _k = (k); asm volatile("" : "+s"(_k)); args.in[_k]; })
#define XIN INP(0)
#define Win_t ((bf16*)(ws + WS_WIN))
#define Wout_t ((bf16*)(ws + WS_WOUT))
#define XN ((bf16*)(ws + WS_XN))
#define H ((float*)(ws + WS_H))
#define GATES ((float*)(ws + WS_GATES))
#define PROJ ((bf16*)(ws + WS_PROJ))
#define MIX ((bf16*)(ws + WS_MIX))
#define EO ((bf16*)(ws + WS_XG))
#define TOPI ((int*)(ws + WS_ROUTE + R_TOPI))
#define TOPG ((float*)(ws + WS_ROUTE + R_TOPG))
#define TOKROW ((int*)(ws + WS_ROUTE + R_TOKROW))
#define ROWTOK ((int*)(ws + WS_ROUTE + R_ROWTOK))
#define ROWGATE ((float*)(ws + WS_ROUTE + R_ROWGATE))
#define BLKCNT ((int*)(ws + WS_ROUTE + R_BLKCNT))
#define BLKEXP ((int*)(ws + WS_ROUTE + R_BLKEXP))
#define NBLK ((int*)(ws + WS_ROUTE + R_NBLK))
#define XBC ((bf16*)(ws + WS_XBC))
#define SSQ ((float*)(ws + WS_SSQ))
#define XN8 (ws + WS_XN)
#define XG8 (ws + WS_XG)
#define ACT8 (ws + WS_ACT)
#define Wgu8 (ws + WS_WGU)
#define Wdn8 (ws + WS_WDN)
    const int lo = args.ph_lo, hi = args.ph_hi;
    if (tid < 64) ((LAS unsigned*)(lds + MISC_OFF))[tid] = 0u;
    __syncthreads();
    XcdBarrier bar = xcd_barrier_post((unsigned*)(ws + WS_CTL) + CW_BAR, (volatile LAS unsigned*)(lds + MISC_OFF), tid == 0);
#define GRID_BAR(k) do { if (IN(k) && IN((k) + 1)) xcd_barrier(bar, wave == 0 && lane_id() == 0); } while (0)
#ifndef PH_MASK
#define PH_MASK 0xffff
#endif
#define IN(k) (((PH_MASK >> (k)) & 1) && lo <= (k) && (k) < hi)


    if (IN(0)) {
        const int tid = fresh_tid(wave), lane = tid & 63; (void)lane;
        LAS float* scr = (LAS float*)(lds + wave * 16384);
        const int gw = bx * NWAVES + wave, NGW = G * NWAVES;
        constexpr int I_IN = 16 * (NPROJ / 32), I_OUT = 32 * 32, I_GU = 16 * 64, I_DN = 16 * 32;
        constexpr int NITEMS = I_IN + I_OUT + NE * I_GU + NE * I_DN;
        for (int it = gw; it < NITEMS; it += NGW) {
            int r = it;
            if (r < I_IN) { const int nb = r % (NPROJ / 32), kb = r / (NPROJ / 32), n0 = nb * 32; const int n0s = n0 + (n0 >= C_Q ? 16 : 0);
                const float cs = (n0 >= C_K && n0 < C_V) ? 0.08838834764831845f : 1.0f;
                transpose_item(INP(2), WIN_LD, n0s, kb * 64, Win_t, 1024, n0, cs, nullptr, scr, lane); continue; } r -= I_IN;
            if (r < I_OUT) { const int nb = r % 32, kb = r / 32; transpose_item(INP(12), 1024, nb * 32, kb * 64, Wout_t, 2048, nb * 32, 1.0f, kb < 16 ? INP(8) : nullptr, scr, lane); continue; } r -= I_OUT;
            if (r < NE * I_GU) { const int e = r / I_GU, q = r % I_GU, nb = q % 64, kb = q / 64, rho = nb * 32; const int n0s = ((rho >> 7) & 1) * 1024 + (rho >> 8) * 128 + (rho & 127);
                transpose_item_f8(INP(16) + (size_t)e * 1024 * 2048, 2048, n0s, kb * 64, Wgu8 + (size_t)e * 2048 * 1024, 1024, rho, 64.0f, scr, lane); continue; } r -= NE * I_GU;
            { const int e = r / I_DN, q = r % I_DN, nb = q % 32, kb = q / 32;
                transpose_item_f8(INP(18) + (size_t)e * 1024 * 1024, 1024, nb * 32, kb * 64, Wdn8 + (size_t)e * 1024 * 1024, 1024, nb * 32, 64.0f, scr, lane); }
        }
        __syncthreads();
        LAS float* Wl = (LAS float*)lds;
        for (int i = tid; i < 1024 * 32; i += NTHR) { const int p = i >> 5, c = i & 31; const int sc = c < 16 ? 2560 + c : (c < 24 ? 6672 + (c - 16) : 6680 + (c - 24)); Wl[p * WL_LD + c] = INP(2)[(size_t)wl_k(p) * WIN_LD + sc]; }
        __syncthreads();
        f32x4 wn[4];
#pragma unroll
        for (int j = 0; j < 4; ++j) wn[j] = *(const f32x4*)(INP(1) + 4 * lane + 256 * j);
        const int c = lane & 31; const float gb = c < 16 ? INP(5)[c] : (c < 24 ? INP(9)[c - 16] : INP(10)[c - 24]);
#pragma unroll 1
        for (int row = gw * RN; row < T; row += NGW * RN) {
            float res[RN];
            rownorm_proj<RN, false>(XIN + (size_t)row * 1024, wn, Wl, XN + (size_t)row * 1024, lane, res);
#pragma unroll
            for (int r = 0; r < RN; ++r) if (lane < 32) GATES[(size_t)(row + r) * 32 + c] = res[r] + gb;
        }
        __syncthreads();
    }
    GRID_BAR(0);

    if (IN(1)) {
        pg8::Gemm g{XN, Win_t, T, NPROJ, 1024}; pg8::StaticOrder S; S.init(T, NPROJ, G, bx);
        pg8::EpiBf16 E{PROJ, NPROJ};
        pg8::gemm_phase<pg8::EpiBf16, pg8::StaticOrder>(lds, g, S, E, wave);
    }
    GRID_BAR(1);

    if (IN(2)) {
        const int tid = fresh_tid(wave), lane = tid & 63; (void)lane;
        const float* cw = INP(3); const float* cb = INP(4);
#pragma unroll 1
        for (int it = bx * NTHR + tid; it < (T / 16) * 192; it += G * NTHR) {
            const int ch = it % 192, t0 = (it / 192) * 16, c0 = ch * 8;
            float w[4][8], bs[8], r0[8], r1[8], r2[8];
#pragma unroll
            for (int k = 0; k < 4; ++k) { const f32x4 a = *(const f32x4*)(cw + k * 1536 + c0), b2 = *(const f32x4*)(cw + k * 1536 + c0 + 4);
#pragma unroll
                for (int e = 0; e < 4; ++e) { w[k][e] = a[e]; w[k][4 + e] = b2[e]; } }
            { const f32x4 a = *(const f32x4*)(cb + c0), b2 = *(const f32x4*)(cb + c0 + 4);
#pragma unroll
              for (int e = 0; e < 4; ++e) { bs[e] = a[e]; bs[4 + e] = b2[e]; } }
            const bf16* src = PROJ + (size_t)t0 * NPROJ + C_XBC + c0;
            if ((t0 & (SEQ - 1)) == 0) {
#pragma unroll
                for (int e = 0; e < 8; ++e) { r0[e] = 0.f; r1[e] = 0.f; r2[e] = 0.f; }
            } else { mx::unpack8(*(const v4u*)(src - 3 * (size_t)NPROJ), r0); mx::unpack8(*(const v4u*)(src - 2 * (size_t)NPROJ), r1); mx::unpack8(*(const v4u*)(src - (size_t)NPROJ), r2); }
#pragma unroll 4
            for (int i = 0; i < 16; ++i) { float cu[8], o[8]; mx::unpack8(*(const v4u*)(src + (size_t)i * NPROJ), cu);
#pragma unroll
                for (int e = 0; e < 8; ++e) { o[e] = silu_f(bs[e] + w[0][e] * r0[e] + w[1][e] * r1[e] + w[2][e] * r2[e] + w[3][e] * cu[e]); r0[e] = r1[e]; r1[e] = r2[e]; r2[e] = cu[e]; }
                v4u ov = {pk2(o[0], o[1]), pk2(o[2], o[3]), pk2(o[4], o[5]), pk2(o[6], o[7])};
                *(v4u*)(XBC + (size_t)(t0 + i) * 1536 + c0) = ov; }
        }
    }
    GRID_BAR(2);

    if (IN(3)) {
#pragma unroll 1
        for (int it = bx; it < 256; it += G) if ((it >> 3) & 1) mx::mlstm_item(lds, ((it >> 4) << 3) | (it & 7), args.variant, wave, PROJ, GATES, INP(11), MIX);
#pragma unroll 1
        for (int it = bx; it < 256; it += G) if (!((it >> 3) & 1)) mx::ssd_item(lds, ((it >> 4) << 3) | (it & 7), args.variant, wave, XBC, PROJ, GATES, INP(6), INP(7), MIX, SSQ);
    }
    GRID_BAR(3);
    if (IN(4)) {
        pg8::Gemm g{MIX, Wout_t, T, 1024, 2048}; pg8::StaticOrder S; S.init(T, 1024, G, bx);
        pg8::EpiResF32 E{XIN, H, 1024, SSQ};
        pg8::gemm_phase<pg8::EpiResF32, pg8::StaticOrder>(lds, g, S, E, wave);
    }

    GRID_BAR(4);
    if (IN(5)) {
        const int tid = fresh_tid(wave), lane = tid & 63; (void)lane;
        LAS float* Wl = (LAS float*)lds; LAS int* hist = (LAS int*)(lds + MISC_OFF + 256);
        for (int i = tid; i < 1024 * 32; i += NTHR) { const int p = i >> 5, c = i & 31; Wl[p * WL_LD + c] = INP(14)[(size_t)wl_k(p) * 32 + c]; }
        if (tid < 32) hist[tid] = 0;
        __syncthreads();
        f32x4 wn[4];
#pragma unroll
        for (int j = 0; j < 4; ++j) wn[j] = *(const f32x4*)(INP(13) + 4 * lane + 256 * j);
        const int c = lane & 31; const float rb = INP(15)[c];
        for (int blk = bx; blk < T / 128; blk += G) {
#pragma unroll 1
            for (int it = 0; it < 16 / RN; ++it) {
                const int row = blk * 128 + wave * 16 + it * RN;
                float res[RN];
                rownorm_proj<RN, true>(H + (size_t)row * 1024, wn, Wl, XN8 + (size_t)row * 1024, lane, res);
#pragma unroll
                for (int r = 0; r < RN; ++r) {
                    float v = res[r] + rb; float tv[4]; int ti[4];
#pragma unroll
                    for (int k = 0; k < 4; ++k) {
                        float bv = v; int bi = c;
#pragma unroll
                        for (int m = 1; m < 32; m <<= 1) { const float ov = __shfl_xor(bv, m); const int oi = __shfl_xor(bi, m); if (ov > bv || (ov == bv && oi < bi)) { bv = ov; bi = oi; } }
                        tv[k] = bv; ti[k] = bi; if (c == bi) v = -INFINITY;
                    }
                    const float e1 = __expf(tv[1] - tv[0]), e2 = __expf(tv[2] - tv[0]), e3 = __expf(tv[3] - tv[0]); const float inv = 1.0f / (1.0f + e1 + e2 + e3);
                    if (lane == 0) { const size_t o = (size_t)(row + r) * 4; TOPI[o] = ti[0]; TOPI[o + 1] = ti[1]; TOPI[o + 2] = ti[2]; TOPI[o + 3] = ti[3];
                        TOPG[o] = inv; TOPG[o + 1] = e1 * inv; TOPG[o + 2] = e2 * inv; TOPG[o + 3] = e3 * inv;
                        __hip_atomic_fetch_add(hist + ti[0], 1, __ATOMIC_RELAXED, __HIP_MEMORY_SCOPE_WORKGROUP); __hip_atomic_fetch_add(hist + ti[1], 1, __ATOMIC_RELAXED, __HIP_MEMORY_SCOPE_WORKGROUP); __hip_atomic_fetch_add(hist + ti[2], 1, __ATOMIC_RELAXED, __HIP_MEMORY_SCOPE_WORKGROUP); __hip_atomic_fetch_add(hist + ti[3], 1, __ATOMIC_RELAXED, __HIP_MEMORY_SCOPE_WORKGROUP); }
                }
            }
            __syncthreads();
            if (tid < 32) { BLKCNT[blk * 32 + tid] = hist[tid]; hist[tid] = 0; }
            __syncthreads();
        }
    }

    GRID_BAR(5);
    if (IN(6)) {
        const int tid = fresh_tid(wave), lane = tid & 63; (void)lane;
        LAS int* tot = (LAS int*)lds; LAS int* base = tot + 32; LAS int* pstart = base + 32; LAS int* wcnt = pstart + 33;
        LAS int* arow = wcnt + 256;
        for (int blk = bx; blk < T / 128; blk += G) {
            if (tid < 32) { int t = 0, b = 0; for (int j = 0; j < T / 128; ++j) { const int v = BLKCNT[j * 32 + tid]; t += v; if (j < blk) b += v; } tot[tid] = t; base[tid] = b; }
            __syncthreads();
            if (tid == 0) { int s = 0; for (int e = 0; e < 32; ++e) { pstart[e] = s; s += (tot[e] + 255) / 256 * 256; } pstart[32] = s; }
            __syncthreads();
            const int token = blk * 128 + (tid >> 2), k = tid & 3; const int e = TOPI[(size_t)token * 4 + k];
            int rank = 0;
#pragma unroll 1
            for (int ee = 0; ee < 32; ++ee) { const unsigned long long m = __ballot(e == ee); if (e == ee) rank = __popcll(m & ((1ull << lane) - 1ull)); if (lane == 0) wcnt[wave * 32 + ee] = __popcll(m); }
            __syncthreads();
            int off = 0; for (int w = 0; w < wave; ++w) off += wcnt[w * 32 + e];
            const int row = pstart[e] + base[e] + off + rank;
            ROWTOK[row] = token; ROWGATE[row] = TOPG[(size_t)token * 4 + k]; TOKROW[(size_t)token * 4 + k] = row; arow[tid] = row;
            __syncthreads();
            for (int a = 0; a < 64; ++a) { const int ai = wave * 64 + a; const int drow = arow[ai]; const int tok = blk * 128 + (ai >> 2);
                const v4u* s = (const v4u*)(XN8 + (size_t)tok * 1024); v4u* d = (v4u*)(XG8 + (size_t)drow * 1024); d[lane] = s[lane]; }
            if (blk < 32) { const int ps = pstart[blk] + tot[blk], pe = pstart[blk + 1];
                for (int r = ps + wave; r < pe; r += NWAVES) { if (lane == 0) { ROWTOK[r] = 0; ROWGATE[r] = 0.f; } v4u* d = (v4u*)(XG8 + (size_t)r * 1024); const v4u z = {0u, 0u, 0u, 0u}; d[lane] = z; } }
            if (blk == 0) { const int nb = pstart[32] / 256; if (tid == 0) NBLK[0] = nb;
                for (int b = tid; b < nb; b += NTHR) { int e2 = 0; while (e2 < 31 && b * 256 >= pstart[e2 + 1]) ++e2; BLKEXP[b] = e2; } }
            __syncthreads();
        }
    }

    GRID_BAR(6);
    if (IN(7)) {
        pg8::Gemm g{(const bf16*)XG8, (const bf16*)Wgu8, MAXROWS, 2048, 512}; pg8::MoeOrder S{BLKEXP, __builtin_amdgcn_readfirstlane(NBLK[0]), 8, G, bx};
        pg8::EpiSwiglu E{ACT8, INP(17)};
        pg8::gemm_phase_f8<pg8::EpiSwiglu, pg8::MoeOrder>(lds, g, S, E, wave);
    }
    GRID_BAR(7);
    if (IN(8)) {
        pg8::Gemm g{(const bf16*)ACT8, (const bf16*)Wdn8, MAXROWS, 1024, 512}; pg8::MoeOrder S{BLKEXP, __builtin_amdgcn_readfirstlane(NBLK[0]), 4, G, bx};
        pg8::EpiDown E{EO, INP(19), ROWGATE};
        pg8::gemm_phase_f8<pg8::EpiDown, pg8::MoeOrder>(lds, g, S, E, wave);
    }
    GRID_BAR(8);
    if (IN(9)) {
        const int tid = fresh_tid(wave), lane = tid & 63; (void)lane;
        const int gw = bx * NWAVES + wave, NGW = G * NWAVES;
        f32x4 wf[4];
#pragma unroll
        for (int j = 0; j < 4; ++j) wf[j] = *(const f32x4*)(INP(20) + 4 * lane + 256 * j);
        for (int row = gw; row < T; row += NGW) {
            f32x4 v[4];
#pragma unroll
            for (int j = 0; j < 4; ++j) v[j] = *(const f32x4*)(H + (size_t)row * 1024 + 4 * lane + 256 * j);
#pragma unroll
            for (int k = 0; k < 4; ++k) { const int er = TOKROW[(size_t)row * 4 + k]; const bf16* ep = EO + (size_t)er * 1024;
#pragma unroll
                for (int j = 0; j < 4; ++j) { const v2u w = *(const v2u*)(ep + 4 * lane + 256 * j); v[j][0] += bflo(w.x); v[j][1] += bfhi(w.x); v[j][2] += bflo(w.y); v[j][3] += bfhi(w.y); } }
            float ss = 0.f;
#pragma unroll
            for (int j = 0; j < 4; ++j) ss += (v[j][0] * v[j][0] + v[j][1] * v[j][1]) + (v[j][2] * v[j][2] + v[j][3] * v[j][3]);
            ss = wave_sum(ss); const float rs = 1.0f / sqrtf(ss * (1.0f / 1024.0f) + RMS_EPS);
#pragma unroll
            for (int j = 0; j < 4; ++j) *(f32x4*)(args.out + (size_t)row * 1024 + 4 * lane + 256 * j) = v[j] * rs * wf[j];
        }
    }
#undef IN
}

extern "C" void kernel_launch(void* const* d_in, const int* in_sizes, int n_in, void* d_out, int out_size, void* d_ws, size_t ws_size, hipStream_t stream) {
    static int grid = 0;
    if (grid == 0) {
        if (n_in != 21 || in_sizes[0] != T * D || out_size != T * D || ws_size < WS_END) { fprintf(stderr, "kernel_launch: unexpected shapes/workspace (n_in %d, ws %zu, need %zu)\n", n_in, ws_size, (size_t)WS_END); grid = -1; return; }
        if (hipFuncSetAttribute((const void*)mega, hipFuncAttributeMaxDynamicSharedMemorySize, LDS_BYTES) != hipSuccess) { fprintf(stderr, "kernel_launch: hipFuncSetAttribute failed\n"); grid = -1; return; }
        int dev = 0, cus = 0, per_cu = 0;
        if (hipGetDevice(&dev) != hipSuccess || hipDeviceGetAttribute(&cus, hipDeviceAttributeMultiprocessorCount, dev) != hipSuccess) { grid = -1; return; }
        if (hipOccupancyMaxActiveBlocksPerMultiprocessor(&per_cu, (const void*)mega, NTHR, LDS_BYTES) != hipSuccess || per_cu < 1) { fprintf(stderr, "kernel_launch: occupancy query says %d blocks per CU\n", per_cu); grid = -1; return; }
        (void)hipGetLastError();
        grid = cus;
    }
    if (grid < 0) return;
    (void)hipMemsetAsync((char*)d_ws + WS_CTL, 0, CTL_ZERO_BYTES, stream);
    Args a{};
    for (int i = 0; i < 21; ++i) a.in[i] = (const float*)d_in[i];
    a.out = (float*)d_out; a.ws = (unsigned char*)d_ws;
    a.ph_lo = 0; a.ph_hi = 10;
    hipLaunchKernelGGL(mega, dim3(grid), dim3(NTHR), LDS_BYTES, stream, a);
#ifdef PROBE_PHASE
    a.ph_lo = PROBE_PHASE; a.ph_hi = PROBE_PHASE + 1;
#ifdef PROBE_VARIANT
    a.variant = PROBE_VARIANT;
#endif
    hipLaunchKernelGGL(mega, dim3(grid), dim3(NTHR), LDS_BYTES, stream, a);
#endif
}
```

```cpp
#include <hip/hip_runtime.h>
#include <cstdio>
#include <cstdint>

__device__ __forceinline__ int lane_id() { int l; asm volatile("v_mbcnt_lo_u32_b32 %0, -1, 0\n\tv_mbcnt_hi_u32_b32 %0, -1, %0" : "=v"(l)); return l; }
namespace pg8 {
#define PG8_LAS __attribute__((address_space(3)))
typedef unsigned short bf16_t;
typedef short bf16x8 __attribute__((ext_vector_type(8)));
typedef float f32x4 __attribute__((ext_vector_type(4)));
typedef unsigned u32x4 __attribute__((ext_vector_type(4)));
constexpr int BM = 256, BK = 64, HALF = 128, HTB = HALF * BK * 2, STAGE_BYTES = 8 * HTB, NXCD = 8, WGM = 8;

__host__ __device__ __forceinline__ int lds_byte(int r, int c) { const int st = (r >> 4) * 2 + (c >> 5), rr = r & 15, cc = c & 31, ob = rr * 64 + cc * 2; return st * 1024 + (ob ^ (((ob >> 9) & 1) << 5)); }
__host__ __device__ __forceinline__ void stage_rc(int b, int& R, int& C) { const int st = b / 1024, sb = b % 1024, swz = sb ^ (((sb >> 9) & 1) << 5); R = (st >> 1) * 16 + swz / 64; C = (st & 1) * 32 + (swz % 64) / 2; }
__host__ __device__ __forceinline__ int perm32(int rho) { const int n = rho >> 4, i = rho & 15; return 8 * (i >> 2) + 4 * n + (i & 3); }

__device__ __forceinline__ const char* uni_ptr(const void* p) { const unsigned long long v = (unsigned long long)p; const unsigned lo = __builtin_amdgcn_readfirstlane((unsigned)v), hi = __builtin_amdgcn_readfirstlane((unsigned)(v >> 32)); return (const char*)(((unsigned long long)hi << 32) | lo); }
struct Unit { int pm, pn, pb, e; };
struct Gemm { const bf16_t* A; const bf16_t* Bt; int M, N, K; };

struct StaticOrder {
    int nM, nN, nwg, G, c;
    __host__ __device__ void init(int M, int N, int G_, int c_) { nM = M / BM; nN = N / BM; nwg = nM * nN; G = G_; c = c_; }
    __host__ __device__ bool next(int i, Unit& u) const {
        const long L = (long)i * G + c; if (L >= nwg) return false;
        int wgid = (int)L; { const int q = nwg / NXCD, r = nwg % NXCD, xcd = wgid % NXCD, off = wgid / NXCD; wgid = (xcd < r ? xcd * (q + 1) : r * (q + 1) + (xcd - r) * q) + off; }
        const int nig = WGM * nN, gid = wgid / nig, fm = gid * WGM, gsz = (nM - fm) < WGM ? (nM - fm) : WGM;
        u.pm = fm + ((wgid % nig) % gsz); u.pn = (wgid % nig) / gsz; u.pb = u.pn; u.e = 0; return true;
    }
};
struct MoeOrder {
    const int* blk_expert; int nblk, ntn, G, c;
    __device__ bool next(int i, Unit& u) const {
        const int xcd = c % NXCD, s = i * (G / NXCD) + c / NXCD;
        const int rb = (s / ntn) * NXCD + xcd; if (rb >= nblk) return false;
        u.pm = rb; u.pn = s % ntn; u.e = __builtin_amdgcn_readfirstlane(blk_expert[rb]); u.pb = u.e * ntn + u.pn; return true;
    }
};

__device__ __forceinline__ unsigned cvt_pk_bf16(float lo, float hi) { unsigned r; asm volatile("v_cvt_pk_bf16_f32 %0, %1, %2" : "=v"(r) : "v"(lo), "v"(hi)); return r; }

struct EpiBf16 {
    static constexpr bool PERM = true; static constexpr int MIDT = -1;
    __device__ __forceinline__ void mid(f32x4 (&)[2][2][4][2], const Unit&, int, int) const {}
    bf16_t* O; int ldc;
    __device__ __forceinline__ void operator()(const f32x4 (&acc)[2][2][4][2], const Unit& u, int wr, int wc, int fr, int fq) const {
        const int row0 = u.pm * BM + wr * 64 + fr, col0 = u.pn * BM + wc * 32 + 8 * fq;
#pragma unroll
        for (int ai = 0; ai < 2; ++ai)
#pragma unroll
            for (int m = 0; m < 4; ++m) { bf16_t* rowp = O + (size_t)(row0 + ai * HALF + m * 16) * ldc + col0;
#pragma unroll
                for (int bj = 0; bj < 2; ++bj) { const f32x4 v0 = acc[ai][bj][m][0], v1 = acc[ai][bj][m][1];
                    u32x4 w; w.x = cvt_pk_bf16(v0[0], v0[1]); w.y = cvt_pk_bf16(v0[2], v0[3]); w.z = cvt_pk_bf16(v1[0], v1[1]); w.w = cvt_pk_bf16(v1[2], v1[3]);
                    *(u32x4*)(rowp + bj * HALF) = w; } }
    }
};
struct EpiResF32 {
    static constexpr bool PERM = true; static constexpr int MIDT = 16;
    const float* base; bf16_t* C; int ldc; const float* ssq;
    __device__ __forceinline__ void mid(f32x4 (&acc)[2][2][4][2], const Unit& u, int wr, int fr) const {
#pragma unroll
        for (int ai = 0; ai < 2; ++ai)
#pragma unroll
            for (int m = 0; m < 4; ++m) { const int row = u.pm * BM + ai * HALF + wr * 64 + m * 16 + fr; const f32x4 a = *(const f32x4*)(ssq + (size_t)row * 8), b = *(const f32x4*)(ssq + (size_t)row * 8 + 4);
                const float rs = 1.0f / sqrtf(((a[0] + a[1]) + (a[2] + a[3]) + (b[0] + b[1]) + (b[2] + b[3])) * (1.0f / 1024.0f) + 1e-6f);
#pragma unroll
                for (int bj = 0; bj < 2; ++bj)
#pragma unroll
                    for (int n = 0; n < 2; ++n) acc[ai][bj][m][n] = acc[ai][bj][m][n] * rs;
                asm volatile("" ::: "memory"); }
    }
    __device__ __forceinline__ void operator()(const f32x4 (&acc)[2][2][4][2], const Unit& u, int wr, int wc, int fr, int fq) const {
        const int row0 = u.pm * BM + wr * 64 + fr, col0 = u.pn * BM + wc * 32 + 8 * fq;
#pragma unroll
        for (int ai = 0; ai < 2; ++ai)
#pragma unroll
            for (int m = 0; m < 4; ++m) { const size_t off = (size_t)(row0 + ai * HALF + m * 16) * ldc + col0;
#pragma unroll
                for (int bj = 0; bj < 2; ++bj) { const f32x4 b0 = *(const f32x4*)(base + off + bj * HALF), b1 = *(const f32x4*)(base + off + bj * HALF + 4);
                    const f32x4 v0 = acc[ai][bj][m][0] + b0, v1 = acc[ai][bj][m][1] + b1;
                    u32x4 w; w.x = cvt_pk_bf16(v0[0], v0[1]); w.y = cvt_pk_bf16(v0[2], v0[3]); w.z = cvt_pk_bf16(v1[0], v1[1]); w.w = cvt_pk_bf16(v1[2], v1[3]);
                    *(u32x4*)(C + off + bj * HALF) = w; } }
    }
};
struct EpiSwiglu {
    static constexpr bool PERM = true; static constexpr int MIDT = -1;
    __device__ __forceinline__ void mid(f32x4 (&)[2][2][4][2], const Unit&, int, int) const {}
    unsigned char* act; const float* bgu;
    __device__ __forceinline__ void operator()(const f32x4 (&acc)[2][2][4][2], const Unit& u, int wr, int wc, int fr, int fq) const {
        const int row0 = u.pm * BM + wr * 64 + fr, col0 = u.pn * HALF + wc * 32 + 8 * fq;
        const float* bg = bgu + (size_t)u.e * 2048 + col0;
        f32x4 bgv[2], buv[2];
#pragma unroll
        for (int n = 0; n < 2; ++n) { bgv[n] = *(const f32x4*)(bg + 4 * n); buv[n] = *(const f32x4*)(bg + 1024 + 4 * n); }
#pragma unroll
        for (int ai = 0; ai < 2; ++ai)
#pragma unroll
            for (int m = 0; m < 4; ++m) { unsigned char* rowp = act + (size_t)(row0 + ai * HALF + m * 16) * 1024 + col0;
                float o[8];
#pragma unroll
                for (int n = 0; n < 2; ++n) { const f32x4 gv = acc[ai][0][m][n] + bgv[n], uv = acc[ai][1][m][n] + buv[n];
#pragma unroll
                    for (int i = 0; i < 4; ++i) { const float g = fminf(gv[i], 7.0f), uu = fminf(fmaxf(uv[i], -7.0f), 7.0f);
                        o[4 * n + i] = (uu + 1.0f) * g * __builtin_amdgcn_rcpf(1.0f + __expf(-1.702f * g)); } }
                int w0 = 0, w1 = 0; w0 = __builtin_amdgcn_cvt_pk_fp8_f32(o[0], o[1], w0, false); w0 = __builtin_amdgcn_cvt_pk_fp8_f32(o[2], o[3], w0, true); w1 = __builtin_amdgcn_cvt_pk_fp8_f32(o[4], o[5], w1, false); w1 = __builtin_amdgcn_cvt_pk_fp8_f32(o[6], o[7], w1, true);
                typedef int i2v __attribute__((ext_vector_type(2))); *(i2v*)rowp = (i2v){w0, w1}; }
    }
};
struct EpiDown {
    static constexpr bool PERM = true; static constexpr int MIDT = -1;
    __device__ __forceinline__ void mid(f32x4 (&)[2][2][4][2], const Unit&, int, int) const {}
    unsigned char* eo; const float* bdn; const float* row_gate;
    __device__ __forceinline__ void operator()(const f32x4 (&acc)[2][2][4][2], const Unit& u, int wr, int wc, int fr, int fq) const {
        const int row0 = u.pm * BM + wr * 64 + fr, col0 = u.pn * BM + wc * 32 + 8 * fq;
        const float* bb = bdn + (size_t)u.e * 1024 + col0;
        f32x4 bv[2][2];
#pragma unroll
        for (int bj = 0; bj < 2; ++bj)
#pragma unroll
            for (int n = 0; n < 2; ++n) bv[bj][n] = *(const f32x4*)(bb + bj * HALF + 4 * n);
#pragma unroll
        for (int ai = 0; ai < 2; ++ai)
#pragma unroll
            for (int m = 0; m < 4; ++m) { const int row = row0 + ai * HALF + m * 16; const float gt = row_gate[row] * 16.0f; unsigned char* rowp = eo + (size_t)row * 1024 + col0;
#pragma unroll
                for (int bj = 0; bj < 2; ++bj) { const f32x4 v0 = (acc[ai][bj][m][0] + bv[bj][0]) * gt, v1 = (acc[ai][bj][m][1] + bv[bj][1]) * gt;
                    int w0 = 0, w1 = 0; w0 = __builtin_amdgcn_cvt_pk_fp8_f32(v0[0], v0[1], w0, false); w0 = __builtin_amdgcn_cvt_pk_fp8_f32(v0[2], v0[3], w0, true); w1 = __builtin_amdgcn_cvt_pk_fp8_f32(v1[0], v1[1], w1, false); w1 = __builtin_amdgcn_cvt_pk_fp8_f32(v1[2], v1[3], w1, true);
                    typedef int i2v __attribute__((ext_vector_type(2))); *(i2v*)(rowp + bj * HALF) = (i2v){w0, w1}; } }
    }
};

typedef int v8i_t __attribute__((ext_vector_type(8)));
typedef int v4i_t __attribute__((ext_vector_type(4)));
template <class Epi, class Sched>
__device__ __forceinline__ void gemm_phase(PG8_LAS unsigned char* lds, const Gemm g, const Sched& S, const Epi& E, int wid) {
    const int lane = lane_id(), tid = wid * 64 + lane, wr = wid >> 2, wc = wid & 3, fr = lane & 15, fq = lane >> 4;
    const int K = g.K, nt = K / BK;
    unsigned voffA[2], voffB[2];
#pragma unroll
    for (int i = 0; i < 2; ++i) { int R, C; stage_rc(tid * 16 + i * 8192, R, C); const int Rb = Epi::PERM ? ((R & ~31) + perm32(R & 31)) : R;
        voffA[i] = (unsigned)(R * K + C) * 2u; voffB[i] = (unsigned)(Rb * K + C) * 2u; }
    const size_t kstep = (size_t)(BK * 2);
    const size_t hstep = (size_t)HALF * K * 2;
    const size_t tstep = 2 * hstep;
    const unsigned ldsw = (unsigned)wid * 1024u;
    const int aoff = lds_byte(wr * 64 + fr, fq * 8), boff = lds_byte(wc * 32 + fr, fq * 8);
#define PG8_SA(b, h) (((b) * 2 + (h)) * HTB)
#define PG8_SB(b, h) ((4 + (b) * 2 + (h)) * HTB)
#define PG8_STAGE(bufoff, gbase, voff) do { _Pragma("unroll") for (int _i = 0; _i < 2; ++_i) \
        __builtin_amdgcn_global_load_lds((const unsigned*)((const char*)(gbase) + (voff)[_i]), (PG8_LAS unsigned*)(lds + (bufoff) + ldsw + _i * 8192), 16, 0, 0); } while (0)
#define PG8_LDA(dst, b, h) do { _Pragma("unroll") for (int m = 0; m < 4; ++m) _Pragma("unroll") for (int k = 0; k < 2; ++k) dst[m][k] = *(const PG8_LAS bf16x8*)(lds + PG8_SA(b, h) + aoff + m * 2048 + k * 1024); } while (0)
#define PG8_LDB(dst, b, h) do { _Pragma("unroll") for (int n = 0; n < 2; ++n) _Pragma("unroll") for (int k = 0; k < 2; ++k) dst[n][k] = *(const PG8_LAS bf16x8*)(lds + PG8_SB(b, h) + boff + n * 2048 + k * 1024); } while (0)
#define PG8_MMA(ai, bj, At, Bt) do { __builtin_amdgcn_s_setprio(1); _Pragma("unroll") for (int m = 0; m < 4; ++m) _Pragma("unroll") for (int n = 0; n < 2; ++n) _Pragma("unroll") for (int k = 0; k < 2; ++k) \
        acc[ai][bj][m][n] = __builtin_amdgcn_mfma_f32_16x16x32_bf16(Bt[n][k], At[m][k], acc[ai][bj][m][n], 0, 0, 0); __builtin_amdgcn_s_setprio(0); } while (0)
#define PG8_WAIT_V(n) asm volatile("s_waitcnt vmcnt(" #n ")" ::: "memory")
#define PG8_WAIT_L(n) asm volatile("s_waitcnt lgkmcnt(" #n ")" ::: "memory")
#define PG8_BAR __builtin_amdgcn_s_barrier()
#define PG8_SCHED __builtin_amdgcn_sched_barrier(0)
    Unit cur, nxt; int ui = 0;
    if (!S.next(0, cur)) return;
    f32x4 acc[2][2][4][2];
#pragma unroll
    for (int a = 0; a < 2; ++a)
#pragma unroll
        for (int b = 0; b < 2; ++b)
#pragma unroll
            for (int m = 0; m < 4; ++m)
#pragma unroll
                for (int n = 0; n < 2; ++n) acc[a][b][m][n] = (f32x4){0.f, 0.f, 0.f, 0.f};
    bf16x8 At[4][2], B0[2][2], B1[2][2];
    const char* cA = uni_ptr((const char*)g.A + (size_t)cur.pm * tstep); const char* cB = uni_ptr((const char*)g.Bt + (size_t)cur.pb * tstep);
    PG8_STAGE(PG8_SB(0, 0), cB, voffB); PG8_STAGE(PG8_SB(0, 1), cB + hstep, voffB); PG8_STAGE(PG8_SA(0, 0), cA, voffA); PG8_STAGE(PG8_SA(0, 1), cA + hstep, voffA);
    if (wr == 1) PG8_BAR;
    PG8_WAIT_V(2); PG8_BAR;
    PG8_STAGE(PG8_SB(1, 0), cB + kstep, voffB); PG8_STAGE(PG8_SA(1, 0), cA + kstep, voffA); PG8_STAGE(PG8_SB(1, 1), cB + hstep + kstep, voffB);
    PG8_WAIT_V(6); PG8_BAR;
    for (;;) {
        const bool has_next = S.next(ui + 1, nxt);
        const char* nA = uni_ptr(has_next ? (const char*)g.A + (size_t)nxt.pm * tstep : cA); const char* nB = uni_ptr(has_next ? (const char*)g.Bt + (size_t)nxt.pb * tstep : cB);
        for (int t = 0; t < nt; t += 2) {
            const bool last = (t == nt - 2);
            const char* a1 = cA + (size_t)(t + 1) * kstep;
            const char* a2 = last ? nA : cA + (size_t)(t + 2) * kstep; const char* b2 = last ? nB : cB + (size_t)(t + 2) * kstep;
            const char* a3 = a2 + kstep; const char* b3 = b2 + kstep;
            if constexpr (Epi::MIDT >= 0) { if (t == Epi::MIDT) E.mid(acc, cur, wr, fr); }
            PG8_LDB(B0, 0, 0); PG8_LDB(B1, 0, 1); PG8_SCHED; PG8_LDA(At, 0, 0); PG8_STAGE(PG8_SA(1, 1), a1 + hstep, voffA);
            PG8_WAIT_V(8); PG8_WAIT_L(0); PG8_BAR; PG8_MMA(0, 0, At, B0); PG8_MMA(0, 1, At, B1); PG8_BAR; PG8_SCHED;
            PG8_LDA(At, 0, 1); PG8_STAGE(PG8_SB(0, 0), b2, voffB); PG8_STAGE(PG8_SB(0, 1), b2 + hstep, voffB); PG8_STAGE(PG8_SA(0, 0), a2, voffA);
            PG8_WAIT_V(8); PG8_WAIT_L(0); PG8_BAR; PG8_MMA(1, 0, At, B0); PG8_MMA(1, 1, At, B1); PG8_BAR; PG8_SCHED;
            PG8_LDB(B0, 1, 0); PG8_LDB(B1, 1, 1); PG8_SCHED; PG8_LDA(At, 1, 0); PG8_STAGE(PG8_SA(0, 1), a2 + hstep, voffA);
            PG8_WAIT_V(8); PG8_WAIT_L(0); PG8_BAR; PG8_MMA(0, 0, At, B0); PG8_MMA(0, 1, At, B1); PG8_BAR; PG8_SCHED;
            PG8_LDA(At, 1, 1); PG8_STAGE(PG8_SB(1, 0), b3, voffB); PG8_STAGE(PG8_SB(1, 1), b3 + hstep, voffB); PG8_STAGE(PG8_SA(1, 0), a3, voffA);
            PG8_WAIT_V(8); PG8_WAIT_L(0); PG8_BAR; PG8_MMA(1, 0, At, B0); PG8_MMA(1, 1, At, B1); PG8_BAR; PG8_SCHED;
        }
        if (wr == 0) PG8_BAR;
        E(acc, cur, wr, wc, fr, fq);
        if (!has_next) break;
#pragma unroll
        for (int a = 0; a < 2; ++a)
#pragma unroll
            for (int b = 0; b < 2; ++b)
#pragma unroll
                for (int m = 0; m < 4; ++m)
#pragma unroll
                    for (int n = 0; n < 2; ++n) acc[a][b][m][n] = (f32x4){0.f, 0.f, 0.f, 0.f};
        cur = nxt; cA = nA; cB = nB; ++ui;
        if (wr == 1) PG8_BAR;
    }
    PG8_WAIT_V(0);
    PG8_BAR;
#undef PG8_SA
#undef PG8_SB
#undef PG8_STAGE
#undef PG8_LDA
#undef PG8_LDB
#undef PG8_MMA
#undef PG8_WAIT_V
#undef PG8_WAIT_L
#undef PG8_BAR
#undef PG8_SCHED
}
template <class Epi, class Sched>
__device__ __forceinline__ void gemm_phase_f8(PG8_LAS unsigned char* lds, const Gemm g, const Sched& S, const Epi& E, int wid) {
    const int lane = lane_id(), tid = wid * 64 + lane, wr = wid >> 2, wc = wid & 3, fr = lane & 15, fq = lane >> 4;
    int Kq = g.K; asm volatile("" : "+s"(Kq));
    const int K = Kq, nt = K / BK;
    unsigned voffA[2], voffB[2];
#pragma unroll
    for (int i = 0; i < 2; ++i) { int R, C; stage_rc(tid * 16 + i * 8192, R, C); const int Rb = Epi::PERM ? ((R & ~31) + perm32(R & 31)) : R;
        voffA[i] = (unsigned)(R * K + C) * 2u; voffB[i] = (unsigned)(Rb * K + C) * 2u; }
    const size_t kstep = (size_t)(BK * 2);
    const size_t hstep = (size_t)HALF * K * 2;
    const size_t tstep = 2 * hstep;
    const unsigned ldsw = (unsigned)wid * 1024u;
    const unsigned ldsb = (unsigned)__builtin_amdgcn_readfirstlane((int)((unsigned)(size_t)lds + ldsw));
    const int aoff = lds_byte(wr * 64 + fr, fq * 8), boff = lds_byte(wc * 32 + fr, fq * 8);
#define PG8_SA(b, h) (((b) * 2 + (h)) * HTB)
#define PG8_SB(b, h) ((4 + (b) * 2 + (h)) * HTB)
#define PG8_STAGE(bufoff, gbase, voff) do { _Pragma("unroll") for (int _i = 0; _i < 2; ++_i) { unsigned _keep; \
        asm volatile("s_mov_b32 %0, m0\n\ts_mov_b32 m0, %3\n\ts_nop 0\n\tglobal_load_lds_dwordx4 %1, %2\n\ts_mov_b32 m0, %0" : "=&s"(_keep) : "v"((voff)[_i]), "s"((const char*)(gbase)), "s"(ldsb + (unsigned)((bufoff) + _i * 8192)) : "memory"); } } while (0)
#define PG8_LDA(dst, b, h) do { _Pragma("unroll") for (int m = 0; m < 4; ++m) { const v4i_t _lo = *(const PG8_LAS v4i_t*)(lds + PG8_SA(b, h) + aoff + m * 2048), _hi = *(const PG8_LAS v4i_t*)(lds + PG8_SA(b, h) + aoff + m * 2048 + 1024); dst[m] = __builtin_shufflevector(_lo, _hi, 0, 1, 2, 3, 4, 5, 6, 7); } } while (0)
#define PG8_LDB(dst, b, h) do { _Pragma("unroll") for (int n = 0; n < 2; ++n) { const v4i_t _lo = *(const PG8_LAS v4i_t*)(lds + PG8_SB(b, h) + boff + n * 2048), _hi = *(const PG8_LAS v4i_t*)(lds + PG8_SB(b, h) + boff + n * 2048 + 1024); dst[n] = __builtin_shufflevector(_lo, _hi, 0, 1, 2, 3, 4, 5, 6, 7); } } while (0)
#define PG8_MMA(ai, bj, At, Bt) do { __builtin_amdgcn_s_setprio(1); _Pragma("unroll") for (int m = 0; m < 4; ++m) _Pragma("unroll") for (int n = 0; n < 2; ++n) \
        acc[ai][bj][m][n] = __builtin_amdgcn_mfma_scale_f32_16x16x128_f8f6f4(Bt[n], At[m], acc[ai][bj][m][n], 0, 0, 0, 0x79797979, 0, 0x7f7f7f7f); __builtin_amdgcn_s_setprio(0); } while (0)
#define PG8_WAIT_V(n) asm volatile("s_waitcnt vmcnt(" #n ")" ::: "memory")
#define PG8_WAIT_L(n) asm volatile("s_waitcnt lgkmcnt(" #n ")" ::: "memory")
#define PG8_BAR __builtin_amdgcn_s_barrier()
#define PG8_SCHED __builtin_amdgcn_sched_barrier(0)
    Unit cur, nxt; int ui = 0;
    if (!S.next(0, cur)) return;
    f32x4 acc[2][2][4][2];
#pragma unroll
    for (int a = 0; a < 2; ++a)
#pragma unroll
        for (int b = 0; b < 2; ++b)
#pragma unroll
            for (int m = 0; m < 4; ++m)
#pragma unroll
                for (int n = 0; n < 2; ++n) acc[a][b][m][n] = (f32x4){0.f, 0.f, 0.f, 0.f};
    v8i_t At[4], B0[2], B1[2];
    const char* cA = uni_ptr((const char*)g.A + (size_t)cur.pm * tstep); const char* cB = uni_ptr((const char*)g.Bt + (size_t)cur.pb * tstep);
    PG8_STAGE(PG8_SB(0, 0), cB, voffB); PG8_STAGE(PG8_SB(0, 1), cB + hstep, voffB); PG8_STAGE(PG8_SA(0, 0), cA, voffA); PG8_STAGE(PG8_SA(0, 1), cA + hstep, voffA);
    if (wr == 1) PG8_BAR;
    PG8_WAIT_V(2); PG8_BAR;
    PG8_STAGE(PG8_SB(1, 0), cB + kstep, voffB); PG8_STAGE(PG8_SA(1, 0), cA + kstep, voffA); PG8_STAGE(PG8_SB(1, 1), cB + hstep + kstep, voffB);
    PG8_WAIT_V(6); PG8_BAR;
    for (;;) {
        const bool has_next = S.next(ui + 1, nxt);
        const char* nA = uni_ptr(has_next ? (const char*)g.A + (size_t)nxt.pm * tstep : cA); const char* nB = uni_ptr(has_next ? (const char*)g.Bt + (size_t)nxt.pb * tstep : cB);
        for (int t = 0; t < nt; t += 2) {
            const bool last = (t == nt - 2);
            const char* a1 = cA + (size_t)(t + 1) * kstep;
            const char* a2 = last ? nA : cA + (size_t)(t + 2) * kstep; const char* b2 = last ? nB : cB + (size_t)(t + 2) * kstep;
            const char* a3 = a2 + kstep; const char* b3 = b2 + kstep;
            if constexpr (Epi::MIDT >= 0) { if (t == Epi::MIDT) E.mid(acc, cur, wr, fr); }
            PG8_LDB(B0, 0, 0); PG8_LDB(B1, 0, 1); PG8_SCHED; PG8_LDA(At, 0, 0); PG8_STAGE(PG8_SA(1, 1), a1 + hstep, voffA);
            PG8_WAIT_V(8); PG8_WAIT_L(0); PG8_BAR; PG8_MMA(0, 0, At, B0); PG8_MMA(0, 1, At, B1); PG8_BAR; PG8_SCHED;
            PG8_LDA(At, 0, 1); PG8_STAGE(PG8_SB(0, 0), b2, voffB); PG8_STAGE(PG8_SB(0, 1), b2 + hstep, voffB); PG8_STAGE(PG8_SA(0, 0), a2, voffA);
            PG8_WAIT_V(8); PG8_WAIT_L(0); PG8_BAR; PG8_MMA(1, 0, At, B0); PG8_MMA(1, 1, At, B1); PG8_BAR; PG8_SCHED;
            PG8_LDB(B0, 1, 0); PG8_LDB(B1, 1, 1); PG8_SCHED; PG8_LDA(At, 1, 0); PG8_STAGE(PG8_SA(0, 1), a2 + hstep, voffA);
            PG8_WAIT_V(8); PG8_WAIT_L(0); PG8_BAR; PG8_MMA(0, 0, At, B0); PG8_MMA(0, 1, At, B1); PG8_BAR; PG8_SCHED;
            PG8_LDA(At, 1, 1); PG8_STAGE(PG8_SB(1, 0), b3, voffB); PG8_STAGE(PG8_SB(1, 1), b3 + hstep, voffB); PG8_STAGE(PG8_SA(1, 0), a3, voffA);
            PG8_WAIT_V(8); PG8_WAIT_L(0); PG8_BAR; PG8_MMA(1, 0, At, B0); PG8_MMA(1, 1, At, B1); PG8_BAR; PG8_SCHED;
        }
        if (wr == 0) PG8_BAR;
        E(acc, cur, wr, wc, fr, fq);
        if (!has_next) break;
#pragma unroll
        for (int a = 0; a < 2; ++a)
#pragma unroll
            for (int b = 0; b < 2; ++b)
#pragma unroll
                for (int m = 0; m < 4; ++m)
#pragma unroll
                    for (int n = 0; n < 2; ++n) acc[a][b][m][n] = (f32x4){0.f, 0.f, 0.f, 0.f};
        cur = nxt; cA = nA; cB = nB; ++ui;
        if (wr == 1) PG8_BAR;
    }
    PG8_WAIT_V(0);
    PG8_BAR;
#undef PG8_SA
#undef PG8_SB
#undef PG8_STAGE
#undef PG8_LDA
#undef PG8_LDB
#undef PG8_MMA
#undef PG8_WAIT_V
#undef PG8_WAIT_L
#undef PG8_BAR
#undef PG8_SCHED
}
}

constexpr int BATCH = 16, SEQ = 2048, T = BATCH * SEQ, D = 1024;
constexpr int NPROJ = 6656;
constexpr int C_Z = 0, C_XBC = 1024, C_Q = 2560, C_K = 3584, C_V = 4608, C_O = 5632;
constexpr int WIN_LD = 6688;
constexpr int NE = 32, TOPK = 4;
constexpr int NASSIGN = T * TOPK, MAXBLK = NASSIGN / 256 + NE, MAXROWS = MAXBLK * 256;
constexpr float RMS_EPS = 1e-6f;
constexpr int NWAVES = 8, NTHR = 512;

constexpr size_t MiB = 1u << 20;
constexpr size_t WS_CTL = 0, CTL_ZERO_BYTES = 1 * MiB;
constexpr size_t WS_WIN = 1 * MiB, WS_WOUT = 14 * MiB, WS_WGU = 18 * MiB, WS_WDN = 146 * MiB;
constexpr size_t WS_XN = 210 * MiB, WS_H = 274 * MiB, WS_GATES = 402 * MiB, WS_ROUTE = 406 * MiB, WS_PROJ = 412 * MiB, WS_MIX = 828 * MiB, WS_END = 956 * MiB;
constexpr size_t WS_XBC = WS_H;
constexpr size_t WS_SSQ = WS_ROUTE + 3 * MiB;
constexpr size_t WS_XG = WS_PROJ, WS_ACT = WS_PROJ + 272 * MiB;
static_assert((size_t)MAXROWS * 1024 * 2 == 272 * MiB && WS_ACT + 272 * MiB == WS_END, "overlay map");
constexpr size_t R_TOPI = 0, R_TOPG = 512 * 1024, R_TOKROW = 1024 * 1024, R_ROWTOK = 1536 * 1024, R_ROWGATE = 2176 * 1024, R_BLKCNT = 2816 * 1024, R_BLKEXP = 2880 * 1024, R_NBLK = 2944 * 1024;
constexpr int CW_BAR = 4096;

constexpr int WL_LD = 36;
constexpr int WL_BYTES = 1024 * WL_LD * 4;
constexpr int MISC_OFF = 150528, LDS_BYTES = MISC_OFF + 1024;

#define GAS __attribute__((address_space(1)))
#define LAS __attribute__((address_space(3)))
typedef unsigned short bf16;
typedef unsigned v4u __attribute__((ext_vector_type(4)));
typedef unsigned v2u __attribute__((ext_vector_type(2)));
typedef float f32x4 __attribute__((ext_vector_type(4)));
#define LDS_WAIT() asm volatile("s_waitcnt lgkmcnt(0)" ::: "memory")
__device__ __forceinline__ unsigned f2bf(float f) { return (unsigned)__builtin_bit_cast(unsigned short, (__bf16)f); }
typedef __bf16 bf2_t __attribute__((ext_vector_type(2)));
__device__ __forceinline__ unsigned pk2(float lo, float hi) { const bf2_t v = {(__bf16)lo, (__bf16)hi}; return __builtin_bit_cast(unsigned, v); }
__device__ __forceinline__ float bf2f(unsigned short b) { return __builtin_bit_cast(float, (unsigned)b << 16); }
__device__ __forceinline__ float bflo(unsigned w) { return __builtin_bit_cast(float, w << 16); }
__device__ __forceinline__ float bfhi(unsigned w) { return __builtin_bit_cast(float, w & 0xffff0000u); }
__device__ __forceinline__ float wave_sum(float v) {
#pragma unroll
    for (int o = 1; o < 64; o <<= 1) v += __shfl_xor(v, o);
    return v;
}
__device__ __forceinline__ float silu_f(float x) { return x * __builtin_amdgcn_rcpf(1.0f + __expf(-x)); }
__device__ __forceinline__ float sigmoid_f(float x) { return __builtin_amdgcn_rcpf(1.0f + __expf(-x)); }
__device__ __forceinline__ float rsqrt_f(float x) { return __builtin_amdgcn_rsqf(x); }
__device__ __forceinline__ float softplus_f(float x) { return x > 20.0f ? x : log1pf(__expf(x)); }


#define XB_TMO      128
#define XB_XCNT(j)  (256  + 64 * (j))
#define XB_XSUB(j)  (1280 + 64 * (j))
#define XB_XGEN(j)  (2304 + 64 * (j))
#define XB_TOP      3328
#define XB_TOPGEN   3392
#define XCD_BAR_WORDS 3456
#define XB_SPIN_CAP (1u << 18)
__device__ __forceinline__ unsigned xb_ld(unsigned* p)              { return __hip_atomic_load(p, __ATOMIC_RELAXED, __HIP_MEMORY_SCOPE_AGENT); }
__device__ __forceinline__ unsigned xb_add(unsigned* p, unsigned v) { return __hip_atomic_fetch_add(p, v, __ATOMIC_RELAXED, __HIP_MEMORY_SCOPE_AGENT); }
__device__ __forceinline__ unsigned xb_xcc_id() { return (unsigned)__builtin_amdgcn_s_getreg((3 << 11) | 20) & 0xFu; }
#define XB_SPIN(cond, bar) do { unsigned _sp = 0; while (cond) { __builtin_amdgcn_s_sleep(1); \
    if ((++_sp & 255u) == 0u) { if (xb_ld(&(bar)[XB_TMO])) break; if (_sp > XB_SPIN_CAP) { atomicAdd(&(bar)[XB_TMO], 1u); break; } } } } while (0)
struct XcdBarrier { unsigned* bar; unsigned x; volatile LAS unsigned* st; };
__device__ __forceinline__ XcdBarrier xcd_barrier_post(unsigned* bar, volatile LAS unsigned* st, bool t0  ) {
    XcdBarrier b; b.bar = bar; b.x = xb_xcc_id(); b.st = st;
    if (t0) (void)xb_add(&bar[XB_XCNT(b.x)], 1u);
    return b;
}
__device__ __forceinline__ void xcd_barrier_complete(unsigned* bar, unsigned x, unsigned& nloc, unsigned& nx) {
    const unsigned G = gridDim.x * gridDim.y * gridDim.z;
    unsigned sum, cnt, mine, sp = 0u;
    for (;;) {
        sum = 0u; cnt = 0u; mine = 0u;
#pragma unroll
        for (unsigned j = 0; j < 16; ++j) { const unsigned c = xb_ld(&bar[XB_XCNT(j)]); sum += c; cnt += (c > 0u) ? 1u : 0u; mine = (j == x) ? c : mine; }
        if (sum == G) break;
        __builtin_amdgcn_s_sleep(1);
        if ((++sp & 255u) == 0u) { if (xb_ld(&bar[XB_TMO])) break; if (sp > XB_SPIN_CAP) { atomicAdd(&bar[XB_TMO], 1u); break; } }
    }
    nloc = mine > 0u ? mine : 1u; nx = cnt > 0u ? cnt : 1u;
}
__device__ __forceinline__ void xcd_barrier(const XcdBarrier& b, bool t0  ) {
    asm volatile("s_waitcnt vmcnt(0)" ::: "memory");
    __syncthreads();
    if (t0) {
        unsigned* bar = b.bar;
        __builtin_amdgcn_s_waitcnt(0);
        unsigned nloc = b.st[0], nx = b.st[1];
        if (nloc == 0u) { xcd_barrier_complete(bar, b.x, nloc, nx); b.st[0] = nloc; b.st[1] = nx; }
        const unsigned old = xb_add(&bar[XB_XSUB(b.x)], 1u);
        const unsigned gen = old / nloc;
        if (old + 1u == (gen + 1u) * nloc) {
            __builtin_amdgcn_fence(__ATOMIC_RELEASE, "agent");
            asm volatile("s_waitcnt vmcnt(0)" ::: "memory");
            const unsigned og = xb_add(&bar[XB_TOP], 1u);
            const unsigned tg = og / nx;
            if (og + 1u == (tg + 1u) * nx) xb_add(&bar[XB_TOPGEN], 1u);
            else XB_SPIN(xb_ld(&bar[XB_TOPGEN]) == tg, bar);
            __builtin_amdgcn_fence(__ATOMIC_ACQUIRE, "agent");
            xb_add(&bar[XB_XGEN(b.x)], 1u);
            asm volatile("s_waitcnt vmcnt(0)" ::: "memory");
        } else {
            XB_SPIN(xb_ld(&bar[XB_XGEN(b.x)]) == gen, bar);
            __builtin_amdgcn_fence(__ATOMIC_ACQUIRE, "agent");
            asm volatile("s_waitcnt vmcnt(0)" ::: "memory");
        }
    }
    __syncthreads();
}

__device__ __forceinline__ int fresh_tid(int wave) { int t = wave * 64 + lane_id(); asm volatile("" : "+v"(t)); return t; }
struct Args { const float* in[21]; float* out; unsigned char* ws; int ph_lo, ph_hi, variant, pad; };

__device__ __forceinline__ void transpose_item(const float* W, int ld_src, int n0s, int k0, bf16* WT, int K, int n0d, float cscale, const float* kscale, LAS float* scr, int lane) {
#pragma unroll 8
    for (int i = 0; i < 32; ++i) { const int kk = 2 * i + (lane >> 5); float v = W[(size_t)(k0 + kk) * ld_src + n0s + (lane & 31)] * cscale; if (kscale) v *= kscale[k0 + kk]; scr[kk * 33 + (lane & 31)] = v; }
    LDS_WAIT(); asm volatile("" ::: "memory");
    const int c = lane & 7;
#pragma unroll
    for (int j = 0; j < 4; ++j) { const int n = (lane >> 3) + 8 * j; const LAS float* s = scr + (8 * c) * 33 + n;
        v4u o; o.x = pk2(s[0 * 33], s[1 * 33]); o.y = pk2(s[2 * 33], s[3 * 33]); o.z = pk2(s[4 * 33], s[5 * 33]); o.w = pk2(s[6 * 33], s[7 * 33]);
        *(v4u*)(WT + (size_t)(n0d + n) * K + k0 + 8 * c) = o; }
    LDS_WAIT(); asm volatile("" ::: "memory");
}

__device__ __forceinline__ int pk4_fp8(float a, float b, float c, float d) { int w = 0; w = __builtin_amdgcn_cvt_pk_fp8_f32(a, b, w, false); w = __builtin_amdgcn_cvt_pk_fp8_f32(c, d, w, true); return w; }
__device__ __forceinline__ void transpose_item_f8(const float* W, int ld_src, int n0s, int k0, unsigned char* WT, int K, int n0d, float cscale, LAS float* scr, int lane) {
#pragma unroll 8
    for (int i = 0; i < 32; ++i) { const int kk = 2 * i + (lane >> 5); scr[kk * 33 + (lane & 31)] = W[(size_t)(k0 + kk) * ld_src + n0s + (lane & 31)] * cscale; }
    LDS_WAIT(); asm volatile("" ::: "memory");
    const int c = lane & 3;
#pragma unroll
    for (int j = 0; j < 2; ++j) { const int n = (lane >> 2) + 16 * j; const LAS float* s = scr + (16 * c) * 33 + n;
        v4u o; o.x = (unsigned)pk4_fp8(s[0 * 33], s[1 * 33], s[2 * 33], s[3 * 33]); o.y = (unsigned)pk4_fp8(s[4 * 33], s[5 * 33], s[6 * 33], s[7 * 33]);
        o.z = (unsigned)pk4_fp8(s[8 * 33], s[9 * 33], s[10 * 33], s[11 * 33]); o.w = (unsigned)pk4_fp8(s[12 * 33], s[13 * 33], s[14 * 33], s[15 * 33]);
        *(v4u*)(WT + (size_t)(n0d + n) * K + k0 + 16 * c) = o; }
    LDS_WAIT(); asm volatile("" ::: "memory");
}

template <int R, bool OUT_F8, bool IN_BF16>
__device__ __forceinline__ void rownorm_proj(const void* srcv, const f32x4 (&wn)[4], const LAS float* Wl, void* dst, int lane, float (&res)[R]) {
    float xv[R][16];
#pragma unroll
    for (int r = 0; r < R; ++r) {
        float ss = 0.f; f32x4 v[4];
#pragma unroll
        for (int j = 0; j < 4; ++j) { if constexpr (IN_BF16) { const v2u w = *(const v2u*)((const bf16*)srcv + (size_t)r * 1024 + 4 * lane + 256 * j); v[j] = (f32x4){bflo(w.x), bfhi(w.x), bflo(w.y), bfhi(w.y)}; }
            else v[j] = *(const f32x4*)((const float*)srcv + (size_t)r * 1024 + 4 * lane + 256 * j);
            ss += (v[j][0] * v[j][0] + v[j][1] * v[j][1]) + (v[j][2] * v[j][2] + v[j][3] * v[j][3]); }
        ss = wave_sum(ss);
        const float rs = 1.0f / sqrtf(ss * (1.0f / 1024.0f) + RMS_EPS);
#pragma unroll
        for (int j = 0; j < 4; ++j) { v[j] = v[j] * rs * wn[j];
#pragma unroll
            for (int i = 0; i < 4; ++i) xv[r][4 * j + i] = v[j][i];
            if constexpr (OUT_F8) *(int*)((unsigned char*)dst + (size_t)r * 1024 + 4 * lane + 256 * j) = pk4_fp8(v[j][0], v[j][1], v[j][2], v[j][3]);
            else { v2u w; w.x = pk2(v[j][0], v[j][1]); w.y = pk2(v[j][2], v[j][3]); *(v2u*)((bf16*)dst + (size_t)r * 1024 + 4 * lane + 256 * j) = w; } }
    }
    float acc[R][32];
#pragma unroll
    for (int r = 0; r < R; ++r)
#pragma unroll
        for (int c = 0; c < 32; ++c) acc[r][c] = 0.f;
#pragma unroll
    for (int j = 0; j < 16; ++j) {
        const LAS float* wrow = Wl + (lane + 64 * j) * WL_LD; asm volatile("" ::: "memory");
#pragma unroll
        for (int c4 = 0; c4 < 8; ++c4) { const f32x4 w = *(const LAS f32x4*)(wrow + 4 * c4);
#pragma unroll
            for (int r = 0; r < R; ++r) { acc[r][4 * c4 + 0] += xv[r][j] * w[0]; acc[r][4 * c4 + 1] += xv[r][j] * w[1]; acc[r][4 * c4 + 2] += xv[r][j] * w[2]; acc[r][4 * c4 + 3] += xv[r][j] * w[3]; } }
    }
#pragma unroll
    for (int r = 0; r < R; ++r) {
#pragma unroll
        for (int i = 0; i < 16; ++i) { const bool up = lane & 16; const float keep = up ? acc[r][i + 16] : acc[r][i], send = up ? acc[r][i] : acc[r][i + 16]; acc[r][i] = keep + __shfl_xor(send, 16); }
#pragma unroll
        for (int i = 0; i < 8; ++i) { const bool up = lane & 8; const float keep = up ? acc[r][i + 8] : acc[r][i], send = up ? acc[r][i] : acc[r][i + 8]; acc[r][i] = keep + __shfl_xor(send, 8); }
#pragma unroll
        for (int i = 0; i < 4; ++i) { const bool up = lane & 4; const float keep = up ? acc[r][i + 4] : acc[r][i], send = up ? acc[r][i] : acc[r][i + 4]; acc[r][i] = keep + __shfl_xor(send, 4); }
#pragma unroll
        for (int i = 0; i < 2; ++i) { const bool up = lane & 2; const float keep = up ? acc[r][i + 2] : acc[r][i], send = up ? acc[r][i] : acc[r][i + 2]; acc[r][i] = keep + __shfl_xor(send, 2); }
        { const bool up = lane & 1; const float keep = up ? acc[r][1] : acc[r][0], send = up ? acc[r][0] : acc[r][1]; acc[r][0] = keep + __shfl_xor(send, 1); }
        res[r] = acc[r][0] + __shfl_xor(acc[r][0], 32);
    }
}

namespace mx {
typedef short s8v __attribute__((ext_vector_type(8)));
typedef short s4v __attribute__((ext_vector_type(4)));
#define MX_MFMA(a, b, c) __builtin_amdgcn_mfma_f32_16x16x32_bf16(a, b, c, 0, 0, 0)
#define MX_SB() __builtin_amdgcn_sched_barrier(0)
#define MX_BAR() do { MX_SB(); asm volatile("s_waitcnt lgkmcnt(0)" ::: "memory"); __builtin_amdgcn_s_barrier(); asm volatile("" ::: "memory"); } while (0)
constexpr int TS = 288, TILE = 64 * TS, PS = 144, PTILE = 64 * PS, BUF = 3 * TILE;
struct LaneBase { unsigned row, perm, tr, prow; };
__device__ __forceinline__ LaneBase lane_base(int lane) { LaneBase L; const unsigned g = lane >> 4, i = lane & 15, q = i >> 2, p = lane & 3;
    L.row = i * TS + g * 16; L.perm = i * TS + g * 8; L.tr = (8 * g + q) * TS + p * 8; L.prow = i * PS + g * 16; return L; }
#define LD_ROW(t, L, rb, s) (*(const LAS mx::s8v*)((t) + (L).row + (rb) * 16 * mx::TS + (s) * 64))
#define LD_ROWP(t, L, rb, s) (*(const LAS mx::s8v*)((t) + (L).prow + (rb) * 16 * mx::PS + (s) * 64))
__device__ __forceinline__ s8v ld_perm2(const LAS unsigned char* p) { const s4v lo = *(const LAS s4v*)p, hi = *(const LAS s4v*)(p + 32); return (s8v){lo[0], lo[1], lo[2], lo[3], hi[0], hi[1], hi[2], hi[3]}; }
#define LD_PERM(t, L, rb, s) mx::ld_perm2((t) + (L).perm + (rb) * 16 * mx::TS + (s) * 64)
__device__ __forceinline__ s8v ld_tr2(const LAS unsigned char* p) {
    const s4v a = __builtin_amdgcn_ds_read_tr16_b64_v4i16((LAS s4v*)p), b = __builtin_amdgcn_ds_read_tr16_b64_v4i16((LAS s4v*)(p + 4 * TS));
    return (s8v){a[0], a[1], a[2], a[3], b[0], b[1], b[2], b[3]}; }
#define LD_TR(t, L, c, ks) mx::ld_tr2((t) + (L).tr + (ks) * 32 * mx::TS + (c) * 32)
__device__ __forceinline__ void dma_tiles(LAS unsigned char* buf, const bf16* g0, int gstride, int co0, int co1, int co2, int wave, int lane) {
#pragma unroll
    for (int pp = 0; pp < 7; ++pp) { const int piece = wave + 8 * pp; if (piece < 54) { const unsigned o = piece * 1024 + lane * 16, tl = o / TILE, ot = o - tl * TILE, row = ot / TS, wb = ot - row * TS;
        const int co = tl == 0 ? co0 : (tl == 1 ? co1 : co2);
        __builtin_amdgcn_global_load_lds((const unsigned*)(g0 + (size_t)row * gstride + co + (wb < 256 ? wb >> 1 : 0)), (LAS unsigned*)(buf + piece * 1024), 16, 0, 0); } }
}
#define MX_DPPF(old, src, ctrl, rm) __builtin_bit_cast(float, __builtin_amdgcn_update_dpp(__builtin_bit_cast(int, (float)(old)), __builtin_bit_cast(int, (float)(src)), ctrl, rm, 0xf, false))
__device__ __forceinline__ float scan_add(float x) {
    x += MX_DPPF(0.f, x, 0x111, 0xf); x += MX_DPPF(0.f, x, 0x112, 0xf); x += MX_DPPF(0.f, x, 0x114, 0xf); x += MX_DPPF(0.f, x, 0x118, 0xf);
    x += MX_DPPF(0.f, x, 0x142, 0xa); x += MX_DPPF(0.f, x, 0x143, 0xc); return x; }
__device__ __forceinline__ float scan_max(float x) { const float ninf = -INFINITY;
    x = fmaxf(x, MX_DPPF(ninf, x, 0x111, 0xf)); x = fmaxf(x, MX_DPPF(ninf, x, 0x112, 0xf)); x = fmaxf(x, MX_DPPF(ninf, x, 0x114, 0xf)); x = fmaxf(x, MX_DPPF(ninf, x, 0x118, 0xf));
    x = fmaxf(x, MX_DPPF(ninf, x, 0x142, 0xa)); x = fmaxf(x, MX_DPPF(ninf, x, 0x143, 0xc)); return x; }
__device__ __forceinline__ float lane63(float x) { return __builtin_bit_cast(float, __builtin_amdgcn_readlane(__builtin_bit_cast(int, x), 63)); }
__device__ __forceinline__ float softplus_fast(float x) { return fmaxf(x, 0.f) + __logf(1.0f + __expf(-fabsf(x))); }
__device__ __forceinline__ s8v pack_acc(const f32x4& a, const f32x4& b) {
    const unsigned w0 = pk2(a[0], a[1]), w1 = pk2(a[2], a[3]), w2 = pk2(b[0], b[1]), w3 = pk2(b[2], b[3]);
    v4u w = {w0, w1, w2, w3}; return __builtin_bit_cast(s8v, w);
}
__device__ __forceinline__ void unpack8(const v4u& w, float (&f)[8]) { f[0] = bflo(w.x); f[1] = bfhi(w.x); f[2] = bflo(w.y); f[3] = bfhi(w.y); f[4] = bflo(w.z); f[5] = bfhi(w.z); f[6] = bflo(w.w); f[7] = bfhi(w.w); }

__device__ __forceinline__ void mlstm_item(LAS unsigned char* lds, int item, int var, int wave, const bf16* __restrict__ PROJ, const float* __restrict__ GATES, const float* __restrict__ lnw, bf16* __restrict__ MIX) {
    const int lane = lane_id(), tid = wave * 64 + lane, g = lane >> 4, c16 = lane & 15;
    const int b = item >> 3, h = item & 7;
    const LaneBase L = lane_base(lane);
    LAS unsigned char* TP = lds + 2 * BUF; LAS unsigned char* TO = TP + PTILE;
    LAS float* denP = (LAS float*)(TO + TILE); LAS float* qnp = denP + 128; LAS float* nsh = qnp + 512;
    LAS float* Au = nsh + 128; LAS float* Avv = Au + 64; LAS float* Awi = Avv + 64; LAS float* Akw = Awi + 64; LAS float* Aid = Akw + 64;
    f32x4 Cst[8];
#pragma unroll
    for (int i = 0; i < 8; ++i) Cst[i] = (f32x4){0.f, 0.f, 0.f, 0.f};
    float nreg = 0.f, m_prev = 0.f;
    if (lane < 16) nsh[wave * 16 + lane] = 0.f;
    const int srow = tid >> 3, sch = tid & 7;
    const bf16* qbase = PROJ + (size_t)(b * SEQ) * NPROJ + h * 128;
    dma_tiles(lds, qbase, NPROJ, C_Q, C_K, C_V, wave, lane);
    float fnext = GATES[(size_t)(b * SEQ + lane) * 32 + 24 + h], inext = GATES[(size_t)(b * SEQ + lane) * 32 + 16 + h];
    asm volatile("s_waitcnt vmcnt(0)" ::: "memory"); MX_BAR();
#pragma unroll 1
    for (int c = 0; c < SEQ / 64; ++c) {
        const int cur = c & 1; const int t0 = b * SEQ + c * 64;
        LAS unsigned char* TQ = lds + cur * BUF; LAS unsigned char* TK = TQ + TILE; LAS unsigned char* TV = TQ + 2 * TILE;
        float fraw = fnext, iraw = inext; asm volatile("" : "+v"(fraw), "+v"(iraw));
        MX_SB();
        const v4u ov0 = *(const v4u*)(PROJ + (size_t)(t0 + srow) * NPROJ + C_O + h * 128 + 8 * sch), ov1 = *(const v4u*)(PROJ + (size_t)(t0 + srow) * NPROJ + C_O + h * 128 + 64 + 8 * sch);
        { const int tn = (c + 1 < SEQ / 64 ? t0 + 64 : t0) + lane; fnext = GATES[(size_t)tn * 32 + 24 + h]; inext = GATES[(size_t)tn * 32 + 16 + h]; }
        if (c + 1 < SEQ / 64 && !(var & 1)) { int lv = lane; asm volatile("" : "+v"(lv)); dma_tiles(lds + (cur ^ 1) * BUF, qbase + (size_t)(c + 1) * 64 * NPROJ, NPROJ, C_Q, C_K, C_V, wave, lv); }
        MX_SB();
        const float lf = -softplus_fast(-fraw), cf = scan_add(lf), chunk_f = lane63(cf);
        const float u = iraw - cf, Mx = scan_max(u);
        const float m_row = cf + fmaxf(m_prev, Mx), vv = cf - m_row;
        const float m_loc = chunk_f + lane63(Mx), m_new = fmaxf(chunk_f + m_prev, m_loc);
        const float w_inter = __expf(vv + m_prev), floorv = __expf(-m_row), kw = __expf(chunk_f + u - m_new), s_old = __expf(chunk_f + m_prev - m_new);
        Au[lane] = u; Avv[lane] = vv; Awi[lane] = w_inter; Akw[lane] = kw;
        if (!(var & 2)) { const int lt = wave & 3, jt0 = 2 * (wave >> 2); const float vv_l = Avv[16 * lt + c16]; float rsum = 0.f;
#pragma unroll
          for (int jj = 0; jj < 2; ++jj) { const int jt = jt0 + jj; float pv[4] = {0.f, 0.f, 0.f, 0.f};
            if (jt <= lt) { f32x4 acc = {0.f, 0.f, 0.f, 0.f};
#pragma unroll
                for (int ks = 0; ks < 4; ++ks) acc = MX_MFMA(LD_ROW(TK, L, jt, ks), LD_ROW(TQ, L, lt, ks), acc);
                const f32x4 uj = *(const LAS f32x4*)(Au + 16 * jt + 4 * g);
#pragma unroll
                for (int r = 0; r < 4; ++r) { const int j = 16 * jt + 4 * g + r, l = 16 * lt + c16; const float val = (j <= l) ? acc[r] * __expf(vv_l + uj[r]) : 0.f; rsum += val; pv[r] = val; } }
            v2u w; w.x = pk2(pv[0], pv[1]); w.y = pk2(pv[2], pv[3]);
            *(LAS v2u*)(TP + (16 * lt + c16) * PS + (16 * jt + 4 * g) * 2) = w; }
          rsum += __shfl_xor(rsum, 16); rsum += __shfl_xor(rsum, 32);
          if (g == 0) denP[(wave >> 2) * 64 + 16 * lt + c16] = rsum;
          v4u q0 = *(const LAS v4u*)(TQ + lane * TS + wave * 32), q1 = *(const LAS v4u*)(TQ + lane * TS + wave * 32 + 16); float qf[16]; { float t8[8]; unpack8(q0, t8);
#pragma unroll
            for (int e = 0; e < 8; ++e) qf[e] = t8[e]; unpack8(q1, t8);
#pragma unroll
            for (int e = 0; e < 8; ++e) qf[8 + e] = t8[e]; }
          float part = 0.f;
#pragma unroll
          for (int e4 = 0; e4 < 4; ++e4) { const f32x4 nv = *(const LAS f32x4*)(nsh + wave * 16 + 4 * e4); part += qf[4 * e4] * nv[0] + qf[4 * e4 + 1] * nv[1] + qf[4 * e4 + 2] * nv[2] + qf[4 * e4 + 3] * nv[3]; }
          qnp[wave * 64 + lane] = part; }
        MX_BAR();
        float inv_den; { float qn = 0.f;
#pragma unroll
          for (int w = 0; w < 8; ++w) qn += qnp[w * 64 + lane];
          float den = denP[lane] + denP[64 + lane] + w_inter * qn; den = fmaxf(fabsf(den), floorv); inv_den = __builtin_amdgcn_rcpf(den); Aid[lane] = inv_den; }
        { s8v sf[4];
#pragma unroll
          for (int ks = 0; ks < 4; ++ks) sf[ks] = pack_acc(Cst[2 * ks], Cst[2 * ks + 1]);
          const s8v vf0 = LD_TR(TV + wave * 32, L, 0, 0), vf1 = LD_TR(TV + wave * 32, L, 0, 1);
          if (!(var & 4))
#pragma unroll
          for (int lt = 0; lt < 4; ++lt) { f32x4 acc = {0.f, 0.f, 0.f, 0.f};
#pragma unroll
            for (int ks = 0; ks < 4; ++ks) acc = MX_MFMA(sf[ks], LD_PERM(TQ, L, lt, ks), acc);
            acc = acc * Awi[16 * lt + c16];
            acc = MX_MFMA(vf0, LD_ROWP(TP, L, lt, 0), acc);
            if (lt >= 2) acc = MX_MFMA(vf1, LD_ROWP(TP, L, lt, 1), acc);
            acc = acc * Aid[16 * lt + c16];
            v2u w; w.x = pk2(acc[0], acc[1]); w.y = pk2(acc[2], acc[3]);
            *(LAS v2u*)(TO + (16 * lt + c16) * TS + (16 * wave + 4 * g) * 2) = w; }
#pragma unroll
          for (int i = 0; i < 8; ++i) Cst[i] = Cst[i] * s_old;
          if (!(var & 8))
#pragma unroll
          for (int ks = 0; ks < 2; ++ks) { const s8v vf = ks ? vf1 : vf0; const v4u vw = __builtin_bit_cast(v4u, vf); float f[8]; unpack8(vw, f);
            { const f32x4 k0 = *(const LAS f32x4*)(Akw + 32 * ks + 8 * g), k1 = *(const LAS f32x4*)(Akw + 32 * ks + 8 * g + 4);
#pragma unroll
              for (int e = 0; e < 4; ++e) { f[e] *= k0[e]; f[4 + e] *= k1[e]; } }
            v4u pw = {pk2(f[0], f[1]), pk2(f[2], f[3]), pk2(f[4], f[5]), pk2(f[6], f[7])}; const s8v vwf = __builtin_bit_cast(s8v, pw);
#pragma unroll
            for (int dkt = 0; dkt < 8; ++dkt) Cst[dkt] = MX_MFMA(LD_TR(TK, L, dkt, ks), vwf, Cst[dkt]); }
          float part = 0.f;
#pragma unroll
          for (int e4 = 0; e4 < 4; ++e4) { const f32x4 kk = *(const LAS f32x4*)(Akw + 16 * g + 4 * e4);
#pragma unroll
            for (int e = 0; e < 4; ++e) { const int j = 16 * g + 4 * e4 + e; part += bf2f(*(const LAS unsigned short*)(TK + j * TS + (16 * wave + c16) * 2)) * kk[e]; } }
          part += __shfl_xor(part, 16); part += __shfl_xor(part, 32);
          nreg = s_old * nreg + part; if (g == 0) nsh[wave * 16 + c16] = nreg;
          m_prev = m_new; }
        asm volatile("s_waitcnt vmcnt(0)" ::: "memory"); MX_BAR();
        if (!(var & 16)) { const v4u a = *(const LAS v4u*)(TO + srow * TS + sch * 16), bq = *(const LAS v4u*)(TO + srow * TS + sch * 16 + 128); float f[16], of[16]; { float t8[8]; unpack8(a, t8);
#pragma unroll
            for (int e = 0; e < 8; ++e) f[e] = t8[e]; unpack8(bq, t8);
#pragma unroll
            for (int e = 0; e < 8; ++e) f[8 + e] = t8[e]; unpack8(ov0, t8);
#pragma unroll
            for (int e = 0; e < 8; ++e) of[e] = t8[e]; unpack8(ov1, t8);
#pragma unroll
            for (int e = 0; e < 8; ++e) of[8 + e] = t8[e]; }
          float ss = 0.f;
#pragma unroll
          for (int e = 0; e < 16; ++e) ss += f[e] * f[e];
          ss += __shfl_xor(ss, 1); ss += __shfl_xor(ss, 2); ss += __shfl_xor(ss, 4);
          const float rs = rsqrt_f(ss * (1.0f / 128.0f) + RMS_EPS);
          float wn[16]; { const f32x4 w0 = *(const f32x4*)(lnw + h * 128 + 8 * sch), w1 = *(const f32x4*)(lnw + h * 128 + 8 * sch + 4), w2 = *(const f32x4*)(lnw + h * 128 + 64 + 8 * sch), w3 = *(const f32x4*)(lnw + h * 128 + 64 + 8 * sch + 4);
#pragma unroll
            for (int e = 0; e < 4; ++e) { wn[e] = w0[e]; wn[4 + e] = w1[e]; wn[8 + e] = w2[e]; wn[12 + e] = w3[e]; } }
#pragma unroll
          for (int e = 0; e < 16; ++e) f[e] = f[e] * rs * wn[e] * sigmoid_f(of[e]);
          v4u o0 = {pk2(f[0], f[1]), pk2(f[2], f[3]), pk2(f[4], f[5]), pk2(f[6], f[7])}, o1 = {pk2(f[8], f[9]), pk2(f[10], f[11]), pk2(f[12], f[13]), pk2(f[14], f[15])};
          bf16* mp = MIX + (size_t)(t0 + srow) * 2048 + 1024 + h * 128 + 8 * sch; *(v4u*)mp = o0; *(v4u*)(mp + 64) = o1; }
    }
    MX_BAR();
}

__device__ __forceinline__ void ssd_item(LAS unsigned char* lds, int item, int var, int wave, const bf16* __restrict__ XBC, const bf16* __restrict__ PROJ, const float* __restrict__ GATES, const float* __restrict__ a_log,
                                         const float* __restrict__ d_skip, bf16* __restrict__ MIX, float* __restrict__ SSQ) {
    const int lane = lane_id(), tid = wave * 64 + lane, g = lane >> 4, c16 = lane & 15;
    const int b = item >> 3, hp = item & 7, grp = hp >> 2, hh = wave >> 2, ps = wave & 3;
    const LaneBase L = lane_base(lane);
    LAS unsigned char* TG = lds + 2 * BUF;
    LAS unsigned char* TO = TG + 2 * PTILE;
    LAS float* Aacs = (LAS float*)(TO + TILE); LAS float* Adinv = Aacs + 128; LAS float* Adt = Adinv + 128; LAS float* Awd = Adt + 128; LAS float* Aea = Awd + 128;
    f32x4 RT[8];
#pragma unroll
    for (int i = 0; i < 8; ++i) RT[i] = (f32x4){0.f, 0.f, 0.f, 0.f};
    const float an0 = -__expf(a_log[2 * hp]), an1 = -__expf(a_log[2 * hp + 1]), dk0 = d_skip[2 * hp], dk1 = d_skip[2 * hp + 1];
    const int srow = tid >> 3, sch = tid & 7;
    const bf16* xb = XBC + (size_t)(b * SEQ) * 1536;
    dma_tiles(lds, xb, 1536, 1280 + grp * 128, 1024 + grp * 128, hp * 128, wave, lane);
    float dn0 = GATES[(size_t)(b * SEQ + lane) * 32 + 2 * hp], dn1 = GATES[(size_t)(b * SEQ + lane) * 32 + 2 * hp + 1];
    asm volatile("s_waitcnt vmcnt(0)" ::: "memory"); MX_BAR();
#pragma unroll 1
    for (int c = 0; c < SEQ / 64; ++c) {
        const int cur = c & 1; const int t0 = b * SEQ + c * 64;
        LAS unsigned char* TC = lds + cur * BUF; LAS unsigned char* TB = TC + TILE; LAS unsigned char* TX = TC + 2 * TILE;
        float dr0 = dn0, dr1 = dn1; asm volatile("" : "+v"(dr0), "+v"(dr1));
        MX_SB();
        const v4u zv0 = *(const v4u*)(PROJ + (size_t)(t0 + srow) * NPROJ + C_Z + hp * 128 + 8 * sch), zv1 = *(const v4u*)(PROJ + (size_t)(t0 + srow) * NPROJ + C_Z + hp * 128 + 64 + 8 * sch);
        { const int tn = (c + 1 < SEQ / 64 ? t0 + 64 : t0) + lane; dn0 = GATES[(size_t)tn * 32 + 2 * hp]; dn1 = GATES[(size_t)tn * 32 + 2 * hp + 1]; }
        if (c + 1 < SEQ / 64 && !(var & 1)) { int lv = lane; asm volatile("" : "+v"(lv)); dma_tiles(lds + (cur ^ 1) * BUF, xb + (size_t)(c + 1) * 64 * 1536, 1536, 1280 + grp * 128, 1024 + grp * 128, hp * 128, wave, lv); }
        MX_SB();
        const float dt0 = softplus_fast(dr0), dt1 = softplus_fast(dr1);
        const float acs0 = scan_add(dt0 * an0), acs1 = scan_add(dt1 * an1);
        const float aend0 = lane63(acs0), aend1 = lane63(acs1);
        Aacs[lane] = acs0; Aacs[64 + lane] = acs1; Adinv[lane] = dk0 * __builtin_amdgcn_rcpf(dt0); Adinv[64 + lane] = dk1 * __builtin_amdgcn_rcpf(dt1); Adt[lane] = dt0; Adt[64 + lane] = dt1;
        Awd[lane] = __expf(aend0 - acs0); Awd[64 + lane] = __expf(aend1 - acs1); Aea[lane] = __expf(acs0); Aea[64 + lane] = __expf(acs1);
        const float aend = hh ? aend1 : aend0;
        if (!(var & 2)) { const int lt = wave & 3, st0 = 2 * (wave >> 2); const int l = 16 * lt + c16;
          const float al0 = Aacs[l], al1 = Aacs[64 + l], di0 = Adinv[l], di1 = Adinv[64 + l];
#pragma unroll
          for (int ss = 0; ss < 2; ++ss) { const int st = st0 + ss; float p0[4] = {0.f, 0.f, 0.f, 0.f}, p1[4] = {0.f, 0.f, 0.f, 0.f};
            if (st <= lt) { f32x4 acc = {0.f, 0.f, 0.f, 0.f};
#pragma unroll
                for (int ks = 0; ks < 4; ++ks) acc = MX_MFMA(LD_ROW(TB, L, st, ks), LD_ROW(TC, L, lt, ks), acc);
                const f32x4 as0 = *(const LAS f32x4*)(Aacs + 16 * st + 4 * g), as1 = *(const LAS f32x4*)(Aacs + 64 + 16 * st + 4 * g);
#pragma unroll
                for (int r = 0; r < 4; ++r) { const int sidx = 16 * st + 4 * g + r;
                    float v0 = (sidx <= l) ? acc[r] * __expf(al0 - as0[r]) : 0.f, v1 = (sidx <= l) ? acc[r] * __expf(al1 - as1[r]) : 0.f;
                    if (sidx == l) { v0 += di0; v1 += di1; } p0[r] = v0; p1[r] = v1; } }
            v2u w0, w1; w0.x = pk2(p0[0], p0[1]); w0.y = pk2(p0[2], p0[3]); w1.x = pk2(p1[0], p1[1]); w1.y = pk2(p1[2], p1[3]);
            const unsigned o = l * PS + (16 * st + 4 * g) * 2;
            *(LAS v2u*)(TG + o) = w0; *(LAS v2u*)(TG + PTILE + o) = w1; } }
        MX_BAR();
        { s8v sf[4];
#pragma unroll
          for (int ks = 0; ks < 4; ++ks) sf[ks] = pack_acc(RT[2 * ks], RT[2 * ks + 1]);
          s8v xd[2], xw[2];
#pragma unroll
          for (int ks = 0; ks < 2; ++ks) { const s8v xf = LD_TR(TX + (4 * hh + ps) * 32, L, 0, ks); const v4u xv = __builtin_bit_cast(v4u, xf); float f[8], fw[8]; unpack8(xv, f);
            { const LAS float* pd = Adt + 64 * hh + 32 * ks + 8 * g; const LAS float* pw = Awd + 64 * hh + 32 * ks + 8 * g; const f32x4 d0 = *(const LAS f32x4*)pd, d1 = *(const LAS f32x4*)(pd + 4), w0 = *(const LAS f32x4*)pw, w1 = *(const LAS f32x4*)(pw + 4);
#pragma unroll
              for (int e = 0; e < 4; ++e) { f[e] *= d0[e]; fw[e] = f[e] * w0[e]; f[4 + e] *= d1[e]; fw[4 + e] = f[4 + e] * w1[e]; } }
            v4u a = {pk2(f[0], f[1]), pk2(f[2], f[3]), pk2(f[4], f[5]), pk2(f[6], f[7])}, bw = {pk2(fw[0], fw[1]), pk2(fw[2], fw[3]), pk2(fw[4], fw[5]), pk2(fw[6], fw[7])};
            xd[ks] = __builtin_bit_cast(s8v, a); xw[ks] = __builtin_bit_cast(s8v, bw); }
          const LAS unsigned char* TGm = TG + hh * PTILE;
          if (!(var & 4))
#pragma unroll
          for (int lt = 0; lt < 4; ++lt) { f32x4 acc = {0.f, 0.f, 0.f, 0.f};
#pragma unroll
            for (int ks = 0; ks < 4; ++ks) acc = MX_MFMA(sf[ks], LD_PERM(TC, L, lt, ks), acc);
            acc = acc * Aea[64 * hh + 16 * lt + c16];
            acc = MX_MFMA(xd[0], LD_ROWP(TGm, L, lt, 0), acc);
            if (lt >= 2) acc = MX_MFMA(xd[1], LD_ROWP(TGm, L, lt, 1), acc);
            v2u w; w.x = pk2(acc[0], acc[1]); w.y = pk2(acc[2], acc[3]);
            *(LAS v2u*)(TO + (16 * lt + c16) * TS + (64 * hh + 16 * ps + 4 * g) * 2) = w; }
          const float ea = __expf(aend);
#pragma unroll
          for (int i = 0; i < 8; ++i) RT[i] = RT[i] * ea;
          if (!(var & 8))
#pragma unroll
          for (int ks = 0; ks < 2; ++ks)
#pragma unroll
            for (int nt = 0; nt < 8; ++nt) RT[nt] = MX_MFMA(LD_TR(TB, L, nt, ks), xw[ks], RT[nt]); }
        asm volatile("s_waitcnt vmcnt(0)" ::: "memory"); MX_BAR();
        if (!(var & 16)) { const v4u a = *(const LAS v4u*)(TO + srow * TS + sch * 16), bq = *(const LAS v4u*)(TO + srow * TS + sch * 16 + 128); float f[16], zf[16]; { float t8[8]; unpack8(a, t8);
#pragma unroll
            for (int e = 0; e < 8; ++e) f[e] = t8[e]; unpack8(bq, t8);
#pragma unroll
            for (int e = 0; e < 8; ++e) f[8 + e] = t8[e]; unpack8(zv0, t8);
#pragma unroll
            for (int e = 0; e < 8; ++e) zf[e] = t8[e]; unpack8(zv1, t8);
#pragma unroll
            for (int e = 0; e < 8; ++e) zf[8 + e] = t8[e]; }
          float ss = 0.f;
#pragma unroll
          for (int e = 0; e < 16; ++e) { f[e] = f[e] * silu_f(zf[e]); ss += f[e] * f[e]; }
          ss += __shfl_xor(ss, 1); ss += __shfl_xor(ss, 2); ss += __shfl_xor(ss, 4);
          if (sch == 0) SSQ[(size_t)(t0 + srow) * 8 + hp] = ss;
          v4u o0 = {pk2(f[0], f[1]), pk2(f[2], f[3]), pk2(f[4], f[5]), pk2(f[6], f[7])}, o1 = {pk2(f[8], f[9]), pk2(f[10], f[11]), pk2(f[12], f[13]), pk2(f[14], f[15])};
          bf16* mp = MIX + (size_t)(t0 + srow) * 2048 + hp * 128 + 8 * sch; *(v4u*)mp = o0; *(v4u*)(mp + 64) = o1; }
    }
    MX_BAR();
}
}

__device__ __forceinline__ int wl_k(int p) { return 4 * (p & 63) + 256 * (p >> 8) + ((p >> 6) & 3); }
constexpr int RN = 2;

__global__ void __launch_bounds__(NTHR, 2) mega(Args args) {
    extern __shared__ __attribute__((aligned(16))) unsigned char lds_raw[];
    LAS unsigned char* lds = (LAS unsigned char*)lds_raw;
    const int wave = __builtin_amdgcn_readfirstlane((int)threadIdx.x >> 6);
    const int lane = lane_id(), tid = wave * 64 + lane;
    const int G = gridDim.x, bx = blockIdx.x;
    unsigned char* ws = args.ws;
#define INP(k) ({ int _k = (k); asm volatile("" : "+s"(_k)); args.in[_k]; })
#define XIN INP(0)
#define Win_t ((bf16*)(ws + WS_WIN))
#define Wout_t ((bf16*)(ws + WS_WOUT))
#define XN ((bf16*)(ws + WS_XN))
#define H ((bf16*)(ws + WS_H))
#define GATES ((float*)(ws + WS_GATES))
#define PROJ ((bf16*)(ws + WS_PROJ))
#define MIX ((bf16*)(ws + WS_MIX))
#define EO8 (ws + WS_XG + 136 * MiB)
#define TOPI ((int*)(ws + WS_ROUTE + R_TOPI))
#define TOPG ((float*)(ws + WS_ROUTE + R_TOPG))
#define TOKROW ((int*)(ws + WS_ROUTE + R_TOKROW))
#define ROWTOK ((int*)(ws + WS_ROUTE + R_ROWTOK))
#define ROWGATE ((float*)(ws + WS_ROUTE + R_ROWGATE))
#define BLKCNT ((int*)(ws + WS_ROUTE + R_BLKCNT))
#define BLKEXP ((int*)(ws + WS_ROUTE + R_BLKEXP))
#define NBLK ((int*)(ws + WS_ROUTE + R_NBLK))
#define XBC ((bf16*)(ws + WS_XBC))
#define SSQ ((float*)(ws + WS_SSQ))
#define XN8 (ws + WS_XN)
#define XG8 (ws + WS_XG)
#define ACT8 (ws + WS_ACT)
#define Wgu8 (ws + WS_WGU)
#define Wdn8 (ws + WS_WDN)
    const int lo = args.ph_lo, hi = args.ph_hi;
    if (tid < 64) ((LAS unsigned*)(lds + MISC_OFF))[tid] = 0u;
    __syncthreads();
    XcdBarrier bar = xcd_barrier_post((unsigned*)(ws + WS_CTL) + CW_BAR, (volatile LAS unsigned*)(lds + MISC_OFF), tid == 0);
#define GRID_BAR(k) do { if (IN(k) && IN((k) + 1)) xcd_barrier(bar, wave == 0 && lane_id() == 0); } while (0)
#ifndef PH_MASK
#define PH_MASK 0xffff
#endif
#define IN(k) (((PH_MASK >> (k)) & 1) && lo <= (k) && (k) < hi)


    if (IN(0)) {
        const int tid = fresh_tid(wave), lane = tid & 63; (void)lane;
        LAS float* scr = (LAS float*)(lds + wave * 16384);
        const int gw = bx * NWAVES + wave, NGW = G * NWAVES;
        constexpr int I_IN = 16 * (NPROJ / 32), I_OUT = 32 * 32, I_GU = 16 * 64, I_DN = 16 * 32;
        constexpr int NITEMS = I_IN + I_OUT + NE * I_GU + NE * I_DN;
        for (int it = gw; it < NITEMS; it += NGW) {
            int r = it;
            if (r < I_IN) { const int nb = r % (NPROJ / 32), kb = r / (NPROJ / 32), n0 = nb * 32; const int n0s = n0 + (n0 >= C_Q ? 16 : 0);
                const float cs = (n0 >= C_K && n0 < C_V) ? 0.08838834764831845f : 1.0f;
                transpose_item(INP(2), WIN_LD, n0s, kb * 64, Win_t, 1024, n0, cs, nullptr, scr, lane); continue; } r -= I_IN;
            if (r < I_OUT) { const int nb = r % 32, kb = r / 32; transpose_item(INP(12), 1024, nb * 32, kb * 64, Wout_t, 2048, nb * 32, 1.0f, kb < 16 ? INP(8) : nullptr, scr, lane); continue; } r -= I_OUT;
            if (r < NE * I_GU) { const int e = r / I_GU, q = r % I_GU, nb = q % 64, kb = q / 64, rho = nb * 32; const int n0s = ((rho >> 7) & 1) * 1024 + (rho >> 8) * 128 + (rho & 127);
                transpose_item_f8(INP(16) + (size_t)e * 1024 * 2048, 2048, n0s, kb * 64, Wgu8 + (size_t)e * 2048 * 1024, 1024, rho, 64.0f, scr, lane); continue; } r -= NE * I_GU;
            { const int e = r / I_DN, q = r % I_DN, nb = q % 32, kb = q / 32;
                transpose_item_f8(INP(18) + (size_t)e * 1024 * 1024, 1024, nb * 32, kb * 64, Wdn8 + (size_t)e * 1024 * 1024, 1024, nb * 32, 64.0f, scr, lane); }
        }
        __syncthreads();
        LAS float* Wl = (LAS float*)lds;
        for (int i = tid; i < 1024 * 32; i += NTHR) { const int p = i >> 5, c = i & 31; const int sc = c < 16 ? 2560 + c : (c < 24 ? 6672 + (c - 16) : 6680 + (c - 24)); Wl[p * WL_LD + c] = INP(2)[(size_t)wl_k(p) * WIN_LD + sc]; }
        __syncthreads();
        f32x4 wn[4];
#pragma unroll
        for (int j = 0; j < 4; ++j) wn[j] = *(const f32x4*)(INP(1) + 4 * lane + 256 * j);
        const int c = lane & 31; const float gb = c < 16 ? INP(5)[c] : (c < 24 ? INP(9)[c - 16] : INP(10)[c - 24]);
#pragma unroll 1
        for (int row = gw * RN; row < T; row += NGW * RN) {
            float res[RN];
            rownorm_proj<RN, false, false>(XIN + (size_t)row * 1024, wn, Wl, XN + (size_t)row * 1024, lane, res);
#pragma unroll
            for (int r = 0; r < RN; ++r) if (lane < 32) GATES[(size_t)(row + r) * 32 + c] = res[r] + gb;
        }
        __syncthreads();
    }
    GRID_BAR(0);

    if (IN(1)) {
        pg8::Gemm g{XN, Win_t, T, NPROJ, 1024}; pg8::StaticOrder S; S.init(T, NPROJ, G, bx);
        pg8::EpiBf16 E{PROJ, NPROJ};
        pg8::gemm_phase<pg8::EpiBf16, pg8::StaticOrder>(lds, g, S, E, wave);
    }
    GRID_BAR(1);

    if (IN(2)) {
        const int tid = fresh_tid(wave), lane = tid & 63; (void)lane;
        const float* cw = INP(3); const float* cb = INP(4);
#pragma unroll 1
        for (int it = bx * NTHR + tid; it < (T / 16) * 192; it += G * NTHR) {
            const int ch = it % 192, t0 = (it / 192) * 16, c0 = ch * 8;
            float w[4][8], bs[8], r0[8], r1[8], r2[8];
#pragma unroll
            for (int k = 0; k < 4; ++k) { const f32x4 a = *(const f32x4*)(cw + k * 1536 + c0), b2 = *(const f32x4*)(cw + k * 1536 + c0 + 4);
#pragma unroll
                for (int e = 0; e < 4; ++e) { w[k][e] = a[e]; w[k][4 + e] = b2[e]; } }
            { const f32x4 a = *(const f32x4*)(cb + c0), b2 = *(const f32x4*)(cb + c0 + 4);
#pragma unroll
              for (int e = 0; e < 4; ++e) { bs[e] = a[e]; bs[4 + e] = b2[e]; } }
            const bf16* src = PROJ + (size_t)t0 * NPROJ + C_XBC + c0;
            if ((t0 & (SEQ - 1)) == 0) {
#pragma unroll
                for (int e = 0; e < 8; ++e) { r0[e] = 0.f; r1[e] = 0.f; r2[e] = 0.f; }
            } else { mx::unpack8(*(const v4u*)(src - 3 * (size_t)NPROJ), r0); mx::unpack8(*(const v4u*)(src - 2 * (size_t)NPROJ), r1); mx::unpack8(*(const v4u*)(src - (size_t)NPROJ), r2); }
#pragma unroll 4
            for (int i = 0; i < 16; ++i) { float cu[8], o[8]; mx::unpack8(*(const v4u*)(src + (size_t)i * NPROJ), cu);
#pragma unroll
                for (int e = 0; e < 8; ++e) { o[e] = silu_f(bs[e] + w[0][e] * r0[e] + w[1][e] * r1[e] + w[2][e] * r2[e] + w[3][e] * cu[e]); r0[e] = r1[e]; r1[e] = r2[e]; r2[e] = cu[e]; }
                v4u ov = {pk2(o[0], o[1]), pk2(o[2], o[3]), pk2(o[4], o[5]), pk2(o[6], o[7])};
                *(v4u*)(XBC + (size_t)(t0 + i) * 1536 + c0) = ov; }
        }
    }
    GRID_BAR(2);

    if (IN(3)) {
#pragma unroll 1
        for (int it = bx; it < 256; it += G) if ((it >> 3) & 1) mx::mlstm_item(lds, ((it >> 4) << 3) | (it & 7), args.variant, wave, PROJ, GATES, INP(11), MIX);
#pragma unroll 1
        for (int it = bx; it < 256; it += G) if (!((it >> 3) & 1)) mx::ssd_item(lds, ((it >> 4) << 3) | (it & 7), args.variant, wave, XBC, PROJ, GATES, INP(6), INP(7), MIX, SSQ);
    }
    GRID_BAR(3);
    if (IN(4)) {
        pg8::Gemm g{MIX, Wout_t, T, 1024, 2048}; pg8::StaticOrder S; S.init(T, 1024, G, bx);
        pg8::EpiResF32 E{XIN, H, 1024, SSQ};
        pg8::gemm_phase<pg8::EpiResF32, pg8::StaticOrder>(lds, g, S, E, wave);
    }

    GRID_BAR(4);
    if (IN(5)) {
        const int tid = fresh_tid(wave), lane = tid & 63; (void)lane;
        LAS float* Wl = (LAS float*)lds; LAS int* hist = (LAS int*)(lds + MISC_OFF + 256);
        for (int i = tid; i < 1024 * 32; i += NTHR) { const int p = i >> 5, c = i & 31; Wl[p * WL_LD + c] = INP(14)[(size_t)wl_k(p) * 32 + c]; }
        if (tid < 32) hist[tid] = 0;
        __syncthreads();
        f32x4 wn[4];
#pragma unroll
        for (int j = 0; j < 4; ++j) wn[j] = *(const f32x4*)(INP(13) + 4 * lane + 256 * j);
        const int c = lane & 31; const float rb = INP(15)[c];
        for (int blk = bx; blk < T / 128; blk += G) {
#pragma unroll 1
            for (int it = 0; it < 16 / RN; ++it) {
                const int row = blk * 128 + wave * 16 + it * RN;
                float res[RN];
                rownorm_proj<RN, true, true>(H + (size_t)row * 1024, wn, Wl, XN8 + (size_t)row * 1024, lane, res);
#pragma unroll
                for (int r = 0; r < RN; ++r) {
                    float v = res[r] + rb; float tv[4]; int ti[4];
#pragma unroll
                    for (int k = 0; k < 4; ++k) {
                        float bv = v; int bi = c;
#pragma unroll
                        for (int m = 1; m < 32; m <<= 1) { const float ov = __shfl_xor(bv, m); const int oi = __shfl_xor(bi, m); if (ov > bv || (ov == bv && oi < bi)) { bv = ov; bi = oi; } }
                        tv[k] = bv; ti[k] = bi; if (c == bi) v = -INFINITY;
                    }
                    const float e1 = __expf(tv[1] - tv[0]), e2 = __expf(tv[2] - tv[0]), e3 = __expf(tv[3] - tv[0]); const float inv = 1.0f / (1.0f + e1 + e2 + e3);
                    if (lane == 0) { const size_t o = (size_t)(row + r) * 4; TOPI[o] = ti[0]; TOPI[o + 1] = ti[1]; TOPI[o + 2] = ti[2]; TOPI[o + 3] = ti[3];
                        TOPG[o] = inv; TOPG[o + 1] = e1 * inv; TOPG[o + 2] = e2 * inv; TOPG[o + 3] = e3 * inv;
                        __hip_atomic_fetch_add(hist + ti[0], 1, __ATOMIC_RELAXED, __HIP_MEMORY_SCOPE_WORKGROUP); __hip_atomic_fetch_add(hist + ti[1], 1, __ATOMIC_RELAXED, __HIP_MEMORY_SCOPE_WORKGROUP); __hip_atomic_fetch_add(hist + ti[2], 1, __ATOMIC_RELAXED, __HIP_MEMORY_SCOPE_WORKGROUP); __hip_atomic_fetch_add(hist + ti[3], 1, __ATOMIC_RELAXED, __HIP_MEMORY_SCOPE_WORKGROUP); }
                }
            }
            __syncthreads();
            if (tid < 32) { BLKCNT[blk * 32 + tid] = hist[tid]; hist[tid] = 0; }
            __syncthreads();
        }
    }

    GRID_BAR(5);
    if (IN(6)) {
        const int tid = fresh_tid(wave), lane = tid & 63; (void)lane;
        LAS int* tot = (LAS int*)lds; LAS int* base = tot + 32; LAS int* pstart = base + 32; LAS int* wcnt = pstart + 33;
        LAS int* arow = wcnt + 256;
        for (int blk = bx; blk < T / 128; blk += G) {
            if (tid < 32) { int t = 0, b = 0; for (int j = 0; j < T / 128; ++j) { const int v = BLKCNT[j * 32 + tid]; t += v; if (j < blk) b += v; } tot[tid] = t; base[tid] = b; }
            __syncthreads();
            if (tid == 0) { int s = 0; for (int e = 0; e < 32; ++e) { pstart[e] = s; s += (tot[e] + 255) / 256 * 256; } pstart[32] = s; }
            __syncthreads();
            const int token = blk * 128 + (tid >> 2), k = tid & 3; const int e = TOPI[(size_t)token * 4 + k];
            int rank = 0;
#pragma unroll 1
            for (int ee = 0; ee < 32; ++ee) { const unsigned long long m = __ballot(e == ee); if (e == ee) rank = __popcll(m & ((1ull << lane) - 1ull)); if (lane == 0) wcnt[wave * 32 + ee] = __popcll(m); }
            __syncthreads();
            int off = 0; for (int w = 0; w < wave; ++w) off += wcnt[w * 32 + e];
            const int row = pstart[e] + base[e] + off + rank;
            ROWTOK[row] = token; ROWGATE[row] = TOPG[(size_t)token * 4 + k]; TOKROW[(size_t)token * 4 + k] = row; arow[tid] = row;
            __syncthreads();
            for (int a = 0; a < 64; ++a) { const int ai = wave * 64 + a; const int drow = arow[ai]; const int tok = blk * 128 + (ai >> 2);
                const v4u* s = (const v4u*)(XN8 + (size_t)tok * 1024); v4u* d = (v4u*)(XG8 + (size_t)drow * 1024); d[lane] = s[lane]; }
            if (blk < 32) { const int ps = pstart[blk] + tot[blk], pe = pstart[blk + 1];
                for (int r = ps + wave; r < pe; r += NWAVES) { if (lane == 0) { ROWTOK[r] = 0; ROWGATE[r] = 0.f; } v4u* d = (v4u*)(XG8 + (size_t)r * 1024); const v4u z = {0u, 0u, 0u, 0u}; d[lane] = z; } }
            if (blk == 0) { const int nb = pstart[32] / 256; if (tid == 0) NBLK[0] = nb;
                for (int b = tid; b < nb; b += NTHR) { int e2 = 0; while (e2 < 31 && b * 256 >= pstart[e2 + 1]) ++e2; BLKEXP[b] = e2; } }
            __syncthreads();
        }
    }

    GRID_BAR(6);
    if (IN(7)) {
        pg8::Gemm g{(const bf16*)XG8, (const bf16*)Wgu8, MAXROWS, 2048, 512}; pg8::MoeOrder S{BLKEXP, __builtin_amdgcn_readfirstlane(NBLK[0]), 8, G, bx};
        pg8::EpiSwiglu E{ACT8, INP(17)};
        pg8::gemm_phase_f8<pg8::EpiSwiglu, pg8::MoeOrder>(lds, g, S, E, wave);
    }
    GRID_BAR(7);
    if (IN(8)) {
        pg8::Gemm g{(const bf16*)ACT8, (const bf16*)Wdn8, MAXROWS, 1024, 512}; pg8::MoeOrder S{BLKEXP, __builtin_amdgcn_readfirstlane(NBLK[0]), 4, G, bx};
        pg8::EpiDown E{EO8, INP(19), ROWGATE};
        pg8::gemm_phase_f8<pg8::EpiDown, pg8::MoeOrder>(lds, g, S, E, wave);
    }
    GRID_BAR(8);
    if (IN(9)) {
        const int tid = fresh_tid(wave), lane = tid & 63; (void)lane;
        const int gw = bx * NWAVES + wave, NGW = G * NWAVES;
        f32x4 wf[4];
#pragma unroll
        for (int j = 0; j < 4; ++j) wf[j] = *(const f32x4*)(INP(20) + 4 * lane + 256 * j);
        for (int row = gw; row < T; row += NGW) {
            f32x4 v[4];
#pragma unroll
            for (int j = 0; j < 4; ++j) { const v2u w = *(const v2u*)(H + (size_t)row * 1024 + 4 * lane + 256 * j); v[j] = (f32x4){bflo(w.x), bfhi(w.x), bflo(w.y), bfhi(w.y)}; }
            f32x4 ya[4];
#pragma unroll
            for (int j = 0; j < 4; ++j) ya[j] = (f32x4){0.f, 0.f, 0.f, 0.f};
#pragma unroll
            for (int k = 0; k < 4; ++k) { const int er = TOKROW[(size_t)row * 4 + k]; const unsigned char* ep = EO8 + (size_t)er * 1024;
#pragma unroll
                for (int j = 0; j < 4; ++j) { const int w = *(const int*)(ep + 4 * lane + 256 * j); typedef float f2v __attribute__((ext_vector_type(2)));
                    const f2v lo = __builtin_amdgcn_cvt_pk_f32_fp8(w, false), hi = __builtin_amdgcn_cvt_pk_f32_fp8(w, true); ya[j][0] += lo[0]; ya[j][1] += lo[1]; ya[j][2] += hi[0]; ya[j][3] += hi[1]; } }
#pragma unroll
            for (int j = 0; j < 4; ++j) v[j] = v[j] + ya[j] * 0.0625f;
            float ss = 0.f;
#pragma unroll
            for (int j = 0; j < 4; ++j) ss += (v[j][0] * v[j][0] + v[j][1] * v[j][1]) + (v[j][2] * v[j][2] + v[j][3] * v[j][3]);
            ss = wave_sum(ss); const float rs = 1.0f / sqrtf(ss * (1.0f / 1024.0f) + RMS_EPS);
#pragma unroll
            for (int j = 0; j < 4; ++j) *(f32x4*)(args.out + (size_t)row * 1024 + 4 * lane + 256 * j) = v[j] * rs * wf[j];
        }
    }
#undef IN
}

extern "C" void kernel_launch(void* const* d_in, const int* in_sizes, int n_in, void* d_out, int out_size, void* d_ws, size_t ws_size, hipStream_t stream) {
    static int grid = 0;
    if (grid == 0) {
        if (n_in != 21 || in_sizes[0] != T * D || out_size != T * D || ws_size < WS_END) { fprintf(stderr, "kernel_launch: unexpected shapes/workspace (n_in %d, ws %zu, need %zu)\n", n_in, ws_size, (size_t)WS_END); grid = -1; return; }
        if (hipFuncSetAttribute((const void*)mega, hipFuncAttributeMaxDynamicSharedMemorySize, LDS_BYTES) != hipSuccess) { fprintf(stderr, "kernel_launch: hipFuncSetAttribute failed\n"); grid = -1; return; }
        int dev = 0, cus = 0, per_cu = 0;
        if (hipGetDevice(&dev) != hipSuccess || hipDeviceGetAttribute(&cus, hipDeviceAttributeMultiprocessorCount, dev) != hipSuccess) { grid = -1; return; }
        if (hipOccupancyMaxActiveBlocksPerMultiprocessor(&per_cu, (const void*)mega, NTHR, LDS_BYTES) != hipSuccess || per_cu < 1) { fprintf(stderr, "kernel_launch: occupancy query says %d blocks per CU\n", per_cu); grid = -1; return; }
        (void)hipGetLastError();
        grid = cus;
    }
    if (grid < 0) return;
    (void)hipMemsetAsync((char*)d_ws + WS_CTL, 0, CTL_ZERO_BYTES, stream);
    Args a{};
    for (int i = 0; i < 21; ++i) a.in[i] = (const float*)d_in[i];
    a.out = (float*)d_out; a.ws = (unsigned char*)d_ws;
    a.ph_lo = 0; a.ph_hi = 10;
    hipLaunchKernelGGL(mega, dim3(grid), dim3(NTHR), LDS_BYTES, stream, a);
#ifdef PROBE_PHASE
    a.ph_lo = PROBE_PHASE; a.ph_hi = PROBE_PHASE + 1;
#ifdef PROBE_VARIANT
    a.variant = PROBE_VARIANT;
#endif
    hipLaunchKernelGGL(mega, dim3(grid), dim3(NTHR), LDS_BYTES, stream, a);
#endif
}
```

```cpp
#include <hip/hip_runtime.h>
#include <cstdio>
#include <cstdint>

__device__ __forceinline__ int lane_id() { int l; asm volatile("v_mbcnt_lo_u32_b32 %0, -1, 0\n\tv_mbcnt_hi_u32_b32 %0, -1, %0" : "=v"(l)); return l; }
namespace pg8 {
#define PG8_LAS __attribute__((address_space(3)))
typedef unsigned short bf16_t;
typedef short bf16x8 __attribute__((ext_vector_type(8)));
typedef float f32x4 __attribute__((ext_vector_type(4)));
typedef unsigned u32x4 __attribute__((ext_vector_type(4)));
constexpr int BM = 256, BK = 64, HALF = 128, HTB = HALF * BK * 2, STAGE_BYTES = 8 * HTB, NXCD = 8, WGM = 8;

__host__ __device__ __forceinline__ int lds_byte(int r, int c) { const int st = (r >> 4) * 2 + (c >> 5), rr = r & 15, cc = c & 31, ob = rr * 64 + cc * 2; return st * 1024 + (ob ^ (((ob >> 9) & 1) << 5)); }
__host__ __device__ __forceinline__ void stage_rc(int b, int& R, int& C) { const int st = b / 1024, sb = b % 1024, swz = sb ^ (((sb >> 9) & 1) << 5); R = (st >> 1) * 16 + swz / 64; C = (st & 1) * 32 + (swz % 64) / 2; }
__host__ __device__ __forceinline__ int perm32(int rho) { const int n = rho >> 4, i = rho & 15; return 8 * (i >> 2) + 4 * n + (i & 3); }

__device__ __forceinline__ const char* uni_ptr(const void* p) { const unsigned long long v = (unsigned long long)p; const unsigned lo = __builtin_amdgcn_readfirstlane((unsigned)v), hi = __builtin_amdgcn_readfirstlane((unsigned)(v >> 32)); return (const char*)(((unsigned long long)hi << 32) | lo); }
struct Unit { int pm, pn, pb, e; };
struct Gemm { const bf16_t* A; const bf16_t* Bt; int M, N, K; };

struct StaticOrder {
    int nM, nN, nwg, G, c;
    __host__ __device__ void init(int M, int N, int G_, int c_) { nM = M / BM; nN = N / BM; nwg = nM * nN; G = G_; c = c_; }
    __host__ __device__ bool next(int i, Unit& u) const {
        const long L = (long)i * G + c; if (L >= nwg) return false;
        int wgid = (int)L; { const int q = nwg / NXCD, r = nwg % NXCD, xcd = wgid % NXCD, off = wgid / NXCD; wgid = (xcd < r ? xcd * (q + 1) : r * (q + 1) + (xcd - r) * q) + off; }
        const int nig = WGM * nN, gid = wgid / nig, fm = gid * WGM, gsz = (nM - fm) < WGM ? (nM - fm) : WGM;
        u.pm = fm + ((wgid % nig) % gsz); u.pn = (wgid % nig) / gsz; u.pb = u.pn; u.e = 0; return true;
    }
};
struct MoeOrder {
    const int* blk_expert; int nblk, ntn, G, c;
    __device__ bool next(int i, Unit& u) const {
        const int xcd = c % NXCD, s = i * (G / NXCD) + c / NXCD;
        const int rb = (s / ntn) * NXCD + xcd; if (rb >= nblk) return false;
        u.pm = rb; u.pn = s % ntn; u.e = __builtin_amdgcn_readfirstlane(blk_expert[rb]); u.pb = u.e * ntn + u.pn; return true;
    }
};

__device__ __forceinline__ unsigned cvt_pk_bf16(float lo, float hi) { unsigned r; asm volatile("v_cvt_pk_bf16_f32 %0, %1, %2" : "=v"(r) : "v"(lo), "v"(hi)); return r; }

struct EpiBf16 {
    static constexpr bool PERM = true; static constexpr int MIDT = -1;
    __device__ __forceinline__ void mid(f32x4 (&)[2][2][4][2], const Unit&, int, int) const {}
    bf16_t* O; int ldc; const float* rs;
    __device__ __forceinline__ void operator()(const f32x4 (&acc)[2][2][4][2], const Unit& u, int wr, int wc, int fr, int fq) const {
        const int row0 = u.pm * BM + wr * 64 + fr, col0 = u.pn * BM + wc * 32 + 8 * fq;
#pragma unroll
        for (int ai = 0; ai < 2; ++ai)
#pragma unroll
            for (int m = 0; m < 4; ++m) { const int row = row0 + ai * HALF + m * 16; const float rr = rs[row]; bf16_t* rowp = O + (size_t)row * ldc + col0;
#pragma unroll
                for (int bj = 0; bj < 2; ++bj) { const f32x4 v0 = acc[ai][bj][m][0] * rr, v1 = acc[ai][bj][m][1] * rr;
                    u32x4 w; w.x = cvt_pk_bf16(v0[0], v0[1]); w.y = cvt_pk_bf16(v0[2], v0[3]); w.z = cvt_pk_bf16(v1[0], v1[1]); w.w = cvt_pk_bf16(v1[2], v1[3]);
                    *(u32x4*)(rowp + bj * HALF) = w; } }
    }
};
struct EpiResF32 {
    static constexpr bool PERM = true; static constexpr int MIDT = 16;
    const float* base; bf16_t* C; int ldc; const float* ssq;
    __device__ __forceinline__ void mid(f32x4 (&acc)[2][2][4][2], const Unit& u, int wr, int fr) const {
#pragma unroll
        for (int ai = 0; ai < 2; ++ai)
#pragma unroll
            for (int m = 0; m < 4; ++m) { const int row = u.pm * BM + ai * HALF + wr * 64 + m * 16 + fr; const f32x4 a = *(const f32x4*)(ssq + (size_t)row * 8), b = *(const f32x4*)(ssq + (size_t)row * 8 + 4);
                const float rs = 1.0f / sqrtf(((a[0] + a[1]) + (a[2] + a[3]) + (b[0] + b[1]) + (b[2] + b[3])) * (1.0f / 1024.0f) + 1e-6f);
#pragma unroll
                for (int bj = 0; bj < 2; ++bj)
#pragma unroll
                    for (int n = 0; n < 2; ++n) acc[ai][bj][m][n] = acc[ai][bj][m][n] * rs;
                asm volatile("" ::: "memory"); }
    }
    __device__ __forceinline__ void operator()(const f32x4 (&acc)[2][2][4][2], const Unit& u, int wr, int wc, int fr, int fq) const {
        const int row0 = u.pm * BM + wr * 64 + fr, col0 = u.pn * BM + wc * 32 + 8 * fq;
#pragma unroll
        for (int ai = 0; ai < 2; ++ai)
#pragma unroll
            for (int m = 0; m < 4; ++m) { const size_t off = (size_t)(row0 + ai * HALF + m * 16) * ldc + col0;
#pragma unroll
                for (int bj = 0; bj < 2; ++bj) { const f32x4 b0 = *(const f32x4*)(base + off + bj * HALF), b1 = *(const f32x4*)(base + off + bj * HALF + 4);
                    const f32x4 v0 = acc[ai][bj][m][0] + b0, v1 = acc[ai][bj][m][1] + b1;
                    u32x4 w; w.x = cvt_pk_bf16(v0[0], v0[1]); w.y = cvt_pk_bf16(v0[2], v0[3]); w.z = cvt_pk_bf16(v1[0], v1[1]); w.w = cvt_pk_bf16(v1[2], v1[3]);
                    *(u32x4*)(C + off + bj * HALF) = w; } }
    }
};
struct EpiSwiglu {
    static constexpr bool PERM = true; static constexpr int MIDT = -1;
    __device__ __forceinline__ void mid(f32x4 (&)[2][2][4][2], const Unit&, int, int) const {}
    unsigned char* act; const float* bgu; const float* rs;
    __device__ __forceinline__ void operator()(const f32x4 (&acc)[2][2][4][2], const Unit& u, int wr, int wc, int fr, int fq) const {
        const int row0 = u.pm * BM + wr * 64 + fr, col0 = u.pn * HALF + wc * 32 + 8 * fq;
        const float* bg = bgu + (size_t)u.e * 2048 + col0;
        f32x4 bgv[2], buv[2];
#pragma unroll
        for (int n = 0; n < 2; ++n) { bgv[n] = *(const f32x4*)(bg + 4 * n); buv[n] = *(const f32x4*)(bg + 1024 + 4 * n); }
#pragma unroll
        for (int ai = 0; ai < 2; ++ai)
#pragma unroll
            for (int m = 0; m < 4; ++m) { const int row = row0 + ai * HALF + m * 16; const float rr = rs[row]; unsigned char* rowp = act + (size_t)row * 1024 + col0;
                float o[8];
#pragma unroll
                for (int n = 0; n < 2; ++n) { const f32x4 gv = acc[ai][0][m][n] * rr + bgv[n], uv = acc[ai][1][m][n] * rr + buv[n];
#pragma unroll
                    for (int i = 0; i < 4; ++i) { const float g = fminf(gv[i], 7.0f), uu = fminf(fmaxf(uv[i], -7.0f), 7.0f);
                        o[4 * n + i] = (uu + 1.0f) * g * __builtin_amdgcn_rcpf(1.0f + __expf(-1.702f * g)); } }
                int w0 = 0, w1 = 0; w0 = __builtin_amdgcn_cvt_pk_fp8_f32(o[0], o[1], w0, false); w0 = __builtin_amdgcn_cvt_pk_fp8_f32(o[2], o[3], w0, true); w1 = __builtin_amdgcn_cvt_pk_fp8_f32(o[4], o[5], w1, false); w1 = __builtin_amdgcn_cvt_pk_fp8_f32(o[6], o[7], w1, true);
                typedef int i2v __attribute__((ext_vector_type(2))); *(i2v*)rowp = (i2v){w0, w1}; }
    }
};
struct EpiDown {
    static constexpr bool PERM = true; static constexpr int MIDT = -1;
    __device__ __forceinline__ void mid(f32x4 (&)[2][2][4][2], const Unit&, int, int) const {}
    unsigned char* eo; const float* bdn; const float* row_gate;
    __device__ __forceinline__ void operator()(const f32x4 (&acc)[2][2][4][2], const Unit& u, int wr, int wc, int fr, int fq) const {
        const int row0 = u.pm * BM + wr * 64 + fr, col0 = u.pn * BM + wc * 32 + 8 * fq;
        const float* bb = bdn + (size_t)u.e * 1024 + col0;
        f32x4 bv[2][2];
#pragma unroll
        for (int bj = 0; bj < 2; ++bj)
#pragma unroll
            for (int n = 0; n < 2; ++n) bv[bj][n] = *(const f32x4*)(bb + bj * HALF + 4 * n);
#pragma unroll
        for (int ai = 0; ai < 2; ++ai)
#pragma unroll
            for (int m = 0; m < 4; ++m) { const int row = row0 + ai * HALF + m * 16; const float gt = row_gate[row] * 16.0f; unsigned char* rowp = eo + (size_t)row * 1024 + col0;
#pragma unroll
                for (int bj = 0; bj < 2; ++bj) { const f32x4 v0 = (acc[ai][bj][m][0] + bv[bj][0]) * gt, v1 = (acc[ai][bj][m][1] + bv[bj][1]) * gt;
                    int w0 = 0, w1 = 0; w0 = __builtin_amdgcn_cvt_pk_fp8_f32(v0[0], v0[1], w0, false); w0 = __builtin_amdgcn_cvt_pk_fp8_f32(v0[2], v0[3], w0, true); w1 = __builtin_amdgcn_cvt_pk_fp8_f32(v1[0], v1[1], w1, false); w1 = __builtin_amdgcn_cvt_pk_fp8_f32(v1[2], v1[3], w1, true);
                    typedef int i2v __attribute__((ext_vector_type(2))); *(i2v*)(rowp + bj * HALF) = (i2v){w0, w1}; } }
    }
};

typedef int v8i_t __attribute__((ext_vector_type(8)));
typedef int v4i_t __attribute__((ext_vector_type(4)));
template <class Epi, class Sched>
__device__ __forceinline__ void gemm_phase(PG8_LAS unsigned char* lds, const Gemm g, const Sched& S, const Epi& E, int wid) {
    const int lane = lane_id(), tid = wid * 64 + lane, wr = wid >> 2, wc = wid & 3, fr = lane & 15, fq = lane >> 4;
    const int K = g.K, nt = K / BK;
    unsigned voffA[2], voffB[2];
#pragma unroll
    for (int i = 0; i < 2; ++i) { int R, C; stage_rc(tid * 16 + i * 8192, R, C); const int Rb = Epi::PERM ? ((R & ~31) + perm32(R & 31)) : R;
        voffA[i] = (unsigned)(R * K + C) * 2u; voffB[i] = (unsigned)(Rb * K + C) * 2u; }
    const size_t kstep = (size_t)(BK * 2);
    const size_t hstep = (size_t)HALF * K * 2;
    const size_t tstep = 2 * hstep;
    const unsigned ldsw = (unsigned)wid * 1024u;
    const int aoff = lds_byte(wr * 64 + fr, fq * 8), boff = lds_byte(wc * 32 + fr, fq * 8);
#define PG8_SA(b, h) (((b) * 2 + (h)) * HTB)
#define PG8_SB(b, h) ((4 + (b) * 2 + (h)) * HTB)
#define PG8_STAGE(bufoff, gbase, voff) do { _Pragma("unroll") for (int _i = 0; _i < 2; ++_i) \
        __builtin_amdgcn_global_load_lds((const unsigned*)((const char*)(gbase) + (voff)[_i]), (PG8_LAS unsigned*)(lds + (bufoff) + ldsw + _i * 8192), 16, 0, 0); } while (0)
#define PG8_LDA(dst, b, h) do { _Pragma("unroll") for (int m = 0; m < 4; ++m) _Pragma("unroll") for (int k = 0; k < 2; ++k) dst[m][k] = *(const PG8_LAS bf16x8*)(lds + PG8_SA(b, h) + aoff + m * 2048 + k * 1024); } while (0)
#define PG8_LDB(dst, b, h) do { _Pragma("unroll") for (int n = 0; n < 2; ++n) _Pragma("unroll") for (int k = 0; k < 2; ++k) dst[n][k] = *(const PG8_LAS bf16x8*)(lds + PG8_SB(b, h) + boff + n * 2048 + k * 1024); } while (0)
#define PG8_MMA(ai, bj, At, Bt) do { __builtin_amdgcn_s_setprio(1); _Pragma("unroll") for (int m = 0; m < 4; ++m) _Pragma("unroll") for (int n = 0; n < 2; ++n) _Pragma("unroll") for (int k = 0; k < 2; ++k) \
        acc[ai][bj][m][n] = __builtin_amdgcn_mfma_f32_16x16x32_bf16(Bt[n][k], At[m][k], acc[ai][bj][m][n], 0, 0, 0); __builtin_amdgcn_s_setprio(0); } while (0)
#define PG8_WAIT_V(n) asm volatile("s_waitcnt vmcnt(" #n ")" ::: "memory")
#define PG8_WAIT_L(n) asm volatile("s_waitcnt lgkmcnt(" #n ")" ::: "memory")
#define PG8_BAR __builtin_amdgcn_s_barrier()
#define PG8_SCHED __builtin_amdgcn_sched_barrier(0)
    Unit cur, nxt; int ui = 0;
    if (!S.next(0, cur)) return;
    f32x4 acc[2][2][4][2];
#pragma unroll
    for (int a = 0; a < 2; ++a)
#pragma unroll
        for (int b = 0; b < 2; ++b)
#pragma unroll
            for (int m = 0; m < 4; ++m)
#pragma unroll
                for (int n = 0; n < 2; ++n) acc[a][b][m][n] = (f32x4){0.f, 0.f, 0.f, 0.f};
    bf16x8 At[4][2], B0[2][2], B1[2][2];
    const char* cA = uni_ptr((const char*)g.A + (size_t)cur.pm * tstep); const char* cB = uni_ptr((const char*)g.Bt + (size_t)cur.pb * tstep);
    PG8_STAGE(PG8_SB(0, 0), cB, voffB); PG8_STAGE(PG8_SB(0, 1), cB + hstep, voffB); PG8_STAGE(PG8_SA(0, 0), cA, voffA); PG8_STAGE(PG8_SA(0, 1), cA + hstep, voffA);
    if (wr == 1) PG8_BAR;
    PG8_WAIT_V(2); PG8_BAR;
    PG8_STAGE(PG8_SB(1, 0), cB + kstep, voffB); PG8_STAGE(PG8_SA(1, 0), cA + kstep, voffA); PG8_STAGE(PG8_SB(1, 1), cB + hstep + kstep, voffB);
    PG8_WAIT_V(6); PG8_BAR;
    for (;;) {
        const bool has_next = S.next(ui + 1, nxt);
        const char* nA = uni_ptr(has_next ? (const char*)g.A + (size_t)nxt.pm * tstep : cA); const char* nB = uni_ptr(has_next ? (const char*)g.Bt + (size_t)nxt.pb * tstep : cB);
        for (int t = 0; t < nt; t += 2) {
            const bool last = (t == nt - 2);
            const char* a1 = cA + (size_t)(t + 1) * kstep;
            const char* a2 = last ? nA : cA + (size_t)(t + 2) * kstep; const char* b2 = last ? nB : cB + (size_t)(t + 2) * kstep;
            const char* a3 = a2 + kstep; const char* b3 = b2 + kstep;
            if constexpr (Epi::MIDT >= 0) { if (t == Epi::MIDT) E.mid(acc, cur, wr, fr); }
            PG8_LDB(B0, 0, 0); PG8_LDB(B1, 0, 1); PG8_SCHED; PG8_LDA(At, 0, 0); PG8_STAGE(PG8_SA(1, 1), a1 + hstep, voffA);
            PG8_WAIT_V(8); PG8_WAIT_L(0); PG8_BAR; PG8_MMA(0, 0, At, B0); PG8_MMA(0, 1, At, B1); PG8_BAR; PG8_SCHED;
            PG8_LDA(At, 0, 1); PG8_STAGE(PG8_SB(0, 0), b2, voffB); PG8_STAGE(PG8_SB(0, 1), b2 + hstep, voffB); PG8_STAGE(PG8_SA(0, 0), a2, voffA);
            PG8_WAIT_V(8); PG8_WAIT_L(0); PG8_BAR; PG8_MMA(1, 0, At, B0); PG8_MMA(1, 1, At, B1); PG8_BAR; PG8_SCHED;
            PG8_LDB(B0, 1, 0); PG8_LDB(B1, 1, 1); PG8_SCHED; PG8_LDA(At, 1, 0); PG8_STAGE(PG8_SA(0, 1), a2 + hstep, voffA);
            PG8_WAIT_V(8); PG8_WAIT_L(0); PG8_BAR; PG8_MMA(0, 0, At, B0); PG8_MMA(0, 1, At, B1); PG8_BAR; PG8_SCHED;
            PG8_LDA(At, 1, 1); PG8_STAGE(PG8_SB(1, 0), b3, voffB); PG8_STAGE(PG8_SB(1, 1), b3 + hstep, voffB); PG8_STAGE(PG8_SA(1, 0), a3, voffA);
            PG8_WAIT_V(8); PG8_WAIT_L(0); PG8_BAR; PG8_MMA(1, 0, At, B0); PG8_MMA(1, 1, At, B1); PG8_BAR; PG8_SCHED;
        }
        if (wr == 0) PG8_BAR;
        E(acc, cur, wr, wc, fr, fq);
        if (!has_next) break;
#pragma unroll
        for (int a = 0; a < 2; ++a)
#pragma unroll
            for (int b = 0; b < 2; ++b)
#pragma unroll
                for (int m = 0; m < 4; ++m)
#pragma unroll
                    for (int n = 0; n < 2; ++n) acc[a][b][m][n] = (f32x4){0.f, 0.f, 0.f, 0.f};
        cur = nxt; cA = nA; cB = nB; ++ui;
        if (wr == 1) PG8_BAR;
    }
    PG8_WAIT_V(0);
    PG8_BAR;
#undef PG8_SA
#undef PG8_SB
#undef PG8_STAGE
#undef PG8_LDA
#undef PG8_LDB
#undef PG8_MMA
#undef PG8_WAIT_V
#undef PG8_WAIT_L
#undef PG8_BAR
#undef PG8_SCHED
}
template <class Epi, class Sched>
__device__ __forceinline__ void gemm_phase_f8(PG8_LAS unsigned char* lds, const Gemm g, const Sched& S, const Epi& E, int wid) {
    const int lane = lane_id(), tid = wid * 64 + lane, wr = wid >> 2, wc = wid & 3, fr = lane & 15, fq = lane >> 4;
    int Kq = g.K; asm volatile("" : "+s"(Kq));
    const int K = Kq, nt = K / BK;
    unsigned voffA[2], voffB[2];
#pragma unroll
    for (int i = 0; i < 2; ++i) { int R, C; stage_rc(tid * 16 + i * 8192, R, C); const int Rb = Epi::PERM ? ((R & ~31) + perm32(R & 31)) : R;
        voffA[i] = (unsigned)(R * K + C) * 2u; voffB[i] = (unsigned)(Rb * K + C) * 2u; }
    const size_t kstep = (size_t)(BK * 2);
    const size_t hstep = (size_t)HALF * K * 2;
    const size_t tstep = 2 * hstep;
    const unsigned ldsw = (unsigned)wid * 1024u;
    const unsigned ldsb = (unsigned)__builtin_amdgcn_readfirstlane((int)((unsigned)(size_t)lds + ldsw));
    const int aoff = lds_byte(wr * 64 + fr, fq * 8), boff = lds_byte(wc * 32 + fr, fq * 8);
#define PG8_SA(b, h) (((b) * 2 + (h)) * HTB)
#define PG8_SB(b, h) ((4 + (b) * 2 + (h)) * HTB)
#define PG8_STAGE(bufoff, gbase, voff) do { _Pragma("unroll") for (int _i = 0; _i < 2; ++_i) { unsigned _keep; \
        asm volatile("s_mov_b32 %0, m0\n\ts_mov_b32 m0, %3\n\ts_nop 0\n\tglobal_load_lds_dwordx4 %1, %2\n\ts_mov_b32 m0, %0" : "=&s"(_keep) : "v"((voff)[_i]), "s"((const char*)(gbase)), "s"(ldsb + (unsigned)((bufoff) + _i * 8192)) : "memory"); } } while (0)
#define PG8_LDA(dst, b, h) do { _Pragma("unroll") for (int m = 0; m < 4; ++m) { const v4i_t _lo = *(const PG8_LAS v4i_t*)(lds + PG8_SA(b, h) + aoff + m * 2048), _hi = *(const PG8_LAS v4i_t*)(lds + PG8_SA(b, h) + aoff + m * 2048 + 1024); dst[m] = __builtin_shufflevector(_lo, _hi, 0, 1, 2, 3, 4, 5, 6, 7); } } while (0)
#define PG8_LDB(dst, b, h) do { _Pragma("unroll") for (int n = 0; n < 2; ++n) { const v4i_t _lo = *(const PG8_LAS v4i_t*)(lds + PG8_SB(b, h) + boff + n * 2048), _hi = *(const PG8_LAS v4i_t*)(lds + PG8_SB(b, h) + boff + n * 2048 + 1024); dst[n] = __builtin_shufflevector(_lo, _hi, 0, 1, 2, 3, 4, 5, 6, 7); } } while (0)
#define PG8_MMA(ai, bj, At, Bt) do { __builtin_amdgcn_s_setprio(1); _Pragma("unroll") for (int m = 0; m < 4; ++m) _Pragma("unroll") for (int n = 0; n < 2; ++n) \
        acc[ai][bj][m][n] = __builtin_amdgcn_mfma_scale_f32_16x16x128_f8f6f4(Bt[n], At[m], acc[ai][bj][m][n], 0, 0, 0, 0x79797979, 0, 0x7f7f7f7f); __builtin_amdgcn_s_setprio(0); } while (0)
#define PG8_WAIT_V(n) asm volatile("s_waitcnt vmcnt(" #n ")" ::: "memory")
#define PG8_WAIT_L(n) asm volatile("s_waitcnt lgkmcnt(" #n ")" ::: "memory")
#define PG8_BAR __builtin_amdgcn_s_barrier()
#define PG8_SCHED __builtin_amdgcn_sched_barrier(0)
    Unit cur, nxt; int ui = 0;
    if (!S.next(0, cur)) return;
    f32x4 acc[2][2][4][2];
#pragma unroll
    for (int a = 0; a < 2; ++a)
#pragma unroll
        for (int b = 0; b < 2; ++b)
#pragma unroll
            for (int m = 0; m < 4; ++m)
#pragma unroll
                for (int n = 0; n < 2; ++n) acc[a][b][m][n] = (f32x4){0.f, 0.f, 0.f, 0.f};
    v8i_t At[4], B0[2], B1[2];
    const char* cA = uni_ptr((const char*)g.A + (size_t)cur.pm * tstep); const char* cB = uni_ptr((const char*)g.Bt + (size_t)cur.pb * tstep);
    PG8_STAGE(PG8_SB(0, 0), cB, voffB); PG8_STAGE(PG8_SB(0, 1), cB + hstep, voffB); PG8_STAGE(PG8_SA(0, 0), cA, voffA); PG8_STAGE(PG8_SA(0, 1), cA + hstep, voffA);
    if (wr == 1) PG8_BAR;
    PG8_WAIT_V(2); PG8_BAR;
    PG8_STAGE(PG8_SB(1, 0), cB + kstep, voffB); PG8_STAGE(PG8_SA(1, 0), cA + kstep, voffA); PG8_STAGE(PG8_SB(1, 1), cB + hstep + kstep, voffB);
    PG8_WAIT_V(6); PG8_BAR;
    for (;;) {
        const bool has_next = S.next(ui + 1, nxt);
        const char* nA = uni_ptr(has_next ? (const char*)g.A + (size_t)nxt.pm * tstep : cA); const char* nB = uni_ptr(has_next ? (const char*)g.Bt + (size_t)nxt.pb * tstep : cB);
        for (int t = 0; t < nt; t += 2) {
            const bool last = (t == nt - 2);
            const char* a1 = cA + (size_t)(t + 1) * kstep;
            const char* a2 = last ? nA : cA + (size_t)(t + 2) * kstep; const char* b2 = last ? nB : cB + (size_t)(t + 2) * kstep;
            const char* a3 = a2 + kstep; const char* b3 = b2 + kstep;
            if constexpr (Epi::MIDT >= 0) { if (t == Epi::MIDT) E.mid(acc, cur, wr, fr); }
            PG8_LDB(B0, 0, 0); PG8_LDB(B1, 0, 1); PG8_SCHED; PG8_LDA(At, 0, 0); PG8_STAGE(PG8_SA(1, 1), a1 + hstep, voffA);
            PG8_WAIT_V(8); PG8_WAIT_L(0); PG8_BAR; PG8_MMA(0, 0, At, B0); PG8_MMA(0, 1, At, B1); PG8_BAR; PG8_SCHED;
            PG8_LDA(At, 0, 1); PG8_STAGE(PG8_SB(0, 0), b2, voffB); PG8_STAGE(PG8_SB(0, 1), b2 + hstep, voffB); PG8_STAGE(PG8_SA(0, 0), a2, voffA);
            PG8_WAIT_V(8); PG8_WAIT_L(0); PG8_BAR; PG8_MMA(1, 0, At, B0); PG8_MMA(1, 1, At, B1); PG8_BAR; PG8_SCHED;
            PG8_LDB(B0, 1, 0); PG8_LDB(B1, 1, 1); PG8_SCHED; PG8_LDA(At, 1, 0); PG8_STAGE(PG8_SA(0, 1), a2 + hstep, voffA);
            PG8_WAIT_V(8); PG8_WAIT_L(0); PG8_BAR; PG8_MMA(0, 0, At, B0); PG8_MMA(0, 1, At, B1); PG8_BAR; PG8_SCHED;
            PG8_LDA(At, 1, 1); PG8_STAGE(PG8_SB(1, 0), b3, voffB); PG8_STAGE(PG8_SB(1, 1), b3 + hstep, voffB); PG8_STAGE(PG8_SA(1, 0), a3, voffA);
            PG8_WAIT_V(8); PG8_WAIT_L(0); PG8_BAR; PG8_MMA(1, 0, At, B0); PG8_MMA(1, 1, At, B1); PG8_BAR; PG8_SCHED;
        }
        if (wr == 0) PG8_BAR;
        E(acc, cur, wr, wc, fr, fq);
        if (!has_next) break;
#pragma unroll
        for (int a = 0; a < 2; ++a)
#pragma unroll
            for (int b = 0; b < 2; ++b)
#pragma unroll
                for (int m = 0; m < 4; ++m)
#pragma unroll
                    for (int n = 0; n < 2; ++n) acc[a][b][m][n] = (f32x4){0.f, 0.f, 0.f, 0.f};
        cur = nxt; cA = nA; cB = nB; ++ui;
        if (wr == 1) PG8_BAR;
    }
    PG8_WAIT_V(0);
    PG8_BAR;
#undef PG8_SA
#undef PG8_SB
#undef PG8_STAGE
#undef PG8_LDA
#undef PG8_LDB
#undef PG8_MMA
#undef PG8_WAIT_V
#undef PG8_WAIT_L
#undef PG8_BAR
#undef PG8_SCHED
}
}

constexpr int BATCH = 16, SEQ = 2048, T = BATCH * SEQ, D = 1024;
constexpr int NPROJ = 6656;
constexpr int C_Z = 0, C_XBC = 1024, C_Q = 2560, C_K = 3584, C_V = 4608, C_O = 5632;
constexpr int WIN_LD = 6688;
constexpr int NE = 32, TOPK = 4;
constexpr int NASSIGN = T * TOPK, MAXBLK = NASSIGN / 256 + NE, MAXROWS = MAXBLK * 256;
constexpr float RMS_EPS = 1e-6f;
constexpr int NWAVES = 8, NTHR = 512;

constexpr size_t MiB = 1u << 20;
constexpr size_t WS_CTL = 0, CTL_ZERO_BYTES = 1 * MiB;
constexpr size_t WS_WIN = 1 * MiB, WS_WOUT = 14 * MiB, WS_WGU = 18 * MiB, WS_WDN = 146 * MiB;
constexpr size_t WS_XN = 210 * MiB, WS_H = 274 * MiB, WS_GATES = 402 * MiB, WS_ROUTE = 406 * MiB, WS_PROJ = 412 * MiB, WS_MIX = 828 * MiB, WS_END = 956 * MiB;
constexpr size_t WS_XBC = WS_H;
constexpr size_t WS_SSQ = WS_ROUTE + 3 * MiB;
constexpr size_t WS_XG = WS_PROJ, WS_ACT = WS_PROJ + 272 * MiB;
static_assert((size_t)MAXROWS * 1024 * 2 == 272 * MiB && WS_ACT + 272 * MiB == WS_END, "overlay map");
constexpr size_t R_TOPI = 0, R_TOPG = 512 * 1024, R_TOKROW = 1024 * 1024, R_ROWTOK = 1536 * 1024, R_ROWGATE = 2176 * 1024, R_BLKCNT = 2816 * 1024, R_BLKEXP = 2880 * 1024, R_NBLK = 2944 * 1024;
constexpr int CW_BAR = 4096;

constexpr int WL_LD = 36;
constexpr int WL_BYTES = 1024 * WL_LD * 4;
constexpr int MISC_OFF = 150528, LDS_BYTES = MISC_OFF + 1024;

#define GAS __attribute__((address_space(1)))
#define LAS __attribute__((address_space(3)))
typedef unsigned short bf16;
typedef unsigned v4u __attribute__((ext_vector_type(4)));
typedef unsigned v2u __attribute__((ext_vector_type(2)));
typedef float f32x4 __attribute__((ext_vector_type(4)));
#define LDS_WAIT() asm volatile("s_waitcnt lgkmcnt(0)" ::: "memory")
__device__ __forceinline__ unsigned f2bf(float f) { return (unsigned)__builtin_bit_cast(unsigned short, (__bf16)f); }
typedef __bf16 bf2_t __attribute__((ext_vector_type(2)));
__device__ __forceinline__ unsigned pk2(float lo, float hi) { const bf2_t v = {(__bf16)lo, (__bf16)hi}; return __builtin_bit_cast(unsigned, v); }
__device__ __forceinline__ float bf2f(unsigned short b) { return __builtin_bit_cast(float, (unsigned)b << 16); }
__device__ __forceinline__ float bflo(unsigned w) { return __builtin_bit_cast(float, w << 16); }
__device__ __forceinline__ float bfhi(unsigned w) { return __builtin_bit_cast(float, w & 0xffff0000u); }
__device__ __forceinline__ float wave_sum(float v) {
#pragma unroll
    for (int o = 1; o < 64; o <<= 1) v += __shfl_xor(v, o);
    return v;
}
__device__ __forceinline__ float silu_f(float x) { return x * __builtin_amdgcn_rcpf(1.0f + __expf(-x)); }
__device__ __forceinline__ float sigmoid_f(float x) { return __builtin_amdgcn_rcpf(1.0f + __expf(-x)); }
__device__ __forceinline__ float rsqrt_f(float x) { return __builtin_amdgcn_rsqf(x); }
__device__ __forceinline__ float softplus_f(float x) { return x > 20.0f ? x : log1pf(__expf(x)); }


#define XB_TMO      128
#define XB_XCNT(j)  (256  + 64 * (j))
#define XB_XSUB(j)  (1280 + 64 * (j))
#define XB_XGEN(j)  (2304 + 64 * (j))
#define XB_TOP      3328
#define XB_TOPGEN   3392
#define XCD_BAR_WORDS 3456
#define XB_SPIN_CAP (1u << 18)
__device__ __forceinline__ unsigned xb_ld(unsigned* p)              { return __hip_atomic_load(p, __ATOMIC_RELAXED, __HIP_MEMORY_SCOPE_AGENT); }
__device__ __forceinline__ unsigned xb_add(unsigned* p, unsigned v) { return __hip_atomic_fetch_add(p, v, __ATOMIC_RELAXED, __HIP_MEMORY_SCOPE_AGENT); }
__device__ __forceinline__ unsigned xb_xcc_id() { return (unsigned)__builtin_amdgcn_s_getreg((3 << 11) | 20) & 0xFu; }
#define XB_SPIN(cond, bar) do { unsigned _sp = 0; while (cond) { __builtin_amdgcn_s_sleep(1); \
    if ((++_sp & 255u) == 0u) { if (xb_ld(&(bar)[XB_TMO])) break; if (_sp > XB_SPIN_CAP) { atomicAdd(&(bar)[XB_TMO], 1u); break; } } } } while (0)
struct XcdBarrier { unsigned* bar; unsigned x; volatile LAS unsigned* st; };
__device__ __forceinline__ XcdBarrier xcd_barrier_post(unsigned* bar, volatile LAS unsigned* st, bool t0  ) {
    XcdBarrier b; b.bar = bar; b.x = xb_xcc_id(); b.st = st;
    if (t0) (void)xb_add(&bar[XB_XCNT(b.x)], 1u);
    return b;
}
__device__ __forceinline__ void xcd_barrier_complete(unsigned* bar, unsigned x, unsigned& nloc, unsigned& nx) {
    const unsigned G = gridDim.x * gridDim.y * gridDim.z;
    unsigned sum, cnt, mine, sp = 0u;
    for (;;) {
        sum = 0u; cnt = 0u; mine = 0u;
#pragma unroll
        for (unsigned j = 0; j < 16; ++j) { const unsigned c = xb_ld(&bar[XB_XCNT(j)]); sum += c; cnt += (c > 0u) ? 1u : 0u; mine = (j == x) ? c : mine; }
        if (sum == G) break;
        __builtin_amdgcn_s_sleep(1);
        if ((++sp & 255u) == 0u) { if (xb_ld(&bar[XB_TMO])) break; if (sp > XB_SPIN_CAP) { atomicAdd(&bar[XB_TMO], 1u); break; } }
    }
    nloc = mine > 0u ? mine : 1u; nx = cnt > 0u ? cnt : 1u;
}
__device__ __forceinline__ void xcd_barrier(const XcdBarrier& b, bool t0  ) {
    asm volatile("s_waitcnt vmcnt(0)" ::: "memory");
    __syncthreads();
    if (t0) {
        unsigned* bar = b.bar;
        __builtin_amdgcn_s_waitcnt(0);
        unsigned nloc = b.st[0], nx = b.st[1];
        if (nloc == 0u) { xcd_barrier_complete(bar, b.x, nloc, nx); b.st[0] = nloc; b.st[1] = nx; }
        const unsigned old = xb_add(&bar[XB_XSUB(b.x)], 1u);
        const unsigned gen = old / nloc;
        if (old + 1u == (gen + 1u) * nloc) {
            __builtin_amdgcn_fence(__ATOMIC_RELEASE, "agent");
            asm volatile("s_waitcnt vmcnt(0)" ::: "memory");
            const unsigned og = xb_add(&bar[XB_TOP], 1u);
            const unsigned tg = og / nx;
            if (og + 1u == (tg + 1u) * nx) xb_add(&bar[XB_TOPGEN], 1u);
            else XB_SPIN(xb_ld(&bar[XB_TOPGEN]) == tg, bar);
            __builtin_amdgcn_fence(__ATOMIC_ACQUIRE, "agent");
            xb_add(&bar[XB_XGEN(b.x)], 1u);
            asm volatile("s_waitcnt vmcnt(0)" ::: "memory");
        } else {
            XB_SPIN(xb_ld(&bar[XB_XGEN(b.x)]) == gen, bar);
            __builtin_amdgcn_fence(__ATOMIC_ACQUIRE, "agent");
            asm volatile("s_waitcnt vmcnt(0)" ::: "memory");
        }
    }
    __syncthreads();
}

__device__ __forceinline__ int fresh_tid(int wave) { int t = wave * 64 + lane_id(); asm volatile("" : "+v"(t)); return t; }
struct Args { const float* in[21]; float* out; unsigned char* ws; int ph_lo, ph_hi, variant, pad; };

__device__ __forceinline__ void transpose_item(const float* W, int ld_src, int n0s, int k0, bf16* WT, int K, int n0d, float cscale, const float* kscale, LAS float* scr, int lane) {
#pragma unroll
    for (int i = 0; i < 32; ++i) { const int kk = 2 * i + (lane >> 5); float v = W[(size_t)(k0 + kk) * ld_src + n0s + (lane & 31)] * cscale; if (kscale) v *= kscale[k0 + kk]; scr[kk * 33 + (lane & 31)] = v; }
    LDS_WAIT(); asm volatile("" ::: "memory");
    const int c = lane & 7;
#pragma unroll
    for (int j = 0; j < 4; ++j) { const int n = (lane >> 3) + 8 * j; const LAS float* s = scr + (8 * c) * 33 + n;
        v4u o; o.x = pk2(s[0 * 33], s[1 * 33]); o.y = pk2(s[2 * 33], s[3 * 33]); o.z = pk2(s[4 * 33], s[5 * 33]); o.w = pk2(s[6 * 33], s[7 * 33]);
        *(v4u*)(WT + (size_t)(n0d + n) * K + k0 + 8 * c) = o; }
    LDS_WAIT(); asm volatile("" ::: "memory");
}

__device__ __forceinline__ int pk4_fp8(float a, float b, float c, float d) { int w = 0; w = __builtin_amdgcn_cvt_pk_fp8_f32(a, b, w, false); w = __builtin_amdgcn_cvt_pk_fp8_f32(c, d, w, true); return w; }
__device__ __forceinline__ void transpose_item_f8(const float* W, int ld_src, int n0s, int k0, unsigned char* WT, int K, int n0d, float cscale, const float* kscale, LAS float* scr, int lane) {
#pragma unroll
    for (int i = 0; i < 32; ++i) { const int kk = 2 * i + (lane >> 5); float v = W[(size_t)(k0 + kk) * ld_src + n0s + (lane & 31)] * cscale; if (kscale) v *= kscale[k0 + kk]; scr[kk * 33 + (lane & 31)] = v; }
    LDS_WAIT(); asm volatile("" ::: "memory");
    const int c = lane & 3;
#pragma unroll
    for (int j = 0; j < 2; ++j) { const int n = (lane >> 2) + 16 * j; const LAS float* s = scr + (16 * c) * 33 + n;
        v4u o; o.x = (unsigned)pk4_fp8(s[0 * 33], s[1 * 33], s[2 * 33], s[3 * 33]); o.y = (unsigned)pk4_fp8(s[4 * 33], s[5 * 33], s[6 * 33], s[7 * 33]);
        o.z = (unsigned)pk4_fp8(s[8 * 33], s[9 * 33], s[10 * 33], s[11 * 33]); o.w = (unsigned)pk4_fp8(s[12 * 33], s[13 * 33], s[14 * 33], s[15 * 33]);
        *(v4u*)(WT + (size_t)(n0d + n) * K + k0 + 16 * c) = o; }
    LDS_WAIT(); asm volatile("" ::: "memory");
}

constexpr int PT_LD = 2064, PT_HALF = 32 * PT_LD;
typedef short s8v_t __attribute__((ext_vector_type(8)));
__device__ __forceinline__ void pt_fill(LAS unsigned char* tab, const float* W, int ldw, int tid, bool gate_cols) {
    for (int i = tid; i < 1024 * 32; i += NTHR) { const int k = i >> 5, c = i & 31; const int sc = gate_cols ? (c < 16 ? 2560 + c : (c < 24 ? 6672 + (c - 16) : 6680 + (c - 24))) : c;
        const float v = W[(size_t)k * ldw + sc]; const unsigned h = f2bf(v); const float hf = __builtin_bit_cast(float, h << 16);
        *(LAS unsigned short*)(tab + c * PT_LD + k * 2) = (unsigned short)h; *(LAS unsigned short*)(tab + PT_HALF + c * PT_LD + k * 2) = (unsigned short)f2bf(v - hf); }
}
template <bool IN_BF16, bool OUT_F8>
__device__ __forceinline__ float rowproj16(const void* srcv, void* dstv, const float* wn, const LAS unsigned char* tab, int row0, int lane, f32x4 (&acc)[2]) {
    const int g = lane >> 4, c16 = lane & 15;
    acc[0] = (f32x4){0.f, 0.f, 0.f, 0.f}; acc[1] = acc[0]; float ss = 0.f;
    const LAS unsigned char* tb = tab + c16 * PT_LD + g * 16;
#pragma unroll 4
    for (int s = 0; s < 32; ++s) {
        f32x4 a, b;
        if constexpr (IN_BF16) { const v4u w = *(const v4u*)((const bf16*)srcv + (size_t)(row0 + c16) * 1024 + 32 * s + 8 * g); a = (f32x4){bflo(w.x), bfhi(w.x), bflo(w.y), bfhi(w.y)}; b = (f32x4){bflo(w.z), bfhi(w.z), bflo(w.w), bfhi(w.w)}; }
        else { const float* p = (const float*)srcv + (size_t)(row0 + c16) * 1024 + 32 * s + 8 * g; a = *(const f32x4*)p; b = *(const f32x4*)(p + 4); }
        ss += (a[0] * a[0] + a[1] * a[1]) + (a[2] * a[2] + a[3] * a[3]) + (b[0] * b[0] + b[1] * b[1]) + (b[2] * b[2] + b[3] * b[3]);
        { const f32x4 w0 = *(const f32x4*)(wn + 32 * s + 8 * g), w1 = *(const f32x4*)(wn + 32 * s + 8 * g + 4); a = a * w0; b = b * w1; }
        v4u hw; hw.x = pk2(a[0], a[1]); hw.y = pk2(a[2], a[3]); hw.z = pk2(b[0], b[1]); hw.w = pk2(b[2], b[3]);
        v4u lw; lw.x = pk2(a[0] - bflo(hw.x), a[1] - bfhi(hw.x)); lw.y = pk2(a[2] - bflo(hw.y), a[3] - bfhi(hw.y)); lw.z = pk2(b[0] - bflo(hw.z), b[1] - bfhi(hw.z)); lw.w = pk2(b[2] - bflo(hw.w), b[3] - bfhi(hw.w));
        if constexpr (OUT_F8) { v2u o; o.x = (unsigned)pk4_fp8(a[0], a[1], a[2], a[3]); o.y = (unsigned)pk4_fp8(b[0], b[1], b[2], b[3]); *(v2u*)((unsigned char*)dstv + (size_t)(row0 + c16) * 1024 + 32 * s + 8 * g) = o; }
        else *(v4u*)((bf16*)dstv + (size_t)(row0 + c16) * 1024 + 32 * s + 8 * g) = hw;
        const s8v_t xh = __builtin_bit_cast(s8v_t, hw), xl = __builtin_bit_cast(s8v_t, lw);
#pragma unroll
        for (int nt = 0; nt < 2; ++nt) { const s8v_t wh = *(const LAS s8v_t*)(tb + nt * 16 * PT_LD + s * 64), wl = *(const LAS s8v_t*)(tb + PT_HALF + nt * 16 * PT_LD + s * 64);
            acc[nt] = __builtin_amdgcn_mfma_f32_16x16x32_bf16(xh, wh, acc[nt], 0, 0, 0); acc[nt] = __builtin_amdgcn_mfma_f32_16x16x32_bf16(xl, wh, acc[nt], 0, 0, 0); acc[nt] = __builtin_amdgcn_mfma_f32_16x16x32_bf16(xh, wl, acc[nt], 0, 0, 0); }
    }
    ss += __shfl_xor(ss, 16); ss += __shfl_xor(ss, 32);
    return 1.0f / sqrtf(ss * (1.0f / 1024.0f) + RMS_EPS);
}

namespace mx {
typedef short s8v __attribute__((ext_vector_type(8)));
typedef short s4v __attribute__((ext_vector_type(4)));
#define MX_MFMA(a, b, c) __builtin_amdgcn_mfma_f32_16x16x32_bf16(a, b, c, 0, 0, 0)
#define MX_SB() __builtin_amdgcn_sched_barrier(0)
#define MX_BAR() do { MX_SB(); asm volatile("s_waitcnt lgkmcnt(0)" ::: "memory"); __builtin_amdgcn_s_barrier(); asm volatile("" ::: "memory"); } while (0)
constexpr int TS = 288, TILE = 64 * TS, PS = 144, PTILE = 64 * PS, BUF = 3 * TILE;
struct LaneBase { unsigned row, perm, tr, prow; };
__device__ __forceinline__ LaneBase lane_base(int lane) { LaneBase L; const unsigned g = lane >> 4, i = lane & 15, q = i >> 2, p = lane & 3;
    L.row = i * TS + g * 16; L.perm = i * TS + g * 8; L.tr = (8 * g + q) * TS + p * 8; L.prow = i * PS + g * 16; return L; }
#define LD_ROW(t, L, rb, s) (*(const LAS mx::s8v*)((t) + (L).row + (rb) * 16 * mx::TS + (s) * 64))
#define LD_ROWP(t, L, rb, s) (*(const LAS mx::s8v*)((t) + (L).prow + (rb) * 16 * mx::PS + (s) * 64))
__device__ __forceinline__ s8v ld_perm2(const LAS unsigned char* p) { const s4v lo = *(const LAS s4v*)p, hi = *(const LAS s4v*)(p + 32); return (s8v){lo[0], lo[1], lo[2], lo[3], hi[0], hi[1], hi[2], hi[3]}; }
#define LD_PERM(t, L, rb, s) mx::ld_perm2((t) + (L).perm + (rb) * 16 * mx::TS + (s) * 64)
__device__ __forceinline__ s8v ld_tr2(const LAS unsigned char* p) {
    const s4v a = __builtin_amdgcn_ds_read_tr16_b64_v4i16((LAS s4v*)p), b = __builtin_amdgcn_ds_read_tr16_b64_v4i16((LAS s4v*)(p + 4 * TS));
    return (s8v){a[0], a[1], a[2], a[3], b[0], b[1], b[2], b[3]}; }
#define LD_TR(t, L, c, ks) mx::ld_tr2((t) + (L).tr + (ks) * 32 * mx::TS + (c) * 32)
__device__ __forceinline__ void dma_tiles(LAS unsigned char* buf, const bf16* g0, int gstride, int co0, int co1, int co2, int wave, int lane) {
#pragma unroll
    for (int pp = 0; pp < 7; ++pp) { const int piece = wave + 8 * pp; if (piece < 54) { const unsigned o = piece * 1024 + lane * 16, tl = o / TILE, ot = o - tl * TILE, row = ot / TS, wb = ot - row * TS;
        const int co = tl == 0 ? co0 : (tl == 1 ? co1 : co2);
        __builtin_amdgcn_global_load_lds((const unsigned*)(g0 + (size_t)row * gstride + co + (wb < 256 ? wb >> 1 : 0)), (LAS unsigned*)(buf + piece * 1024), 16, 0, 0); } }
}
#define MX_DPPF(old, src, ctrl, rm) __builtin_bit_cast(float, __builtin_amdgcn_update_dpp(__builtin_bit_cast(int, (float)(old)), __builtin_bit_cast(int, (float)(src)), ctrl, rm, 0xf, false))
__device__ __forceinline__ float scan_add(float x) {
    x += MX_DPPF(0.f, x, 0x111, 0xf); x += MX_DPPF(0.f, x, 0x112, 0xf); x += MX_DPPF(0.f, x, 0x114, 0xf); x += MX_DPPF(0.f, x, 0x118, 0xf);
    x += MX_DPPF(0.f, x, 0x142, 0xa); x += MX_DPPF(0.f, x, 0x143, 0xc); return x; }
__device__ __forceinline__ float scan_max(float x) { const float ninf = -INFINITY;
    x = fmaxf(x, MX_DPPF(ninf, x, 0x111, 0xf)); x = fmaxf(x, MX_DPPF(ninf, x, 0x112, 0xf)); x = fmaxf(x, MX_DPPF(ninf, x, 0x114, 0xf)); x = fmaxf(x, MX_DPPF(ninf, x, 0x118, 0xf));
    x = fmaxf(x, MX_DPPF(ninf, x, 0x142, 0xa)); x = fmaxf(x, MX_DPPF(ninf, x, 0x143, 0xc)); return x; }
__device__ __forceinline__ float lane63(float x) { return __builtin_bit_cast(float, __builtin_amdgcn_readlane(__builtin_bit_cast(int, x), 63)); }
__device__ __forceinline__ float softplus_fast(float x) { return fmaxf(x, 0.f) + __logf(1.0f + __expf(-fabsf(x))); }
__device__ __forceinline__ s8v pack_acc(const f32x4& a, const f32x4& b) {
    const unsigned w0 = pk2(a[0], a[1]), w1 = pk2(a[2], a[3]), w2 = pk2(b[0], b[1]), w3 = pk2(b[2], b[3]);
    v4u w = {w0, w1, w2, w3}; return __builtin_bit_cast(s8v, w);
}
__device__ __forceinline__ void unpack8(const v4u& w, float (&f)[8]) { f[0] = bflo(w.x); f[1] = bfhi(w.x); f[2] = bflo(w.y); f[3] = bfhi(w.y); f[4] = bflo(w.z); f[5] = bfhi(w.z); f[6] = bflo(w.w); f[7] = bfhi(w.w); }

__device__ __forceinline__ void mlstm_item(LAS unsigned char* lds, int item, int var, int wave, const bf16* __restrict__ PROJ, const float* __restrict__ GATES, const float* __restrict__ lnw, bf16* __restrict__ MIX) {
    const int lane = lane_id(), tid = wave * 64 + lane, g = lane >> 4, c16 = lane & 15;
    const int b = item >> 3, h = item & 7;
    const LaneBase L = lane_base(lane);
    LAS unsigned char* TP = lds + 2 * BUF; LAS unsigned char* TO = TP + PTILE;
    LAS float* denP = (LAS float*)(TO + TILE); LAS float* qnp = denP + 128; LAS float* nsh = qnp + 512;
    LAS float* Au = nsh + 128; LAS float* Avv = Au + 64; LAS float* Awi = Avv + 64; LAS float* Akw = Awi + 64; LAS float* Aid = Akw + 64;
    f32x4 Cst[8];
#pragma unroll
    for (int i = 0; i < 8; ++i) Cst[i] = (f32x4){0.f, 0.f, 0.f, 0.f};
    float nreg = 0.f, m_prev = 0.f;
    if (lane < 16) nsh[wave * 16 + lane] = 0.f;
    const int srow = tid >> 3, sch = tid & 7;
    const bf16* qbase = PROJ + (size_t)(b * SEQ) * NPROJ + h * 128;
    dma_tiles(lds, qbase, NPROJ, C_Q, C_K, C_V, wave, lane);
    float fnext = GATES[(size_t)(b * SEQ + lane) * 32 + 24 + h], inext = GATES[(size_t)(b * SEQ + lane) * 32 + 16 + h];
    asm volatile("s_waitcnt vmcnt(0)" ::: "memory"); MX_BAR();
#pragma unroll 1
    for (int c = 0; c < SEQ / 64; ++c) {
        const int cur = c & 1; const int t0 = b * SEQ + c * 64;
        LAS unsigned char* TQ = lds + cur * BUF; LAS unsigned char* TK = TQ + TILE; LAS unsigned char* TV = TQ + 2 * TILE;
        float fraw = fnext, iraw = inext; asm volatile("" : "+v"(fraw), "+v"(iraw));
        MX_SB();
        const v4u ov0 = *(const v4u*)(PROJ + (size_t)(t0 + srow) * NPROJ + C_O + h * 128 + 8 * sch), ov1 = *(const v4u*)(PROJ + (size_t)(t0 + srow) * NPROJ + C_O + h * 128 + 64 + 8 * sch);
        { const int tn = (c + 1 < SEQ / 64 ? t0 + 64 : t0) + lane; fnext = GATES[(size_t)tn * 32 + 24 + h]; inext = GATES[(size_t)tn * 32 + 16 + h]; }
        if (c + 1 < SEQ / 64 && !(var & 1)) { int lv = lane; asm volatile("" : "+v"(lv)); dma_tiles(lds + (cur ^ 1) * BUF, qbase + (size_t)(c + 1) * 64 * NPROJ, NPROJ, C_Q, C_K, C_V, wave, lv); }
        MX_SB();
        const float lf = -softplus_fast(-fraw), cf = scan_add(lf), chunk_f = lane63(cf);
        const float u = iraw - cf, Mx = scan_max(u);
        const float m_row = cf + fmaxf(m_prev, Mx), vv = cf - m_row;
        const float m_loc = chunk_f + lane63(Mx), m_new = fmaxf(chunk_f + m_prev, m_loc);
        const float w_inter = __expf(vv + m_prev), floorv = __expf(-m_row), kw = __expf(chunk_f + u - m_new), s_old = __expf(chunk_f + m_prev - m_new);
        Au[lane] = u; Avv[lane] = vv; Awi[lane] = w_inter; Akw[lane] = kw;
        if (!(var & 2)) { const int lt = wave & 3, jt0 = 2 * (wave >> 2); const float vv_l = Avv[16 * lt + c16]; float rsum = 0.f;
#pragma unroll
          for (int jj = 0; jj < 2; ++jj) { const int jt = jt0 + jj; float pv[4] = {0.f, 0.f, 0.f, 0.f};
            if (jt <= lt) { f32x4 acc = {0.f, 0.f, 0.f, 0.f};
#pragma unroll
                for (int ks = 0; ks < 4; ++ks) acc = MX_MFMA(LD_ROW(TK, L, jt, ks), LD_ROW(TQ, L, lt, ks), acc);
                const f32x4 uj = *(const LAS f32x4*)(Au + 16 * jt + 4 * g);
#pragma unroll
                for (int r = 0; r < 4; ++r) { const int j = 16 * jt + 4 * g + r, l = 16 * lt + c16; const float val = (j <= l) ? acc[r] * __expf(vv_l + uj[r]) : 0.f; rsum += val; pv[r] = val; } }
            v2u w; w.x = pk2(pv[0], pv[1]); w.y = pk2(pv[2], pv[3]);
            *(LAS v2u*)(TP + (16 * lt + c16) * PS + (16 * jt + 4 * g) * 2) = w; }
          rsum += __shfl_xor(rsum, 16); rsum += __shfl_xor(rsum, 32);
          if (g == 0) denP[(wave >> 2) * 64 + 16 * lt + c16] = rsum;
          v4u q0 = *(const LAS v4u*)(TQ + lane * TS + wave * 32), q1 = *(const LAS v4u*)(TQ + lane * TS + wave * 32 + 16); float qf[16]; { float t8[8]; unpack8(q0, t8);
#pragma unroll
            for (int e = 0; e < 8; ++e) qf[e] = t8[e]; unpack8(q1, t8);
#pragma unroll
            for (int e = 0; e < 8; ++e) qf[8 + e] = t8[e]; }
          float part = 0.f;
#pragma unroll
          for (int e4 = 0; e4 < 4; ++e4) { const f32x4 nv = *(const LAS f32x4*)(nsh + wave * 16 + 4 * e4); part += qf[4 * e4] * nv[0] + qf[4 * e4 + 1] * nv[1] + qf[4 * e4 + 2] * nv[2] + qf[4 * e4 + 3] * nv[3]; }
          qnp[wave * 64 + lane] = part; }
        MX_BAR();
        float inv_den; { float qn = 0.f;
#pragma unroll
          for (int w = 0; w < 8; ++w) qn += qnp[w * 64 + lane];
          float den = denP[lane] + denP[64 + lane] + w_inter * qn; den = fmaxf(fabsf(den), floorv); inv_den = __builtin_amdgcn_rcpf(den); Aid[lane] = inv_den; }
        { s8v sf[4];
#pragma unroll
          for (int ks = 0; ks < 4; ++ks) sf[ks] = pack_acc(Cst[2 * ks], Cst[2 * ks + 1]);
          const s8v vf0 = LD_TR(TV + wave * 32, L, 0, 0), vf1 = LD_TR(TV + wave * 32, L, 0, 1);
          if (!(var & 4))
#pragma unroll
          for (int lt = 0; lt < 4; ++lt) { f32x4 acc = {0.f, 0.f, 0.f, 0.f};
#pragma unroll
            for (int ks = 0; ks < 4; ++ks) acc = MX_MFMA(sf[ks], LD_PERM(TQ, L, lt, ks), acc);
            acc = acc * Awi[16 * lt + c16];
            acc = MX_MFMA(vf0, LD_ROWP(TP, L, lt, 0), acc);
            if (lt >= 2) acc = MX_MFMA(vf1, LD_ROWP(TP, L, lt, 1), acc);
            acc = acc * Aid[16 * lt + c16];
            v2u w; w.x = pk2(acc[0], acc[1]); w.y = pk2(acc[2], acc[3]);
            *(LAS v2u*)(TO + (16 * lt + c16) * TS + (16 * wave + 4 * g) * 2) = w; }
#pragma unroll
          for (int i = 0; i < 8; ++i) Cst[i] = Cst[i] * s_old;
          if (!(var & 8))
#pragma unroll
          for (int ks = 0; ks < 2; ++ks) { const s8v vf = ks ? vf1 : vf0; const v4u vw = __builtin_bit_cast(v4u, vf); float f[8]; unpack8(vw, f);
            { const f32x4 k0 = *(const LAS f32x4*)(Akw + 32 * ks + 8 * g), k1 = *(const LAS f32x4*)(Akw + 32 * ks + 8 * g + 4);
#pragma unroll
              for (int e = 0; e < 4; ++e) { f[e] *= k0[e]; f[4 + e] *= k1[e]; } }
            v4u pw = {pk2(f[0], f[1]), pk2(f[2], f[3]), pk2(f[4], f[5]), pk2(f[6], f[7])}; const s8v vwf = __builtin_bit_cast(s8v, pw);
#pragma unroll
            for (int dkt = 0; dkt < 8; ++dkt) Cst[dkt] = MX_MFMA(LD_TR(TK, L, dkt, ks), vwf, Cst[dkt]); }
          float part = 0.f;
#pragma unroll
          for (int e4 = 0; e4 < 4; ++e4) { const f32x4 kk = *(const LAS f32x4*)(Akw + 16 * g + 4 * e4);
#pragma unroll
            for (int e = 0; e < 4; ++e) { const int j = 16 * g + 4 * e4 + e; part += bf2f(*(const LAS unsigned short*)(TK + j * TS + (16 * wave + c16) * 2)) * kk[e]; } }
          part += __shfl_xor(part, 16); part += __shfl_xor(part, 32);
          nreg = s_old * nreg + part; if (g == 0) nsh[wave * 16 + c16] = nreg;
          m_prev = m_new; }
        asm volatile("s_waitcnt vmcnt(0)" ::: "memory"); MX_BAR();
        if (!(var & 16)) { const v4u a = *(const LAS v4u*)(TO + srow * TS + sch * 16), bq = *(const LAS v4u*)(TO + srow * TS + sch * 16 + 128); float f[16], of[16]; { float t8[8]; unpack8(a, t8);
#pragma unroll
            for (int e = 0; e < 8; ++e) f[e] = t8[e]; unpack8(bq, t8);
#pragma unroll
            for (int e = 0; e < 8; ++e) f[8 + e] = t8[e]; unpack8(ov0, t8);
#pragma unroll
            for (int e = 0; e < 8; ++e) of[e] = t8[e]; unpack8(ov1, t8);
#pragma unroll
            for (int e = 0; e < 8; ++e) of[8 + e] = t8[e]; }
          float ss = 0.f;
#pragma unroll
          for (int e = 0; e < 16; ++e) ss += f[e] * f[e];
          ss += __shfl_xor(ss, 1); ss += __shfl_xor(ss, 2); ss += __shfl_xor(ss, 4);
          const float rs = rsqrt_f(ss * (1.0f / 128.0f) + RMS_EPS);
          float wn[16]; { const f32x4 w0 = *(const f32x4*)(lnw + h * 128 + 8 * sch), w1 = *(const f32x4*)(lnw + h * 128 + 8 * sch + 4), w2 = *(const f32x4*)(lnw + h * 128 + 64 + 8 * sch), w3 = *(const f32x4*)(lnw + h * 128 + 64 + 8 * sch + 4);
#pragma unroll
            for (int e = 0; e < 4; ++e) { wn[e] = w0[e]; wn[4 + e] = w1[e]; wn[8 + e] = w2[e]; wn[12 + e] = w3[e]; } }
#pragma unroll
          for (int e = 0; e < 16; ++e) f[e] = f[e] * rs * wn[e] * sigmoid_f(of[e]);
          v4u o0 = {pk2(f[0], f[1]), pk2(f[2], f[3]), pk2(f[4], f[5]), pk2(f[6], f[7])}, o1 = {pk2(f[8], f[9]), pk2(f[10], f[11]), pk2(f[12], f[13]), pk2(f[14], f[15])};
          bf16* mp = MIX + (size_t)(t0 + srow) * 2048 + 1024 + h * 128 + 8 * sch; *(v4u*)mp = o0; *(v4u*)(mp + 64) = o1; }
    }
    MX_BAR();
}

__device__ __forceinline__ void ssd_item(LAS unsigned char* lds, int item, int var, int wave, const bf16* __restrict__ XBC, const bf16* __restrict__ PROJ, const float* __restrict__ GATES, const float* __restrict__ a_log,
                                         const float* __restrict__ d_skip, bf16* __restrict__ MIX, float* __restrict__ SSQ) {
    const int lane = lane_id(), tid = wave * 64 + lane, g = lane >> 4, c16 = lane & 15;
    const int b = item >> 3, hp = item & 7, grp = hp >> 2, hh = wave >> 2, ps = wave & 3;
    const LaneBase L = lane_base(lane);
    LAS unsigned char* TG = lds + 2 * BUF;
    LAS unsigned char* TO = TG + 2 * PTILE;
    LAS float* Aacs = (LAS float*)(TO + TILE); LAS float* Adinv = Aacs + 128; LAS float* Adt = Adinv + 128; LAS float* Awd = Adt + 128; LAS float* Aea = Awd + 128;
    f32x4 RT[8];
#pragma unroll
    for (int i = 0; i < 8; ++i) RT[i] = (f32x4){0.f, 0.f, 0.f, 0.f};
    const float an0 = -__expf(a_log[2 * hp]), an1 = -__expf(a_log[2 * hp + 1]), dk0 = d_skip[2 * hp], dk1 = d_skip[2 * hp + 1];
    const int srow = tid >> 3, sch = tid & 7;
    const bf16* xb = XBC + (size_t)(b * SEQ) * 1536;
    dma_tiles(lds, xb, 1536, 1280 + grp * 128, 1024 + grp * 128, hp * 128, wave, lane);
    float dn0 = GATES[(size_t)(b * SEQ + lane) * 32 + 2 * hp], dn1 = GATES[(size_t)(b * SEQ + lane) * 32 + 2 * hp + 1];
    asm volatile("s_waitcnt vmcnt(0)" ::: "memory"); MX_BAR();
#pragma unroll 1
    for (int c = 0; c < SEQ / 64; ++c) {
        const int cur = c & 1; const int t0 = b * SEQ + c * 64;
        LAS unsigned char* TC = lds + cur * BUF; LAS unsigned char* TB = TC + TILE; LAS unsigned char* TX = TC + 2 * TILE;
        float dr0 = dn0, dr1 = dn1; asm volatile("" : "+v"(dr0), "+v"(dr1));
        MX_SB();
        const v4u zv0 = *(const v4u*)(PROJ + (size_t)(t0 + srow) * NPROJ + C_Z + hp * 128 + 8 * sch), zv1 = *(const v4u*)(PROJ + (size_t)(t0 + srow) * NPROJ + C_Z + hp * 128 + 64 + 8 * sch);
        { const int tn = (c + 1 < SEQ / 64 ? t0 + 64 : t0) + lane; dn0 = GATES[(size_t)tn * 32 + 2 * hp]; dn1 = GATES[(size_t)tn * 32 + 2 * hp + 1]; }
        if (c + 1 < SEQ / 64 && !(var & 1)) { int lv = lane; asm volatile("" : "+v"(lv)); dma_tiles(lds + (cur ^ 1) * BUF, xb + (size_t)(c + 1) * 64 * 1536, 1536, 1280 + grp * 128, 1024 + grp * 128, hp * 128, wave, lv); }
        MX_SB();
        const float dt0 = softplus_fast(dr0), dt1 = softplus_fast(dr1);
        const float acs0 = scan_add(dt0 * an0), acs1 = scan_add(dt1 * an1);
        const float aend0 = lane63(acs0), aend1 = lane63(acs1);
        Aacs[lane] = acs0; Aacs[64 + lane] = acs1; Adinv[lane] = dk0 * __builtin_amdgcn_rcpf(dt0); Adinv[64 + lane] = dk1 * __builtin_amdgcn_rcpf(dt1); Adt[lane] = dt0; Adt[64 + lane] = dt1;
        Awd[lane] = __expf(aend0 - acs0); Awd[64 + lane] = __expf(aend1 - acs1); Aea[lane] = __expf(acs0); Aea[64 + lane] = __expf(acs1);
        const float aend = hh ? aend1 : aend0;
        if (!(var & 2)) { const int lt = wave & 3, st0 = 2 * (wave >> 2); const int l = 16 * lt + c16;
          const float al0 = Aacs[l], al1 = Aacs[64 + l], di0 = Adinv[l], di1 = Adinv[64 + l];
#pragma unroll
          for (int ss = 0; ss < 2; ++ss) { const int st = st0 + ss; float p0[4] = {0.f, 0.f, 0.f, 0.f}, p1[4] = {0.f, 0.f, 0.f, 0.f};
            if (st <= lt) { f32x4 acc = {0.f, 0.f, 0.f, 0.f};
#pragma unroll
                for (int ks = 0; ks < 4; ++ks) acc = MX_MFMA(LD_ROW(TB, L, st, ks), LD_ROW(TC, L, lt, ks), acc);
                const f32x4 as0 = *(const LAS f32x4*)(Aacs + 16 * st + 4 * g), as1 = *(const LAS f32x4*)(Aacs + 64 + 16 * st + 4 * g);
#pragma unroll
                for (int r = 0; r < 4; ++r) { const int sidx = 16 * st + 4 * g + r;
                    float v0 = (sidx <= l) ? acc[r] * __expf(al0 - as0[r]) : 0.f, v1 = (sidx <= l) ? acc[r] * __expf(al1 - as1[r]) : 0.f;
                    if (sidx == l) { v0 += di0; v1 += di1; } p0[r] = v0; p1[r] = v1; } }
            v2u w0, w1; w0.x = pk2(p0[0], p0[1]); w0.y = pk2(p0[2], p0[3]); w1.x = pk2(p1[0], p1[1]); w1.y = pk2(p1[2], p1[3]);
            const unsigned o = l * PS + (16 * st + 4 * g) * 2;
            *(LAS v2u*)(TG + o) = w0; *(LAS v2u*)(TG + PTILE + o) = w1; } }
        MX_BAR();
        { s8v sf[4];
#pragma unroll
          for (int ks = 0; ks < 4; ++ks) sf[ks] = pack_acc(RT[2 * ks], RT[2 * ks + 1]);
          s8v xd[2], xw[2];
#pragma unroll
          for (int ks = 0; ks < 2; ++ks) { const s8v xf = LD_TR(TX + (4 * hh + ps) * 32, L, 0, ks); const v4u xv = __builtin_bit_cast(v4u, xf); float f[8], fw[8]; unpack8(xv, f);
            { const LAS float* pd = Adt + 64 * hh + 32 * ks + 8 * g; const LAS float* pw = Awd + 64 * hh + 32 * ks + 8 * g; const f32x4 d0 = *(const LAS f32x4*)pd, d1 = *(const LAS f32x4*)(pd + 4), w0 = *(const LAS f32x4*)pw, w1 = *(const LAS f32x4*)(pw + 4);
#pragma unroll
              for (int e = 0; e < 4; ++e) { f[e] *= d0[e]; fw[e] = f[e] * w0[e]; f[4 + e] *= d1[e]; fw[4 + e] = f[4 + e] * w1[e]; } }
            v4u a = {pk2(f[0], f[1]), pk2(f[2], f[3]), pk2(f[4], f[5]), pk2(f[6], f[7])}, bw = {pk2(fw[0], fw[1]), pk2(fw[2], fw[3]), pk2(fw[4], fw[5]), pk2(fw[6], fw[7])};
            xd[ks] = __builtin_bit_cast(s8v, a); xw[ks] = __builtin_bit_cast(s8v, bw); }
          const LAS unsigned char* TGm = TG + hh * PTILE;
          if (!(var & 4))
#pragma unroll
          for (int lt = 0; lt < 4; ++lt) { f32x4 acc = {0.f, 0.f, 0.f, 0.f};
#pragma unroll
            for (int ks = 0; ks < 4; ++ks) acc = MX_MFMA(sf[ks], LD_PERM(TC, L, lt, ks), acc);
            acc = acc * Aea[64 * hh + 16 * lt + c16];
            acc = MX_MFMA(xd[0], LD_ROWP(TGm, L, lt, 0), acc);
            if (lt >= 2) acc = MX_MFMA(xd[1], LD_ROWP(TGm, L, lt, 1), acc);
            v2u w; w.x = pk2(acc[0], acc[1]); w.y = pk2(acc[2], acc[3]);
            *(LAS v2u*)(TO + (16 * lt + c16) * TS + (64 * hh + 16 * ps + 4 * g) * 2) = w; }
          const float ea = __expf(aend);
#pragma unroll
          for (int i = 0; i < 8; ++i) RT[i] = RT[i] * ea;
          if (!(var & 8))
#pragma unroll
          for (int ks = 0; ks < 2; ++ks)
#pragma unroll
            for (int nt = 0; nt < 8; ++nt) RT[nt] = MX_MFMA(LD_TR(TB, L, nt, ks), xw[ks], RT[nt]); }
        asm volatile("s_waitcnt vmcnt(0)" ::: "memory"); MX_BAR();
        if (!(var & 16)) { const v4u a = *(const LAS v4u*)(TO + srow * TS + sch * 16), bq = *(const LAS v4u*)(TO + srow * TS + sch * 16 + 128); float f[16], zf[16]; { float t8[8]; unpack8(a, t8);
#pragma unroll
            for (int e = 0; e < 8; ++e) f[e] = t8[e]; unpack8(bq, t8);
#pragma unroll
            for (int e = 0; e < 8; ++e) f[8 + e] = t8[e]; unpack8(zv0, t8);
#pragma unroll
            for (int e = 0; e < 8; ++e) zf[e] = t8[e]; unpack8(zv1, t8);
#pragma unroll
            for (int e = 0; e < 8; ++e) zf[8 + e] = t8[e]; }
          float ss = 0.f;
#pragma unroll
          for (int e = 0; e < 16; ++e) { f[e] = f[e] * silu_f(zf[e]); ss += f[e] * f[e]; }
          ss += __shfl_xor(ss, 1); ss += __shfl_xor(ss, 2); ss += __shfl_xor(ss, 4);
          if (sch == 0) SSQ[(size_t)(t0 + srow) * 8 + hp] = ss;
          v4u o0 = {pk2(f[0], f[1]), pk2(f[2], f[3]), pk2(f[4], f[5]), pk2(f[6], f[7])}, o1 = {pk2(f[8], f[9]), pk2(f[10], f[11]), pk2(f[12], f[13]), pk2(f[14], f[15])};
          bf16* mp = MIX + (size_t)(t0 + srow) * 2048 + hp * 128 + 8 * sch; *(v4u*)mp = o0; *(v4u*)(mp + 64) = o1; }
    }
    MX_BAR();
}
}

__global__ void __launch_bounds__(NTHR, 2) mega(Args args) {
    extern __shared__ __attribute__((aligned(16))) unsigned char lds_raw[];
    LAS unsigned char* lds = (LAS unsigned char*)lds_raw;
    const int wave = __builtin_amdgcn_readfirstlane((int)threadIdx.x >> 6);
    const int lane = lane_id(), tid = wave * 64 + lane;
    const int G = gridDim.x, bx = blockIdx.x;
    unsigned char* ws = args.ws;
#define INP(k) ({ int _k = (k); asm volatile("" : "+s"(_k)); args.in[_k]; })
#define XIN INP(0)
#define Win_t ((bf16*)(ws + WS_WIN))
#define Wout_t ((bf16*)(ws + WS_WOUT))
#define XN ((bf16*)(ws + WS_XN))
#define H ((bf16*)(ws + WS_H))
#define GATES ((float*)(ws + WS_GATES))
#define PROJ ((bf16*)(ws + WS_PROJ))
#define MIX ((bf16*)(ws + WS_MIX))
#define EO8 (ws + WS_XG + 136 * MiB)
#define TOPI ((int*)(ws + WS_ROUTE + R_TOPI))
#define TOPG ((float*)(ws + WS_ROUTE + R_TOPG))
#define TOKROW ((int*)(ws + WS_ROUTE + R_TOKROW))
#define ROWTOK ((int*)(ws + WS_ROUTE + R_ROWTOK))
#define ROWGATE ((float*)(ws + WS_ROUTE + R_ROWGATE))
#define BLKCNT ((int*)(ws + WS_ROUTE + R_BLKCNT))
#define BLKEXP ((int*)(ws + WS_ROUTE + R_BLKEXP))
#define NBLK ((int*)(ws + WS_ROUTE + R_NBLK))
#define XBC ((bf16*)(ws + WS_XBC))
#define SSQ ((float*)(ws + WS_SSQ))
#define RS1 ((float*)(ws + WS_SSQ + 1 * MiB))
#define RS2 ((float*)(ws + WS_SSQ + 1 * MiB + 128 * 1024))
#define ROWRS ((float*)(ws + WS_SSQ + 1 * MiB + 256 * 1024))
#define XN8 (ws + WS_XN)
#define XG8 (ws + WS_XG)
#define ACT8 (ws + WS_ACT)
#define Wgu8 (ws + WS_WGU)
#define Wdn8 (ws + WS_WDN)
    const int lo = args.ph_lo, hi = args.ph_hi;
    if (tid < 64) ((LAS unsigned*)(lds + MISC_OFF))[tid] = 0u;
    __syncthreads();
    XcdBarrier bar = xcd_barrier_post((unsigned*)(ws + WS_CTL) + CW_BAR, (volatile LAS unsigned*)(lds + MISC_OFF), tid == 0);
#define GRID_BAR(k) do { if (IN(k) && IN((k) + 1)) xcd_barrier(bar, wave == 0 && lane_id() == 0); } while (0)
#ifndef PH_MASK
#define PH_MASK 0xffff
#endif
#define IN(k) (((PH_MASK >> (k)) & 1) && lo <= (k) && (k) < hi)


    if (IN(0)) {
        const int tid = fresh_tid(wave), lane = tid & 63; (void)lane;
        LAS float* scr = (LAS float*)(lds + wave * 16384);
        const int gw = bx * NWAVES + wave, NGW = G * NWAVES;
        constexpr int I_IN = 16 * (NPROJ / 32), I_OUT = 32 * 32, I_GU = 16 * 64, I_DN = 16 * 32;
        constexpr int NITEMS = I_IN + I_OUT + NE * I_GU + NE * I_DN;
        if (!(args.variant & 32))
        for (int it = gw; it < NITEMS; it += NGW) {
            int r = it;
            if (r < I_IN) { const int nb = r % (NPROJ / 32), kb = r / (NPROJ / 32), n0 = nb * 32; const int n0s = n0 + (n0 >= C_Q ? 16 : 0);
                const float cs = (n0 >= C_K && n0 < C_V) ? 0.08838834764831845f : 1.0f;
                transpose_item(INP(2), WIN_LD, n0s, kb * 64, Win_t, 1024, n0, cs, nullptr, scr, lane); continue; } r -= I_IN;
            if (r < I_OUT) { const int nb = r % 32, kb = r / 32; transpose_item(INP(12), 1024, nb * 32, kb * 64, Wout_t, 2048, nb * 32, 1.0f, kb < 16 ? INP(8) : nullptr, scr, lane); continue; } r -= I_OUT;
            if (r < NE * I_GU) { const int e = r / I_GU, q = r % I_GU, nb = q % 64, kb = q / 64, rho = nb * 32; const int n0s = ((rho >> 7) & 1) * 1024 + (rho >> 8) * 128 + (rho & 127);
                transpose_item_f8(INP(16) + (size_t)e * 1024 * 2048, 2048, n0s, kb * 64, Wgu8 + (size_t)e * 2048 * 1024, 1024, rho, 64.0f, nullptr, scr, lane); continue; } r -= NE * I_GU;
            { const int e = r / I_DN, q = r % I_DN, nb = q % 32, kb = q / 32;
                transpose_item_f8(INP(18) + (size_t)e * 1024 * 1024, 1024, nb * 32, kb * 64, Wdn8 + (size_t)e * 1024 * 1024, 1024, nb * 32, 64.0f, nullptr, scr, lane); }
        }
        __syncthreads();
        pt_fill(lds, INP(2), WIN_LD, tid, true);
        __syncthreads();
        { const int c16 = lane & 15, g = lane >> 4;
          const float* wnp = INP(1); const float* bi_ = INP(9); const float* bf_ = INP(10); const float gb0 = INP(5)[c16], gb1 = *(c16 < 8 ? bi_ + c16 : bf_ + (c16 - 8));
          if (!(args.variant & 64))
#pragma unroll 1
          for (int task = gw; task < T / 16; task += NGW) { const int row0 = task * 16; f32x4 acc[2];
            const float rs = rowproj16<false, false>(XIN, XN, wnp, lds, row0, lane, acc);
            if (g == 0) RS1[row0 + c16] = rs;
#pragma unroll
            for (int r = 0; r < 4; ++r) { const float rr = __shfl(rs, 4 * g + r); float* gp = GATES + (size_t)(row0 + 4 * g + r) * 32; gp[c16] = rr * acc[0][r] + gb0; gp[16 + c16] = rr * acc[1][r] + gb1; } } }
        __syncthreads();
    }
    GRID_BAR(0);

    if (IN(1)) {
        pg8::Gemm g{XN, Win_t, T, NPROJ, 1024}; pg8::StaticOrder S; S.init(T, NPROJ, G, bx);
        pg8::EpiBf16 E{PROJ, NPROJ, RS1};
        pg8::gemm_phase<pg8::EpiBf16, pg8::StaticOrder>(lds, g, S, E, wave);
    }
    GRID_BAR(1);

    if (IN(2)) {
        const int tid = fresh_tid(wave), lane = tid & 63; (void)lane;
        const float* cw = INP(3); const float* cb = INP(4);
#pragma unroll 1
        for (int it = bx * NTHR + tid; it < (T / 16) * 192; it += G * NTHR) {
            const int ch = it % 192, t0 = (it / 192) * 16, c0 = ch * 8;
            float w[4][8], bs[8], r0[8], r1[8], r2[8];
#pragma unroll
            for (int k = 0; k < 4; ++k) { const f32x4 a = *(const f32x4*)(cw + k * 1536 + c0), b2 = *(const f32x4*)(cw + k * 1536 + c0 + 4);
#pragma unroll
                for (int e = 0; e < 4; ++e) { w[k][e] = a[e]; w[k][4 + e] = b2[e]; } }
            { const f32x4 a = *(const f32x4*)(cb + c0), b2 = *(const f32x4*)(cb + c0 + 4);
#pragma unroll
              for (int e = 0; e < 4; ++e) { bs[e] = a[e]; bs[4 + e] = b2[e]; } }
            const bf16* src = PROJ + (size_t)t0 * NPROJ + C_XBC + c0;
            if ((t0 & (SEQ - 1)) == 0) {
#pragma unroll
                for (int e = 0; e < 8; ++e) { r0[e] = 0.f; r1[e] = 0.f; r2[e] = 0.f; }
            } else { mx::unpack8(*(const v4u*)(src - 3 * (size_t)NPROJ), r0); mx::unpack8(*(const v4u*)(src - 2 * (size_t)NPROJ), r1); mx::unpack8(*(const v4u*)(src - (size_t)NPROJ), r2); }
#pragma unroll 4
            for (int i = 0; i < 16; ++i) { float cu[8], o[8]; mx::unpack8(*(const v4u*)(src + (size_t)i * NPROJ), cu);
#pragma unroll
                for (int e = 0; e < 8; ++e) { o[e] = silu_f(bs[e] + w[0][e] * r0[e] + w[1][e] * r1[e] + w[2][e] * r2[e] + w[3][e] * cu[e]); r0[e] = r1[e]; r1[e] = r2[e]; r2[e] = cu[e]; }
                v4u ov = {pk2(o[0], o[1]), pk2(o[2], o[3]), pk2(o[4], o[5]), pk2(o[6], o[7])};
                *(v4u*)(XBC + (size_t)(t0 + i) * 1536 + c0) = ov; }
        }
    }
    GRID_BAR(2);

    if (IN(3)) {
#pragma unroll 1
        for (int it = bx; it < 256; it += G) if ((it >> 3) & 1) mx::mlstm_item(lds, ((it >> 4) << 3) | (it & 7), args.variant, wave, PROJ, GATES, INP(11), MIX);
#pragma unroll 1
        for (int it = bx; it < 256; it += G) if (!((it >> 3) & 1)) mx::ssd_item(lds, ((it >> 4) << 3) | (it & 7), args.variant, wave, XBC, PROJ, GATES, INP(6), INP(7), MIX, SSQ);
    }
    GRID_BAR(3);
    if (IN(4)) {
        pg8::Gemm g{MIX, Wout_t, T, 1024, 2048}; pg8::StaticOrder S; S.init(T, 1024, G, bx);
        pg8::EpiResF32 E{XIN, H, 1024, SSQ};
        pg8::gemm_phase<pg8::EpiResF32, pg8::StaticOrder>(lds, g, S, E, wave);
    }

    GRID_BAR(4);
    if (IN(5)) {
        const int tid = fresh_tid(wave), lane = tid & 63; (void)lane;
        LAS int* hist = (LAS int*)(lds + MISC_OFF + 256);
        pt_fill(lds, INP(14), 32, tid, false);
        if (tid < 32) hist[tid] = 0;
        __syncthreads();
        const int c16 = lane & 15, g = lane >> 4; const float* wnp = INP(13); const float rb0 = INP(15)[c16], rb1 = INP(15)[16 + c16];
        for (int blk = bx; blk < T / 128; blk += G) {
            const int row0 = blk * 128 + wave * 16; f32x4 acc[2];
            const float rs = rowproj16<true, true>(H, XN8, wnp, lds, row0, lane, acc);
            if (g == 0) RS2[row0 + c16] = rs;
#pragma unroll
            for (int r = 0; r < 4; ++r) { const float rr = __shfl(rs, 4 * g + r); float v0 = rr * acc[0][r] + rb0, v1 = rr * acc[1][r] + rb1; float tv[4]; int ti[4];
#pragma unroll
                for (int k = 0; k < 4; ++k) { float bv = v0 >= v1 ? v0 : v1; int bi = v0 >= v1 ? c16 : c16 + 16;
#pragma unroll
                    for (int m = 1; m < 16; m <<= 1) { const float ov = __shfl_xor(bv, m); const int oi = __shfl_xor(bi, m); if (ov > bv || (ov == bv && oi < bi)) { bv = ov; bi = oi; } }
                    tv[k] = bv; ti[k] = bi; if (bi == c16) v0 = -INFINITY; if (bi == c16 + 16) v1 = -INFINITY; }
                const float e1 = __expf(tv[1] - tv[0]), e2 = __expf(tv[2] - tv[0]), e3 = __expf(tv[3] - tv[0]); const float inv = 1.0f / (1.0f + e1 + e2 + e3);
                if (c16 == 0) { const size_t o = (size_t)(row0 + 4 * g + r) * 4; TOPI[o] = ti[0]; TOPI[o + 1] = ti[1]; TOPI[o + 2] = ti[2]; TOPI[o + 3] = ti[3];
                    TOPG[o] = inv; TOPG[o + 1] = e1 * inv; TOPG[o + 2] = e2 * inv; TOPG[o + 3] = e3 * inv;
                    __hip_atomic_fetch_add(hist + ti[0], 1, __ATOMIC_RELAXED, __HIP_MEMORY_SCOPE_WORKGROUP); __hip_atomic_fetch_add(hist + ti[1], 1, __ATOMIC_RELAXED, __HIP_MEMORY_SCOPE_WORKGROUP); __hip_atomic_fetch_add(hist + ti[2], 1, __ATOMIC_RELAXED, __HIP_MEMORY_SCOPE_WORKGROUP); __hip_atomic_fetch_add(hist + ti[3], 1, __ATOMIC_RELAXED, __HIP_MEMORY_SCOPE_WORKGROUP); } }
            __syncthreads();
            if (tid < 32) { BLKCNT[blk * 32 + tid] = hist[tid]; hist[tid] = 0; }
            __syncthreads();
        }
    }
    GRID_BAR(5);
    if (IN(6)) {
        const int tid = fresh_tid(wave), lane = tid & 63; (void)lane;
        LAS int* tot = (LAS int*)lds; LAS int* base = tot + 32; LAS int* pstart = base + 32; LAS int* wcnt = pstart + 33;
        LAS int* arow = wcnt + 256;
        for (int blk = bx; blk < T / 128; blk += G) {
            if (tid < 32) { int t = 0, b = 0; for (int j = 0; j < T / 128; ++j) { const int v = BLKCNT[j * 32 + tid]; t += v; if (j < blk) b += v; } tot[tid] = t; base[tid] = b; }
            __syncthreads();
            if (tid == 0) { int s = 0; for (int e = 0; e < 32; ++e) { pstart[e] = s; s += (tot[e] + 255) / 256 * 256; } pstart[32] = s; }
            __syncthreads();
            const int token = blk * 128 + (tid >> 2), k = tid & 3; const int e = TOPI[(size_t)token * 4 + k];
            int rank = 0;
#pragma unroll 1
            for (int ee = 0; ee < 32; ++ee) { const unsigned long long m = __ballot(e == ee); if (e == ee) rank = __popcll(m & ((1ull << lane) - 1ull)); if (lane == 0) wcnt[wave * 32 + ee] = __popcll(m); }
            __syncthreads();
            int off = 0; for (int w = 0; w < wave; ++w) off += wcnt[w * 32 + e];
            const int row = pstart[e] + base[e] + off + rank;
            ROWTOK[row] = token; ROWGATE[row] = TOPG[(size_t)token * 4 + k]; ROWRS[row] = RS2[token]; TOKROW[(size_t)token * 4 + k] = row; arow[tid] = row;
            __syncthreads();
            for (int a = 0; a < 64; ++a) { const int ai = wave * 64 + a; const int drow = arow[ai]; const int tok = blk * 128 + (ai >> 2);
                const v4u* s = (const v4u*)(XN8 + (size_t)tok * 1024); v4u* d = (v4u*)(XG8 + (size_t)drow * 1024); d[lane] = s[lane]; }
            if (blk < 32) { const int ps = pstart[blk] + tot[blk], pe = pstart[blk + 1];
                for (int r = ps + wave; r < pe; r += NWAVES) { if (lane == 0) { ROWTOK[r] = 0; ROWGATE[r] = 0.f; ROWRS[r] = 0.f; } v4u* d = (v4u*)(XG8 + (size_t)r * 1024); const v4u z = {0u, 0u, 0u, 0u}; d[lane] = z; } }
            if (blk == 0) { const int nb = pstart[32] / 256; if (tid == 0) NBLK[0] = nb;
                for (int b = tid; b < nb; b += NTHR) { int e2 = 0; while (e2 < 31 && b * 256 >= pstart[e2 + 1]) ++e2; BLKEXP[b] = e2; } }
            __syncthreads();
        }
    }

    GRID_BAR(6);
    if (IN(7)) {
        pg8::Gemm g{(const bf16*)XG8, (const bf16*)Wgu8, MAXROWS, 2048, 512}; pg8::MoeOrder S{BLKEXP, __builtin_amdgcn_readfirstlane(NBLK[0]), 8, G, bx};
        pg8::EpiSwiglu E{ACT8, INP(17), ROWRS};
        pg8::gemm_phase_f8<pg8::EpiSwiglu, pg8::MoeOrder>(lds, g, S, E, wave);
    }
    GRID_BAR(7);
    if (IN(8)) {
        pg8::Gemm g{(const bf16*)ACT8, (const bf16*)Wdn8, MAXROWS, 1024, 512}; pg8::MoeOrder S{BLKEXP, __builtin_amdgcn_readfirstlane(NBLK[0]), 4, G, bx};
        pg8::EpiDown E{EO8, INP(19), ROWGATE};
        pg8::gemm_phase_f8<pg8::EpiDown, pg8::MoeOrder>(lds, g, S, E, wave);
    }
    GRID_BAR(8);
    if (IN(9)) {
        const int tid = fresh_tid(wave), lane = tid & 63; (void)lane;
        const int gw = bx * NWAVES + wave, NGW = G * NWAVES;
        f32x4 wf[4];
#pragma unroll
        for (int j = 0; j < 4; ++j) wf[j] = *(const f32x4*)(INP(20) + 4 * lane + 256 * j);
        for (int row = gw; row < T; row += NGW) {
            f32x4 v[4];
#pragma unroll
            for (int j = 0; j < 4; ++j) { const v2u w = *(const v2u*)(H + (size_t)row * 1024 + 4 * lane + 256 * j); v[j] = (f32x4){bflo(w.x), bfhi(w.x), bflo(w.y), bfhi(w.y)}; }
            f32x4 ya[4];
#pragma unroll
            for (int j = 0; j < 4; ++j) ya[j] = (f32x4){0.f, 0.f, 0.f, 0.f};
#pragma unroll
            for (int k = 0; k < 4; ++k) { const int er = TOKROW[(size_t)row * 4 + k]; const unsigned char* ep = EO8 + (size_t)er * 1024;
#pragma unroll
                for (int j = 0; j < 4; ++j) { const int w = *(const int*)(ep + 4 * lane + 256 * j); typedef float f2v __attribute__((ext_vector_type(2)));
                    const f2v lo = __builtin_amdgcn_cvt_pk_f32_fp8(w, false), hi = __builtin_amdgcn_cvt_pk_f32_fp8(w, true); ya[j][0] += lo[0]; ya[j][1] += lo[1]; ya[j][2] += hi[0]; ya[j][3] += hi[1]; } }
#pragma unroll
            for (int j = 0; j < 4; ++j) v[j] = v[j] + ya[j] * 0.0625f;
            float ss = 0.f;
#pragma unroll
            for (int j = 0; j < 4; ++j) ss += (v[j][0] * v[j][0] + v[j][1] * v[j][1]) + (v[j][2] * v[j][2] + v[j][3] * v[j][3]);
            ss = wave_sum(ss); const float rs = 1.0f / sqrtf(ss * (1.0f / 1024.0f) + RMS_EPS);
#pragma unroll
            for (int j = 0; j < 4; ++j) *(f32x4*)(args.out + (size_t)row * 1024 + 4 * lane + 256 * j) = v[j] * rs * wf[j];
        }
    }
#undef IN
}

extern "C" void kernel_launch(void* const* d_in, const int* in_sizes, int n_in, void* d_out, int out_size, void* d_ws, size_t ws_size, hipStream_t stream) {
    static int grid = 0;
    if (grid == 0) {
        if (n_in != 21 || in_sizes[0] != T * D || out_size != T * D || ws_size < WS_END) { fprintf(stderr, "kernel_launch: unexpected shapes/workspace (n_in %d, ws %zu, need %zu)\n", n_in, ws_size, (size_t)WS_END); grid = -1; return; }
        if (hipFuncSetAttribute((const void*)mega, hipFuncAttributeMaxDynamicSharedMemorySize, LDS_BYTES) != hipSuccess) { fprintf(stderr, "kernel_launch: hipFuncSetAttribute failed\n"); grid = -1; return; }
        int dev = 0, cus = 0, per_cu = 0;
        if (hipGetDevice(&dev) != hipSuccess || hipDeviceGetAttribute(&cus, hipDeviceAttributeMultiprocessorCount, dev) != hipSuccess) { grid = -1; return; }
        if (hipOccupancyMaxActiveBlocksPerMultiprocessor(&per_cu, (const void*)mega, NTHR, LDS_BYTES) != hipSuccess || per_cu < 1) { fprintf(stderr, "kernel_launch: occupancy query says %d blocks per CU\n", per_cu); grid = -1; return; }
        (void)hipGetLastError();
        grid = cus;
    }
    if (grid < 0) return;
    (void)hipMemsetAsync((char*)d_ws + WS_CTL, 0, CTL_ZERO_BYTES, stream);
    Args a{};
    for (int i = 0; i < 21; ++i) a.in[i] = (const float*)d_in[i];
    a.out = (float*)d_out; a.ws = (unsigned char*)d_ws;
    a.ph_lo = 0; a.ph_hi = 10;
    hipLaunchKernelGGL(mega, dim3(grid), dim3(NTHR), LDS_BYTES, stream, a);
#ifdef PROBE_PHASE
    a.ph_lo = PROBE_PHASE; a.ph_hi = PROBE_PHASE + 1;
#ifdef PROBE_VARIANT
    a.variant = PROBE_VARIANT;
#endif
    hipLaunchKernelGGL(mega, dim3(grid), dim3(NTHR), LDS_BYTES, stream, a);
#endif
}
```

```cpp
#include <hip/hip_runtime.h>
#include <cstdio>
#include <cstdint>

__device__ __forceinline__ int lane_id() { int l; asm volatile("v_mbcnt_lo_u32_b32 %0, -1, 0\n\tv_mbcnt_hi_u32_b32 %0, -1, %0" : "=v"(l)); return l; }
namespace pg8 {
#define PG8_LAS __attribute__((address_space(3)))
typedef unsigned short bf16_t;
typedef short bf16x8 __attribute__((ext_vector_type(8)));
typedef float f32x4 __attribute__((ext_vector_type(4)));
typedef unsigned u32x4 __attribute__((ext_vector_type(4)));
constexpr int BM = 256, BK = 64, HALF = 128, HTB = HALF * BK * 2, STAGE_BYTES = 8 * HTB, NXCD = 8, WGM = 8;

__host__ __device__ __forceinline__ int lds_byte(int r, int c) { const int st = (r >> 4) * 2 + (c >> 5), rr = r & 15, cc = c & 31, ob = rr * 64 + cc * 2; return st * 1024 + (ob ^ (((ob >> 9) & 1) << 5)); }
__host__ __device__ __forceinline__ void stage_rc(int b, int& R, int& C) { const int st = b / 1024, sb = b % 1024, swz = sb ^ (((sb >> 9) & 1) << 5); R = (st >> 1) * 16 + swz / 64; C = (st & 1) * 32 + (swz % 64) / 2; }
__host__ __device__ __forceinline__ int perm32(int rho) { const int n = rho >> 4, i = rho & 15; return 8 * (i >> 2) + 4 * n + (i & 3); }

__device__ __forceinline__ const char* uni_ptr(const void* p) { const unsigned long long v = (unsigned long long)p; const unsigned lo = __builtin_amdgcn_readfirstlane((unsigned)v), hi = __builtin_amdgcn_readfirstlane((unsigned)(v >> 32)); return (const char*)(((unsigned long long)hi << 32) | lo); }
struct Unit { int pm, pn, pb, e; };
struct Gemm { const bf16_t* A; const bf16_t* Bt; int M, N, K; };

struct StaticOrder {
    int nM, nN, nwg, G, c;
    __host__ __device__ void init(int M, int N, int G_, int c_) { nM = M / BM; nN = N / BM; nwg = nM * nN; G = G_; c = c_; }
    __host__ __device__ bool next(int i, Unit& u) const {
        const long L = (long)i * G + c; if (L >= nwg) return false;
        int wgid = (int)L; { const int q = nwg / NXCD, r = nwg % NXCD, xcd = wgid % NXCD, off = wgid / NXCD; wgid = (xcd < r ? xcd * (q + 1) : r * (q + 1) + (xcd - r) * q) + off; }
        const int nig = WGM * nN, gid = wgid / nig, fm = gid * WGM, gsz = (nM - fm) < WGM ? (nM - fm) : WGM;
        u.pm = fm + ((wgid % nig) % gsz); u.pn = (wgid % nig) / gsz; u.pb = u.pn; u.e = 0; return true;
    }
};
struct MoeOrder {
    const int* blk_expert; int nblk, ntn, G, c;
    __device__ bool next(int i, Unit& u) const {
        const int xcd = c % NXCD, s = i * (G / NXCD) + c / NXCD;
        const int rb = (s / ntn) * NXCD + xcd; if (rb >= nblk) return false;
        u.pm = rb; u.pn = s % ntn; u.e = __builtin_amdgcn_readfirstlane(blk_expert[rb]); u.pb = u.e * ntn + u.pn; return true;
    }
};

__device__ __forceinline__ unsigned cvt_pk_bf16(float lo, float hi) { unsigned r; asm volatile("v_cvt_pk_bf16_f32 %0, %1, %2" : "=v"(r) : "v"(lo), "v"(hi)); return r; }

struct EpiBf16 {
    static constexpr bool PERM = true; static constexpr int MIDT = -1;
    __device__ __forceinline__ void mid(f32x4 (&)[2][2][4][2], const Unit&, int, int) const {}
    bf16_t* O; int ldc; const float* rs;
    __device__ __forceinline__ void operator()(const f32x4 (&acc)[2][2][4][2], const Unit& u, int wr, int wc, int fr, int fq) const {
        const int row0 = u.pm * BM + wr * 64 + fr, col0 = u.pn * BM + wc * 32 + 8 * fq;
#pragma unroll
        for (int ai = 0; ai < 2; ++ai)
#pragma unroll
            for (int m = 0; m < 4; ++m) { const int row = row0 + ai * HALF + m * 16; const float rr = rs[row]; bf16_t* rowp = O + (size_t)row * ldc + col0;
#pragma unroll
                for (int bj = 0; bj < 2; ++bj) { const f32x4 v0 = acc[ai][bj][m][0] * rr, v1 = acc[ai][bj][m][1] * rr;
                    u32x4 w; w.x = cvt_pk_bf16(v0[0], v0[1]); w.y = cvt_pk_bf16(v0[2], v0[3]); w.z = cvt_pk_bf16(v1[0], v1[1]); w.w = cvt_pk_bf16(v1[2], v1[3]);
                    *(u32x4*)(rowp + bj * HALF) = w; } }
    }
};
struct EpiResF32 {
    static constexpr bool PERM = true; static constexpr int MIDT = 16;
    const float* base; bf16_t* C; int ldc; const float* ssq;
    __device__ __forceinline__ void mid(f32x4 (&acc)[2][2][4][2], const Unit& u, int wr, int fr) const {
#pragma unroll
        for (int ai = 0; ai < 2; ++ai)
#pragma unroll
            for (int m = 0; m < 4; ++m) { const int row = u.pm * BM + ai * HALF + wr * 64 + m * 16 + fr; const f32x4 a = *(const f32x4*)(ssq + (size_t)row * 8), b = *(const f32x4*)(ssq + (size_t)row * 8 + 4);
                const float rs = 1.0f / sqrtf(((a[0] + a[1]) + (a[2] + a[3]) + (b[0] + b[1]) + (b[2] + b[3])) * (1.0f / 1024.0f) + 1e-6f);
#pragma unroll
                for (int bj = 0; bj < 2; ++bj)
#pragma unroll
                    for (int n = 0; n < 2; ++n) acc[ai][bj][m][n] = acc[ai][bj][m][n] * rs;
                asm volatile("" ::: "memory"); }
    }
    __device__ __forceinline__ void operator()(const f32x4 (&acc)[2][2][4][2], const Unit& u, int wr, int wc, int fr, int fq) const {
        const int row0 = u.pm * BM + wr * 64 + fr, col0 = u.pn * BM + wc * 32 + 8 * fq;
#pragma unroll
        for (int ai = 0; ai < 2; ++ai)
#pragma unroll
            for (int m = 0; m < 4; ++m) { const size_t off = (size_t)(row0 + ai * HALF + m * 16) * ldc + col0;
#pragma unroll
                for (int bj = 0; bj < 2; ++bj) { const f32x4 b0 = *(const f32x4*)(base + off + bj * HALF), b1 = *(const f32x4*)(base + off + bj * HALF + 4);
                    const f32x4 v0 = acc[ai][bj][m][0] + b0, v1 = acc[ai][bj][m][1] + b1;
                    u32x4 w; w.x = cvt_pk_bf16(v0[0], v0[1]); w.y = cvt_pk_bf16(v0[2], v0[3]); w.z = cvt_pk_bf16(v1[0], v1[1]); w.w = cvt_pk_bf16(v1[2], v1[3]);
                    *(u32x4*)(C + off + bj * HALF) = w; } }
    }
};
struct EpiSwiglu {
    static constexpr bool PERM = true; static constexpr int MIDT = -1;
    __device__ __forceinline__ void mid(f32x4 (&)[2][2][4][2], const Unit&, int, int) const {}
    unsigned char* act; const float* bgu; const float* rs;
    __device__ __forceinline__ void operator()(const f32x4 (&acc)[2][2][4][2], const Unit& u, int wr, int wc, int fr, int fq) const {
        const int row0 = u.pm * BM + wr * 64 + fr, col0 = u.pn * HALF + wc * 32 + 8 * fq;
        const float* bg = bgu + (size_t)u.e * 2048 + col0;
        f32x4 bgv[2], buv[2];
#pragma unroll
        for (int n = 0; n < 2; ++n) { bgv[n] = *(const f32x4*)(bg + 4 * n); buv[n] = *(const f32x4*)(bg + 1024 + 4 * n); }
#pragma unroll
        for (int ai = 0; ai < 2; ++ai)
#pragma unroll
            for (int m = 0; m < 4; ++m) { const int row = row0 + ai * HALF + m * 16; const float rr = rs[row]; unsigned char* rowp = act + (size_t)row * 1024 + col0;
                float o[8];
#pragma unroll
                for (int n = 0; n < 2; ++n) { const f32x4 gv = acc[ai][0][m][n] * rr + bgv[n], uv = acc[ai][1][m][n] * rr + buv[n];
#pragma unroll
                    for (int i = 0; i < 4; ++i) { const float g = fminf(gv[i], 7.0f), uu = fminf(fmaxf(uv[i], -7.0f), 7.0f);
                        o[4 * n + i] = (uu + 1.0f) * g * __builtin_amdgcn_rcpf(1.0f + __expf(-1.702f * g)); } }
                int w0 = 0, w1 = 0; w0 = __builtin_amdgcn_cvt_pk_fp8_f32(o[0], o[1], w0, false); w0 = __builtin_amdgcn_cvt_pk_fp8_f32(o[2], o[3], w0, true); w1 = __builtin_amdgcn_cvt_pk_fp8_f32(o[4], o[5], w1, false); w1 = __builtin_amdgcn_cvt_pk_fp8_f32(o[6], o[7], w1, true);
                typedef int i2v __attribute__((ext_vector_type(2))); *(i2v*)rowp = (i2v){w0, w1}; }
    }
};
struct EpiDown {
    static constexpr bool PERM = true; static constexpr int MIDT = -1;
    __device__ __forceinline__ void mid(f32x4 (&)[2][2][4][2], const Unit&, int, int) const {}
    unsigned char* eo; const float* bdn; const float* row_gate;
    __device__ __forceinline__ void operator()(const f32x4 (&acc)[2][2][4][2], const Unit& u, int wr, int wc, int fr, int fq) const {
        const int row0 = u.pm * BM + wr * 64 + fr, col0 = u.pn * BM + wc * 32 + 8 * fq;
        const float* bb = bdn + (size_t)u.e * 1024 + col0;
        f32x4 bv[2][2];
#pragma unroll
        for (int bj = 0; bj < 2; ++bj)
#pragma unroll
            for (int n = 0; n < 2; ++n) bv[bj][n] = *(const f32x4*)(bb + bj * HALF + 4 * n);
#pragma unroll
        for (int ai = 0; ai < 2; ++ai)
#pragma unroll
            for (int m = 0; m < 4; ++m) { const int row = row0 + ai * HALF + m * 16; const float gt = row_gate[row] * 16.0f; unsigned char* rowp = eo + (size_t)row * 1024 + col0;
#pragma unroll
                for (int bj = 0; bj < 2; ++bj) { const f32x4 v0 = (acc[ai][bj][m][0] + bv[bj][0]) * gt, v1 = (acc[ai][bj][m][1] + bv[bj][1]) * gt;
                    int w0 = 0, w1 = 0; w0 = __builtin_amdgcn_cvt_pk_fp8_f32(v0[0], v0[1], w0, false); w0 = __builtin_amdgcn_cvt_pk_fp8_f32(v0[2], v0[3], w0, true); w1 = __builtin_amdgcn_cvt_pk_fp8_f32(v1[0], v1[1], w1, false); w1 = __builtin_amdgcn_cvt_pk_fp8_f32(v1[2], v1[3], w1, true);
                    typedef int i2v __attribute__((ext_vector_type(2))); *(i2v*)(rowp + bj * HALF) = (i2v){w0, w1}; } }
    }
};

typedef int v8i_t __attribute__((ext_vector_type(8)));
typedef int v4i_t __attribute__((ext_vector_type(4)));
template <class Epi, class Sched>
__device__ __forceinline__ void gemm_phase(PG8_LAS unsigned char* lds, const Gemm g, const Sched& S, const Epi& E, int wid) {
    const int lane = lane_id(), tid = wid * 64 + lane, wr = wid >> 2, wc = wid & 3, fr = lane & 15, fq = lane >> 4;
    const int K = g.K, nt = K / BK;
    unsigned voffA[2], voffB[2];
#pragma unroll
    for (int i = 0; i < 2; ++i) { int R, C; stage_rc(tid * 16 + i * 8192, R, C); const int Rb = Epi::PERM ? ((R & ~31) + perm32(R & 31)) : R;
        voffA[i] = (unsigned)(R * K + C) * 2u; voffB[i] = (unsigned)(Rb * K + C) * 2u; }
    const size_t kstep = (size_t)(BK * 2);
    const size_t hstep = (size_t)HALF * K * 2;
    const size_t tstep = 2 * hstep;
    const unsigned ldsw = (unsigned)wid * 1024u;
    const int aoff = lds_byte(wr * 64 + fr, fq * 8), boff = lds_byte(wc * 32 + fr, fq * 8);
#define PG8_SA(b, h) (((b) * 2 + (h)) * HTB)
#define PG8_SB(b, h) ((4 + (b) * 2 + (h)) * HTB)
#define PG8_STAGE(bufoff, gbase, voff) do { _Pragma("unroll") for (int _i = 0; _i < 2; ++_i) \
        __builtin_amdgcn_global_load_lds((const unsigned*)((const char*)(gbase) + (voff)[_i]), (PG8_LAS unsigned*)(lds + (bufoff) + ldsw + _i * 8192), 16, 0, 0); } while (0)
#define PG8_LDA(dst, b, h) do { _Pragma("unroll") for (int m = 0; m < 4; ++m) _Pragma("unroll") for (int k = 0; k < 2; ++k) dst[m][k] = *(const PG8_LAS bf16x8*)(lds + PG8_SA(b, h) + aoff + m * 2048 + k * 1024); } while (0)
#define PG8_LDB(dst, b, h) do { _Pragma("unroll") for (int n = 0; n < 2; ++n) _Pragma("unroll") for (int k = 0; k < 2; ++k) dst[n][k] = *(const PG8_LAS bf16x8*)(lds + PG8_SB(b, h) + boff + n * 2048 + k * 1024); } while (0)
#define PG8_MMA(ai, bj, At, Bt) do { __builtin_amdgcn_s_setprio(1); _Pragma("unroll") for (int m = 0; m < 4; ++m) _Pragma("unroll") for (int n = 0; n < 2; ++n) _Pragma("unroll") for (int k = 0; k < 2; ++k) \
        acc[ai][bj][m][n] = __builtin_amdgcn_mfma_f32_16x16x32_bf16(Bt[n][k], At[m][k], acc[ai][bj][m][n], 0, 0, 0); __builtin_amdgcn_s_setprio(0); } while (0)
#define PG8_WAIT_V(n) asm volatile("s_waitcnt vmcnt(" #n ")" ::: "memory")
#define PG8_WAIT_L(n) asm volatile("s_waitcnt lgkmcnt(" #n ")" ::: "memory")
#define PG8_BAR __builtin_amdgcn_s_barrier()
#define PG8_SCHED __builtin_amdgcn_sched_barrier(0)
    Unit cur, nxt; int ui = 0;
    if (!S.next(0, cur)) return;
    f32x4 acc[2][2][4][2];
#pragma unroll
    for (int a = 0; a < 2; ++a)
#pragma unroll
        for (int b = 0; b < 2; ++b)
#pragma unroll
            for (int m = 0; m < 4; ++m)
#pragma unroll
                for (int n = 0; n < 2; ++n) acc[a][b][m][n] = (f32x4){0.f, 0.f, 0.f, 0.f};
    bf16x8 At[4][2], B0[2][2], B1[2][2];
    const char* cA = uni_ptr((const char*)g.A + (size_t)cur.pm * tstep); const char* cB = uni_ptr((const char*)g.Bt + (size_t)cur.pb * tstep);
    PG8_STAGE(PG8_SB(0, 0), cB, voffB); PG8_STAGE(PG8_SB(0, 1), cB + hstep, voffB); PG8_STAGE(PG8_SA(0, 0), cA, voffA); PG8_STAGE(PG8_SA(0, 1), cA + hstep, voffA);
    if (wr == 1) PG8_BAR;
    PG8_WAIT_V(2); PG8_BAR;
    PG8_STAGE(PG8_SB(1, 0), cB + kstep, voffB); PG8_STAGE(PG8_SA(1, 0), cA + kstep, voffA); PG8_STAGE(PG8_SB(1, 1), cB + hstep + kstep, voffB);
    PG8_WAIT_V(6); PG8_BAR;
    for (;;) {
        const bool has_next = S.next(ui + 1, nxt);
        const char* nA = uni_ptr(has_next ? (const char*)g.A + (size_t)nxt.pm * tstep : cA); const char* nB = uni_ptr(has_next ? (const char*)g.Bt + (size_t)nxt.pb * tstep : cB);
        for (int t = 0; t < nt; t += 2) {
            const bool last = (t == nt - 2);
            const char* a1 = cA + (size_t)(t + 1) * kstep;
            const char* a2 = last ? nA : cA + (size_t)(t + 2) * kstep; const char* b2 = last ? nB : cB + (size_t)(t + 2) * kstep;
            const char* a3 = a2 + kstep; const char* b3 = b2 + kstep;
            if constexpr (Epi::MIDT >= 0) { if (t == Epi::MIDT) E.mid(acc, cur, wr, fr); }
            PG8_LDB(B0, 0, 0); PG8_LDB(B1, 0, 1); PG8_SCHED; PG8_LDA(At, 0, 0); PG8_STAGE(PG8_SA(1, 1), a1 + hstep, voffA);
            PG8_WAIT_V(8); PG8_WAIT_L(0); PG8_BAR; PG8_MMA(0, 0, At, B0); PG8_MMA(0, 1, At, B1); PG8_BAR; PG8_SCHED;
            PG8_LDA(At, 0, 1); PG8_STAGE(PG8_SB(0, 0), b2, voffB); PG8_STAGE(PG8_SB(0, 1), b2 + hstep, voffB); PG8_STAGE(PG8_SA(0, 0), a2, voffA);
            PG8_WAIT_V(8); PG8_WAIT_L(0); PG8_BAR; PG8_MMA(1, 0, At, B0); PG8_MMA(1, 1, At, B1); PG8_BAR; PG8_SCHED;
            PG8_LDB(B0, 1, 0); PG8_LDB(B1, 1, 1); PG8_SCHED; PG8_LDA(At, 1, 0); PG8_STAGE(PG8_SA(0, 1), a2 + hstep, voffA);
            PG8_WAIT_V(8); PG8_WAIT_L(0); PG8_BAR; PG8_MMA(0, 0, At, B0); PG8_MMA(0, 1, At, B1); PG8_BAR; PG8_SCHED;
            PG8_LDA(At, 1, 1); PG8_STAGE(PG8_SB(1, 0), b3, voffB); PG8_STAGE(PG8_SB(1, 1), b3 + hstep, voffB); PG8_STAGE(PG8_SA(1, 0), a3, voffA);
            PG8_WAIT_V(8); PG8_WAIT_L(0); PG8_BAR; PG8_MMA(1, 0, At, B0); PG8_MMA(1, 1, At, B1); PG8_BAR; PG8_SCHED;
        }
        if (wr == 0) PG8_BAR;
        E(acc, cur, wr, wc, fr, fq);
        if (!has_next) break;
#pragma unroll
        for (int a = 0; a < 2; ++a)
#pragma unroll
            for (int b = 0; b < 2; ++b)
#pragma unroll
                for (int m = 0; m < 4; ++m)
#pragma unroll
                    for (int n = 0; n < 2; ++n) acc[a][b][m][n] = (f32x4){0.f, 0.f, 0.f, 0.f};
        cur = nxt; cA = nA; cB = nB; ++ui;
        if (wr == 1) PG8_BAR;
    }
    PG8_WAIT_V(0);
    PG8_BAR;
#undef PG8_SA
#undef PG8_SB
#undef PG8_STAGE
#undef PG8_LDA
#undef PG8_LDB
#undef PG8_MMA
#undef PG8_WAIT_V
#undef PG8_WAIT_L
#undef PG8_BAR
#undef PG8_SCHED
}
template <class Epi, class Sched>
__device__ __forceinline__ void gemm_phase_f8(PG8_LAS unsigned char* lds, const Gemm g, const Sched& S, const Epi& E, int wid) {
    const int lane = lane_id(), tid = wid * 64 + lane, wr = wid >> 2, wc = wid & 3, fr = lane & 15, fq = lane >> 4;
    int Kq = g.K; asm volatile("" : "+s"(Kq));
    const int K = Kq, nt = K / BK;
    unsigned voffA[2], voffB[2];
#pragma unroll
    for (int i = 0; i < 2; ++i) { int R, C; stage_rc(tid * 16 + i * 8192, R, C); const int Rb = Epi::PERM ? ((R & ~31) + perm32(R & 31)) : R;
        voffA[i] = (unsigned)(R * K + C) * 2u; voffB[i] = (unsigned)(Rb * K + C) * 2u; }
    const size_t kstep = (size_t)(BK * 2);
    const size_t hstep = (size_t)HALF * K * 2;
    const size_t tstep = 2 * hstep;
    const unsigned ldsw = (unsigned)wid * 1024u;
    const unsigned ldsb = (unsigned)__builtin_amdgcn_readfirstlane((int)((unsigned)(size_t)lds + ldsw));
    const int aoff = lds_byte(wr * 64 + fr, fq * 8), boff = lds_byte(wc * 32 + fr, fq * 8);
#define PG8_SA(b, h) (((b) * 2 + (h)) * HTB)
#define PG8_SB(b, h) ((4 + (b) * 2 + (h)) * HTB)
#define PG8_STAGE(bufoff, gbase, voff) do { _Pragma("unroll") for (int _i = 0; _i < 2; ++_i) { unsigned _keep; \
        asm volatile("s_mov_b32 %0, m0\n\ts_mov_b32 m0, %3\n\ts_nop 0\n\tglobal_load_lds_dwordx4 %1, %2\n\ts_mov_b32 m0, %0" : "=&s"(_keep) : "v"((voff)[_i]), "s"((const char*)(gbase)), "s"(ldsb + (unsigned)((bufoff) + _i * 8192)) : "memory"); } } while (0)
#define PG8_LDA(dst, b, h) do { _Pragma("unroll") for (int m = 0; m < 4; ++m) { const v4i_t _lo = *(const PG8_LAS v4i_t*)(lds + PG8_SA(b, h) + aoff + m * 2048), _hi = *(const PG8_LAS v4i_t*)(lds + PG8_SA(b, h) + aoff + m * 2048 + 1024); dst[m] = __builtin_shufflevector(_lo, _hi, 0, 1, 2, 3, 4, 5, 6, 7); } } while (0)
#define PG8_LDB(dst, b, h) do { _Pragma("unroll") for (int n = 0; n < 2; ++n) { const v4i_t _lo = *(const PG8_LAS v4i_t*)(lds + PG8_SB(b, h) + boff + n * 2048), _hi = *(const PG8_LAS v4i_t*)(lds + PG8_SB(b, h) + boff + n * 2048 + 1024); dst[n] = __builtin_shufflevector(_lo, _hi, 0, 1, 2, 3, 4, 5, 6, 7); } } while (0)
#define PG8_MMA(ai, bj, At, Bt) do { __builtin_amdgcn_s_setprio(1); _Pragma("unroll") for (int m = 0; m < 4; ++m) _Pragma("unroll") for (int n = 0; n < 2; ++n) \
        acc[ai][bj][m][n] = __builtin_amdgcn_mfma_scale_f32_16x16x128_f8f6f4(Bt[n], At[m], acc[ai][bj][m][n], 0, 0, 0, 0x79797979, 0, 0x7f7f7f7f); __builtin_amdgcn_s_setprio(0); } while (0)
#define PG8_WAIT_V(n) asm volatile("s_waitcnt vmcnt(" #n ")" ::: "memory")
#define PG8_WAIT_L(n) asm volatile("s_waitcnt lgkmcnt(" #n ")" ::: "memory")
#define PG8_BAR __builtin_amdgcn_s_barrier()
#define PG8_SCHED __builtin_amdgcn_sched_barrier(0)
    Unit cur, nxt; int ui = 0;
    if (!S.next(0, cur)) return;
    f32x4 acc[2][2][4][2];
#pragma unroll
    for (int a = 0; a < 2; ++a)
#pragma unroll
        for (int b = 0; b < 2; ++b)
#pragma unroll
            for (int m = 0; m < 4; ++m)
#pragma unroll
                for (int n = 0; n < 2; ++n) acc[a][b][m][n] = (f32x4){0.f, 0.f, 0.f, 0.f};
    v8i_t At[4], B0[2], B1[2];
    const char* cA = uni_ptr((const char*)g.A + (size_t)cur.pm * tstep); const char* cB = uni_ptr((const char*)g.Bt + (size_t)cur.pb * tstep);
    PG8_STAGE(PG8_SB(0, 0), cB, voffB); PG8_STAGE(PG8_SB(0, 1), cB + hstep, voffB); PG8_STAGE(PG8_SA(0, 0), cA, voffA); PG8_STAGE(PG8_SA(0, 1), cA + hstep, voffA);
    if (wr == 1) PG8_BAR;
    PG8_WAIT_V(2); PG8_BAR;
    PG8_STAGE(PG8_SB(1, 0), cB + kstep, voffB); PG8_STAGE(PG8_SA(1, 0), cA + kstep, voffA); PG8_STAGE(PG8_SB(1, 1), cB + hstep + kstep, voffB);
    PG8_WAIT_V(6); PG8_BAR;
    for (;;) {
        const bool has_next = S.next(ui + 1, nxt);
        const char* nA = uni_ptr(has_next ? (const char*)g.A + (size_t)nxt.pm * tstep : cA); const char* nB = uni_ptr(has_next ? (const char*)g.Bt + (size_t)nxt.pb * tstep : cB);
        for (int t = 0; t < nt; t += 2) {
            const bool last = (t == nt - 2);
            const char* a1 = cA + (size_t)(t + 1) * kstep;
            const char* a2 = last ? nA : cA + (size_t)(t + 2) * kstep; const char* b2 = last ? nB : cB + (size_t)(t + 2) * kstep;
            const char* a3 = a2 + kstep; const char* b3 = b2 + kstep;
            if constexpr (Epi::MIDT >= 0) { if (t == Epi::MIDT) E.mid(acc, cur, wr, fr); }
            PG8_LDB(B0, 0, 0); PG8_LDB(B1, 0, 1); PG8_SCHED; PG8_LDA(At, 0, 0); PG8_STAGE(PG8_SA(1, 1), a1 + hstep, voffA);
            PG8_WAIT_V(8); PG8_WAIT_L(0); PG8_BAR; PG8_MMA(0, 0, At, B0); PG8_MMA(0, 1, At, B1); PG8_BAR; PG8_SCHED;
            PG8_LDA(At, 0, 1); PG8_STAGE(PG8_SB(0, 0), b2, voffB); PG8_STAGE(PG8_SB(0, 1), b2 + hstep, voffB); PG8_STAGE(PG8_SA(0, 0), a2, voffA);
            PG8_WAIT_V(8); PG8_WAIT_L(0); PG8_BAR; PG8_MMA(1, 0, At, B0); PG8_MMA(1, 1, At, B1); PG8_BAR; PG8_SCHED;
            PG8_LDB(B0, 1, 0); PG8_LDB(B1, 1, 1); PG8_SCHED; PG8_LDA(At, 1, 0); PG8_STAGE(PG8_SA(0, 1), a2 + hstep, voffA);
            PG8_WAIT_V(8); PG8_WAIT_L(0); PG8_BAR; PG8_MMA(0, 0, At, B0); PG8_MMA(0, 1, At, B1); PG8_BAR; PG8_SCHED;
            PG8_LDA(At, 1, 1); PG8_STAGE(PG8_SB(1, 0), b3, voffB); PG8_STAGE(PG8_SB(1, 1), b3 + hstep, voffB); PG8_STAGE(PG8_SA(1, 0), a3, voffA);
            PG8_WAIT_V(8); PG8_WAIT_L(0); PG8_BAR; PG8_MMA(1, 0, At, B0); PG8_MMA(1, 1, At, B1); PG8_BAR; PG8_SCHED;
        }
        if (wr == 0) PG8_BAR;
        E(acc, cur, wr, wc, fr, fq);
        if (!has_next) break;
#pragma unroll
        for (int a = 0; a < 2; ++a)
#pragma unroll
            for (int b = 0; b < 2; ++b)
#pragma unroll
                for (int m = 0; m < 4; ++m)
#pragma unroll
                    for (int n = 0; n < 2; ++n) acc[a][b][m][n] = (f32x4){0.f, 0.f, 0.f, 0.f};
        cur = nxt; cA = nA; cB = nB; ++ui;
        if (wr == 1) PG8_BAR;
    }
    PG8_WAIT_V(0);
    PG8_BAR;
#undef PG8_SA
#undef PG8_SB
#undef PG8_STAGE
#undef PG8_LDA
#undef PG8_LDB
#undef PG8_MMA
#undef PG8_WAIT_V
#undef PG8_WAIT_L
#undef PG8_BAR
#undef PG8_SCHED
}
}

constexpr int BATCH = 16, SEQ = 2048, T = BATCH * SEQ, D = 1024;
constexpr int NPROJ = 6656;
constexpr int C_Z = 0, C_XBC = 1024, C_Q = 2560, C_K = 3584, C_V = 4608, C_O = 5632;
constexpr int WIN_LD = 6688;
constexpr int NE = 32, TOPK = 4;
constexpr int NASSIGN = T * TOPK, MAXBLK = NASSIGN / 256 + NE, MAXROWS = MAXBLK * 256;
constexpr float RMS_EPS = 1e-6f;
constexpr int NWAVES = 8, NTHR = 512;

constexpr size_t MiB = 1u << 20;
constexpr size_t WS_CTL = 0, CTL_ZERO_BYTES = 1 * MiB;
constexpr size_t WS_WIN = 1 * MiB, WS_WOUT = 14 * MiB, WS_WGU = 18 * MiB, WS_WDN = 146 * MiB;
constexpr size_t WS_XN = 210 * MiB, WS_H = 274 * MiB, WS_GATES = 402 * MiB, WS_ROUTE = 406 * MiB, WS_PROJ = 412 * MiB, WS_MIX = 828 * MiB, WS_END = 956 * MiB;
constexpr size_t WS_XBC = WS_H;
constexpr size_t WS_SSQ = WS_ROUTE + 3 * MiB;
constexpr size_t WS_XG = WS_PROJ, WS_ACT = WS_PROJ + 272 * MiB;
static_assert((size_t)MAXROWS * 1024 * 2 == 272 * MiB && WS_ACT + 272 * MiB == WS_END, "overlay map");
constexpr size_t R_TOPI = 0, R_TOPG = 512 * 1024, R_TOKROW = 1024 * 1024, R_ROWTOK = 1536 * 1024, R_ROWGATE = 2176 * 1024, R_BLKCNT = 2816 * 1024, R_BLKEXP = 2880 * 1024, R_NBLK = 2944 * 1024;
constexpr int CW_BAR = 4096;

constexpr int WL_LD = 36;
constexpr int WL_BYTES = 1024 * WL_LD * 4;
constexpr int MISC_OFF = 150528, LDS_BYTES = MISC_OFF + 1024;

#define GAS __attribute__((address_space(1)))
#define LAS __attribute__((address_space(3)))
typedef unsigned short bf16;
typedef unsigned v4u __attribute__((ext_vector_type(4)));
typedef unsigned v2u __attribute__((ext_vector_type(2)));
typedef float f32x4 __attribute__((ext_vector_type(4)));
#define LDS_WAIT() asm volatile("s_waitcnt lgkmcnt(0)" ::: "memory")
__device__ __forceinline__ unsigned f2bf(float f) { return (unsigned)__builtin_bit_cast(unsigned short, (__bf16)f); }
typedef __bf16 bf2_t __attribute__((ext_vector_type(2)));
__device__ __forceinline__ unsigned pk2(float lo, float hi) { const bf2_t v = {(__bf16)lo, (__bf16)hi}; return __builtin_bit_cast(unsigned, v); }
__device__ __forceinline__ float bf2f(unsigned short b) { return __builtin_bit_cast(float, (unsigned)b << 16); }
__device__ __forceinline__ float bflo(unsigned w) { return __builtin_bit_cast(float, w << 16); }
__device__ __forceinline__ float bfhi(unsigned w) { return __builtin_bit_cast(float, w & 0xffff0000u); }
__device__ __forceinline__ float wave_sum(float v) {
#pragma unroll
    for (int o = 1; o < 64; o <<= 1) v += __shfl_xor(v, o);
    return v;
}
__device__ __forceinline__ float silu_f(float x) { return x * __builtin_amdgcn_rcpf(1.0f + __expf(-x)); }
__device__ __forceinline__ float sigmoid_f(float x) { return __builtin_amdgcn_rcpf(1.0f + __expf(-x)); }
__device__ __forceinline__ float rsqrt_f(float x) { return __builtin_amdgcn_rsqf(x); }
__device__ __forceinline__ float softplus_f(float x) { return x > 20.0f ? x : log1pf(__expf(x)); }


#define XB_TMO      128
#define XB_XCNT(j)  (256  + 64 * (j))
#define XB_XSUB(j)  (1280 + 64 * (j))
#define XB_XGEN(j)  (2304 + 64 * (j))
#define XB_TOP      3328
#define XB_TOPGEN   3392
#define XCD_BAR_WORDS 3456
#define XB_SPIN_CAP (1u << 18)
__device__ __forceinline__ unsigned xb_ld(unsigned* p)              { return __hip_atomic_load(p, __ATOMIC_RELAXED, __HIP_MEMORY_SCOPE_AGENT); }
__device__ __forceinline__ unsigned xb_add(unsigned* p, unsigned v) { return __hip_atomic_fetch_add(p, v, __ATOMIC_RELAXED, __HIP_MEMORY_SCOPE_AGENT); }
__device__ __forceinline__ unsigned xb_xcc_id() { return (unsigned)__builtin_amdgcn_s_getreg((3 << 11) | 20) & 0xFu; }
#define XB_SPIN(cond, bar) do { unsigned _sp = 0; while (cond) { __builtin_amdgcn_s_sleep(1); \
    if ((++_sp & 255u) == 0u) { if (xb_ld(&(bar)[XB_TMO])) break; if (_sp > XB_SPIN_CAP) { atomicAdd(&(bar)[XB_TMO], 1u); break; } } } } while (0)
struct XcdBarrier { unsigned* bar; unsigned x; volatile LAS unsigned* st; };
__device__ __forceinline__ XcdBarrier xcd_barrier_post(unsigned* bar, volatile LAS unsigned* st, bool t0  ) {
    XcdBarrier b; b.bar = bar; b.x = xb_xcc_id(); b.st = st;
    if (t0) (void)xb_add(&bar[XB_XCNT(b.x)], 1u);
    return b;
}
__device__ __forceinline__ void xcd_barrier_complete(unsigned* bar, unsigned x, unsigned& nloc, unsigned& nx) {
    const unsigned G = gridDim.x * gridDim.y * gridDim.z;
    unsigned sum, cnt, mine, sp = 0u;
    for (;;) {
        sum = 0u; cnt = 0u; mine = 0u;
#pragma unroll
        for (unsigned j = 0; j < 16; ++j) { const unsigned c = xb_ld(&bar[XB_XCNT(j)]); sum += c; cnt += (c > 0u) ? 1u : 0u; mine = (j == x) ? c : mine; }
        if (sum == G) break;
        __builtin_amdgcn_s_sleep(1);
        if ((++sp & 255u) == 0u) { if (xb_ld(&bar[XB_TMO])) break; if (sp > XB_SPIN_CAP) { atomicAdd(&bar[XB_TMO], 1u); break; } }
    }
    nloc = mine > 0u ? mine : 1u; nx = cnt > 0u ? cnt : 1u;
}
__device__ __forceinline__ void xcd_barrier(const XcdBarrier& b, bool t0  ) {
    asm volatile("s_waitcnt vmcnt(0)" ::: "memory");
    __syncthreads();
    if (t0) {
        unsigned* bar = b.bar;
        __builtin_amdgcn_s_waitcnt(0);
        unsigned nloc = b.st[0], nx = b.st[1];
        if (nloc == 0u) { xcd_barrier_complete(bar, b.x, nloc, nx); b.st[0] = nloc; b.st[1] = nx; }
        const unsigned old = xb_add(&bar[XB_XSUB(b.x)], 1u);
        const unsigned gen = old / nloc;
        if (old + 1u == (gen + 1u) * nloc) {
            __builtin_amdgcn_fence(__ATOMIC_RELEASE, "agent");
            asm volatile("s_waitcnt vmcnt(0)" ::: "memory");
            const unsigned og = xb_add(&bar[XB_TOP], 1u);
            const unsigned tg = og / nx;
            if (og + 1u == (tg + 1u) * nx) xb_add(&bar[XB_TOPGEN], 1u);
            else XB_SPIN(xb_ld(&bar[XB_TOPGEN]) == tg, bar);
            __builtin_amdgcn_fence(__ATOMIC_ACQUIRE, "agent");
            xb_add(&bar[XB_XGEN(b.x)], 1u);
            asm volatile("s_waitcnt vmcnt(0)" ::: "memory");
        } else {
            XB_SPIN(xb_ld(&bar[XB_XGEN(b.x)]) == gen, bar);
            __builtin_amdgcn_fence(__ATOMIC_ACQUIRE, "agent");
            asm volatile("s_waitcnt vmcnt(0)" ::: "memory");
        }
    }
    __syncthreads();
}

__device__ __forceinline__ int fresh_tid(int wave) { int t = wave * 64 + lane_id(); asm volatile("" : "+v"(t)); return t; }
struct Args { const float* in[21]; float* out; unsigned char* ws; int ph_lo, ph_hi, variant, pad; };

__device__ __forceinline__ void transpose_item(const float* W, int ld_src, int n0s, int k0, bf16* WT, int K, int n0d, float cscale, const float* kscale, LAS float* scr, int lane) {
#pragma unroll
    for (int i = 0; i < 32; ++i) { const int kk = 2 * i + (lane >> 5); float v = W[(size_t)(k0 + kk) * ld_src + n0s + (lane & 31)] * cscale; if (kscale) v *= kscale[k0 + kk]; scr[kk * 33 + (lane & 31)] = v; }
    LDS_WAIT(); asm volatile("" ::: "memory");
    const int c = lane & 7;
#pragma unroll
    for (int j = 0; j < 4; ++j) { const int n = (lane >> 3) + 8 * j; const LAS float* s = scr + (8 * c) * 33 + n;
        v4u o; o.x = pk2(s[0 * 33], s[1 * 33]); o.y = pk2(s[2 * 33], s[3 * 33]); o.z = pk2(s[4 * 33], s[5 * 33]); o.w = pk2(s[6 * 33], s[7 * 33]);
        *(v4u*)(WT + (size_t)(n0d + n) * K + k0 + 8 * c) = o; }
    LDS_WAIT(); asm volatile("" ::: "memory");
}

__device__ __forceinline__ int pk4_fp8(float a, float b, float c, float d) { int w = 0; w = __builtin_amdgcn_cvt_pk_fp8_f32(a, b, w, false); w = __builtin_amdgcn_cvt_pk_fp8_f32(c, d, w, true); return w; }
__device__ __forceinline__ void transpose_item_f8(const float* W, int ld_src, int n0s, int k0, unsigned char* WT, int K, int n0d, float cscale, const float* kscale, LAS float* scr, int lane) {
#pragma unroll
    for (int i = 0; i < 32; ++i) { const int kk = 2 * i + (lane >> 5); float v = W[(size_t)(k0 + kk) * ld_src + n0s + (lane & 31)] * cscale; if (kscale) v *= kscale[k0 + kk]; scr[kk * 33 + (lane & 31)] = v; }
    LDS_WAIT(); asm volatile("" ::: "memory");
    const int c = lane & 3;
#pragma unroll
    for (int j = 0; j < 2; ++j) { const int n = (lane >> 2) + 16 * j; const LAS float* s = scr + (16 * c) * 33 + n;
        v4u o; o.x = (unsigned)pk4_fp8(s[0 * 33], s[1 * 33], s[2 * 33], s[3 * 33]); o.y = (unsigned)pk4_fp8(s[4 * 33], s[5 * 33], s[6 * 33], s[7 * 33]);
        o.z = (unsigned)pk4_fp8(s[8 * 33], s[9 * 33], s[10 * 33], s[11 * 33]); o.w = (unsigned)pk4_fp8(s[12 * 33], s[13 * 33], s[14 * 33], s[15 * 33]);
        *(v4u*)(WT + (size_t)(n0d + n) * K + k0 + 16 * c) = o; }
    LDS_WAIT(); asm volatile("" ::: "memory");
}

constexpr int PT_LD = 2064, PT_HALF = 32 * PT_LD;
typedef short s8v_t __attribute__((ext_vector_type(8)));
__device__ __forceinline__ void pt_fill(LAS unsigned char* tab, const float* W, int ldw, int tid, bool gate_cols) {
    const int c = tid & 31; const int sc = gate_cols ? (c < 16 ? 2560 + c : (c < 24 ? 6672 + (c - 16) : 6680 + (c - 24))) : c;
#pragma unroll 1
    for (int j0 = 0; j0 < 64; j0 += 16) { float v[16];
#pragma unroll
        for (int j = 0; j < 16; ++j) v[j] = W[(size_t)((tid >> 5) + 16 * (j0 + j)) * ldw + sc];
#pragma unroll
        for (int j = 0; j < 16; ++j) { const int k = (tid >> 5) + 16 * (j0 + j); const unsigned h = f2bf(v[j]); const float hf = __builtin_bit_cast(float, h << 16);
            *(LAS unsigned short*)(tab + c * PT_LD + k * 2) = (unsigned short)h; *(LAS unsigned short*)(tab + PT_HALF + c * PT_LD + k * 2) = (unsigned short)f2bf(v[j] - hf); } }
}
template <bool IN_BF16, bool OUT_F8>
__device__ __forceinline__ float rowproj16(const void* srcv, void* dstv, const float* wn, const LAS unsigned char* tab, int row0, int lane, f32x4 (&acc)[2]) {
    const int g = lane >> 4, c16 = lane & 15;
    acc[0] = (f32x4){0.f, 0.f, 0.f, 0.f}; acc[1] = acc[0]; float ss = 0.f;
    const LAS unsigned char* tb = tab + c16 * PT_LD + g * 16;
#pragma unroll 4
    for (int s = 0; s < 32; ++s) {
        f32x4 a, b;
        if constexpr (IN_BF16) { const v4u w = *(const v4u*)((const bf16*)srcv + (size_t)(row0 + c16) * 1024 + 32 * s + 8 * g); a = (f32x4){bflo(w.x), bfhi(w.x), bflo(w.y), bfhi(w.y)}; b = (f32x4){bflo(w.z), bfhi(w.z), bflo(w.w), bfhi(w.w)}; }
        else { const float* p = (const float*)srcv + (size_t)(row0 + c16) * 1024 + 32 * s + 8 * g; a = *(const f32x4*)p; b = *(const f32x4*)(p + 4); }
        ss += (a[0] * a[0] + a[1] * a[1]) + (a[2] * a[2] + a[3] * a[3]) + (b[0] * b[0] + b[1] * b[1]) + (b[2] * b[2] + b[3] * b[3]);
        { const f32x4 w0 = *(const f32x4*)(wn + 32 * s + 8 * g), w1 = *(const f32x4*)(wn + 32 * s + 8 * g + 4); a = a * w0; b = b * w1; }
        v4u hw; hw.x = pk2(a[0], a[1]); hw.y = pk2(a[2], a[3]); hw.z = pk2(b[0], b[1]); hw.w = pk2(b[2], b[3]);
        v4u lw; lw.x = pk2(a[0] - bflo(hw.x), a[1] - bfhi(hw.x)); lw.y = pk2(a[2] - bflo(hw.y), a[3] - bfhi(hw.y)); lw.z = pk2(b[0] - bflo(hw.z), b[1] - bfhi(hw.z)); lw.w = pk2(b[2] - bflo(hw.w), b[3] - bfhi(hw.w));
        if constexpr (OUT_F8) { v2u o; o.x = (unsigned)pk4_fp8(a[0], a[1], a[2], a[3]); o.y = (unsigned)pk4_fp8(b[0], b[1], b[2], b[3]); *(v2u*)((unsigned char*)dstv + (size_t)(row0 + c16) * 1024 + 32 * s + 8 * g) = o; }
        else *(v4u*)((bf16*)dstv + (size_t)(row0 + c16) * 1024 + 32 * s + 8 * g) = hw;
        const s8v_t xh = __builtin_bit_cast(s8v_t, hw), xl = __builtin_bit_cast(s8v_t, lw);
#pragma unroll
        for (int nt = 0; nt < 2; ++nt) { const s8v_t wh = *(const LAS s8v_t*)(tb + nt * 16 * PT_LD + s * 64), wl = *(const LAS s8v_t*)(tb + PT_HALF + nt * 16 * PT_LD + s * 64);
            acc[nt] = __builtin_amdgcn_mfma_f32_16x16x32_bf16(xh, wh, acc[nt], 0, 0, 0); acc[nt] = __builtin_amdgcn_mfma_f32_16x16x32_bf16(xl, wh, acc[nt], 0, 0, 0); acc[nt] = __builtin_amdgcn_mfma_f32_16x16x32_bf16(xh, wl, acc[nt], 0, 0, 0); }
    }
    ss += __shfl_xor(ss, 16); ss += __shfl_xor(ss, 32);
    return 1.0f / sqrtf(ss * (1.0f / 1024.0f) + RMS_EPS);
}

namespace mx {
typedef short s8v __attribute__((ext_vector_type(8)));
typedef short s4v __attribute__((ext_vector_type(4)));
#define MX_MFMA(a, b, c) __builtin_amdgcn_mfma_f32_16x16x32_bf16(a, b, c, 0, 0, 0)
#define MX_SB() __builtin_amdgcn_sched_barrier(0)
#define MX_BAR() do { MX_SB(); asm volatile("s_waitcnt lgkmcnt(0)" ::: "memory"); __builtin_amdgcn_s_barrier(); asm volatile("" ::: "memory"); } while (0)
constexpr int TS = 288, TILE = 64 * TS, PS = 144, PTILE = 64 * PS, BUF = 3 * TILE;
struct LaneBase { unsigned row, perm, tr, prow; };
__device__ __forceinline__ LaneBase lane_base(int lane) { LaneBase L; const unsigned g = lane >> 4, i = lane & 15, q = i >> 2, p = lane & 3;
    L.row = i * TS + g * 16; L.perm = i * TS + g * 8; L.tr = (8 * g + q) * TS + p * 8; L.prow = i * PS + g * 16; return L; }
#define LD_ROW(t, L, rb, s) (*(const LAS mx::s8v*)((t) + (L).row + (rb) * 16 * mx::TS + (s) * 64))
#define LD_ROWP(t, L, rb, s) (*(const LAS mx::s8v*)((t) + (L).prow + (rb) * 16 * mx::PS + (s) * 64))
__device__ __forceinline__ s8v ld_perm2(const LAS unsigned char* p) { const s4v lo = *(const LAS s4v*)p, hi = *(const LAS s4v*)(p + 32); return (s8v){lo[0], lo[1], lo[2], lo[3], hi[0], hi[1], hi[2], hi[3]}; }
#define LD_PERM(t, L, rb, s) mx::ld_perm2((t) + (L).perm + (rb) * 16 * mx::TS + (s) * 64)
__device__ __forceinline__ s8v ld_tr2(const LAS unsigned char* p) {
    const s4v a = __builtin_amdgcn_ds_read_tr16_b64_v4i16((LAS s4v*)p), b = __builtin_amdgcn_ds_read_tr16_b64_v4i16((LAS s4v*)(p + 4 * TS));
    return (s8v){a[0], a[1], a[2], a[3], b[0], b[1], b[2], b[3]}; }
#define LD_TR(t, L, c, ks) mx::ld_tr2((t) + (L).tr + (ks) * 32 * mx::TS + (c) * 32)
__device__ __forceinline__ void dma_tiles(LAS unsigned char* buf, const bf16* g0, int gstride, int co0, int co1, int co2, int wave, int lane) {
#pragma unroll
    for (int pp = 0; pp < 7; ++pp) { const int piece = wave + 8 * pp; if (piece < 54) { const unsigned o = piece * 1024 + lane * 16, tl = o / TILE, ot = o - tl * TILE, row = ot / TS, wb = ot - row * TS;
        const int co = tl == 0 ? co0 : (tl == 1 ? co1 : co2);
        __builtin_amdgcn_global_load_lds((const unsigned*)(g0 + (size_t)row * gstride + co + (wb < 256 ? wb >> 1 : 0)), (LAS unsigned*)(buf + piece * 1024), 16, 0, 0); } }
}
#define MX_DPPF(old, src, ctrl, rm) __builtin_bit_cast(float, __builtin_amdgcn_update_dpp(__builtin_bit_cast(int, (float)(old)), __builtin_bit_cast(int, (float)(src)), ctrl, rm, 0xf, false))
__device__ __forceinline__ float scan_add(float x) {
    x += MX_DPPF(0.f, x, 0x111, 0xf); x += MX_DPPF(0.f, x, 0x112, 0xf); x += MX_DPPF(0.f, x, 0x114, 0xf); x += MX_DPPF(0.f, x, 0x118, 0xf);
    x += MX_DPPF(0.f, x, 0x142, 0xa); x += MX_DPPF(0.f, x, 0x143, 0xc); return x; }
__device__ __forceinline__ float scan_max(float x) { const float ninf = -INFINITY;
    x = fmaxf(x, MX_DPPF(ninf, x, 0x111, 0xf)); x = fmaxf(x, MX_DPPF(ninf, x, 0x112, 0xf)); x = fmaxf(x, MX_DPPF(ninf, x, 0x114, 0xf)); x = fmaxf(x, MX_DPPF(ninf, x, 0x118, 0xf));
    x = fmaxf(x, MX_DPPF(ninf, x, 0x142, 0xa)); x = fmaxf(x, MX_DPPF(ninf, x, 0x143, 0xc)); return x; }
__device__ __forceinline__ float lane63(float x) { return __builtin_bit_cast(float, __builtin_amdgcn_readlane(__builtin_bit_cast(int, x), 63)); }
__device__ __forceinline__ float softplus_fast(float x) { return fmaxf(x, 0.f) + __logf(1.0f + __expf(-fabsf(x))); }
__device__ __forceinline__ s8v pack_acc(const f32x4& a, const f32x4& b) {
    const unsigned w0 = pk2(a[0], a[1]), w1 = pk2(a[2], a[3]), w2 = pk2(b[0], b[1]), w3 = pk2(b[2], b[3]);
    v4u w = {w0, w1, w2, w3}; return __builtin_bit_cast(s8v, w);
}
__device__ __forceinline__ void unpack8(const v4u& w, float (&f)[8]) { f[0] = bflo(w.x); f[1] = bfhi(w.x); f[2] = bflo(w.y); f[3] = bfhi(w.y); f[4] = bflo(w.z); f[5] = bfhi(w.z); f[6] = bflo(w.w); f[7] = bfhi(w.w); }

__device__ __forceinline__ void mlstm_item(LAS unsigned char* lds, int item, int var, int wave, const bf16* __restrict__ PROJ, const float* __restrict__ GATES, const float* __restrict__ lnw, bf16* __restrict__ MIX) {
    const int lane = lane_id(), tid = wave * 64 + lane, g = lane >> 4, c16 = lane & 15;
    const int b = item >> 3, h = item & 7;
    const LaneBase L = lane_base(lane);
    LAS unsigned char* TP = lds + 2 * BUF; LAS unsigned char* TO = TP + PTILE;
    LAS float* denP = (LAS float*)(TO + TILE); LAS float* qnp = denP + 128; LAS float* nsh = qnp + 512;
    LAS float* Au = nsh + 128; LAS float* Avv = Au + 64; LAS float* Awi = Avv + 64; LAS float* Akw = Awi + 64; LAS float* Aid = Akw + 64;
    f32x4 Cst[8];
#pragma unroll
    for (int i = 0; i < 8; ++i) Cst[i] = (f32x4){0.f, 0.f, 0.f, 0.f};
    float nreg = 0.f, m_prev = 0.f;
    if (lane < 16) nsh[wave * 16 + lane] = 0.f;
    const int srow = tid >> 3, sch = tid & 7;
    const bf16* qbase = PROJ + (size_t)(b * SEQ) * NPROJ + h * 128;
    dma_tiles(lds, qbase, NPROJ, C_Q, C_K, C_V, wave, lane);
    float fnext = GATES[(size_t)(b * SEQ + lane) * 32 + 24 + h], inext = GATES[(size_t)(b * SEQ + lane) * 32 + 16 + h];
    asm volatile("s_waitcnt vmcnt(0)" ::: "memory"); MX_BAR();
#pragma unroll 1
    for (int c = 0; c < SEQ / 64; ++c) {
        const int cur = c & 1; const int t0 = b * SEQ + c * 64;
        LAS unsigned char* TQ = lds + cur * BUF; LAS unsigned char* TK = TQ + TILE; LAS unsigned char* TV = TQ + 2 * TILE;
        float fraw = fnext, iraw = inext; asm volatile("" : "+v"(fraw), "+v"(iraw));
        MX_SB();
        const v4u ov0 = *(const v4u*)(PROJ + (size_t)(t0 + srow) * NPROJ + C_O + h * 128 + 8 * sch), ov1 = *(const v4u*)(PROJ + (size_t)(t0 + srow) * NPROJ + C_O + h * 128 + 64 + 8 * sch);
        { const int tn = (c + 1 < SEQ / 64 ? t0 + 64 : t0) + lane; fnext = GATES[(size_t)tn * 32 + 24 + h]; inext = GATES[(size_t)tn * 32 + 16 + h]; }
        if (c + 1 < SEQ / 64 && !(var & 1)) { int lv = lane; asm volatile("" : "+v"(lv)); dma_tiles(lds + (cur ^ 1) * BUF, qbase + (size_t)(c + 1) * 64 * NPROJ, NPROJ, C_Q, C_K, C_V, wave, lv); }
        MX_SB();
        const float lf = -softplus_fast(-fraw), cf = scan_add(lf), chunk_f = lane63(cf);
        const float u = iraw - cf, Mx = scan_max(u);
        const float m_row = cf + fmaxf(m_prev, Mx), vv = cf - m_row;
        const float m_loc = chunk_f + lane63(Mx), m_new = fmaxf(chunk_f + m_prev, m_loc);
        const float w_inter = __expf(vv + m_prev), floorv = __expf(-m_row), kw = __expf(chunk_f + u - m_new), s_old = __expf(chunk_f + m_prev - m_new);
        Au[lane] = u; Avv[lane] = vv; Awi[lane] = w_inter; Akw[lane] = kw;
        if (!(var & 2)) { const int lt = wave & 3, jt0 = 2 * (wave >> 2); const float vv_l = Avv[16 * lt + c16]; float rsum = 0.f;
#pragma unroll
          for (int jj = 0; jj < 2; ++jj) { const int jt = jt0 + jj; float pv[4] = {0.f, 0.f, 0.f, 0.f};
            if (jt <= lt) { f32x4 acc = {0.f, 0.f, 0.f, 0.f};
#pragma unroll
                for (int ks = 0; ks < 4; ++ks) acc = MX_MFMA(LD_ROW(TK, L, jt, ks), LD_ROW(TQ, L, lt, ks), acc);
                const f32x4 uj = *(const LAS f32x4*)(Au + 16 * jt + 4 * g);
#pragma unroll
                for (int r = 0; r < 4; ++r) { const int j = 16 * jt + 4 * g + r, l = 16 * lt + c16; const float val = (j <= l) ? acc[r] * __expf(vv_l + uj[r]) : 0.f; rsum += val; pv[r] = val; } }
            v2u w; w.x = pk2(pv[0], pv[1]); w.y = pk2(pv[2], pv[3]);
            *(LAS v2u*)(TP + (16 * lt + c16) * PS + (16 * jt + 4 * g) * 2) = w; }
          rsum += __shfl_xor(rsum, 16); rsum += __shfl_xor(rsum, 32);
          if (g == 0) denP[(wave >> 2) * 64 + 16 * lt + c16] = rsum;
          v4u q0 = *(const LAS v4u*)(TQ + lane * TS + wave * 32), q1 = *(const LAS v4u*)(TQ + lane * TS + wave * 32 + 16); float qf[16]; { float t8[8]; unpack8(q0, t8);
#pragma unroll
            for (int e = 0; e < 8; ++e) qf[e] = t8[e]; unpack8(q1, t8);
#pragma unroll
            for (int e = 0; e < 8; ++e) qf[8 + e] = t8[e]; }
          float part = 0.f;
#pragma unroll
          for (int e4 = 0; e4 < 4; ++e4) { const f32x4 nv = *(const LAS f32x4*)(nsh + wave * 16 + 4 * e4); part += qf[4 * e4] * nv[0] + qf[4 * e4 + 1] * nv[1] + qf[4 * e4 + 2] * nv[2] + qf[4 * e4 + 3] * nv[3]; }
          qnp[wave * 64 + lane] = part; }
        MX_BAR();
        float inv_den; { float qn = 0.f;
#pragma unroll
          for (int w = 0; w < 8; ++w) qn += qnp[w * 64 + lane];
          float den = denP[lane] + denP[64 + lane] + w_inter * qn; den = fmaxf(fabsf(den), floorv); inv_den = __builtin_amdgcn_rcpf(den); Aid[lane] = inv_den; }
        { s8v sf[4];
#pragma unroll
          for (int ks = 0; ks < 4; ++ks) sf[ks] = pack_acc(Cst[2 * ks], Cst[2 * ks + 1]);
          const s8v vf0 = LD_TR(TV + wave * 32, L, 0, 0), vf1 = LD_TR(TV + wave * 32, L, 0, 1);
          if (!(var & 4))
#pragma unroll
          for (int lt = 0; lt < 4; ++lt) { f32x4 acc = {0.f, 0.f, 0.f, 0.f};
#pragma unroll
            for (int ks = 0; ks < 4; ++ks) acc = MX_MFMA(sf[ks], LD_PERM(TQ, L, lt, ks), acc);
            acc = acc * Awi[16 * lt + c16];
            acc = MX_MFMA(vf0, LD_ROWP(TP, L, lt, 0), acc);
            if (lt >= 2) acc = MX_MFMA(vf1, LD_ROWP(TP, L, lt, 1), acc);
            acc = acc * Aid[16 * lt + c16];
            v2u w; w.x = pk2(acc[0], acc[1]); w.y = pk2(acc[2], acc[3]);
            *(LAS v2u*)(TO + (16 * lt + c16) * TS + (16 * wave + 4 * g) * 2) = w; }
#pragma unroll
          for (int i = 0; i < 8; ++i) Cst[i] = Cst[i] * s_old;
          if (!(var & 8))
#pragma unroll
          for (int ks = 0; ks < 2; ++ks) { const s8v vf = ks ? vf1 : vf0; const v4u vw = __builtin_bit_cast(v4u, vf); float f[8]; unpack8(vw, f);
            { const f32x4 k0 = *(const LAS f32x4*)(Akw + 32 * ks + 8 * g), k1 = *(const LAS f32x4*)(Akw + 32 * ks + 8 * g + 4);
#pragma unroll
              for (int e = 0; e < 4; ++e) { f[e] *= k0[e]; f[4 + e] *= k1[e]; } }
            v4u pw = {pk2(f[0], f[1]), pk2(f[2], f[3]), pk2(f[4], f[5]), pk2(f[6], f[7])}; const s8v vwf = __builtin_bit_cast(s8v, pw);
#pragma unroll
            for (int dkt = 0; dkt < 8; ++dkt) Cst[dkt] = MX_MFMA(LD_TR(TK, L, dkt, ks), vwf, Cst[dkt]); }
          float part = 0.f;
#pragma unroll
          for (int e4 = 0; e4 < 4; ++e4) { const f32x4 kk = *(const LAS f32x4*)(Akw + 16 * g + 4 * e4);
#pragma unroll
            for (int e = 0; e < 4; ++e) { const int j = 16 * g + 4 * e4 + e; part += bf2f(*(const LAS unsigned short*)(TK + j * TS + (16 * wave + c16) * 2)) * kk[e]; } }
          part += __shfl_xor(part, 16); part += __shfl_xor(part, 32);
          nreg = s_old * nreg + part; if (g == 0) nsh[wave * 16 + c16] = nreg;
          m_prev = m_new; }
        asm volatile("s_waitcnt vmcnt(0)" ::: "memory"); MX_BAR();
        if (!(var & 16)) { const v4u a = *(const LAS v4u*)(TO + srow * TS + sch * 16), bq = *(const LAS v4u*)(TO + srow * TS + sch * 16 + 128); float f[16], of[16]; { float t8[8]; unpack8(a, t8);
#pragma unroll
            for (int e = 0; e < 8; ++e) f[e] = t8[e]; unpack8(bq, t8);
#pragma unroll
            for (int e = 0; e < 8; ++e) f[8 + e] = t8[e]; unpack8(ov0, t8);
#pragma unroll
            for (int e = 0; e < 8; ++e) of[e] = t8[e]; unpack8(ov1, t8);
#pragma unroll
            for (int e = 0; e < 8; ++e) of[8 + e] = t8[e]; }
          float ss = 0.f;
#pragma unroll
          for (int e = 0; e < 16; ++e) ss += f[e] * f[e];
          ss += __shfl_xor(ss, 1); ss += __shfl_xor(ss, 2); ss += __shfl_xor(ss, 4);
          const float rs = rsqrt_f(ss * (1.0f / 128.0f) + RMS_EPS);
          float wn[16]; { const f32x4 w0 = *(const f32x4*)(lnw + h * 128 + 8 * sch), w1 = *(const f32x4*)(lnw + h * 128 + 8 * sch + 4), w2 = *(const f32x4*)(lnw + h * 128 + 64 + 8 * sch), w3 = *(const f32x4*)(lnw + h * 128 + 64 + 8 * sch + 4);
#pragma unroll
            for (int e = 0; e < 4; ++e) { wn[e] = w0[e]; wn[4 + e] = w1[e]; wn[8 + e] = w2[e]; wn[12 + e] = w3[e]; } }
#pragma unroll
          for (int e = 0; e < 16; ++e) f[e] = f[e] * rs * wn[e] * sigmoid_f(of[e]);
          v4u o0 = {pk2(f[0], f[1]), pk2(f[2], f[3]), pk2(f[4], f[5]), pk2(f[6], f[7])}, o1 = {pk2(f[8], f[9]), pk2(f[10], f[11]), pk2(f[12], f[13]), pk2(f[14], f[15])};
          bf16* mp = MIX + (size_t)(t0 + srow) * 2048 + 1024 + h * 128 + 8 * sch; *(v4u*)mp = o0; *(v4u*)(mp + 64) = o1; }
    }
    MX_BAR();
}

__device__ __forceinline__ void ssd_item(LAS unsigned char* lds, int item, int var, int wave, const bf16* __restrict__ XBC, const bf16* __restrict__ PROJ, const float* __restrict__ GATES, const float* __restrict__ a_log,
                                         const float* __restrict__ d_skip, bf16* __restrict__ MIX, float* __restrict__ SSQ) {
    const int lane = lane_id(), tid = wave * 64 + lane, g = lane >> 4, c16 = lane & 15;
    const int b = item >> 3, hp = item & 7, grp = hp >> 2, hh = wave >> 2, ps = wave & 3;
    const LaneBase L = lane_base(lane);
    LAS unsigned char* TG = lds + 2 * BUF;
    LAS unsigned char* TO = TG + 2 * PTILE;
    LAS float* Aacs = (LAS float*)(TO + TILE); LAS float* Adinv = Aacs + 128; LAS float* Adt = Adinv + 128; LAS float* Awd = Adt + 128; LAS float* Aea = Awd + 128;
    f32x4 RT[8];
#pragma unroll
    for (int i = 0; i < 8; ++i) RT[i] = (f32x4){0.f, 0.f, 0.f, 0.f};
    const float an0 = -__expf(a_log[2 * hp]), an1 = -__expf(a_log[2 * hp + 1]), dk0 = d_skip[2 * hp], dk1 = d_skip[2 * hp + 1];
    const int srow = tid >> 3, sch = tid & 7;
    const bf16* xb = XBC + (size_t)(b * SEQ) * 1536;
    dma_tiles(lds, xb, 1536, 1280 + grp * 128, 1024 + grp * 128, hp * 128, wave, lane);
    float dn0 = GATES[(size_t)(b * SEQ + lane) * 32 + 2 * hp], dn1 = GATES[(size_t)(b * SEQ + lane) * 32 + 2 * hp + 1];
    asm volatile("s_waitcnt vmcnt(0)" ::: "memory"); MX_BAR();
#pragma unroll 1
    for (int c = 0; c < SEQ / 64; ++c) {
        const int cur = c & 1; const int t0 = b * SEQ + c * 64;
        LAS unsigned char* TC = lds + cur * BUF; LAS unsigned char* TB = TC + TILE; LAS unsigned char* TX = TC + 2 * TILE;
        float dr0 = dn0, dr1 = dn1; asm volatile("" : "+v"(dr0), "+v"(dr1));
        MX_SB();
        const v4u zv0 = *(const v4u*)(PROJ + (size_t)(t0 + srow) * NPROJ + C_Z + hp * 128 + 8 * sch), zv1 = *(const v4u*)(PROJ + (size_t)(t0 + srow) * NPROJ + C_Z + hp * 128 + 64 + 8 * sch);
        { const int tn = (c + 1 < SEQ / 64 ? t0 + 64 : t0) + lane; dn0 = GATES[(size_t)tn * 32 + 2 * hp]; dn1 = GATES[(size_t)tn * 32 + 2 * hp + 1]; }
        if (c + 1 < SEQ / 64 && !(var & 1)) { int lv = lane; asm volatile("" : "+v"(lv)); dma_tiles(lds + (cur ^ 1) * BUF, xb + (size_t)(c + 1) * 64 * 1536, 1536, 1280 + grp * 128, 1024 + grp * 128, hp * 128, wave, lv); }
        MX_SB();
        const float dt0 = softplus_fast(dr0), dt1 = softplus_fast(dr1);
        const float acs0 = scan_add(dt0 * an0), acs1 = scan_add(dt1 * an1);
        const float aend0 = lane63(acs0), aend1 = lane63(acs1);
        Aacs[lane] = acs0; Aacs[64 + lane] = acs1; Adinv[lane] = dk0 * __builtin_amdgcn_rcpf(dt0); Adinv[64 + lane] = dk1 * __builtin_amdgcn_rcpf(dt1); Adt[lane] = dt0; Adt[64 + lane] = dt1;
        Awd[lane] = __expf(aend0 - acs0); Awd[64 + lane] = __expf(aend1 - acs1); Aea[lane] = __expf(acs0); Aea[64 + lane] = __expf(acs1);
        const float aend = hh ? aend1 : aend0;
        if (!(var & 2)) { const int lt = wave & 3, st0 = 2 * (wave >> 2); const int l = 16 * lt + c16;
          const float al0 = Aacs[l], al1 = Aacs[64 + l], di0 = Adinv[l], di1 = Adinv[64 + l];
#pragma unroll
          for (int ss = 0; ss < 2; ++ss) { const int st = st0 + ss; float p0[4] = {0.f, 0.f, 0.f, 0.f}, p1[4] = {0.f, 0.f, 0.f, 0.f};
            if (st <= lt) { f32x4 acc = {0.f, 0.f, 0.f, 0.f};
#pragma unroll
                for (int ks = 0; ks < 4; ++ks) acc = MX_MFMA(LD_ROW(TB, L, st, ks), LD_ROW(TC, L, lt, ks), acc);
                const f32x4 as0 = *(const LAS f32x4*)(Aacs + 16 * st + 4 * g), as1 = *(const LAS f32x4*)(Aacs + 64 + 16 * st + 4 * g);
#pragma unroll
                for (int r = 0; r < 4; ++r) { const int sidx = 16 * st + 4 * g + r;
                    float v0 = (sidx <= l) ? acc[r] * __expf(al0 - as0[r]) : 0.f, v1 = (sidx <= l) ? acc[r] * __expf(al1 - as1[r]) : 0.f;
                    if (sidx == l) { v0 += di0; v1 += di1; } p0[r] = v0; p1[r] = v1; } }
            v2u w0, w1; w0.x = pk2(p0[0], p0[1]); w0.y = pk2(p0[2], p0[3]); w1.x = pk2(p1[0], p1[1]); w1.y = pk2(p1[2], p1[3]);
            const unsigned o = l * PS + (16 * st + 4 * g) * 2;
            *(LAS v2u*)(TG + o) = w0; *(LAS v2u*)(TG + PTILE + o) = w1; } }
        MX_BAR();
        { s8v sf[4];
#pragma unroll
          for (int ks = 0; ks < 4; ++ks) sf[ks] = pack_acc(RT[2 * ks], RT[2 * ks + 1]);
          s8v xd[2], xw[2];
#pragma unroll
          for (int ks = 0; ks < 2; ++ks) { const s8v xf = LD_TR(TX + (4 * hh + ps) * 32, L, 0, ks); const v4u xv = __builtin_bit_cast(v4u, xf); float f[8], fw[8]; unpack8(xv, f);
            { const LAS float* pd = Adt + 64 * hh + 32 * ks + 8 * g; const LAS float* pw = Awd + 64 * hh + 32 * ks + 8 * g; const f32x4 d0 = *(const LAS f32x4*)pd, d1 = *(const LAS f32x4*)(pd + 4), w0 = *(const LAS f32x4*)pw, w1 = *(const LAS f32x4*)(pw + 4);
#pragma unroll
              for (int e = 0; e < 4; ++e) { f[e] *= d0[e]; fw[e] = f[e] * w0[e]; f[4 + e] *= d1[e]; fw[4 + e] = f[4 + e] * w1[e]; } }
            v4u a = {pk2(f[0], f[1]), pk2(f[2], f[3]), pk2(f[4], f[5]), pk2(f[6], f[7])}, bw = {pk2(fw[0], fw[1]), pk2(fw[2], fw[3]), pk2(fw[4], fw[5]), pk2(fw[6], fw[7])};
            xd[ks] = __builtin_bit_cast(s8v, a); xw[ks] = __builtin_bit_cast(s8v, bw); }
          const LAS unsigned char* TGm = TG + hh * PTILE;
          if (!(var & 4))
#pragma unroll
          for (int lt = 0; lt < 4; ++lt) { f32x4 acc = {0.f, 0.f, 0.f, 0.f};
#pragma unroll
            for (int ks = 0; ks < 4; ++ks) acc = MX_MFMA(sf[ks], LD_PERM(TC, L, lt, ks), acc);
            acc = acc * Aea[64 * hh + 16 * lt + c16];
            acc = MX_MFMA(xd[0], LD_ROWP(TGm, L, lt, 0), acc);
            if (lt >= 2) acc = MX_MFMA(xd[1], LD_ROWP(TGm, L, lt, 1), acc);
            v2u w; w.x = pk2(acc[0], acc[1]); w.y = pk2(acc[2], acc[3]);
            *(LAS v2u*)(TO + (16 * lt + c16) * TS + (64 * hh + 16 * ps + 4 * g) * 2) = w; }
          const float ea = __expf(aend);
#pragma unroll
          for (int i = 0; i < 8; ++i) RT[i] = RT[i] * ea;
          if (!(var & 8))
#pragma unroll
          for (int ks = 0; ks < 2; ++ks)
#pragma unroll
            for (int nt = 0; nt < 8; ++nt) RT[nt] = MX_MFMA(LD_TR(TB, L, nt, ks), xw[ks], RT[nt]); }
        asm volatile("s_waitcnt vmcnt(0)" ::: "memory"); MX_BAR();
        if (!(var & 16)) { const v4u a = *(const LAS v4u*)(TO + srow * TS + sch * 16), bq = *(const LAS v4u*)(TO + srow * TS + sch * 16 + 128); float f[16], zf[16]; { float t8[8]; unpack8(a, t8);
#pragma unroll
            for (int e = 0; e < 8; ++e) f[e] = t8[e]; unpack8(bq, t8);
#pragma unroll
            for (int e = 0; e < 8; ++e) f[8 + e] = t8[e]; unpack8(zv0, t8);
#pragma unroll
            for (int e = 0; e < 8; ++e) zf[e] = t8[e]; unpack8(zv1, t8);
#pragma unroll
            for (int e = 0; e < 8; ++e) zf[8 + e] = t8[e]; }
          float ss = 0.f;
#pragma unroll
          for (int e = 0; e < 16; ++e) { f[e] = f[e] * silu_f(zf[e]); ss += f[e] * f[e]; }
          ss += __shfl_xor(ss, 1); ss += __shfl_xor(ss, 2); ss += __shfl_xor(ss, 4);
          if (sch == 0) SSQ[(size_t)(t0 + srow) * 8 + hp] = ss;
          v4u o0 = {pk2(f[0], f[1]), pk2(f[2], f[3]), pk2(f[4], f[5]), pk2(f[6], f[7])}, o1 = {pk2(f[8], f[9]), pk2(f[10], f[11]), pk2(f[12], f[13]), pk2(f[14], f[15])};
          bf16* mp = MIX + (size_t)(t0 + srow) * 2048 + hp * 128 + 8 * sch; *(v4u*)mp = o0; *(v4u*)(mp + 64) = o1; }
    }
    MX_BAR();
}
}

__global__ void __launch_bounds__(NTHR, 2) mega(Args args) {
    extern __shared__ __attribute__((aligned(16))) unsigned char lds_raw[];
    LAS unsigned char* lds = (LAS unsigned char*)lds_raw;
    const int wave = __builtin_amdgcn_readfirstlane((int)threadIdx.x >> 6);
    const int lane = lane_id(), tid = wave * 64 + lane;
    const int G = gridDim.x, bx = blockIdx.x;
    unsigned char* ws = args.ws;
#define INP(k) ({ int _k = (k); asm volatile("" : "+s"(_k)); args.in[_k]; })
#define XIN INP(0)
#define Win_t ((bf16*)(ws + WS_WIN))
#define Wout_t ((bf16*)(ws + WS_WOUT))
#define XN ((bf16*)(ws + WS_XN))
#define H ((bf16*)(ws + WS_H))
#define GATES ((float*)(ws + WS_GATES))
#define PROJ ((bf16*)(ws + WS_PROJ))
#define MIX ((bf16*)(ws + WS_MIX))
#define EO8 (ws + WS_XG + 136 * MiB)
#define TOPI ((int*)(ws + WS_ROUTE + R_TOPI))
#define TOPG ((float*)(ws + WS_ROUTE + R_TOPG))
#define TOKROW ((int*)(ws + WS_ROUTE + R_TOKROW))
#define ROWTOK ((int*)(ws + WS_ROUTE + R_ROWTOK))
#define ROWGATE ((float*)(ws + WS_ROUTE + R_ROWGATE))
#define BLKCNT ((int*)(ws + WS_ROUTE + R_BLKCNT))
#define BLKEXP ((int*)(ws + WS_ROUTE + R_BLKEXP))
#define NBLK ((int*)(ws + WS_ROUTE + R_NBLK))
#define XBC ((bf16*)(ws + WS_XBC))
#define SSQ ((float*)(ws + WS_SSQ))
#define RS1 ((float*)(ws + WS_SSQ + 1 * MiB))
#define RS2 ((float*)(ws + WS_SSQ + 1 * MiB + 128 * 1024))
#define ROWRS ((float*)(ws + WS_SSQ + 1 * MiB + 256 * 1024))
#define XN8 (ws + WS_XN)
#define XG8 (ws + WS_XG)
#define ACT8 (ws + WS_ACT)
#define Wgu8 (ws + WS_WGU)
#define Wdn8 (ws + WS_WDN)
    const int lo = args.ph_lo, hi = args.ph_hi;
    if (tid < 64) ((LAS unsigned*)(lds + MISC_OFF))[tid] = 0u;
    __syncthreads();
    XcdBarrier bar = xcd_barrier_post((unsigned*)(ws + WS_CTL) + CW_BAR, (volatile LAS unsigned*)(lds + MISC_OFF), tid == 0);
#define GRID_BAR(k) do { if (IN(k) && IN((k) + 1)) xcd_barrier(bar, wave == 0 && lane_id() == 0); } while (0)
#ifndef PH_MASK
#define PH_MASK 0xffff
#endif
#define IN(k) (((PH_MASK >> (k)) & 1) && lo <= (k) && (k) < hi)


    if (IN(0)) {
        const int tid = fresh_tid(wave), lane = tid & 63; (void)lane;
        LAS float* scr = (LAS float*)(lds + wave * 16384);
        const int gw = bx * NWAVES + wave, NGW = G * NWAVES;
        constexpr int I_IN = 16 * (NPROJ / 32), I_OUT = 32 * 32, I_GU = 16 * 64, I_DN = 16 * 32;
        constexpr int NITEMS = I_IN + I_OUT + NE * I_GU + NE * I_DN;
        if (!(args.variant & 32))
        for (int it = gw; it < NITEMS; it += NGW) {
            int r = it;
            if (r < I_IN) { const int nb = r % (NPROJ / 32), kb = r / (NPROJ / 32), n0 = nb * 32; const int n0s = n0 + (n0 >= C_Q ? 16 : 0);
                const float cs = (n0 >= C_K && n0 < C_V) ? 0.08838834764831845f : 1.0f;
                transpose_item(INP(2), WIN_LD, n0s, kb * 64, Win_t, 1024, n0, cs, nullptr, scr, lane); continue; } r -= I_IN;
            if (r < I_OUT) { const int nb = r % 32, kb = r / 32; transpose_item(INP(12), 1024, nb * 32, kb * 64, Wout_t, 2048, nb * 32, 1.0f, kb < 16 ? INP(8) : nullptr, scr, lane); continue; } r -= I_OUT;
            if (r < NE * I_GU) { const int e = r / I_GU, q = r % I_GU, nb = q % 64, kb = q / 64, rho = nb * 32; const int n0s = ((rho >> 7) & 1) * 1024 + (rho >> 8) * 128 + (rho & 127);
                transpose_item_f8(INP(16) + (size_t)e * 1024 * 2048, 2048, n0s, kb * 64, Wgu8 + (size_t)e * 2048 * 1024, 1024, rho, 64.0f, nullptr, scr, lane); continue; } r -= NE * I_GU;
            { const int e = r / I_DN, q = r % I_DN, nb = q % 32, kb = q / 32;
                transpose_item_f8(INP(18) + (size_t)e * 1024 * 1024, 1024, nb * 32, kb * 64, Wdn8 + (size_t)e * 1024 * 1024, 1024, nb * 32, 64.0f, nullptr, scr, lane); }
        }
        __syncthreads();
        pt_fill(lds, INP(2), WIN_LD, tid, true);
        __syncthreads();
        { const int c16 = lane & 15, g = lane >> 4;
          const float* wnp = INP(1); const float* bi_ = INP(9); const float* bf_ = INP(10); const float gb0 = INP(5)[c16], gb1 = *(c16 < 8 ? bi_ + c16 : bf_ + (c16 - 8));
          if (!(args.variant & 64))
#pragma unroll 1
          for (int task = gw; task < T / 16; task += NGW) { const int row0 = task * 16; f32x4 acc[2];
            const float rs = rowproj16<false, false>(XIN, XN, wnp, lds, row0, lane, acc);
            if (g == 0) RS1[row0 + c16] = rs;
#pragma unroll
            for (int r = 0; r < 4; ++r) { const float rr = __shfl(rs, 4 * g + r); float* gp = GATES + (size_t)(row0 + 4 * g + r) * 32; gp[c16] = rr * acc[0][r] + gb0; gp[16 + c16] = rr * acc[1][r] + gb1; } } }
        __syncthreads();
    }
    GRID_BAR(0);

    if (IN(1)) {
        pg8::Gemm g{XN, Win_t, T, NPROJ, 1024}; pg8::StaticOrder S; S.init(T, NPROJ, G, bx);
        pg8::EpiBf16 E{PROJ, NPROJ, RS1};
        pg8::gemm_phase<pg8::EpiBf16, pg8::StaticOrder>(lds, g, S, E, wave);
    }
    GRID_BAR(1);

    if (IN(2)) {
        const int tid = fresh_tid(wave), lane = tid & 63; (void)lane;
        const float* cw = INP(3); const float* cb = INP(4);
#pragma unroll 1
        for (int it = bx * NTHR + tid; it < (T / 16) * 192; it += G * NTHR) {
            const int ch = it % 192, t0 = (it / 192) * 16, c0 = ch * 8;
            float w[4][8], bs[8], r0[8], r1[8], r2[8];
#pragma unroll
            for (int k = 0; k < 4; ++k) { const f32x4 a = *(const f32x4*)(cw + k * 1536 + c0), b2 = *(const f32x4*)(cw + k * 1536 + c0 + 4);
#pragma unroll
                for (int e = 0; e < 4; ++e) { w[k][e] = a[e]; w[k][4 + e] = b2[e]; } }
            { const f32x4 a = *(const f32x4*)(cb + c0), b2 = *(const f32x4*)(cb + c0 + 4);
#pragma unroll
              for (int e = 0; e < 4; ++e) { bs[e] = a[e]; bs[4 + e] = b2[e]; } }
            const bf16* src = PROJ + (size_t)t0 * NPROJ + C_XBC + c0;
            if ((t0 & (SEQ - 1)) == 0) {
#pragma unroll
                for (int e = 0; e < 8; ++e) { r0[e] = 0.f; r1[e] = 0.f; r2[e] = 0.f; }
            } else { mx::unpack8(*(const v4u*)(src - 3 * (size_t)NPROJ), r0); mx::unpack8(*(const v4u*)(src - 2 * (size_t)NPROJ), r1); mx::unpack8(*(const v4u*)(src - (size_t)NPROJ), r2); }
            v4u raw[16];
#pragma unroll
            for (int i = 0; i < 16; ++i) raw[i] = *(const v4u*)(src + (size_t)i * NPROJ);
#pragma unroll
            for (int i = 0; i < 16; ++i) { float cu[8], o[8]; mx::unpack8(raw[i], cu);
#pragma unroll
                for (int e = 0; e < 8; ++e) { o[e] = silu_f(bs[e] + w[0][e] * r0[e] + w[1][e] * r1[e] + w[2][e] * r2[e] + w[3][e] * cu[e]); r0[e] = r1[e]; r1[e] = r2[e]; r2[e] = cu[e]; }
                v4u ov = {pk2(o[0], o[1]), pk2(o[2], o[3]), pk2(o[4], o[5]), pk2(o[6], o[7])};
                *(v4u*)(XBC + (size_t)(t0 + i) * 1536 + c0) = ov; }
        }
    }
    GRID_BAR(2);

    if (IN(3)) {
#pragma unroll 1
        for (int it = bx; it < 256; it += G) if ((it >> 3) & 1) mx::mlstm_item(lds, ((it >> 4) << 3) | (it & 7), args.variant, wave, PROJ, GATES, INP(11), MIX);
#pragma unroll 1
        for (int it = bx; it < 256; it += G) if (!((it >> 3) & 1)) mx::ssd_item(lds, ((it >> 4) << 3) | (it & 7), args.variant, wave, XBC, PROJ, GATES, INP(6), INP(7), MIX, SSQ);
    }
    GRID_BAR(3);
    if (IN(4)) {
        pg8::Gemm g{MIX, Wout_t, T, 1024, 2048}; pg8::StaticOrder S; S.init(T, 1024, G, bx);
        pg8::EpiResF32 E{XIN, H, 1024, SSQ};
        pg8::gemm_phase<pg8::EpiResF32, pg8::StaticOrder>(lds, g, S, E, wave);
    }

    GRID_BAR(4);
    if (IN(5)) {
        const int tid = fresh_tid(wave), lane = tid & 63; (void)lane;
        LAS int* hist = (LAS int*)(lds + MISC_OFF + 256);
        pt_fill(lds, INP(14), 32, tid, false);
        if (tid < 32) hist[tid] = 0;
        __syncthreads();
        const int c16 = lane & 15, g = lane >> 4; const float* wnp = INP(13); const float rb0 = INP(15)[c16], rb1 = INP(15)[16 + c16];
        for (int blk = bx; blk < T / 128; blk += G) {
            const int row0 = blk * 128 + wave * 16; f32x4 acc[2];
            const float rs = rowproj16<true, true>(H, XN8, wnp, lds, row0, lane, acc);
            if (g == 0) RS2[row0 + c16] = rs;
#pragma unroll
            for (int r = 0; r < 4; ++r) { const float rr = __shfl(rs, 4 * g + r); float v0 = rr * acc[0][r] + rb0, v1 = rr * acc[1][r] + rb1; float tv[4]; int ti[4];
#pragma unroll
                for (int k = 0; k < 4; ++k) { float bv = v0 >= v1 ? v0 : v1; int bi = v0 >= v1 ? c16 : c16 + 16;
#pragma unroll
                    for (int m = 1; m < 16; m <<= 1) { const float ov = __shfl_xor(bv, m); const int oi = __shfl_xor(bi, m); if (ov > bv || (ov == bv && oi < bi)) { bv = ov; bi = oi; } }
                    tv[k] = bv; ti[k] = bi; if (bi == c16) v0 = -INFINITY; if (bi == c16 + 16) v1 = -INFINITY; }
                const float e1 = __expf(tv[1] - tv[0]), e2 = __expf(tv[2] - tv[0]), e3 = __expf(tv[3] - tv[0]); const float inv = 1.0f / (1.0f + e1 + e2 + e3);
                if (c16 == 0) { const size_t o = (size_t)(row0 + 4 * g + r) * 4; TOPI[o] = ti[0]; TOPI[o + 1] = ti[1]; TOPI[o + 2] = ti[2]; TOPI[o + 3] = ti[3];
                    TOPG[o] = inv; TOPG[o + 1] = e1 * inv; TOPG[o + 2] = e2 * inv; TOPG[o + 3] = e3 * inv;
                    __hip_atomic_fetch_add(hist + ti[0], 1, __ATOMIC_RELAXED, __HIP_MEMORY_SCOPE_WORKGROUP); __hip_atomic_fetch_add(hist + ti[1], 1, __ATOMIC_RELAXED, __HIP_MEMORY_SCOPE_WORKGROUP); __hip_atomic_fetch_add(hist + ti[2], 1, __ATOMIC_RELAXED, __HIP_MEMORY_SCOPE_WORKGROUP); __hip_atomic_fetch_add(hist + ti[3], 1, __ATOMIC_RELAXED, __HIP_MEMORY_SCOPE_WORKGROUP); } }
            __syncthreads();
            if (tid < 32) { BLKCNT[blk * 32 + tid] = hist[tid]; hist[tid] = 0; }
            __syncthreads();
        }
    }
    GRID_BAR(5);
    if (IN(6)) {
        const int tid = fresh_tid(wave), lane = tid & 63; (void)lane;
        LAS int* tot = (LAS int*)lds; LAS int* base = tot + 32; LAS int* pstart = base + 32; LAS int* wcnt = pstart + 33;
        LAS int* arow = wcnt + 256;
        LAS int* psum = arow + 512;
        for (int blk = bx; blk < T / 128; blk += G) {
            { const int e = tid & 31, part = tid >> 5; int v[16], t = 0, b = 0;
#pragma unroll
              for (int j = 0; j < 16; ++j) v[j] = BLKCNT[(part * 16 + j) * 32 + e];
#pragma unroll
              for (int j = 0; j < 16; ++j) { t += v[j]; if (part * 16 + j < blk) b += v[j]; }
              psum[part * 32 + e] = t; psum[512 + part * 32 + e] = b; }
            __syncthreads();
            if (tid < 32) { int t = 0, b = 0;
#pragma unroll
              for (int p = 0; p < 16; ++p) { t += psum[p * 32 + tid]; b += psum[512 + p * 32 + tid]; } tot[tid] = t; base[tid] = b; }
            __syncthreads();
            if (tid == 0) { int s = 0; for (int e = 0; e < 32; ++e) { pstart[e] = s; s += (tot[e] + 255) / 256 * 256; } pstart[32] = s; }
            __syncthreads();
            const int token = blk * 128 + (tid >> 2), k = tid & 3; const int e = TOPI[(size_t)token * 4 + k];
            int rank = 0;
#pragma unroll 1
            for (int ee = 0; ee < 32; ++ee) { const unsigned long long m = __ballot(e == ee); if (e == ee) rank = __popcll(m & ((1ull << lane) - 1ull)); if (lane == 0) wcnt[wave * 32 + ee] = __popcll(m); }
            __syncthreads();
            int off = 0; for (int w = 0; w < wave; ++w) off += wcnt[w * 32 + e];
            const int row = pstart[e] + base[e] + off + rank;
            ROWTOK[row] = token; ROWGATE[row] = TOPG[(size_t)token * 4 + k]; ROWRS[row] = RS2[token]; TOKROW[(size_t)token * 4 + k] = row; arow[tid] = row;
            __syncthreads();
#pragma unroll 1
            for (int a0 = 0; a0 < 64; a0 += 8) { v4u rv[8];
#pragma unroll
                for (int a = 0; a < 8; ++a) { const int ai = wave * 64 + a0 + a; rv[a] = ((const v4u*)(XN8 + (size_t)(blk * 128 + (ai >> 2)) * 1024))[lane]; }
#pragma unroll
                for (int a = 0; a < 8; ++a) { const int drow = arow[wave * 64 + a0 + a]; ((v4u*)(XG8 + (size_t)drow * 1024))[lane] = rv[a]; } }
            if (blk < 32) { const int ps = pstart[blk] + tot[blk], pe = pstart[blk + 1];
                for (int r = ps + wave; r < pe; r += NWAVES) { if (lane == 0) { ROWTOK[r] = 0; ROWGATE[r] = 0.f; ROWRS[r] = 0.f; } v4u* d = (v4u*)(XG8 + (size_t)r * 1024); const v4u z = {0u, 0u, 0u, 0u}; d[lane] = z; } }
            if (blk == 0) { const int nb = pstart[32] / 256; if (tid == 0) NBLK[0] = nb;
                for (int b = tid; b < nb; b += NTHR) { int e2 = 0; while (e2 < 31 && b * 256 >= pstart[e2 + 1]) ++e2; BLKEXP[b] = e2; } }
            __syncthreads();
        }
    }

    GRID_BAR(6);
    if (IN(7)) {
        pg8::Gemm g{(const bf16*)XG8, (const bf16*)Wgu8, MAXROWS, 2048, 512}; pg8::MoeOrder S{BLKEXP, __builtin_amdgcn_readfirstlane(NBLK[0]), 8, G, bx};
        pg8::EpiSwiglu E{ACT8, INP(17), ROWRS};
        pg8::gemm_phase_f8<pg8::EpiSwiglu, pg8::MoeOrder>(lds, g, S, E, wave);
    }
    GRID_BAR(7);
    if (IN(8)) {
        pg8::Gemm g{(const bf16*)ACT8, (const bf16*)Wdn8, MAXROWS, 1024, 512}; pg8::MoeOrder S{BLKEXP, __builtin_amdgcn_readfirstlane(NBLK[0]), 4, G, bx};
        pg8::EpiDown E{EO8, INP(19), ROWGATE};
        pg8::gemm_phase_f8<pg8::EpiDown, pg8::MoeOrder>(lds, g, S, E, wave);
    }
    GRID_BAR(8);
    if (IN(9)) {
        const int tid = fresh_tid(wave), lane = tid & 63; (void)lane;
        const int gw = bx * NWAVES + wave, NGW = G * NWAVES;
        f32x4 wf[4];
#pragma unroll
        for (int j = 0; j < 4; ++j) wf[j] = *(const f32x4*)(INP(20) + 4 * lane + 256 * j);
#pragma unroll 1
        for (int row = gw; row < T; row += 2 * NGW) {
            int er[2][4];
#pragma unroll
            for (int q = 0; q < 2; ++q) { const typeof(*(const v4u*)0) t4 = *(const v4u*)(TOKROW + (size_t)(row + q * NGW) * 4); er[q][0] = (int)t4.x; er[q][1] = (int)t4.y; er[q][2] = (int)t4.z; er[q][3] = (int)t4.w; }
            v2u hw[2][4]; int ew[2][4][4];
#pragma unroll
            for (int q = 0; q < 2; ++q)
#pragma unroll
                for (int j = 0; j < 4; ++j) hw[q][j] = *(const v2u*)(H + (size_t)(row + q * NGW) * 1024 + 4 * lane + 256 * j);
#pragma unroll
            for (int q = 0; q < 2; ++q)
#pragma unroll
                for (int k = 0; k < 4; ++k)
#pragma unroll
                    for (int j = 0; j < 4; ++j) ew[q][k][j] = *(const int*)(EO8 + (size_t)er[q][k] * 1024 + 4 * lane + 256 * j);
#pragma unroll
            for (int q = 0; q < 2; ++q) { f32x4 v[4], ya[4]; typedef float f2v __attribute__((ext_vector_type(2)));
#pragma unroll
                for (int j = 0; j < 4; ++j) { v[j] = (f32x4){bflo(hw[q][j].x), bfhi(hw[q][j].x), bflo(hw[q][j].y), bfhi(hw[q][j].y)}; ya[j] = (f32x4){0.f, 0.f, 0.f, 0.f}; }
#pragma unroll
                for (int k = 0; k < 4; ++k)
#pragma unroll
                    for (int j = 0; j < 4; ++j) { const f2v lo = __builtin_amdgcn_cvt_pk_f32_fp8(ew[q][k][j], false), hi = __builtin_amdgcn_cvt_pk_f32_fp8(ew[q][k][j], true); ya[j][0] += lo[0]; ya[j][1] += lo[1]; ya[j][2] += hi[0]; ya[j][3] += hi[1]; }
                float ss = 0.f;
#pragma unroll
                for (int j = 0; j < 4; ++j) { v[j] = v[j] + ya[j] * 0.0625f; ss += (v[j][0] * v[j][0] + v[j][1] * v[j][1]) + (v[j][2] * v[j][2] + v[j][3] * v[j][3]); }
                ss = wave_sum(ss); const float rs = rsqrt_f(ss * (1.0f / 1024.0f) + RMS_EPS);
#pragma unroll
                for (int j = 0; j < 4; ++j) *(f32x4*)(args.out + (size_t)(row + q * NGW) * 1024 + 4 * lane + 256 * j) = v[j] * rs * wf[j]; }
        }
    }
#undef IN
}

extern "C" void kernel_launch(void* const* d_in, const int* in_sizes, int n_in, void* d_out, int out_size, void* d_ws, size_t ws_size, hipStream_t stream) {
    static int grid = 0;
    if (grid == 0) {
        if (n_in != 21 || in_sizes[0] != T * D || out_size != T * D || ws_size < WS_END) { fprintf(stderr, "kernel_launch: unexpected shapes/workspace (n_in %d, ws %zu, need %zu)\n", n_in, ws_size, (size_t)WS_END); grid = -1; return; }
        if (hipFuncSetAttribute((const void*)mega, hipFuncAttributeMaxDynamicSharedMemorySize, LDS_BYTES) != hipSuccess) { fprintf(stderr, "kernel_launch: hipFuncSetAttribute failed\n"); grid = -1; return; }
        int dev = 0, cus = 0, per_cu = 0;
        if (hipGetDevice(&dev) != hipSuccess || hipDeviceGetAttribute(&cus, hipDeviceAttributeMultiprocessorCount, dev) != hipSuccess) { grid = -1; return; }
        if (hipOccupancyMaxActiveBlocksPerMultiprocessor(&per_cu, (const void*)mega, NTHR, LDS_BYTES) != hipSuccess || per_cu < 1) { fprintf(stderr, "kernel_launch: occupancy query says %d blocks per CU\n", per_cu); grid = -1; return; }
        (void)hipGetLastError();
        grid = cus;
    }
    if (grid < 0) return;
    (void)hipMemsetAsync((char*)d_ws + WS_CTL, 0, CTL_ZERO_BYTES, stream);
    Args a{};
    for (int i = 0; i < 21; ++i) a.in[i] = (const float*)d_in[i];
    a.out = (float*)d_out; a.ws = (unsigned char*)d_ws;
    a.ph_lo = 0; a.ph_hi = 10;
    hipLaunchKernelGGL(mega, dim3(grid), dim3(NTHR), LDS_BYTES, stream, a);
#ifdef PROBE_PHASE
    a.ph_lo = PROBE_PHASE; a.ph_hi = PROBE_PHASE + 1;
#ifdef PROBE_VARIANT
    a.variant = PROBE_VARIANT;
#endif
    hipLaunchKernelGGL(mega, dim3(grid), dim3(NTHR), LDS_BYTES, stream, a);
#endif
}
```

```cpp
#define WGM_SET 2
#include <hip/hip_runtime.h>
#include <cstdio>
#include <cstdint>

__device__ __forceinline__ int lane_id() { int l; asm volatile("v_mbcnt_lo_u32_b32 %0, -1, 0\n\tv_mbcnt_hi_u32_b32 %0, -1, %0" : "=v"(l)); return l; }
__device__ __forceinline__ void probe_spin(unsigned long long ticks) { const unsigned long long t0 = __builtin_amdgcn_s_memrealtime(); while (__builtin_amdgcn_s_memrealtime() - t0 < ticks) __builtin_amdgcn_s_sleep(8); }
namespace pg8 {
#define PG8_LAS __attribute__((address_space(3)))
typedef unsigned short bf16_t;
typedef short bf16x8 __attribute__((ext_vector_type(8)));
typedef float f32x4 __attribute__((ext_vector_type(4)));
typedef unsigned u32x4 __attribute__((ext_vector_type(4)));
#ifndef WGM_SET
#define WGM_SET 8
#endif
constexpr int BM = 256, BK = 64, HALF = 128, HTB = HALF * BK * 2, STAGE_BYTES = 8 * HTB, NXCD = 8, WGM = WGM_SET;

__host__ __device__ __forceinline__ int lds_byte(int r, int c) { const int st = (r >> 4) * 2 + (c >> 5), rr = r & 15, cc = c & 31, ob = rr * 64 + cc * 2; return st * 1024 + (ob ^ (((ob >> 9) & 1) << 5)); }
__host__ __device__ __forceinline__ void stage_rc(int b, int& R, int& C) { const int st = b / 1024, sb = b % 1024, swz = sb ^ (((sb >> 9) & 1) << 5); R = (st >> 1) * 16 + swz / 64; C = (st & 1) * 32 + (swz % 64) / 2; }
__host__ __device__ __forceinline__ int perm32(int rho) { const int n = rho >> 4, i = rho & 15; return 8 * (i >> 2) + 4 * n + (i & 3); }

__device__ __forceinline__ const char* uni_ptr(const void* p) { const unsigned long long v = (unsigned long long)p; const unsigned lo = __builtin_amdgcn_readfirstlane((unsigned)v), hi = __builtin_amdgcn_readfirstlane((unsigned)(v >> 32)); return (const char*)(((unsigned long long)hi << 32) | lo); }
struct Unit { int pm, pn, pb, e; };
struct Gemm { const bf16_t* A; const bf16_t* Bt; int M, N, K; };

struct StaticOrder {
    int nM, nN, nwg, G, c;
    __host__ __device__ void init(int M, int N, int G_, int c_) { nM = M / BM; nN = N / BM; nwg = nM * nN; G = G_; c = c_; }
    __host__ __device__ bool next(int i, Unit& u) const {
        const long L = (long)i * G + c; if (L >= nwg) return false;
        int wgid = (int)L; { const int q = nwg / NXCD, r = nwg % NXCD, xcd = wgid % NXCD, off = wgid / NXCD; wgid = (xcd < r ? xcd * (q + 1) : r * (q + 1) + (xcd - r) * q) + off; }
        const int nig = WGM * nN, gid = wgid / nig, fm = gid * WGM, gsz = (nM - fm) < WGM ? (nM - fm) : WGM;
        u.pm = fm + ((wgid % nig) % gsz); u.pn = (wgid % nig) / gsz; u.pb = u.pn; u.e = 0; return true;
    }
};
struct MoeOrder {
    const int* blk_expert; int nblk, ntn, G, c;
    __device__ bool next(int i, Unit& u) const {
        const int xcd = c % NXCD, s = i * (G / NXCD) + c / NXCD;
        const int rb = (s / ntn) * NXCD + xcd; if (rb >= nblk) return false;
        u.pm = rb; u.pn = s % ntn; u.e = __builtin_amdgcn_readfirstlane(blk_expert[rb]); u.pb = u.e * ntn + u.pn; return true;
    }
};

__device__ __forceinline__ unsigned cvt_pk_bf16(float lo, float hi) { unsigned r; asm volatile("v_cvt_pk_bf16_f32 %0, %1, %2" : "=v"(r) : "v"(lo), "v"(hi)); return r; }

struct EpiBf16 {
    static constexpr bool PERM = true; static constexpr int MIDT = -1;
    __device__ __forceinline__ void mid(f32x4 (&)[2][2][4][2], const Unit&, int, int) const {}
    bf16_t* O; int ldc; const float* rs;
    static constexpr bool HAS_ROWTAB = true;
    __device__ __forceinline__ const float* rowtab(const Unit& u) const { return rs + (size_t)u.pm * BM; }
    __device__ __forceinline__ void operator()(const f32x4 (&acc)[2][2][4][2], const Unit& u, int wr, int wc, int fr, int fq, const PG8_LAS float* rt) const {
        const int row0 = u.pm * BM + wr * 64 + fr, col0 = u.pn * BM + wc * 32 + 8 * fq;
#pragma unroll
        for (int ai = 0; ai < 2; ++ai)
#pragma unroll
            for (int m = 0; m < 4; ++m) { const int row = row0 + ai * HALF + m * 16; const float rr = rt[ai * HALF + wr * 64 + m * 16 + fr]; bf16_t* rowp = O + (size_t)row * ldc + col0;
#pragma unroll
                for (int bj = 0; bj < 2; ++bj) { const f32x4 v0 = acc[ai][bj][m][0] * rr, v1 = acc[ai][bj][m][1] * rr;
                    u32x4 w; w.x = cvt_pk_bf16(v0[0], v0[1]); w.y = cvt_pk_bf16(v0[2], v0[3]); w.z = cvt_pk_bf16(v1[0], v1[1]); w.w = cvt_pk_bf16(v1[2], v1[3]);
                    *(u32x4*)(rowp + bj * HALF) = w; } }
    }
};
struct EpiResF32 {
    static constexpr bool PERM = true; static constexpr int MIDT = 16;
    const bf16_t* base; bf16_t* C; int ldc; const float* ssq;
    __device__ __forceinline__ void mid(f32x4 (&acc)[2][2][4][2], const Unit& u, int wr, int fr) const {
#pragma unroll
        for (int ai = 0; ai < 2; ++ai)
#pragma unroll
            for (int m = 0; m < 4; ++m) { const int row = u.pm * BM + ai * HALF + wr * 64 + m * 16 + fr; const f32x4 a = *(const f32x4*)(ssq + (size_t)row * 8), b = *(const f32x4*)(ssq + (size_t)row * 8 + 4);
                const float rs = 1.0f / sqrtf(((a[0] + a[1]) + (a[2] + a[3]) + (b[0] + b[1]) + (b[2] + b[3])) * (1.0f / 1024.0f) + 1e-6f);
#pragma unroll
                for (int bj = 0; bj < 2; ++bj)
#pragma unroll
                    for (int n = 0; n < 2; ++n) acc[ai][bj][m][n] = acc[ai][bj][m][n] * rs;
                asm volatile("" ::: "memory"); }
    }
    static constexpr bool HAS_ROWTAB = false;
    __device__ __forceinline__ const float* rowtab(const Unit&) const { return nullptr; }
    __device__ __forceinline__ void operator()(const f32x4 (&acc)[2][2][4][2], const Unit& u, int wr, int wc, int fr, int fq, const PG8_LAS float*) const {
        const int row0 = u.pm * BM + wr * 64 + fr, col0 = u.pn * BM + wc * 32 + 8 * fq;
#pragma unroll
        for (int ai = 0; ai < 2; ++ai)
#pragma unroll
            for (int m = 0; m < 4; ++m) { const size_t off = (size_t)(row0 + ai * HALF + m * 16) * ldc + col0;
#pragma unroll
                for (int bj = 0; bj < 2; ++bj) { const u32x4 rw = *(const u32x4*)(base + off + bj * HALF);
                    const f32x4 b0 = {__builtin_bit_cast(float, rw.x << 16), __builtin_bit_cast(float, rw.x & 0xffff0000u), __builtin_bit_cast(float, rw.y << 16), __builtin_bit_cast(float, rw.y & 0xffff0000u)};
                    const f32x4 b1 = {__builtin_bit_cast(float, rw.z << 16), __builtin_bit_cast(float, rw.z & 0xffff0000u), __builtin_bit_cast(float, rw.w << 16), __builtin_bit_cast(float, rw.w & 0xffff0000u)};
                    const f32x4 v0 = acc[ai][bj][m][0] + b0, v1 = acc[ai][bj][m][1] + b1;
                    u32x4 w; w.x = cvt_pk_bf16(v0[0], v0[1]); w.y = cvt_pk_bf16(v0[2], v0[3]); w.z = cvt_pk_bf16(v1[0], v1[1]); w.w = cvt_pk_bf16(v1[2], v1[3]);
                    *(u32x4*)(C + off + bj * HALF) = w; } }
    }
};
struct EpiSwiglu {
    static constexpr bool PERM = true; static constexpr int MIDT = -1;
    __device__ __forceinline__ void mid(f32x4 (&)[2][2][4][2], const Unit&, int, int) const {}
    static constexpr bool GATHER = true; const int* rowtok;
    unsigned char* act; const float* bgu; const float* rs;
    __device__ __forceinline__ const float* rowtab(const Unit& u) const { return rs + (size_t)u.pm * BM; }
    __device__ __forceinline__ const float* coltab(const Unit& u, int q) const { return bgu + (size_t)u.e * 2048 + u.pn * HALF + (q >> 1) * 1024 + (q & 1) * 64; }
    __device__ __forceinline__ void operator()(const f32x4 (&acc)[2][2][4][2], const Unit& u, int wr, int wc, int fr, int fq, const PG8_LAS float* tab) const {
        const int row0 = u.pm * BM + wr * 64 + fr, col0 = u.pn * HALF + wc * 32 + 8 * fq;
        const PG8_LAS float* ct = tab + 256 + wc * 32 + 8 * fq;
        f32x4 bgv[2], buv[2];
#pragma unroll
        for (int n = 0; n < 2; ++n) { bgv[n] = *(const PG8_LAS f32x4*)(ct + 4 * n); buv[n] = *(const PG8_LAS f32x4*)(ct + 128 + 4 * n); }
#pragma unroll
        for (int ai = 0; ai < 2; ++ai)
#pragma unroll
            for (int m = 0; m < 4; ++m) { const int row = row0 + ai * HALF + m * 16; const float rr = tab[ai * HALF + wr * 64 + m * 16 + fr]; unsigned char* rowp = act + (size_t)row * 1024 + col0;
                float o[8];
#pragma unroll
                for (int n = 0; n < 2; ++n) { typedef float f2 __attribute__((ext_vector_type(2)));
#pragma unroll
                    for (int h = 0; h < 2; ++h) { const f2 ag = {acc[ai][0][m][n][2 * h], acc[ai][0][m][n][2 * h + 1]}, au = {acc[ai][1][m][n][2 * h], acc[ai][1][m][n][2 * h + 1]};
                        const f2 bg2 = {bgv[n][2 * h], bgv[n][2 * h + 1]}, bu2 = {buv[n][2 * h], buv[n][2 * h + 1]};
                        f2 gv = ag * rr + bg2, uv = au * rr + bu2;
                        gv.x = fminf(gv.x, 7.0f); gv.y = fminf(gv.y, 7.0f); uv.x = __builtin_amdgcn_fmed3f(uv.x, -7.0f, 7.0f); uv.y = __builtin_amdgcn_fmed3f(uv.y, -7.0f, 7.0f);
                        const f2 t = gv * (-1.702f * 1.44269504f); f2 e; e.x = __builtin_amdgcn_exp2f(t.x); e.y = __builtin_amdgcn_exp2f(t.y);
                        const f2 d = e + 1.0f; f2 r; r.x = __builtin_amdgcn_rcpf(d.x); r.y = __builtin_amdgcn_rcpf(d.y);
                        const f2 res = ((uv + 1.0f) * gv) * r; o[4 * n + 2 * h] = res.x; o[4 * n + 2 * h + 1] = res.y; } }
                int w0 = 0, w1 = 0; w0 = __builtin_amdgcn_cvt_pk_fp8_f32(o[0], o[1], w0, false); w0 = __builtin_amdgcn_cvt_pk_fp8_f32(o[2], o[3], w0, true); w1 = __builtin_amdgcn_cvt_pk_fp8_f32(o[4], o[5], w1, false); w1 = __builtin_amdgcn_cvt_pk_fp8_f32(o[6], o[7], w1, true);
                typedef int i2v __attribute__((ext_vector_type(2))); *(i2v*)rowp = (i2v){w0, w1}; }
    }
};
struct EpiDown {
    static constexpr bool PERM = true; static constexpr int MIDT = -1;
    __device__ __forceinline__ void mid(f32x4 (&)[2][2][4][2], const Unit&, int, int) const {}
    static constexpr bool GATHER = false; const int* rowtok;
    unsigned char* eo; const float* bdn; const float* row_gate;
    __device__ __forceinline__ const float* rowtab(const Unit& u) const { return row_gate + (size_t)u.pm * BM; }
    __device__ __forceinline__ const float* coltab(const Unit& u, int q) const { return bdn + (size_t)u.e * 1024 + u.pn * BM + q * 64; }
    __device__ __forceinline__ void operator()(const f32x4 (&acc)[2][2][4][2], const Unit& u, int wr, int wc, int fr, int fq, const PG8_LAS float* tab) const {
        const int row0 = u.pm * BM + wr * 64 + fr, col0 = u.pn * BM + wc * 32 + 8 * fq;
        const PG8_LAS float* ct = tab + 256 + wc * 32 + 8 * fq;
        f32x4 bv[2][2];
#pragma unroll
        for (int bj = 0; bj < 2; ++bj)
#pragma unroll
            for (int n = 0; n < 2; ++n) bv[bj][n] = *(const PG8_LAS f32x4*)(ct + bj * HALF + 4 * n);
#pragma unroll
        for (int ai = 0; ai < 2; ++ai)
#pragma unroll
            for (int m = 0; m < 4; ++m) { const int row = row0 + ai * HALF + m * 16; const float gt = tab[ai * HALF + wr * 64 + m * 16 + fr] * 16.0f; unsigned char* rowp = eo + (size_t)row * 1024 + col0;
#pragma unroll
                for (int bj = 0; bj < 2; ++bj) { f32x4 v0 = (acc[ai][bj][m][0] + bv[bj][0]) * gt, v1 = (acc[ai][bj][m][1] + bv[bj][1]) * gt;
#pragma unroll
                    for (int i = 0; i < 4; ++i) { v0[i] = __builtin_amdgcn_fmed3f(v0[i], -448.0f, 448.0f); v1[i] = __builtin_amdgcn_fmed3f(v1[i], -448.0f, 448.0f); }
                    int w0 = 0, w1 = 0; w0 = __builtin_amdgcn_cvt_pk_fp8_f32(v0[0], v0[1], w0, false); w0 = __builtin_amdgcn_cvt_pk_fp8_f32(v0[2], v0[3], w0, true); w1 = __builtin_amdgcn_cvt_pk_fp8_f32(v1[0], v1[1], w1, false); w1 = __builtin_amdgcn_cvt_pk_fp8_f32(v1[2], v1[3], w1, true);
                    typedef int i2v __attribute__((ext_vector_type(2))); *(i2v*)(rowp + bj * HALF) = (i2v){w0, w1}; } }
    }
};

typedef int v8i_t __attribute__((ext_vector_type(8)));
typedef int v4i_t __attribute__((ext_vector_type(4)));
template <class Epi, class Sched>
__device__ __forceinline__ void gemm_phase(PG8_LAS unsigned char* lds, const Gemm g, const Sched& S, const Epi& E, int wid) {
    const int lane = lane_id(), tid = wid * 64 + lane, wr = wid >> 2, wc = wid & 3, fr = lane & 15, fq = lane >> 4;
    const int K = g.K, nt = K / BK;
    unsigned voffA[2], voffB[2];
#pragma unroll
    for (int i = 0; i < 2; ++i) { int R, C; stage_rc(tid * 16 + i * 8192, R, C); const int Rb = Epi::PERM ? ((R & ~31) + perm32(R & 31)) : R;
        voffA[i] = (unsigned)(R * K + C) * 2u; voffB[i] = (unsigned)(Rb * K + C) * 2u; }
    const size_t kstep = (size_t)(BK * 2);
    const size_t hstep = (size_t)HALF * K * 2;
    const size_t tstep = 2 * hstep;
    const unsigned ldsw = (unsigned)wid * 1024u;
    const int aoff = lds_byte(wr * 64 + fr, fq * 8), boff = lds_byte(wc * 32 + fr, fq * 8);
#define PG8_SA(b, h) (((b) * 2 + (h)) * HTB)
#define PG8_SB(b, h) ((4 + (b) * 2 + (h)) * HTB)
#define PG8_STAGE(bufoff, gbase, voff) do { _Pragma("unroll") for (int _i = 0; _i < 2; ++_i) \
        __builtin_amdgcn_global_load_lds((const unsigned*)((const char*)(gbase) + (voff)[_i]), (PG8_LAS unsigned*)(lds + (bufoff) + ldsw + _i * 8192), 16, 0, 0); } while (0)
#define PG8_LDA(dst, b, h) do { _Pragma("unroll") for (int m = 0; m < 4; ++m) _Pragma("unroll") for (int k = 0; k < 2; ++k) dst[m][k] = *(const PG8_LAS bf16x8*)(lds + PG8_SA(b, h) + aoff + m * 2048 + k * 1024); } while (0)
#define PG8_LDB(dst, b, h) do { _Pragma("unroll") for (int n = 0; n < 2; ++n) _Pragma("unroll") for (int k = 0; k < 2; ++k) dst[n][k] = *(const PG8_LAS bf16x8*)(lds + PG8_SB(b, h) + boff + n * 2048 + k * 1024); } while (0)
#define PG8_MMA(ai, bj, At, Bt) do { __builtin_amdgcn_s_setprio(1); _Pragma("unroll") for (int m = 0; m < 4; ++m) _Pragma("unroll") for (int n = 0; n < 2; ++n) _Pragma("unroll") for (int k = 0; k < 2; ++k) \
        acc[ai][bj][m][n] = __builtin_amdgcn_mfma_f32_16x16x32_bf16(Bt[n][k], At[m][k], acc[ai][bj][m][n], 0, 0, 0); __builtin_amdgcn_s_setprio(0); } while (0)
#define PG8_WAIT_V(n) asm volatile("s_waitcnt vmcnt(" #n ")" ::: "memory")
#define PG8_WAIT_L(n) asm volatile("s_waitcnt lgkmcnt(" #n ")" ::: "memory")
#define PG8_BAR __builtin_amdgcn_s_barrier()
#define PG8_SCHED __builtin_amdgcn_sched_barrier(0)
    Unit cur, nxt; int ui = 0;
    if (!S.next(0, cur)) return;
    f32x4 acc[2][2][4][2];
#pragma unroll
    for (int a = 0; a < 2; ++a)
#pragma unroll
        for (int b = 0; b < 2; ++b)
#pragma unroll
            for (int m = 0; m < 4; ++m)
#pragma unroll
                for (int n = 0; n < 2; ++n) acc[a][b][m][n] = (f32x4){0.f, 0.f, 0.f, 0.f};
    bf16x8 At[4][2], B0[2][2], B1[2][2];
    const char* cA = uni_ptr((const char*)g.A + (size_t)cur.pm * tstep); const char* cB = uni_ptr((const char*)g.Bt + (size_t)cur.pb * tstep);
#define PG8_ROWTAB(u_, slot_) do { if (Epi::HAS_ROWTAB && wid < 4) __builtin_amdgcn_global_load_lds((const unsigned*)(E.rowtab(u_) + wid * 64 + lane), (PG8_LAS unsigned*)(lds + STAGE_BYTES + (slot_) * 1024 + wid * 256), 4, 0, 0); } while (0)
    PG8_ROWTAB(cur, 0);
    PG8_STAGE(PG8_SB(0, 0), cB, voffB); PG8_STAGE(PG8_SB(0, 1), cB + hstep, voffB); PG8_STAGE(PG8_SA(0, 0), cA, voffA); PG8_STAGE(PG8_SA(0, 1), cA + hstep, voffA);
    if (wr == 1) PG8_BAR;
    PG8_WAIT_V(2); PG8_BAR;
    PG8_STAGE(PG8_SB(1, 0), cB + kstep, voffB); PG8_STAGE(PG8_SA(1, 0), cA + kstep, voffA); PG8_STAGE(PG8_SB(1, 1), cB + hstep + kstep, voffB);
    PG8_WAIT_V(6); PG8_BAR;
    for (;;) {
        const bool has_next = S.next(ui + 1, nxt);
        const char* nA = uni_ptr(has_next ? (const char*)g.A + (size_t)nxt.pm * tstep : cA); const char* nB = uni_ptr(has_next ? (const char*)g.Bt + (size_t)nxt.pb * tstep : cB);
        for (int t = 0; t < nt; t += 2) {
            const bool last = (t == nt - 2);
            const char* a1 = cA + (size_t)(t + 1) * kstep;
            const char* a2 = last ? nA : cA + (size_t)(t + 2) * kstep; const char* b2 = last ? nB : cB + (size_t)(t + 2) * kstep;
            const char* a3 = a2 + kstep; const char* b3 = b2 + kstep;
            if constexpr (Epi::MIDT >= 0) { if (t == Epi::MIDT) E.mid(acc, cur, wr, fr); }
            PG8_LDB(B0, 0, 0); PG8_LDB(B1, 0, 1); PG8_SCHED; PG8_LDA(At, 0, 0); PG8_STAGE(PG8_SA(1, 1), a1 + hstep, voffA);
            PG8_WAIT_V(8); PG8_WAIT_L(0); PG8_BAR; PG8_MMA(0, 0, At, B0); PG8_MMA(0, 1, At, B1); PG8_BAR; PG8_SCHED;
            PG8_LDA(At, 0, 1); PG8_STAGE(PG8_SB(0, 0), b2, voffB); PG8_STAGE(PG8_SB(0, 1), b2 + hstep, voffB); PG8_STAGE(PG8_SA(0, 0), a2, voffA);
            PG8_WAIT_V(8); PG8_WAIT_L(0); PG8_BAR; PG8_MMA(1, 0, At, B0); PG8_MMA(1, 1, At, B1); PG8_BAR; PG8_SCHED;
            PG8_LDB(B0, 1, 0); PG8_LDB(B1, 1, 1); PG8_SCHED; PG8_LDA(At, 1, 0); PG8_STAGE(PG8_SA(0, 1), a2 + hstep, voffA);
            PG8_WAIT_V(8); PG8_WAIT_L(0); PG8_BAR; PG8_MMA(0, 0, At, B0); PG8_MMA(0, 1, At, B1); PG8_BAR; PG8_SCHED;
            PG8_LDA(At, 1, 1); PG8_STAGE(PG8_SB(1, 0), b3, voffB); PG8_STAGE(PG8_SB(1, 1), b3 + hstep, voffB); PG8_STAGE(PG8_SA(1, 0), a3, voffA);
            PG8_WAIT_V(8); PG8_WAIT_L(0); PG8_BAR; PG8_MMA(1, 0, At, B0); PG8_MMA(1, 1, At, B1); PG8_BAR; PG8_SCHED;
        }
        if (wr == 0) PG8_BAR;
        E(acc, cur, wr, wc, fr, fq, (const PG8_LAS float*)(lds + STAGE_BYTES + (ui & 1) * 1024));
        if (!has_next) break;
#pragma unroll
        for (int a = 0; a < 2; ++a)
#pragma unroll
            for (int b = 0; b < 2; ++b)
#pragma unroll
                for (int m = 0; m < 4; ++m)
#pragma unroll
                    for (int n = 0; n < 2; ++n) acc[a][b][m][n] = (f32x4){0.f, 0.f, 0.f, 0.f};
        cur = nxt; cA = nA; cB = nB; ++ui;
        PG8_ROWTAB(cur, ui & 1);
        if (wr == 1) PG8_BAR;
    }
    PG8_WAIT_V(0);
    PG8_BAR;
#undef PG8_ROWTAB
#undef PG8_SA
#undef PG8_SB
#undef PG8_STAGE
#undef PG8_LDA
#undef PG8_LDB
#undef PG8_MMA
#undef PG8_WAIT_V
#undef PG8_WAIT_L
#undef PG8_BAR
#undef PG8_SCHED
}
template <class Epi, class Sched>
__device__ __forceinline__ void gemm_phase_f8(PG8_LAS unsigned char* lds, const Gemm g, const Sched& S, const Epi& E, int wid, int var = 0) {
    const int lane = lane_id(), tid = wid * 64 + lane, wr = wid >> 2, wc = wid & 3, fr = lane & 15, fq = lane >> 4;
    int Kq = g.K; asm volatile("" : "+s"(Kq));
    const int K = Kq, nt = K / BK;
    unsigned voffA[2], voffB[2];
#pragma unroll
    for (int i = 0; i < 2; ++i) { int R, C; stage_rc(tid * 16 + i * 8192, R, C); const int Rb = Epi::PERM ? ((R & ~31) + perm32(R & 31)) : R;
        voffA[i] = (unsigned)(R * K + C) * 2u; voffB[i] = (unsigned)(Rb * K + C) * 2u; }
    const size_t kstep = (size_t)(BK * 2);
    const size_t hstep = (size_t)HALF * K * 2;
    const size_t tstep = 2 * hstep;
    const unsigned ldsw = (unsigned)wid * 1024u;
    const unsigned ldsb = (unsigned)__builtin_amdgcn_readfirstlane((int)((unsigned)(size_t)lds + ldsw));
    const int aoff = lds_byte(wr * 64 + fr, fq * 8), boff = lds_byte(wc * 32 + fr, fq * 8);
#define PG8_SA(b, h) (((b) * 2 + (h)) * HTB)
#define PG8_SB(b, h) ((4 + (b) * 2 + (h)) * HTB)
#define PG8_STAGE(bufoff, gbase, voff) do { _Pragma("unroll") for (int _i = 0; _i < 2; ++_i) { unsigned _keep; \
        asm volatile("s_mov_b32 %0, m0\n\ts_mov_b32 m0, %3\n\ts_nop 0\n\tglobal_load_lds_dwordx4 %1, %2\n\ts_mov_b32 m0, %0" : "=&s"(_keep) : "v"((voff)[_i]), "s"((const char*)(gbase)), "s"(ldsb + (unsigned)((bufoff) + _i * 8192)) : "memory"); } } while (0)
#define PG8_STAGE_A(b, h, ka) do { if constexpr (Epi::GATHER) { _Pragma("unroll") for (int _i = 0; _i < 2; ++_i) { unsigned _keep; const unsigned _vo = (((voffA[_i] >> (16 * (h))) & 0xffffu) << 10) + cbA; \
        asm volatile("s_mov_b32 %0, m0\n\ts_mov_b32 m0, %3\n\ts_nop 0\n\tglobal_load_lds_dwordx4 %1, %2\n\ts_mov_b32 m0, %0" : "=&s"(_keep) : "v"(_vo), "s"((const char*)(ka)), "s"(ldsb + (unsigned)(PG8_SA(b, h) + _i * 8192)) : "memory"); } } \
    else PG8_STAGE(PG8_SA(b, h), (ka) + (h) * hstep, voffA); } while (0)
#define PG8_LDA(dst, b, h) do { _Pragma("unroll") for (int m = 0; m < 4; ++m) { const v4i_t _lo = *(const PG8_LAS v4i_t*)(lds + PG8_SA(b, h) + aoff + m * 2048), _hi = *(const PG8_LAS v4i_t*)(lds + PG8_SA(b, h) + aoff + m * 2048 + 1024); dst[m] = __builtin_shufflevector(_lo, _hi, 0, 1, 2, 3, 4, 5, 6, 7); } } while (0)
#define PG8_LDB(dst, b, h) do { _Pragma("unroll") for (int n = 0; n < 2; ++n) { const v4i_t _lo = *(const PG8_LAS v4i_t*)(lds + PG8_SB(b, h) + boff + n * 2048), _hi = *(const PG8_LAS v4i_t*)(lds + PG8_SB(b, h) + boff + n * 2048 + 1024); dst[n] = __builtin_shufflevector(_lo, _hi, 0, 1, 2, 3, 4, 5, 6, 7); } } while (0)
#define PG8_MMA(ai, bj, At, Bt) do { __builtin_amdgcn_s_setprio(1); _Pragma("unroll") for (int m = 0; m < 4; ++m) _Pragma("unroll") for (int n = 0; n < 2; ++n) \
        acc[ai][bj][m][n] = __builtin_amdgcn_mfma_scale_f32_16x16x128_f8f6f4(Bt[n], At[m], acc[ai][bj][m][n], 0, 0, 0, 0x79797979, 0, 0x7f7f7f7f); __builtin_amdgcn_s_setprio(0); } while (0)
#define PG8_WAIT_V(n) asm volatile("s_waitcnt vmcnt(" #n ")" ::: "memory")
#define PG8_WAIT_L(n) asm volatile("s_waitcnt lgkmcnt(" #n ")" ::: "memory")
#define PG8_BAR __builtin_amdgcn_s_barrier()
#define PG8_SCHED __builtin_amdgcn_sched_barrier(0)
#ifdef PROBE_GEMM
    unsigned long long p_acc = 0;
#endif
    Unit cur, nxt; int ui = 0;
    if (!S.next(0, cur)) return;
    f32x4 acc[2][2][4][2];
#pragma unroll
    for (int a = 0; a < 2; ++a)
#pragma unroll
        for (int b = 0; b < 2; ++b)
#pragma unroll
            for (int m = 0; m < 4; ++m)
#pragma unroll
                for (int n = 0; n < 2; ++n) acc[a][b][m][n] = (f32x4){0.f, 0.f, 0.f, 0.f};
    v8i_t At[4], B0[2], B1[2];
    const char* cA = uni_ptr((const char*)g.A + (Epi::GATHER ? (size_t)0 : (size_t)cur.pm * tstep)); const char* cB = uni_ptr((const char*)g.Bt + (size_t)cur.pb * tstep);
    unsigned cbA = 0;
    if constexpr (Epi::GATHER) { int R, C; stage_rc(tid * 16, R, C); cbA = (unsigned)C * 2u; const int* rt = E.rowtok + (size_t)cur.pm * BM + R;
        const int t00 = rt[0], t01 = rt[64], t10 = rt[128], t11 = rt[192]; voffA[0] = (unsigned)t00 | ((unsigned)t10 << 16); voffA[1] = (unsigned)t01 | ((unsigned)t11 << 16); }
#define PG8_TABS(u_, slot_) do { const char* _src = uni_ptr(wid < 4 ? E.rowtab(u_) + wid * 64 : E.coltab(u_, wid - 4)); unsigned _keep; \
        asm volatile("s_mov_b32 %0, m0\n\ts_mov_b32 m0, %3\n\ts_nop 0\n\tglobal_load_lds_dword %1, %2\n\ts_mov_b32 m0, %0" : "=&s"(_keep) : "v"(lane_id() * 4), "s"(_src), "s"(ldsb - ldsw + (unsigned)(STAGE_BYTES + (slot_) * 2048) + (unsigned)wid * 256u) : "memory"); } while (0)
    PG8_TABS(cur, 0);
    PG8_STAGE(PG8_SB(0, 0), cB, voffB); PG8_STAGE(PG8_SB(0, 1), cB + hstep, voffB); PG8_STAGE_A(0, 0, cA); PG8_STAGE_A(0, 1, cA);
    if (wr == 1) PG8_BAR;
    PG8_WAIT_V(2); PG8_BAR;
    PG8_STAGE(PG8_SB(1, 0), cB + kstep, voffB); PG8_STAGE_A(1, 0, cA + kstep); PG8_STAGE(PG8_SB(1, 1), cB + hstep + kstep, voffB);
    PG8_WAIT_V(6); PG8_BAR;
    for (;;) {
        const bool has_next = S.next(ui + 1, nxt);
        const char* nA = uni_ptr(has_next && !Epi::GATHER ? (const char*)g.A + (size_t)nxt.pm * tstep : cA); const char* nB = uni_ptr(has_next ? (const char*)g.Bt + (size_t)nxt.pb * tstep : cB);
        if constexpr (Epi::GATHER) { if (has_next && wid < 4) { const char* _src = uni_ptr(E.rowtok + (size_t)nxt.pm * BM + wid * 64); unsigned _keep;
            asm volatile("s_mov_b32 %0, m0\n\ts_mov_b32 m0, %3\n\ts_nop 0\n\tglobal_load_lds_dword %1, %2\n\ts_mov_b32 m0, %0" : "=&s"(_keep) : "v"(lane_id() * 4), "s"(_src), "s"(ldsb - ldsw + (unsigned)(STAGE_BYTES + 4096) + (unsigned)wid * 256u) : "memory"); } }
#ifdef PROBE_GEMM
        unsigned long long pt0 = 0; if (var && PROBE_GEMM == 1) pt0 = __builtin_amdgcn_s_memrealtime();
#endif
        for (int t = 0; t < nt; t += 2) {
            const bool last = (t == nt - 2);
            const char* a1 = cA + (size_t)(t + 1) * kstep;
            const char* a2 = last ? nA : cA + (size_t)(t + 2) * kstep; const char* b2 = last ? nB : cB + (size_t)(t + 2) * kstep;
            const char* a3 = a2 + kstep; const char* b3 = b2 + kstep;
            if constexpr (Epi::MIDT >= 0) { if (t == Epi::MIDT) E.mid(acc, cur, wr, fr); }
            PG8_LDB(B0, 0, 0); PG8_LDB(B1, 0, 1); PG8_SCHED; PG8_LDA(At, 0, 0); PG8_STAGE_A(1, 1, a1);
            PG8_WAIT_V(8); PG8_WAIT_L(0); PG8_BAR; PG8_MMA(0, 0, At, B0); PG8_MMA(0, 1, At, B1); PG8_BAR; PG8_SCHED;
            if constexpr (Epi::GATHER) { if (last && has_next) {
                const PG8_LAS int* tk = (const PG8_LAS int*)(lds + STAGE_BYTES + 4096) + (wid >> 1) * 16 + (lane_id() >> 2);
                const int t00 = tk[0], t01 = tk[64], t10 = tk[128], t11 = tk[192]; voffA[0] = (unsigned)t00 | ((unsigned)t10 << 16); voffA[1] = (unsigned)t01 | ((unsigned)t11 << 16); } }
            PG8_LDA(At, 0, 1); PG8_STAGE(PG8_SB(0, 0), b2, voffB); PG8_STAGE(PG8_SB(0, 1), b2 + hstep, voffB); PG8_STAGE_A(0, 0, a2);
            PG8_WAIT_V(8); PG8_WAIT_L(0); PG8_BAR; PG8_MMA(1, 0, At, B0); PG8_MMA(1, 1, At, B1); PG8_BAR; PG8_SCHED;
            PG8_LDB(B0, 1, 0); PG8_LDB(B1, 1, 1); PG8_SCHED; PG8_LDA(At, 1, 0); PG8_STAGE_A(0, 1, a2);
            PG8_WAIT_V(8); PG8_WAIT_L(0); PG8_BAR; PG8_MMA(0, 0, At, B0); PG8_MMA(0, 1, At, B1); PG8_BAR; PG8_SCHED;
            PG8_LDA(At, 1, 1); PG8_STAGE(PG8_SB(1, 0), b3, voffB); PG8_STAGE(PG8_SB(1, 1), b3 + hstep, voffB); PG8_STAGE_A(1, 0, a3);
            PG8_WAIT_V(8); PG8_WAIT_L(0); PG8_BAR; PG8_MMA(1, 0, At, B0); PG8_MMA(1, 1, At, B1); PG8_BAR; PG8_SCHED;
        }
#ifdef PROBE_GEMM
        if (var && PROBE_GEMM == 1) p_acc += __builtin_amdgcn_s_memrealtime() - pt0;
        if (var && PROBE_GEMM == 2) pt0 = __builtin_amdgcn_s_memrealtime();
#endif
        if (wr == 0) PG8_BAR;
        { const int l2 = lane_id(); E(acc, cur, wr, wc, l2 & 15, l2 >> 4, (const PG8_LAS float*)(lds + STAGE_BYTES + (ui & 1) * 2048)); }
#ifdef PROBE_GEMM
        if (var && PROBE_GEMM == 2) p_acc += __builtin_amdgcn_s_memrealtime() - pt0;
        if (var && PROBE_GEMM == 3) p_acc += 1000;
#endif
        if (!has_next) break;
#pragma unroll
        for (int a = 0; a < 2; ++a)
#pragma unroll
            for (int b = 0; b < 2; ++b)
#pragma unroll
                for (int m = 0; m < 4; ++m)
#pragma unroll
                    for (int n = 0; n < 2; ++n) acc[a][b][m][n] = (f32x4){0.f, 0.f, 0.f, 0.f};
        cur = nxt; cA = nA; cB = nB; ++ui;
        PG8_TABS(cur, ui & 1);
        if (wr == 1) PG8_BAR;
    }
    PG8_WAIT_V(0);
    PG8_BAR;
#ifdef PROBE_GEMM
    if (var && blockIdx.x == 0 && wid == 0) probe_spin(p_acc * 16);
#endif
#undef PG8_TABS
#undef PG8_STAGE_A
#undef PG8_SA
#undef PG8_SB
#undef PG8_STAGE
#undef PG8_LDA
#undef PG8_LDB
#undef PG8_MMA
#undef PG8_WAIT_V
#undef PG8_WAIT_L
#undef PG8_BAR
#undef PG8_SCHED
}
}

constexpr int BATCH = 16, SEQ = 2048, T = BATCH * SEQ, D = 1024;
constexpr int NPROJ = 6656;
constexpr int C_Z = 0, C_XBC = 1024, C_Q = 2560, C_K = 3584, C_V = 4608, C_O = 5632;
constexpr int WIN_LD = 6688;
constexpr int NE = 32, TOPK = 4;
constexpr int NASSIGN = T * TOPK, MAXBLK = NASSIGN / 256 + NE, MAXROWS = MAXBLK * 256;
constexpr float RMS_EPS = 1e-6f;
constexpr int NWAVES = 8, NTHR = 512;

constexpr size_t MiB = 1u << 20;
constexpr size_t WS_CTL = 0, CTL_ZERO_BYTES = 1 * MiB;
constexpr size_t WS_WIN = 1 * MiB, WS_WOUT = 14 * MiB, WS_WGU = 18 * MiB, WS_WDN = 146 * MiB;
constexpr size_t WS_XN = 210 * MiB, WS_H = 274 * MiB, WS_GATES = 402 * MiB, WS_ROUTE = 406 * MiB, WS_PROJ = 412 * MiB, WS_MIX = 828 * MiB, WS_END = 956 * MiB;
constexpr size_t WS_XBC = WS_H;
constexpr size_t WS_SSQ = WS_ROUTE + 3 * MiB;
constexpr size_t WS_XG = WS_PROJ, WS_ACT = WS_PROJ + 272 * MiB;
static_assert((size_t)MAXROWS * 1024 * 2 == 272 * MiB && WS_ACT + 272 * MiB == WS_END, "overlay map");
constexpr size_t R_TOPI = 0, R_TOPG = 512 * 1024, R_TOKROW = 1024 * 1024, R_ROWTOK = 1536 * 1024, R_ROWGATE = 2176 * 1024, R_BLKCNT = 2816 * 1024, R_BLKEXP = 2880 * 1024, R_NBLK = 2944 * 1024;
constexpr int CW_BAR = 4096;

constexpr int WL_LD = 36;
constexpr int WL_BYTES = 1024 * WL_LD * 4;
constexpr int MISC_OFF = 150528, LDS_BYTES = MISC_OFF + 1024;

#define GAS __attribute__((address_space(1)))
#define LAS __attribute__((address_space(3)))
typedef unsigned short bf16;
typedef unsigned v4u __attribute__((ext_vector_type(4)));
typedef unsigned v2u __attribute__((ext_vector_type(2)));
typedef float f32x4 __attribute__((ext_vector_type(4)));
#define LDS_WAIT() asm volatile("s_waitcnt lgkmcnt(0)" ::: "memory")
__device__ __forceinline__ unsigned f2bf(float f) { return (unsigned)__builtin_bit_cast(unsigned short, (__bf16)f); }
typedef __bf16 bf2_t __attribute__((ext_vector_type(2)));
__device__ __forceinline__ unsigned pk2(float lo, float hi) { const bf2_t v = {(__bf16)lo, (__bf16)hi}; return __builtin_bit_cast(unsigned, v); }
__device__ __forceinline__ float bf2f(unsigned short b) { return __builtin_bit_cast(float, (unsigned)b << 16); }
__device__ __forceinline__ float bflo(unsigned w) { return __builtin_bit_cast(float, w << 16); }
__device__ __forceinline__ float bfhi(unsigned w) { return __builtin_bit_cast(float, w & 0xffff0000u); }
__device__ __forceinline__ float wave_sum(float v) {
#pragma unroll
    for (int o = 1; o < 64; o <<= 1) v += __shfl_xor(v, o);
    return v;
}
__device__ __forceinline__ float silu_f(float x) { return x * __builtin_amdgcn_rcpf(1.0f + __expf(-x)); }
__device__ __forceinline__ float sigmoid_f(float x) { return __builtin_amdgcn_rcpf(1.0f + __expf(-x)); }
__device__ __forceinline__ float rsqrt_f(float x) { return __builtin_amdgcn_rsqf(x); }
__device__ __forceinline__ float softplus_f(float x) { return x > 20.0f ? x : log1pf(__expf(x)); }


#define XB_TMO      128
#define XB_XCNT(j)  (256  + 64 * (j))
#define XB_XSUB(j)  (1280 + 64 * (j))
#define XB_XGEN(j)  (2304 + 64 * (j))
#define XB_TOP      3328
#define XB_TOPGEN   3392
#define XCD_BAR_WORDS 3456
#define XB_SPIN_CAP (1u << 18)
__device__ __forceinline__ unsigned xb_ld(unsigned* p)              { return __hip_atomic_load(p, __ATOMIC_RELAXED, __HIP_MEMORY_SCOPE_AGENT); }
__device__ __forceinline__ unsigned xb_add(unsigned* p, unsigned v) { return __hip_atomic_fetch_add(p, v, __ATOMIC_RELAXED, __HIP_MEMORY_SCOPE_AGENT); }
__device__ __forceinline__ unsigned xb_xcc_id() { return (unsigned)__builtin_amdgcn_s_getreg((3 << 11) | 20) & 0xFu; }
#define XB_SPIN(cond, bar) do { unsigned _sp = 0; while (cond) { __builtin_amdgcn_s_sleep(1); \
    if ((++_sp & 255u) == 0u) { if (xb_ld(&(bar)[XB_TMO])) break; if (_sp > XB_SPIN_CAP) { atomicAdd(&(bar)[XB_TMO], 1u); break; } } } } while (0)
struct XcdBarrier { unsigned* bar; unsigned x; volatile LAS unsigned* st; };
__device__ __forceinline__ XcdBarrier xcd_barrier_post(unsigned* bar, volatile LAS unsigned* st, bool t0  ) {
    XcdBarrier b; b.bar = bar; b.x = xb_xcc_id(); b.st = st;
    if (t0) (void)xb_add(&bar[XB_XCNT(b.x)], 1u);
    return b;
}
__device__ __forceinline__ void xcd_barrier_complete(unsigned* bar, unsigned x, unsigned& nloc, unsigned& nx) {
    const unsigned G = gridDim.x * gridDim.y * gridDim.z;
    unsigned sum, cnt, mine, sp = 0u;
    for (;;) {
        sum = 0u; cnt = 0u; mine = 0u;
#pragma unroll
        for (unsigned j = 0; j < 16; ++j) { const unsigned c = xb_ld(&bar[XB_XCNT(j)]); sum += c; cnt += (c > 0u) ? 1u : 0u; mine = (j == x) ? c : mine; }
        if (sum == G) break;
        __builtin_amdgcn_s_sleep(1);
        if ((++sp & 255u) == 0u) { if (xb_ld(&bar[XB_TMO])) break; if (sp > XB_SPIN_CAP) { atomicAdd(&bar[XB_TMO], 1u); break; } }
    }
    nloc = mine > 0u ? mine : 1u; nx = cnt > 0u ? cnt : 1u;
}
__device__ __forceinline__ void xcd_barrier(const XcdBarrier& b, bool t0  ) {
    asm volatile("s_waitcnt vmcnt(0)" ::: "memory");
    __syncthreads();
    if (t0) {
        unsigned* bar = b.bar;
        __builtin_amdgcn_s_waitcnt(0);
        unsigned nloc = b.st[0], nx = b.st[1];
        if (nloc == 0u) { xcd_barrier_complete(bar, b.x, nloc, nx); b.st[0] = nloc; b.st[1] = nx; }
        const unsigned old = xb_add(&bar[XB_XSUB(b.x)], 1u);
        const unsigned gen = old / nloc;
        if (old + 1u == (gen + 1u) * nloc) {
            __builtin_amdgcn_fence(__ATOMIC_RELEASE, "agent");
            asm volatile("s_waitcnt vmcnt(0)" ::: "memory");
            const unsigned og = xb_add(&bar[XB_TOP], 1u);
            const unsigned tg = og / nx;
            if (og + 1u == (tg + 1u) * nx) xb_add(&bar[XB_TOPGEN], 1u);
            else XB_SPIN(xb_ld(&bar[XB_TOPGEN]) == tg, bar);
            __builtin_amdgcn_fence(__ATOMIC_ACQUIRE, "agent");
            xb_add(&bar[XB_XGEN(b.x)], 1u);
            asm volatile("s_waitcnt vmcnt(0)" ::: "memory");
        } else {
            XB_SPIN(xb_ld(&bar[XB_XGEN(b.x)]) == gen, bar);
            __builtin_amdgcn_fence(__ATOMIC_ACQUIRE, "agent");
            asm volatile("s_waitcnt vmcnt(0)" ::: "memory");
        }
    }
    __syncthreads();
}

__device__ __forceinline__ int fresh_tid(int wave) { int t = wave * 64 + lane_id(); asm volatile("" : "+v"(t)); return t; }
struct Args { const float* in[21]; float* out; unsigned char* ws; int ph_lo, ph_hi, variant, pad; };

__device__ __forceinline__ void transpose_item(const float* W, int ld_src, int n0s, int k0, bf16* WT, int K, int n0d, float cscale, const float* kscale, LAS float* scr, int lane) {
#pragma unroll
    for (int i = 0; i < 32; ++i) { const int kk = 2 * i + (lane >> 5); float v = W[(size_t)(k0 + kk) * ld_src + n0s + (lane & 31)] * cscale; if (kscale) v *= kscale[k0 + kk]; scr[kk * 33 + (lane & 31)] = v; }
    LDS_WAIT(); asm volatile("" ::: "memory");
    const int c = lane & 7;
#pragma unroll
    for (int j = 0; j < 4; ++j) { const int n = (lane >> 3) + 8 * j; const LAS float* s = scr + (8 * c) * 33 + n;
        v4u o; o.x = pk2(s[0 * 33], s[1 * 33]); o.y = pk2(s[2 * 33], s[3 * 33]); o.z = pk2(s[4 * 33], s[5 * 33]); o.w = pk2(s[6 * 33], s[7 * 33]);
        *(v4u*)(WT + (size_t)(n0d + n) * K + k0 + 8 * c) = o; }
    LDS_WAIT(); asm volatile("" ::: "memory");
}

__device__ __forceinline__ int pk4_fp8(float a, float b, float c, float d) { int w = 0; w = __builtin_amdgcn_cvt_pk_fp8_f32(a, b, w, false); w = __builtin_amdgcn_cvt_pk_fp8_f32(c, d, w, true); return w; }
__device__ __forceinline__ void transpose_item_f8(const float* W, int ld_src, int n0s, int k0, unsigned char* WT, int K, int n0d, float cscale, const float* kscale, LAS float* scr, int lane) {
#pragma unroll
    for (int i = 0; i < 32; ++i) { const int kk = 2 * i + (lane >> 5); float v = W[(size_t)(k0 + kk) * ld_src + n0s + (lane & 31)] * cscale; if (kscale) v *= kscale[k0 + kk]; scr[kk * 33 + (lane & 31)] = v; }
    LDS_WAIT(); asm volatile("" ::: "memory");
    const int c = lane & 3;
#pragma unroll
    for (int j = 0; j < 2; ++j) { const int n = (lane >> 2) + 16 * j; const LAS float* s = scr + (16 * c) * 33 + n;
        v4u o; o.x = (unsigned)pk4_fp8(s[0 * 33], s[1 * 33], s[2 * 33], s[3 * 33]); o.y = (unsigned)pk4_fp8(s[4 * 33], s[5 * 33], s[6 * 33], s[7 * 33]);
        o.z = (unsigned)pk4_fp8(s[8 * 33], s[9 * 33], s[10 * 33], s[11 * 33]); o.w = (unsigned)pk4_fp8(s[12 * 33], s[13 * 33], s[14 * 33], s[15 * 33]);
        *(v4u*)(WT + (size_t)(n0d + n) * K + k0 + 16 * c) = o; }
    LDS_WAIT(); asm volatile("" ::: "memory");
}

__device__ __forceinline__ void transpose_item_f8_128(const float* __restrict__ W, int ld_src, int n0s, int k0, unsigned char* __restrict__ WT, int K, int n0d, float cscale, LAS float* scr, int lane) {
#pragma unroll 1
    for (int i0 = 0; i0 < 64; i0 += 32) { float v[32];
#pragma unroll
        for (int i = 0; i < 32; ++i) v[i] = W[(size_t)(k0 + 2 * (i0 + i) + (lane >> 5)) * ld_src + n0s + (lane & 31)];
#pragma unroll
        for (int i = 0; i < 32; ++i) scr[(2 * (i0 + i) + (lane >> 5)) * 33 + (lane & 31)] = v[i] * cscale; }
    LDS_WAIT(); asm volatile("" ::: "memory");
    const int c = lane & 7;
#pragma unroll
    for (int j = 0; j < 4; ++j) { const int n = (lane >> 3) + 8 * j; const LAS float* s = scr + (16 * c) * 33 + n;
        v4u o; o.x = (unsigned)pk4_fp8(s[0 * 33], s[1 * 33], s[2 * 33], s[3 * 33]); o.y = (unsigned)pk4_fp8(s[4 * 33], s[5 * 33], s[6 * 33], s[7 * 33]);
        o.z = (unsigned)pk4_fp8(s[8 * 33], s[9 * 33], s[10 * 33], s[11 * 33]); o.w = (unsigned)pk4_fp8(s[12 * 33], s[13 * 33], s[14 * 33], s[15 * 33]);
        *(v4u*)(WT + (size_t)(n0d + n) * K + k0 + 16 * c) = o; }
    LDS_WAIT(); asm volatile("" ::: "memory");
}

constexpr int PT_LD = 2064, PT_HALF = 32 * PT_LD;
typedef short s8v_t __attribute__((ext_vector_type(8)));
constexpr int PT_WN = 2 * PT_HALF;
__device__ __forceinline__ void pt_fill(LAS unsigned char* tab, const float* W, int ldw, int tid, bool gate_cols, const float* wn) {
    { const float w0 = wn[tid], w1 = wn[512 + tid]; ((LAS float*)(tab + PT_WN))[tid] = gate_cols ? 1.0f : w0; ((LAS float*)(tab + PT_WN))[512 + tid] = gate_cols ? 1.0f : w1;
      ((LAS float*)(tab + PT_WN + 4096))[tid] = w0; ((LAS float*)(tab + PT_WN + 4096))[512 + tid] = w1; }
    __syncthreads();
    const int c = tid & 31; const int sc = gate_cols ? (c < 16 ? 2560 + c : (c < 24 ? 6672 + (c - 16) : 6680 + (c - 24))) : c;
#pragma unroll 1
    for (int j0 = 0; j0 < 64; j0 += 32) { float v[32];
#pragma unroll
        for (int j = 0; j < 32; ++j) v[j] = W[(size_t)((tid >> 5) + 16 * (j0 + j)) * ldw + sc];
#pragma unroll
        for (int j = 0; j < 32; ++j) { const int k = (tid >> 5) + 16 * (j0 + j); if (gate_cols) v[j] *= ((const LAS float*)(tab + PT_WN + 4096))[k]; const unsigned h = f2bf(v[j]); const float hf = __builtin_bit_cast(float, h << 16);
            *(LAS unsigned short*)(tab + c * PT_LD + k * 2) = (unsigned short)h; *(LAS unsigned short*)(tab + PT_HALF + c * PT_LD + k * 2) = (unsigned short)f2bf(v[j] - hf); } }
}
template <bool IN_BF16, bool OUT_F8>
__device__ __forceinline__ float rowproj16(const void* __restrict__ srcv, void* __restrict__ dstv, const float* __restrict__ wn, const LAS unsigned char* tab, int row0, int lane, f32x4 (&acc)[2]) {
    const int g = lane >> 4, c16 = lane & 15;
    acc[0] = (f32x4){0.f, 0.f, 0.f, 0.f}; acc[1] = acc[0]; float ss = 0.f;
    const LAS unsigned char* tb = tab + c16 * PT_LD + g * 16;
    v4u ra[4], rb[4];
#define RP_LOAD(dstA, dstB, s_) do { if constexpr (IN_BF16) { dstA = *(const v4u*)((const bf16*)srcv + (size_t)(row0 + c16) * 1024 + 32 * (s_) + 8 * g); } \
        else { const float* p_ = (const float*)srcv + (size_t)(row0 + c16) * 1024 + 32 * (s_) + 8 * g; dstA = *(const v4u*)p_; dstB = *(const v4u*)(p_ + 4); } } while (0)
#pragma unroll
    for (int i = 0; i < 4; ++i) RP_LOAD(ra[i], rb[i], i);
#pragma unroll 1
    for (int s0 = 0; s0 < 32; s0 += 4) {
        v4u na[4], nb[4];
#pragma unroll
        for (int i = 0; i < 4; ++i) { na[i] = ra[i]; nb[i] = rb[i]; }
        if (s0 + 4 < 32) {
#pragma unroll
            for (int i = 0; i < 4; ++i) RP_LOAD(na[i], nb[i], s0 + 4 + i);
        }
        f32x4 gw0[4], gw1[4];
#pragma unroll
        for (int i = 0; i < 4; ++i) { gw0[i] = *(const LAS f32x4*)(tab + PT_WN + (32 * (s0 + i) + 8 * g) * 4); gw1[i] = *(const LAS f32x4*)(tab + PT_WN + (32 * (s0 + i) + 8 * g) * 4 + 16); }
#pragma unroll
        for (int i = 0; i < 4; ++i) { const int s = s0 + i;
        f32x4 a, b;
        if constexpr (IN_BF16) { const v4u w = ra[i]; a = (f32x4){bflo(w.x), bfhi(w.x), bflo(w.y), bfhi(w.y)}; b = (f32x4){bflo(w.z), bfhi(w.z), bflo(w.w), bfhi(w.w)}; }
        else { a = __builtin_bit_cast(f32x4, ra[i]); b = __builtin_bit_cast(f32x4, rb[i]); }
        ss += (a[0] * a[0] + a[1] * a[1]) + (a[2] * a[2] + a[3] * a[3]) + (b[0] * b[0] + b[1] * b[1]) + (b[2] * b[2] + b[3] * b[3]);
        a = a * gw0[i]; b = b * gw1[i];
        v4u hw; hw.x = pk2(a[0], a[1]); hw.y = pk2(a[2], a[3]); hw.z = pk2(b[0], b[1]); hw.w = pk2(b[2], b[3]);
        v4u lw; lw.x = pk2(a[0] - bflo(hw.x), a[1] - bfhi(hw.x)); lw.y = pk2(a[2] - bflo(hw.y), a[3] - bfhi(hw.y)); lw.z = pk2(b[0] - bflo(hw.z), b[1] - bfhi(hw.z)); lw.w = pk2(b[2] - bflo(hw.w), b[3] - bfhi(hw.w));
        if constexpr (OUT_F8) { v2u o; o.x = (unsigned)pk4_fp8(a[0], a[1], a[2], a[3]); o.y = (unsigned)pk4_fp8(b[0], b[1], b[2], b[3]); *(v2u*)((unsigned char*)dstv + (size_t)(row0 + c16) * 1024 + 32 * s + 8 * g) = o; }
        else *(v4u*)((bf16*)dstv + (size_t)(row0 + c16) * 1024 + 32 * s + 8 * g) = hw;
        const s8v_t xh = __builtin_bit_cast(s8v_t, hw), xl = __builtin_bit_cast(s8v_t, lw);
#pragma unroll
        for (int nt = 0; nt < 2; ++nt) { const s8v_t wh = *(const LAS s8v_t*)(tb + nt * 16 * PT_LD + s * 64), wl = *(const LAS s8v_t*)(tb + PT_HALF + nt * 16 * PT_LD + s * 64);
            acc[nt] = __builtin_amdgcn_mfma_f32_16x16x32_bf16(xh, wh, acc[nt], 0, 0, 0); acc[nt] = __builtin_amdgcn_mfma_f32_16x16x32_bf16(xl, wh, acc[nt], 0, 0, 0); acc[nt] = __builtin_amdgcn_mfma_f32_16x16x32_bf16(xh, wl, acc[nt], 0, 0, 0); }
        }
#pragma unroll
        for (int i = 0; i < 4; ++i) { ra[i] = na[i]; rb[i] = nb[i]; }
    }
#undef RP_LOAD
    ss += __shfl_xor(ss, 16); ss += __shfl_xor(ss, 32);
    return 1.0f / sqrtf(ss * (1.0f / 1024.0f) + RMS_EPS);
}

namespace mx {
typedef short s8v __attribute__((ext_vector_type(8)));
typedef short s4v __attribute__((ext_vector_type(4)));
#define MX_MFMA(a, b, c) __builtin_amdgcn_mfma_f32_16x16x32_bf16(a, b, c, 0, 0, 0)
#define MX_SB() __builtin_amdgcn_sched_barrier(0)
#define MX_BAR() do { MX_SB(); asm volatile("s_waitcnt lgkmcnt(0)" ::: "memory"); __builtin_amdgcn_s_barrier(); asm volatile("" ::: "memory"); } while (0)
constexpr int TS = 288, TILE = 64 * TS, PS = 144, PTILE = 64 * PS, BUF = 3 * TILE;
struct LaneBase { unsigned row, perm, tr, prow; };
__device__ __forceinline__ LaneBase lane_base(int lane) { LaneBase L; const unsigned g = lane >> 4, i = lane & 15, q = i >> 2, p = lane & 3;
    L.row = i * TS + g * 16; L.perm = i * TS + g * 8; L.tr = (8 * g + q) * TS + p * 8; L.prow = i * PS + g * 16; return L; }
#define LD_ROW(t, L, rb, s) (*(const LAS mx::s8v*)((t) + (L).row + (rb) * 16 * mx::TS + (s) * 64))
#define LD_ROWP(t, L, rb, s) (*(const LAS mx::s8v*)((t) + (L).prow + (rb) * 16 * mx::PS + (s) * 64))
__device__ __forceinline__ s8v ld_perm2(const LAS unsigned char* p) { const s4v lo = *(const LAS s4v*)p, hi = *(const LAS s4v*)(p + 32); return (s8v){lo[0], lo[1], lo[2], lo[3], hi[0], hi[1], hi[2], hi[3]}; }
#define LD_PERM(t, L, rb, s) mx::ld_perm2((t) + (L).perm + (rb) * 16 * mx::TS + (s) * 64)
__device__ __forceinline__ s8v ld_tr2(const LAS unsigned char* p) {
    const s4v a = __builtin_amdgcn_ds_read_tr16_b64_v4i16((LAS s4v*)p), b = __builtin_amdgcn_ds_read_tr16_b64_v4i16((LAS s4v*)(p + 4 * TS));
    return (s8v){a[0], a[1], a[2], a[3], b[0], b[1], b[2], b[3]}; }
#define LD_TR(t, L, c, ks) mx::ld_tr2((t) + (L).tr + (ks) * 32 * mx::TS + (c) * 32)
__device__ __forceinline__ void dma_tiles(LAS unsigned char* buf, const bf16* g0, int gstride, int co0, int co1, int co2, int wave, int lane) {
#pragma unroll
    for (int pp = 0; pp < 7; ++pp) { const int piece = wave + 8 * pp; if (piece < 54) { const unsigned o = piece * 1024 + lane * 16, tl = o / TILE, ot = o - tl * TILE, row = ot / TS, wb = ot - row * TS;
        const int co = tl == 0 ? co0 : (tl == 1 ? co1 : co2);
        __builtin_amdgcn_global_load_lds((const unsigned*)(g0 + (size_t)row * gstride + co + (wb < 256 ? wb >> 1 : 0)), (LAS unsigned*)(buf + piece * 1024), 16, 0, 0); } }
}
#define MX_DPPF(old, src, ctrl, rm) __builtin_bit_cast(float, __builtin_amdgcn_update_dpp(__builtin_bit_cast(int, (float)(old)), __builtin_bit_cast(int, (float)(src)), ctrl, rm, 0xf, false))
__device__ __forceinline__ float scan_add(float x) {
    x += MX_DPPF(0.f, x, 0x111, 0xf); x += MX_DPPF(0.f, x, 0x112, 0xf); x += MX_DPPF(0.f, x, 0x114, 0xf); x += MX_DPPF(0.f, x, 0x118, 0xf);
    x += MX_DPPF(0.f, x, 0x142, 0xa); x += MX_DPPF(0.f, x, 0x143, 0xc); return x; }
__device__ __forceinline__ float scan_max(float x) { const float ninf = -INFINITY;
    x = fmaxf(x, MX_DPPF(ninf, x, 0x111, 0xf)); x = fmaxf(x, MX_DPPF(ninf, x, 0x112, 0xf)); x = fmaxf(x, MX_DPPF(ninf, x, 0x114, 0xf)); x = fmaxf(x, MX_DPPF(ninf, x, 0x118, 0xf));
    x = fmaxf(x, MX_DPPF(ninf, x, 0x142, 0xa)); x = fmaxf(x, MX_DPPF(ninf, x, 0x143, 0xc)); return x; }
__device__ __forceinline__ float lane63(float x) { return __builtin_bit_cast(float, __builtin_amdgcn_readlane(__builtin_bit_cast(int, x), 63)); }
__device__ __forceinline__ float softplus_fast(float x) { const float e = __expf(-fabsf(x)); return fmaxf(x, 0.f) + (e < 1e-6f ? e : __logf(1.0f + e)); }
__device__ __forceinline__ s8v pack_acc(const f32x4& a, const f32x4& b) {
    const unsigned w0 = pk2(a[0], a[1]), w1 = pk2(a[2], a[3]), w2 = pk2(b[0], b[1]), w3 = pk2(b[2], b[3]);
    v4u w = {w0, w1, w2, w3}; return __builtin_bit_cast(s8v, w);
}
__device__ __forceinline__ void unpack8(const v4u& w, float (&f)[8]) { f[0] = bflo(w.x); f[1] = bfhi(w.x); f[2] = bflo(w.y); f[3] = bfhi(w.y); f[4] = bflo(w.z); f[5] = bfhi(w.z); f[6] = bflo(w.w); f[7] = bfhi(w.w); }

__device__ __forceinline__ void mlstm_item(LAS unsigned char* lds, int item, int var, int wave, const bf16* __restrict__ PROJ, const float* __restrict__ GATES, const float* __restrict__ lnw, bf16* __restrict__ MIX) {
    const int lane = lane_id(), tid = wave * 64 + lane, g = lane >> 4, c16 = lane & 15;
    const int b = item >> 3, h = item & 7;
    const LaneBase L = lane_base(lane);
    LAS unsigned char* TP = lds + 2 * BUF; LAS unsigned char* TO = TP + PTILE;
    LAS float* denP = (LAS float*)(TO + TILE); LAS float* qnp = denP + 128; LAS float* nsh = qnp + 512;
    LAS float* Au = nsh + 128; LAS float* Avv = Au + 64; LAS float* Awi = Avv + 64; LAS float* Akw = Awi + 64; LAS float* Aid = Akw + 64;
    f32x4 Cst[8];
#pragma unroll
    for (int i = 0; i < 8; ++i) Cst[i] = (f32x4){0.f, 0.f, 0.f, 0.f};
    float nreg = 0.f, m_prev = 0.f;
    if (lane < 16) nsh[wave * 16 + lane] = 0.f;
    const int srow = tid >> 3, sch = tid & 7;
    const bf16* qbase = PROJ + (size_t)(b * SEQ) * NPROJ + h * 128;
    dma_tiles(lds, qbase, NPROJ, C_Q, C_K, C_V, wave, lane);
    float fnext = GATES[(size_t)(b * SEQ + lane) * 32 + 24 + h], inext = GATES[(size_t)(b * SEQ + lane) * 32 + 16 + h];
    asm volatile("s_waitcnt vmcnt(0)" ::: "memory"); MX_BAR();
#pragma unroll 1
    for (int c = 0; c < SEQ / 64; ++c) {
        const int cur = c & 1; const int t0 = b * SEQ + c * 64;
        LAS unsigned char* TQ = lds + cur * BUF; LAS unsigned char* TK = TQ + TILE; LAS unsigned char* TV = TQ + 2 * TILE;
        float fraw = fnext, iraw = inext; asm volatile("" : "+v"(fraw), "+v"(iraw));
        MX_SB();
        const v4u ov0 = *(const v4u*)(PROJ + (size_t)(t0 + srow) * NPROJ + C_O + h * 128 + 8 * sch), ov1 = *(const v4u*)(PROJ + (size_t)(t0 + srow) * NPROJ + C_O + h * 128 + 64 + 8 * sch);
        { const int tn = (c + 1 < SEQ / 64 ? t0 + 64 : t0) + lane; fnext = GATES[(size_t)tn * 32 + 24 + h]; inext = GATES[(size_t)tn * 32 + 16 + h]; }
        const float lf = -softplus_fast(-fraw), cf = scan_add(lf), chunk_f = lane63(cf);
        const float u = iraw - cf, Mx = scan_max(u);
        const float m_row = cf + fmaxf(m_prev, Mx), vv = cf - m_row;
        const float m_loc = chunk_f + lane63(Mx), m_new = fmaxf(chunk_f + m_prev, m_loc);
        const float w_inter = __expf(vv + m_prev), floorv = __expf(-m_row), kw = __expf(chunk_f + u - m_new), s_old = __expf(chunk_f + m_prev - m_new);
        Au[lane] = u; Avv[lane] = vv; Awi[lane] = w_inter; Akw[lane] = kw;
        if (!(var & 2)) { const int lt = wave & 3, jt0 = 2 * (wave >> 2); const float vv_l = Avv[16 * lt + c16]; float rsum = 0.f;
#pragma unroll
          for (int jj = 0; jj < 2; ++jj) { const int jt = jt0 + jj; float pv[4] = {0.f, 0.f, 0.f, 0.f};
            if (jt <= lt) { f32x4 acc = {0.f, 0.f, 0.f, 0.f};
#pragma unroll
                for (int ks = 0; ks < 4; ++ks) acc = MX_MFMA(LD_ROW(TK, L, jt, ks), LD_ROW(TQ, L, lt, ks), acc);
                const f32x4 uj = *(const LAS f32x4*)(Au + 16 * jt + 4 * g);
#pragma unroll
                for (int r = 0; r < 4; ++r) { const int j = 16 * jt + 4 * g + r, l = 16 * lt + c16; const float val = (j <= l) ? acc[r] * __expf(vv_l + uj[r]) : 0.f; rsum += val; pv[r] = val; } }
            v2u w; w.x = pk2(pv[0], pv[1]); w.y = pk2(pv[2], pv[3]);
            *(LAS v2u*)(TP + (16 * lt + c16) * PS + (16 * jt + 4 * g) * 2) = w; }
          rsum += __shfl_xor(rsum, 16); rsum += __shfl_xor(rsum, 32);
          if (g == 0) denP[(wave >> 2) * 64 + 16 * lt + c16] = rsum;
          v4u q0 = *(const LAS v4u*)(TQ + lane * TS + wave * 32), q1 = *(const LAS v4u*)(TQ + lane * TS + wave * 32 + 16); float qf[16]; { float t8[8]; unpack8(q0, t8);
#pragma unroll
            for (int e = 0; e < 8; ++e) qf[e] = t8[e]; unpack8(q1, t8);
#pragma unroll
            for (int e = 0; e < 8; ++e) qf[8 + e] = t8[e]; }
          float part = 0.f;
#pragma unroll
          for (int e4 = 0; e4 < 4; ++e4) { const f32x4 nv = *(const LAS f32x4*)(nsh + wave * 16 + 4 * e4); part += qf[4 * e4] * nv[0] + qf[4 * e4 + 1] * nv[1] + qf[4 * e4 + 2] * nv[2] + qf[4 * e4 + 3] * nv[3]; }
          qnp[wave * 64 + lane] = part; }
        if (c + 1 < SEQ / 64 && !(var & 1)) { int lv = lane; asm volatile("" : "+v"(lv)); dma_tiles(lds + (cur ^ 1) * BUF, qbase + (size_t)(c + 1) * 64 * NPROJ, NPROJ, C_Q, C_K, C_V, wave, lv); }
        MX_SB();
        f32x4 acc[4];
        { s8v sf[4];
#pragma unroll
          for (int ks = 0; ks < 4; ++ks) sf[ks] = pack_acc(Cst[2 * ks], Cst[2 * ks + 1]);
#pragma unroll
          for (int lt = 0; lt < 4; ++lt) acc[lt] = (f32x4){0.f, 0.f, 0.f, 0.f};
          if (!(var & 4)) {
#pragma unroll
            for (int ks = 0; ks < 4; ++ks)
#pragma unroll
                for (int lt = 0; lt < 4; ++lt) acc[lt] = MX_MFMA(sf[ks], LD_PERM(TQ, L, lt, ks), acc[lt]);
#pragma unroll
            for (int lt = 0; lt < 4; ++lt) acc[lt] = acc[lt] * Awi[16 * lt + c16]; } }
        const s8v vf0 = LD_TR(TV + wave * 32, L, 0, 0), vf1 = LD_TR(TV + wave * 32, L, 0, 1);
        {
#pragma unroll
          for (int i = 0; i < 8; ++i) Cst[i] = Cst[i] * s_old;
          if (!(var & 8))
#pragma unroll
          for (int ks = 0; ks < 2; ++ks) { const s8v vf = ks ? vf1 : vf0; const v4u vw = __builtin_bit_cast(v4u, vf); float f[8]; unpack8(vw, f);
            { const f32x4 k0 = *(const LAS f32x4*)(Akw + 32 * ks + 8 * g), k1 = *(const LAS f32x4*)(Akw + 32 * ks + 8 * g + 4);
#pragma unroll
              for (int e = 0; e < 4; ++e) { f[e] *= k0[e]; f[4 + e] *= k1[e]; } }
            v4u pw = {pk2(f[0], f[1]), pk2(f[2], f[3]), pk2(f[4], f[5]), pk2(f[6], f[7])}; const s8v vwf = __builtin_bit_cast(s8v, pw);
#pragma unroll
            for (int dkt = 0; dkt < 8; ++dkt) Cst[dkt] = MX_MFMA(LD_TR(TK, L, dkt, ks), vwf, Cst[dkt]); }
          float part = 0.f;
#pragma unroll
          for (int e4 = 0; e4 < 4; ++e4) { const f32x4 kk = *(const LAS f32x4*)(Akw + 16 * g + 4 * e4);
#pragma unroll
            for (int e = 0; e < 4; ++e) { const int j = 16 * g + 4 * e4 + e; part += bf2f(*(const LAS unsigned short*)(TK + j * TS + (16 * wave + c16) * 2)) * kk[e]; } }
          part += __shfl_xor(part, 16); part += __shfl_xor(part, 32);
          nreg = s_old * nreg + part; if (g == 0) nsh[wave * 16 + c16] = nreg;
        }
        MX_BAR();
        float inv_den; { float qn = 0.f;
#pragma unroll
          for (int w = 0; w < 8; ++w) qn += qnp[w * 64 + lane];
          float den = denP[lane] + denP[64 + lane] + w_inter * qn; den = fmaxf(fabsf(den), floorv); inv_den = __builtin_amdgcn_rcpf(den); Aid[lane] = inv_den; }
        { if (!(var & 4))
#pragma unroll
          for (int lt = 0; lt < 4; ++lt) { f32x4 a4 = MX_MFMA(vf0, LD_ROWP(TP, L, lt, 0), acc[lt]);
            if (lt >= 2) a4 = MX_MFMA(vf1, LD_ROWP(TP, L, lt, 1), a4);
            a4 = a4 * Aid[16 * lt + c16];
            v2u w; w.x = pk2(a4[0], a4[1]); w.y = pk2(a4[2], a4[3]);
            *(LAS v2u*)(TO + (16 * lt + c16) * TS + (16 * wave + 4 * g) * 2) = w; }
          m_prev = m_new; }
        asm volatile("s_waitcnt vmcnt(0)" ::: "memory"); MX_BAR();
        if (!(var & 16)) { const v4u a = *(const LAS v4u*)(TO + srow * TS + sch * 16), bq = *(const LAS v4u*)(TO + srow * TS + sch * 16 + 128); float f[16], of[16]; { float t8[8]; unpack8(a, t8);
#pragma unroll
            for (int e = 0; e < 8; ++e) f[e] = t8[e]; unpack8(bq, t8);
#pragma unroll
            for (int e = 0; e < 8; ++e) f[8 + e] = t8[e]; unpack8(ov0, t8);
#pragma unroll
            for (int e = 0; e < 8; ++e) of[e] = t8[e]; unpack8(ov1, t8);
#pragma unroll
            for (int e = 0; e < 8; ++e) of[8 + e] = t8[e]; }
          float ss = 0.f;
#pragma unroll
          for (int e = 0; e < 16; ++e) ss += f[e] * f[e];
          ss += __shfl_xor(ss, 1); ss += __shfl_xor(ss, 2); ss += __shfl_xor(ss, 4);
          const float rs = rsqrt_f(ss * (1.0f / 128.0f) + RMS_EPS);
          float wn[16]; { const f32x4 w0 = *(const f32x4*)(lnw + h * 128 + 8 * sch), w1 = *(const f32x4*)(lnw + h * 128 + 8 * sch + 4), w2 = *(const f32x4*)(lnw + h * 128 + 64 + 8 * sch), w3 = *(const f32x4*)(lnw + h * 128 + 64 + 8 * sch + 4);
#pragma unroll
            for (int e = 0; e < 4; ++e) { wn[e] = w0[e]; wn[4 + e] = w1[e]; wn[8 + e] = w2[e]; wn[12 + e] = w3[e]; } }
#pragma unroll
          for (int e = 0; e < 16; ++e) f[e] = f[e] * rs * wn[e] * sigmoid_f(of[e]);
          v4u o0 = {pk2(f[0], f[1]), pk2(f[2], f[3]), pk2(f[4], f[5]), pk2(f[6], f[7])}, o1 = {pk2(f[8], f[9]), pk2(f[10], f[11]), pk2(f[12], f[13]), pk2(f[14], f[15])};
          bf16* mp = MIX + (size_t)(t0 + srow) * 2048 + 1024 + h * 128 + 8 * sch; *(v4u*)mp = o0; *(v4u*)(mp + 64) = o1; }
    }
    MX_BAR();
}

__device__ __forceinline__ void ssd_item(LAS unsigned char* lds, int item, int var, int wave, const bf16* __restrict__ XBC, const bf16* __restrict__ PROJ, const float* __restrict__ GATES, const float* __restrict__ a_log,
                                         const float* __restrict__ d_skip, bf16* __restrict__ MIX, float* __restrict__ SSQ) {
    const int lane = lane_id(), tid = wave * 64 + lane, g = lane >> 4, c16 = lane & 15;
    const int b = item >> 3, hp = item & 7, grp = hp >> 2, hh = wave >> 2, ps = wave & 3;
    const LaneBase L = lane_base(lane);
    LAS unsigned char* TG = lds + 2 * BUF;
    LAS unsigned char* TO = TG + 2 * PTILE;
    LAS float* Aacs = (LAS float*)(TO + TILE); LAS float* Adinv = Aacs + 128; LAS float* Adt = Adinv + 128; LAS float* Awd = Adt + 128; LAS float* Aea = Awd + 128;
    f32x4 RT[8];
#pragma unroll
    for (int i = 0; i < 8; ++i) RT[i] = (f32x4){0.f, 0.f, 0.f, 0.f};
    const float an0 = -__expf(a_log[2 * hp]), an1 = -__expf(a_log[2 * hp + 1]), dk0 = d_skip[2 * hp], dk1 = d_skip[2 * hp + 1];
    const int srow = tid >> 3, sch = tid & 7;
    const bf16* xb = XBC + (size_t)(b * SEQ) * 1536;
    dma_tiles(lds, xb, 1536, 1280 + grp * 128, 1024 + grp * 128, hp * 128, wave, lane);
    float dn0 = GATES[(size_t)(b * SEQ + lane) * 32 + 2 * hp], dn1 = GATES[(size_t)(b * SEQ + lane) * 32 + 2 * hp + 1];
    asm volatile("s_waitcnt vmcnt(0)" ::: "memory"); MX_BAR();
#pragma unroll 1
    for (int c = 0; c < SEQ / 64; ++c) {
        const int cur = c & 1; const int t0 = b * SEQ + c * 64;
        LAS unsigned char* TC = lds + cur * BUF; LAS unsigned char* TB = TC + TILE; LAS unsigned char* TX = TC + 2 * TILE;
        float dr0 = dn0, dr1 = dn1; asm volatile("" : "+v"(dr0), "+v"(dr1));
        MX_SB();
        const v4u zv0 = *(const v4u*)(PROJ + (size_t)(t0 + srow) * NPROJ + C_Z + hp * 128 + 8 * sch), zv1 = *(const v4u*)(PROJ + (size_t)(t0 + srow) * NPROJ + C_Z + hp * 128 + 64 + 8 * sch);
        { const int tn = (c + 1 < SEQ / 64 ? t0 + 64 : t0) + lane; dn0 = GATES[(size_t)tn * 32 + 2 * hp]; dn1 = GATES[(size_t)tn * 32 + 2 * hp + 1]; }
        const float dt0 = softplus_fast(dr0), dt1 = softplus_fast(dr1);
        const float acs0 = scan_add(dt0 * an0), acs1 = scan_add(dt1 * an1);
        const float aend0 = lane63(acs0), aend1 = lane63(acs1);
        Aacs[lane] = acs0; Aacs[64 + lane] = acs1; Adinv[lane] = dk0 * __builtin_amdgcn_rcpf(dt0); Adinv[64 + lane] = dk1 * __builtin_amdgcn_rcpf(dt1); Adt[lane] = dt0; Adt[64 + lane] = dt1;
        Awd[lane] = __expf(aend0 - acs0); Awd[64 + lane] = __expf(aend1 - acs1); Aea[lane] = __expf(acs0); Aea[64 + lane] = __expf(acs1);
        const float aend = hh ? aend1 : aend0;
        if (!(var & 2)) { const int lt = wave & 3, st0 = 2 * (wave >> 2); const int l = 16 * lt + c16;
          const float al0 = Aacs[l], al1 = Aacs[64 + l], di0 = Adinv[l], di1 = Adinv[64 + l];
#pragma unroll
          for (int ss = 0; ss < 2; ++ss) { const int st = st0 + ss; float p0[4] = {0.f, 0.f, 0.f, 0.f}, p1[4] = {0.f, 0.f, 0.f, 0.f};
            if (st <= lt) { f32x4 acc = {0.f, 0.f, 0.f, 0.f};
#pragma unroll
                for (int ks = 0; ks < 4; ++ks) acc = MX_MFMA(LD_ROW(TB, L, st, ks), LD_ROW(TC, L, lt, ks), acc);
                const f32x4 as0 = *(const LAS f32x4*)(Aacs + 16 * st + 4 * g), as1 = *(const LAS f32x4*)(Aacs + 64 + 16 * st + 4 * g);
#pragma unroll
                for (int r = 0; r < 4; ++r) { const int sidx = 16 * st + 4 * g + r;
                    float v0 = (sidx <= l) ? acc[r] * __expf(al0 - as0[r]) : 0.f, v1 = (sidx <= l) ? acc[r] * __expf(al1 - as1[r]) : 0.f;
                    if (sidx == l) { v0 += di0; v1 += di1; } p0[r] = v0; p1[r] = v1; } }
            v2u w0, w1; w0.x = pk2(p0[0], p0[1]); w0.y = pk2(p0[2], p0[3]); w1.x = pk2(p1[0], p1[1]); w1.y = pk2(p1[2], p1[3]);
            const unsigned o = l * PS + (16 * st + 4 * g) * 2;
            *(LAS v2u*)(TG + o) = w0; *(LAS v2u*)(TG + PTILE + o) = w1; } }
        if (c + 1 < SEQ / 64 && !(var & 1)) { int lv = lane; asm volatile("" : "+v"(lv)); dma_tiles(lds + (cur ^ 1) * BUF, xb + (size_t)(c + 1) * 64 * 1536, 1536, 1280 + grp * 128, 1024 + grp * 128, hp * 128, wave, lv); }
        MX_SB();
        f32x4 acc[4];
        { s8v sf[4];
#pragma unroll
          for (int ks = 0; ks < 4; ++ks) sf[ks] = pack_acc(RT[2 * ks], RT[2 * ks + 1]);
#pragma unroll
          for (int lt = 0; lt < 4; ++lt) acc[lt] = (f32x4){0.f, 0.f, 0.f, 0.f};
          if (!(var & 4)) {
#pragma unroll
            for (int ks = 0; ks < 4; ++ks)
#pragma unroll
                for (int lt = 0; lt < 4; ++lt) acc[lt] = MX_MFMA(sf[ks], LD_PERM(TC, L, lt, ks), acc[lt]);
#pragma unroll
            for (int lt = 0; lt < 4; ++lt) acc[lt] = acc[lt] * Aea[64 * hh + 16 * lt + c16]; } }
          s8v xd[2], xw[2];
#pragma unroll
          for (int ks = 0; ks < 2; ++ks) { const s8v xf = LD_TR(TX + (4 * hh + ps) * 32, L, 0, ks); const v4u xv = __builtin_bit_cast(v4u, xf); float f[8], fw[8]; unpack8(xv, f);
            { const LAS float* pd = Adt + 64 * hh + 32 * ks + 8 * g; const LAS float* pw = Awd + 64 * hh + 32 * ks + 8 * g; const f32x4 d0 = *(const LAS f32x4*)pd, d1 = *(const LAS f32x4*)(pd + 4), w0 = *(const LAS f32x4*)pw, w1 = *(const LAS f32x4*)(pw + 4);
#pragma unroll
              for (int e = 0; e < 4; ++e) { f[e] *= d0[e]; fw[e] = f[e] * w0[e]; f[4 + e] *= d1[e]; fw[4 + e] = f[4 + e] * w1[e]; } }
            v4u a = {pk2(f[0], f[1]), pk2(f[2], f[3]), pk2(f[4], f[5]), pk2(f[6], f[7])}, bw = {pk2(fw[0], fw[1]), pk2(fw[2], fw[3]), pk2(fw[4], fw[5]), pk2(fw[6], fw[7])};
            xd[ks] = __builtin_bit_cast(s8v, a); xw[ks] = __builtin_bit_cast(s8v, bw); }
        {
          const float ea = __expf(aend);
#pragma unroll
          for (int i = 0; i < 8; ++i) RT[i] = RT[i] * ea;
          if (!(var & 8))
#pragma unroll
          for (int ks = 0; ks < 2; ++ks)
#pragma unroll
            for (int nt = 0; nt < 8; ++nt) RT[nt] = MX_MFMA(LD_TR(TB, L, nt, ks), xw[ks], RT[nt]);
        }
        MX_BAR();
        {
          const LAS unsigned char* TGm = TG + hh * PTILE;
          if (!(var & 4))
#pragma unroll
          for (int lt = 0; lt < 4; ++lt) { f32x4 a4 = MX_MFMA(xd[0], LD_ROWP(TGm, L, lt, 0), acc[lt]);
            if (lt >= 2) a4 = MX_MFMA(xd[1], LD_ROWP(TGm, L, lt, 1), a4);
            v2u w; w.x = pk2(a4[0], a4[1]); w.y = pk2(a4[2], a4[3]);
            *(LAS v2u*)(TO + (16 * lt + c16) * TS + (64 * hh + 16 * ps + 4 * g) * 2) = w; }
        }
        asm volatile("s_waitcnt vmcnt(0)" ::: "memory"); MX_BAR();
        if (!(var & 16)) { const v4u a = *(const LAS v4u*)(TO + srow * TS + sch * 16), bq = *(const LAS v4u*)(TO + srow * TS + sch * 16 + 128); float f[16], zf[16]; { float t8[8]; unpack8(a, t8);
#pragma unroll
            for (int e = 0; e < 8; ++e) f[e] = t8[e]; unpack8(bq, t8);
#pragma unroll
            for (int e = 0; e < 8; ++e) f[8 + e] = t8[e]; unpack8(zv0, t8);
#pragma unroll
            for (int e = 0; e < 8; ++e) zf[e] = t8[e]; unpack8(zv1, t8);
#pragma unroll
            for (int e = 0; e < 8; ++e) zf[8 + e] = t8[e]; }
          float ss = 0.f;
#pragma unroll
          for (int e = 0; e < 16; ++e) { f[e] = f[e] * silu_f(zf[e]); ss += f[e] * f[e]; }
          ss += __shfl_xor(ss, 1); ss += __shfl_xor(ss, 2); ss += __shfl_xor(ss, 4);
          if (sch == 0) SSQ[(size_t)(t0 + srow) * 8 + hp] = ss;
          v4u o0 = {pk2(f[0], f[1]), pk2(f[2], f[3]), pk2(f[4], f[5]), pk2(f[6], f[7])}, o1 = {pk2(f[8], f[9]), pk2(f[10], f[11]), pk2(f[12], f[13]), pk2(f[14], f[15])};
          bf16* mp = MIX + (size_t)(t0 + srow) * 2048 + hp * 128 + 8 * sch; *(v4u*)mp = o0; *(v4u*)(mp + 64) = o1; }
    }
    MX_BAR();
}
}

__global__ void __launch_bounds__(NTHR, 2) mega(Args args) {
    extern __shared__ __attribute__((aligned(16))) unsigned char lds_raw[];
    LAS unsigned char* lds = (LAS unsigned char*)lds_raw;
    const int wave = __builtin_amdgcn_readfirstlane((int)threadIdx.x >> 6);
    const int lane = lane_id(), tid = wave * 64 + lane;
    const int G = gridDim.x, bx = blockIdx.x;
    unsigned char* ws = args.ws;
#define INP(k) ({ int _k = (k); asm volatile("" : "+s"(_k)); args.in[_k]; })
#define XIN INP(0)
#define Win_t ((bf16*)(ws + WS_WIN))
#define Wout_t ((bf16*)(ws + WS_WOUT))
#define XN ((bf16*)(ws + WS_XN))
#define H ((bf16*)(ws + WS_H))
#define GATES ((float*)(ws + WS_GATES))
#define PROJ ((bf16*)(ws + WS_PROJ))
#define MIX ((bf16*)(ws + WS_MIX))
#define EO8 (ws + WS_XG + 136 * MiB)
#define TOPI ((int*)(ws + WS_ROUTE + R_TOPI))
#define TOPG ((float*)(ws + WS_ROUTE + R_TOPG))
#define TOKROW ((int*)(ws + WS_ROUTE + R_TOKROW))
#define ROWTOK ((int*)(ws + WS_ROUTE + R_ROWTOK))
#define ROWGATE ((float*)(ws + WS_ROUTE + R_ROWGATE))
#define BLKCNT ((int*)(ws + WS_ROUTE + R_BLKCNT))
#define BLKEXP ((int*)(ws + WS_ROUTE + R_BLKEXP))
#define NBLK ((int*)(ws + WS_ROUTE + R_NBLK))
#define XBC ((bf16*)(ws + WS_XBC))
#define SSQ ((float*)(ws + WS_SSQ))
#define RS1 ((float*)(ws + WS_SSQ + 1 * MiB))
#define RS2 ((float*)(ws + WS_SSQ + 1 * MiB + 128 * 1024))
#define ROWRS ((float*)(ws + WS_SSQ + 1 * MiB + 256 * 1024))
#define XN8 (ws + WS_XN)
#define XG8 (ws + WS_XG)
#define ACT8 (ws + WS_ACT)
#define Wgu8 (ws + WS_WGU)
#define Wdn8 (ws + WS_WDN)
    const int lo = args.ph_lo, hi = args.ph_hi;
    if (tid < 64) ((LAS unsigned*)(lds + MISC_OFF))[tid] = 0u;
    __syncthreads();
    XcdBarrier bar = xcd_barrier_post((unsigned*)(ws + WS_CTL) + CW_BAR, (volatile LAS unsigned*)(lds + MISC_OFF), tid == 0);
#define GRID_BAR(k) do { if (IN(k) && IN((k) + 1)) xcd_barrier(bar, wave == 0 && lane_id() == 0); } while (0)
#ifndef PH_MASK
#define PH_MASK 0xffff
#endif
#define IN(k) (((PH_MASK >> (k)) & 1) && lo <= (k) && (k) < hi)


    if (IN(0)) {
        const int tid = fresh_tid(wave), lane = tid & 63; (void)lane;
        LAS float* scr = (LAS float*)(lds + wave * 17408);
        const int gw = bx * NWAVES + wave, NGW = G * NWAVES;
        constexpr int I_IN = 16 * (NPROJ / 32), I_OUT = 32 * 32, I_GU = 8 * 64, I_DN = 8 * 32;
        constexpr int NITEMS = I_IN + I_OUT + NE * I_GU + NE * I_DN;
        if (!(args.variant & 32))
        for (int it = gw; it < NITEMS; it += NGW) {
            int r = it;
            if (r < I_IN) { const int nb = r % (NPROJ / 32), kb = r / (NPROJ / 32), n0 = nb * 32; const int n0s = n0 + (n0 >= C_Q ? 16 : 0);
                const float cs = (n0 >= C_K && n0 < C_V) ? 0.08838834764831845f : 1.0f;
                transpose_item(INP(2), WIN_LD, n0s, kb * 64, Win_t, 1024, n0, cs, INP(1), scr, lane); continue; } r -= I_IN;
            if (r < I_OUT) { const int nb = r % 32, kb = r / 32; transpose_item(INP(12), 1024, nb * 32, kb * 64, Wout_t, 2048, nb * 32, 1.0f, kb < 16 ? INP(8) : nullptr, scr, lane); continue; } r -= I_OUT;
            if (r < NE * I_GU) { const int e = r / I_GU, q = r % I_GU, nb = q % 64, kb = q / 64, rho = nb * 32; const int n0s = ((rho >> 7) & 1) * 1024 + (rho >> 8) * 128 + (rho & 127);
                transpose_item_f8_128(INP(16) + (size_t)e * 1024 * 2048, 2048, n0s, kb * 128, Wgu8 + (size_t)e * 2048 * 1024, 1024, rho, 64.0f, scr, lane); continue; } r -= NE * I_GU;
            { const int e = r / I_DN, q = r % I_DN, nb = q % 32, kb = q / 32;
                transpose_item_f8_128(INP(18) + (size_t)e * 1024 * 1024, 1024, nb * 32, kb * 128, Wdn8 + (size_t)e * 1024 * 1024, 1024, nb * 32, 64.0f, scr, lane); }
        }
        __syncthreads();
        pt_fill(lds, INP(2), WIN_LD, tid, true, INP(1));
        __syncthreads();
        { const int c16 = lane & 15, g = lane >> 4;
          const float* wnp = INP(1); const float* bi_ = INP(9); const float* bf_ = INP(10); const float gb0 = INP(5)[c16], gb1 = *(c16 < 8 ? bi_ + c16 : bf_ + (c16 - 8));
          if (!(args.variant & 64))
#pragma unroll 1
          for (int task = gw; task < T / 16; task += NGW) { const int row0 = task * 16; f32x4 acc[2];
            const float rs = rowproj16<false, false>(XIN, XN, wnp, lds, row0, lane, acc);
            if (g == 0) RS1[row0 + c16] = rs;
#pragma unroll
            for (int r = 0; r < 4; ++r) { const float rr = __shfl(rs, 4 * g + r); float* gp = GATES + (size_t)(row0 + 4 * g + r) * 32; gp[c16] = rr * acc[0][r] + gb0; gp[16 + c16] = rr * acc[1][r] + gb1; } } }
        __syncthreads();
    }
    GRID_BAR(0);

    if (IN(1)) {
        pg8::Gemm g{XN, Win_t, T, NPROJ, 1024}; pg8::StaticOrder S; S.init(T, NPROJ, G, bx);
        pg8::EpiBf16 E{PROJ, NPROJ, RS1};
        pg8::gemm_phase<pg8::EpiBf16, pg8::StaticOrder>(lds, g, S, E, wave);
    }
    GRID_BAR(1);

    if (IN(2)) {
        const int tid = fresh_tid(wave), lane = tid & 63; (void)lane;
        const float* cw = INP(3); const float* cb = INP(4);
#pragma unroll 1
        for (int it = bx * NTHR + tid; it < (T / 16) * 192; it += G * NTHR) {
            const int ch = it % 192, t0 = (it / 192) * 16, c0 = ch * 8;
            float w[4][8], bs[8], r0[8], r1[8], r2[8];
#pragma unroll
            for (int k = 0; k < 4; ++k) { const f32x4 a = *(const f32x4*)(cw + k * 1536 + c0), b2 = *(const f32x4*)(cw + k * 1536 + c0 + 4);
#pragma unroll
                for (int e = 0; e < 4; ++e) { w[k][e] = a[e]; w[k][4 + e] = b2[e]; } }
            { const f32x4 a = *(const f32x4*)(cb + c0), b2 = *(const f32x4*)(cb + c0 + 4);
#pragma unroll
              for (int e = 0; e < 4; ++e) { bs[e] = a[e]; bs[4 + e] = b2[e]; } }
            const bf16* src = PROJ + (size_t)t0 * NPROJ + C_XBC + c0;
            if ((t0 & (SEQ - 1)) == 0) {
#pragma unroll
                for (int e = 0; e < 8; ++e) { r0[e] = 0.f; r1[e] = 0.f; r2[e] = 0.f; }
            } else { mx::unpack8(*(const v4u*)(src - 3 * (size_t)NPROJ), r0); mx::unpack8(*(const v4u*)(src - 2 * (size_t)NPROJ), r1); mx::unpack8(*(const v4u*)(src - (size_t)NPROJ), r2); }
            v4u raw[16];
#pragma unroll
            for (int i = 0; i < 16; ++i) raw[i] = *(const v4u*)(src + (size_t)i * NPROJ);
#pragma unroll
            for (int i = 0; i < 16; ++i) { float cu[8], o[8]; mx::unpack8(raw[i], cu);
#pragma unroll
                for (int e = 0; e < 8; ++e) { o[e] = silu_f(bs[e] + w[0][e] * r0[e] + w[1][e] * r1[e] + w[2][e] * r2[e] + w[3][e] * cu[e]); r0[e] = r1[e]; r1[e] = r2[e]; r2[e] = cu[e]; }
                v4u ov = {pk2(o[0], o[1]), pk2(o[2], o[3]), pk2(o[4], o[5]), pk2(o[6], o[7])};
                *(v4u*)(XBC + (size_t)(t0 + i) * 1536 + c0) = ov; }
        }
    }
    GRID_BAR(2);

    if (IN(3)) {
#pragma unroll 1
        for (int it = bx; it < 256; it += G) if ((it >> 3) & 1) mx::mlstm_item(lds, ((it >> 4) << 3) | (it & 7), args.variant, wave, PROJ, GATES, INP(11), MIX);
#pragma unroll 1
        for (int it = bx; it < 256; it += G) if (!((it >> 3) & 1)) mx::ssd_item(lds, ((it >> 4) << 3) | (it & 7), args.variant, wave, XBC, PROJ, GATES, INP(6), INP(7), MIX, SSQ);
    }
    GRID_BAR(3);
    if (IN(4)) {
        pg8::Gemm g{MIX, Wout_t, T, 1024, 2048}; pg8::StaticOrder S; S.init(T, 1024, G, bx);
        pg8::EpiResF32 E{XN, H, 1024, SSQ};
        pg8::gemm_phase<pg8::EpiResF32, pg8::StaticOrder>(lds, g, S, E, wave);
    }

    GRID_BAR(4);
    if (IN(5)) {
        const int tid = fresh_tid(wave), lane = tid & 63; (void)lane;
        LAS int* hist = (LAS int*)(lds + MISC_OFF + 256);
        pt_fill(lds, INP(14), 32, tid, false, INP(13));
        if (tid < 32) hist[tid] = 0;
        __syncthreads();
        const int c16 = lane & 15, g = lane >> 4; const float* wnp = INP(13); const float rb0 = INP(15)[c16], rb1 = INP(15)[16 + c16];
        for (int blk = bx; blk < T / 128; blk += G) {
            const int row0 = blk * 128 + wave * 16; f32x4 acc[2];
            const float rs = rowproj16<true, true>(H, XN8, wnp, lds, row0, lane, acc);
            if (g == 0) RS2[row0 + c16] = rs;
#pragma unroll
            for (int r = 0; r < 4; ++r) { const float rr = __shfl(rs, 4 * g + r); float v0 = rr * acc[0][r] + rb0, v1 = rr * acc[1][r] + rb1; float tv[4]; int ti[4];
#pragma unroll
                for (int k = 0; k < 4; ++k) { float bv = v0 >= v1 ? v0 : v1; int bi = v0 >= v1 ? c16 : c16 + 16;
#define TK_STEP(ctrl) do { const float ov = __builtin_bit_cast(float, __builtin_amdgcn_update_dpp(0, __builtin_bit_cast(int, bv), ctrl, 0xf, 0xf, false)); const int oi = __builtin_amdgcn_update_dpp(0, bi, ctrl, 0xf, 0xf, false); \
                        if (ov > bv || (ov == bv && oi < bi)) { bv = ov; bi = oi; } } while (0)
                    TK_STEP(0xB1); TK_STEP(0x4E); TK_STEP(0x141); TK_STEP(0x140);
#undef TK_STEP
                    tv[k] = bv; ti[k] = bi; if (bi == c16) v0 = -INFINITY; if (bi == c16 + 16) v1 = -INFINITY; }
                const float e1 = __expf(tv[1] - tv[0]), e2 = __expf(tv[2] - tv[0]), e3 = __expf(tv[3] - tv[0]); const float inv = 1.0f / (1.0f + e1 + e2 + e3);
                if (c16 == 0) { const size_t o = (size_t)(row0 + 4 * g + r) * 4; TOPI[o] = ti[0]; TOPI[o + 1] = ti[1]; TOPI[o + 2] = ti[2]; TOPI[o + 3] = ti[3];
                    TOPG[o] = inv; TOPG[o + 1] = e1 * inv; TOPG[o + 2] = e2 * inv; TOPG[o + 3] = e3 * inv;
                    __hip_atomic_fetch_add(hist + ti[0], 1, __ATOMIC_RELAXED, __HIP_MEMORY_SCOPE_WORKGROUP); __hip_atomic_fetch_add(hist + ti[1], 1, __ATOMIC_RELAXED, __HIP_MEMORY_SCOPE_WORKGROUP); __hip_atomic_fetch_add(hist + ti[2], 1, __ATOMIC_RELAXED, __HIP_MEMORY_SCOPE_WORKGROUP); __hip_atomic_fetch_add(hist + ti[3], 1, __ATOMIC_RELAXED, __HIP_MEMORY_SCOPE_WORKGROUP); } }
            __syncthreads();
            if (tid < 32) { BLKCNT[blk * 32 + tid] = hist[tid]; hist[tid] = 0; }
            __syncthreads();
        }
    }
    GRID_BAR(5);
    if (IN(6)) {
        const int tid = fresh_tid(wave), lane = tid & 63; (void)lane;
        LAS int* tot = (LAS int*)lds; LAS int* base = tot + 32; LAS int* pstart = base + 32; LAS int* wcnt = pstart + 33;
        LAS int* arow = wcnt + 256;
        LAS int* psum = arow + 512;
        for (int blk = bx; blk < T / 128; blk += G) {
            { const int e = tid & 31, part = tid >> 5; int v[16], t = 0, b = 0;
#pragma unroll
              for (int j = 0; j < 16; ++j) v[j] = BLKCNT[(part * 16 + j) * 32 + e];
#pragma unroll
              for (int j = 0; j < 16; ++j) { t += v[j]; if (part * 16 + j < blk) b += v[j]; }
              psum[part * 32 + e] = t; psum[512 + part * 32 + e] = b; }
            __syncthreads();
            if (tid < 32) { int t = 0, b = 0;
#pragma unroll
              for (int p = 0; p < 16; ++p) { t += psum[p * 32 + tid]; b += psum[512 + p * 32 + tid]; } tot[tid] = t; base[tid] = b; }
            __syncthreads();
            if (tid == 0) { int s = 0; for (int e = 0; e < 32; ++e) { pstart[e] = s; s += (tot[e] + 255) / 256 * 256; } pstart[32] = s; }
            __syncthreads();
            const int token = blk * 128 + (tid >> 2), k = tid & 3; const int e = TOPI[(size_t)token * 4 + k];
            int rank = 0;
#pragma unroll 1
            for (int ee = 0; ee < 32; ++ee) { const unsigned long long m = __ballot(e == ee); if (e == ee) rank = __popcll(m & ((1ull << lane) - 1ull)); if (lane == 0) wcnt[wave * 32 + ee] = __popcll(m); }
            __syncthreads();
            int off = 0; for (int w = 0; w < wave; ++w) off += wcnt[w * 32 + e];
            const int row = pstart[e] + base[e] + off + rank;
            ROWTOK[row] = token; ROWGATE[row] = TOPG[(size_t)token * 4 + k]; ROWRS[row] = RS2[token]; TOKROW[(size_t)token * 4 + k] = row; arow[tid] = row;
            __syncthreads();
            if (blk < 32) { const int ps = pstart[blk] + tot[blk], pe = pstart[blk + 1];
                for (int r = ps + tid; r < pe; r += NTHR) { ROWTOK[r] = 0; ROWGATE[r] = 0.f; ROWRS[r] = 0.f; } }
            if (blk == 0) { const int nb = pstart[32] / 256; if (tid == 0) NBLK[0] = nb;
                for (int b = tid; b < nb; b += NTHR) { int e2 = 0; while (e2 < 31 && b * 256 >= pstart[e2 + 1]) ++e2; BLKEXP[b] = e2; } }
            __syncthreads();
        }
    }

    GRID_BAR(6);
    if (IN(7)) {
        pg8::Gemm g{(const bf16*)XN8, (const bf16*)Wgu8, MAXROWS, 2048, 512}; pg8::MoeOrder S{BLKEXP, __builtin_amdgcn_readfirstlane(NBLK[0]), 8, G, bx};
        pg8::EpiSwiglu E{ROWTOK, ACT8, INP(17), ROWRS};
        pg8::gemm_phase_f8<pg8::EpiSwiglu, pg8::MoeOrder>(lds, g, S, E, wave, args.variant);
    }
    GRID_BAR(7);
    if (IN(8)) {
        pg8::Gemm g{(const bf16*)ACT8, (const bf16*)Wdn8, MAXROWS, 1024, 512}; pg8::MoeOrder S{BLKEXP, __builtin_amdgcn_readfirstlane(NBLK[0]), 4, G, bx};
        pg8::EpiDown E{nullptr, EO8, INP(19), ROWGATE};
        pg8::gemm_phase_f8<pg8::EpiDown, pg8::MoeOrder>(lds, g, S, E, wave);
    }
    GRID_BAR(8);
    if (IN(9)) {
        const int tid = fresh_tid(wave), lane = tid & 63; (void)lane;
        const int gw = bx * NWAVES + wave, NGW = G * NWAVES;
        f32x4 wf[4];
#pragma unroll
        for (int j = 0; j < 4; ++j) wf[j] = *(const f32x4*)(INP(20) + 4 * lane + 256 * j);
#pragma unroll 1
        for (int row = gw; row < T; row += 2 * NGW) {
            int er[2][4];
#pragma unroll
            for (int q = 0; q < 2; ++q) { const typeof(*(const v4u*)0) t4 = *(const v4u*)(TOKROW + (size_t)(row + q * NGW) * 4); er[q][0] = (int)t4.x; er[q][1] = (int)t4.y; er[q][2] = (int)t4.z; er[q][3] = (int)t4.w; }
            v2u hw[2][4]; int ew[2][4][4];
#pragma unroll
            for (int q = 0; q < 2; ++q)
#pragma unroll
                for (int j = 0; j < 4; ++j) hw[q][j] = *(const v2u*)(H + (size_t)(row + q * NGW) * 1024 + 4 * lane + 256 * j);
#pragma unroll
            for (int q = 0; q < 2; ++q)
#pragma unroll
                for (int k = 0; k < 4; ++k)
#pragma unroll
                    for (int j = 0; j < 4; ++j) ew[q][k][j] = *(const int*)(EO8 + (size_t)er[q][k] * 1024 + 4 * lane + 256 * j);
#pragma unroll
            for (int q = 0; q < 2; ++q) { f32x4 v[4], ya[4]; typedef float f2v __attribute__((ext_vector_type(2)));
#pragma unroll
                for (int j = 0; j < 4; ++j) { v[j] = (f32x4){bflo(hw[q][j].x), bfhi(hw[q][j].x), bflo(hw[q][j].y), bfhi(hw[q][j].y)}; ya[j] = (f32x4){0.f, 0.f, 0.f, 0.f}; }
#pragma unroll
                for (int k = 0; k < 4; ++k)
#pragma unroll
                    for (int j = 0; j < 4; ++j) { const f2v lo = __builtin_amdgcn_cvt_pk_f32_fp8(ew[q][k][j], false), hi = __builtin_amdgcn_cvt_pk_f32_fp8(ew[q][k][j], true); ya[j][0] += lo[0]; ya[j][1] += lo[1]; ya[j][2] += hi[0]; ya[j][3] += hi[1]; }
                float ss = 0.f;
#pragma unroll
                for (int j = 0; j < 4; ++j) { v[j] = v[j] + ya[j] * 0.0625f; ss += (v[j][0] * v[j][0] + v[j][1] * v[j][1]) + (v[j][2] * v[j][2] + v[j][3] * v[j][3]); }
                ss = wave_sum(ss); const float rs = rsqrt_f(ss * (1.0f / 1024.0f) + RMS_EPS);
#pragma unroll
                for (int j = 0; j < 4; ++j) *(f32x4*)(args.out + (size_t)(row + q * NGW) * 1024 + 4 * lane + 256 * j) = v[j] * rs * wf[j]; }
        }
    }
#undef IN
}

extern "C" void kernel_launch(void* const* d_in, const int* in_sizes, int n_in, void* d_out, int out_size, void* d_ws, size_t ws_size, hipStream_t stream) {
    static int grid = 0;
    if (grid == 0) {
        if (n_in != 21 || in_sizes[0] != T * D || out_size != T * D || ws_size < WS_END) { fprintf(stderr, "kernel_launch: unexpected shapes/workspace (n_in %d, ws %zu, need %zu)\n", n_in, ws_size, (size_t)WS_END); grid = -1; return; }
        if (hipFuncSetAttribute((const void*)mega, hipFuncAttributeMaxDynamicSharedMemorySize, LDS_BYTES) != hipSuccess) { fprintf(stderr, "kernel_launch: hipFuncSetAttribute failed\n"); grid = -1; return; }
        int dev = 0, cus = 0, per_cu = 0;
        if (hipGetDevice(&dev) != hipSuccess || hipDeviceGetAttribute(&cus, hipDeviceAttributeMultiprocessorCount, dev) != hipSuccess) { grid = -1; return; }
        if (hipOccupancyMaxActiveBlocksPerMultiprocessor(&per_cu, (const void*)mega, NTHR, LDS_BYTES) != hipSuccess || per_cu < 1) { fprintf(stderr, "kernel_launch: occupancy query says %d blocks per CU\n", per_cu); grid = -1; return; }
        (void)hipGetLastError();
        grid = cus;
    }
    if (grid < 0) return;
    (void)hipMemsetAsync((char*)d_ws + WS_CTL + (size_t)CW_BAR * 4, 0, (size_t)XCD_BAR_WORDS * 4, stream);
    Args a{};
    for (int i = 0; i < 21; ++i) a.in[i] = (const float*)d_in[i];
    a.out = (float*)d_out; a.ws = (unsigned char*)d_ws;
    a.ph_lo = 0; a.ph_hi = 10;
    hipLaunchKernelGGL(mega, dim3(grid), dim3(NTHR), LDS_BYTES, stream, a);
#ifdef PROBE_PHASE
    a.ph_lo = PROBE_PHASE; a.ph_hi = PROBE_PHASE + 1;
#ifdef PROBE_VARIANT
    a.variant = PROBE_VARIANT;
#endif
    hipLaunchKernelGGL(mega, dim3(grid), dim3(NTHR), LDS_BYTES, stream, a);
#endif
}
```

```cpp
#define WGM_SET 2
#include <hip/hip_runtime.h>
#include <cstdio>
#include <cstdint>

__device__ __forceinline__ int lane_id() { int l; asm volatile("v_mbcnt_lo_u32_b32 %0, -1, 0\n\tv_mbcnt_hi_u32_b32 %0, -1, %0" : "=v"(l)); return l; }
__device__ __forceinline__ void probe_spin(unsigned long long ticks) { const unsigned long long t0 = __builtin_amdgcn_s_memrealtime(); while (__builtin_amdgcn_s_memrealtime() - t0 < ticks) __builtin_amdgcn_s_sleep(8); }
namespace pg8 {
#define PG8_LAS __attribute__((address_space(3)))
typedef unsigned short bf16_t;
typedef short bf16x8 __attribute__((ext_vector_type(8)));
typedef float f32x4 __attribute__((ext_vector_type(4)));
typedef unsigned u32x4 __attribute__((ext_vector_type(4)));
#ifndef WGM_SET
#define WGM_SET 8
#endif
constexpr int BM = 256, BK = 64, HALF = 128, HTB = HALF * BK * 2, STAGE_BYTES = 8 * HTB, NXCD = 8, WGM = WGM_SET;

__host__ __device__ __forceinline__ int lds_byte(int r, int c) { const int st = (r >> 4) * 2 + (c >> 5), rr = r & 15, cc = c & 31, ob = rr * 64 + cc * 2; return st * 1024 + (ob ^ (((ob >> 9) & 1) << 5)); }
__host__ __device__ __forceinline__ void stage_rc(int b, int& R, int& C) { const int st = b / 1024, sb = b % 1024, swz = sb ^ (((sb >> 9) & 1) << 5); R = (st >> 1) * 16 + swz / 64; C = (st & 1) * 32 + (swz % 64) / 2; }
__host__ __device__ __forceinline__ int perm32(int rho) { const int n = rho >> 4, i = rho & 15; return 8 * (i >> 2) + 4 * n + (i & 3); }

__device__ __forceinline__ const char* uni_ptr(const void* p) { const unsigned long long v = (unsigned long long)p; const unsigned lo = __builtin_amdgcn_readfirstlane((unsigned)v), hi = __builtin_amdgcn_readfirstlane((unsigned)(v >> 32)); return (const char*)(((unsigned long long)hi << 32) | lo); }
struct Unit { int pm, pn, pb, e; };
struct Gemm { const bf16_t* A; const bf16_t* Bt; int M, N, K; };

struct StaticOrder {
    int nM, nN, nwg, G, c;
    __host__ __device__ void init(int M, int N, int G_, int c_) { nM = M / BM; nN = N / BM; nwg = nM * nN; G = G_; c = c_; }
    __host__ __device__ bool next(int i, Unit& u) const {
        const long L = (long)i * G + c; if (L >= nwg) return false;
        int wgid = (int)L; { const int q = nwg / NXCD, r = nwg % NXCD, xcd = wgid % NXCD, off = wgid / NXCD; wgid = (xcd < r ? xcd * (q + 1) : r * (q + 1) + (xcd - r) * q) + off; }
        const int nig = WGM * nN, gid = wgid / nig, fm = gid * WGM, gsz = (nM - fm) < WGM ? (nM - fm) : WGM;
        u.pm = fm + ((wgid % nig) % gsz); u.pn = (wgid % nig) / gsz; u.pb = u.pn; u.e = 0; return true;
    }
};
struct MoeOrder {
    const int* blk_expert; int nblk, ntn, G, c;
    __device__ bool next(int i, Unit& u) const {
        const int xcd = c % NXCD, s = i * (G / NXCD) + c / NXCD;
        const int rb = (s / ntn) * NXCD + xcd; if (rb >= nblk) return false;
        u.pm = rb; u.pn = s % ntn; u.e = __builtin_amdgcn_readfirstlane(blk_expert[rb]); u.pb = u.e * ntn + u.pn; return true;
    }
};

__device__ __forceinline__ unsigned cvt_pk_bf16(float lo, float hi) { unsigned r; asm volatile("v_cvt_pk_bf16_f32 %0, %1, %2" : "=v"(r) : "v"(lo), "v"(hi)); return r; }

struct EpiBf16 {
    static constexpr bool PERM = true; static constexpr int MIDT = -1;
    __device__ __forceinline__ void mid(f32x4 (&)[2][2][4][2], const Unit&, int, int) const {}
    bf16_t* O; int ldc; const float* rs;
    static constexpr bool HAS_ROWTAB = true;
    __device__ __forceinline__ const float* rowtab(const Unit& u) const { return rs + (size_t)u.pm * BM; }
    __device__ __forceinline__ void operator()(const f32x4 (&acc)[2][2][4][2], const Unit& u, int wr, int wc, int fr, int fq, const PG8_LAS float* rt) const {
        const int row0 = u.pm * BM + wr * 64 + fr, col0 = u.pn * BM + wc * 32 + 8 * fq;
#pragma unroll
        for (int ai = 0; ai < 2; ++ai)
#pragma unroll
            for (int m = 0; m < 4; ++m) { const int row = row0 + ai * HALF + m * 16; const float rr = rt[ai * HALF + wr * 64 + m * 16 + fr]; bf16_t* rowp = O + (size_t)row * ldc + col0;
#pragma unroll
                for (int bj = 0; bj < 2; ++bj) { const f32x4 v0 = acc[ai][bj][m][0] * rr, v1 = acc[ai][bj][m][1] * rr;
                    u32x4 w; w.x = cvt_pk_bf16(v0[0], v0[1]); w.y = cvt_pk_bf16(v0[2], v0[3]); w.z = cvt_pk_bf16(v1[0], v1[1]); w.w = cvt_pk_bf16(v1[2], v1[3]);
                    *(u32x4*)(rowp + bj * HALF) = w; } }
    }
};
struct EpiResF32 {
    static constexpr bool PERM = true; static constexpr int MIDT = 16;
    const float* base; bf16_t* C; int ldc; const float* ssq;
    __device__ __forceinline__ void mid(f32x4 (&acc)[2][2][4][2], const Unit& u, int wr, int fr) const {
#pragma unroll
        for (int ai = 0; ai < 2; ++ai)
#pragma unroll
            for (int m = 0; m < 4; ++m) { const int row = u.pm * BM + ai * HALF + wr * 64 + m * 16 + fr; const f32x4 a = *(const f32x4*)(ssq + (size_t)row * 8), b = *(const f32x4*)(ssq + (size_t)row * 8 + 4);
                const float rs = 1.0f / sqrtf(((a[0] + a[1]) + (a[2] + a[3]) + (b[0] + b[1]) + (b[2] + b[3])) * (1.0f / 1024.0f) + 1e-6f);
#pragma unroll
                for (int bj = 0; bj < 2; ++bj)
#pragma unroll
                    for (int n = 0; n < 2; ++n) acc[ai][bj][m][n] = acc[ai][bj][m][n] * rs;
                asm volatile("" ::: "memory"); }
    }
    static constexpr bool HAS_ROWTAB = false;
    __device__ __forceinline__ const float* rowtab(const Unit&) const { return nullptr; }
    __device__ __forceinline__ void operator()(const f32x4 (&acc)[2][2][4][2], const Unit& u, int wr, int wc, int fr, int fq, const PG8_LAS float*) const {
        const int row0 = u.pm * BM + wr * 64 + fr, col0 = u.pn * BM + wc * 32 + 8 * fq;
#pragma unroll
        for (int ai = 0; ai < 2; ++ai)
#pragma unroll
            for (int m = 0; m < 4; ++m) { const size_t off = (size_t)(row0 + ai * HALF + m * 16) * ldc + col0;
#pragma unroll
                for (int bj = 0; bj < 2; ++bj) { const f32x4 b0 = *(const f32x4*)(base + off + bj * HALF), b1 = *(const f32x4*)(base + off + bj * HALF + 4);
                    const f32x4 v0 = acc[ai][bj][m][0] + b0, v1 = acc[ai][bj][m][1] + b1;
                    u32x4 w; w.x = cvt_pk_bf16(v0[0], v0[1]); w.y = cvt_pk_bf16(v0[2], v0[3]); w.z = cvt_pk_bf16(v1[0], v1[1]); w.w = cvt_pk_bf16(v1[2], v1[3]);
                    *(u32x4*)(C + off + bj * HALF) = w; } }
    }
};
struct EpiSwiglu {
    static constexpr bool PERM = true; static constexpr int MIDT = -1;
    __device__ __forceinline__ void mid(f32x4 (&)[2][2][4][2], const Unit&, int, int) const {}
    static constexpr bool GATHER = true; const int* rowtok;
    unsigned char* act; const float* bgu; const float* rs;
    __device__ __forceinline__ const float* rowtab(const Unit& u) const { return rs + (size_t)u.pm * BM; }
    __device__ __forceinline__ const float* coltab(const Unit& u, int q) const { return bgu + (size_t)u.e * 2048 + u.pn * HALF + (q >> 1) * 1024 + (q & 1) * 64; }
    __device__ __forceinline__ void operator()(const f32x4 (&acc)[2][2][4][2], const Unit& u, int wr, int wc, int fr, int fq, const PG8_LAS float* tab) const {
        const int row0 = u.pm * BM + wr * 64 + fr, col0 = u.pn * HALF + wc * 32 + 8 * fq;
        const PG8_LAS float* ct = tab + 256 + wc * 32 + 8 * fq;
        f32x4 bgv[2], buv[2];
#pragma unroll
        for (int n = 0; n < 2; ++n) { bgv[n] = *(const PG8_LAS f32x4*)(ct + 4 * n); buv[n] = *(const PG8_LAS f32x4*)(ct + 128 + 4 * n); }
#pragma unroll
        for (int ai = 0; ai < 2; ++ai)
#pragma unroll
            for (int m = 0; m < 4; ++m) { const int row = row0 + ai * HALF + m * 16; const float rr = tab[ai * HALF + wr * 64 + m * 16 + fr]; unsigned char* rowp = act + (size_t)row * 1024 + col0;
                float o[8];
#pragma unroll
                for (int n = 0; n < 2; ++n) { typedef float f2 __attribute__((ext_vector_type(2)));
#pragma unroll
                    for (int h = 0; h < 2; ++h) { const f2 ag = {acc[ai][0][m][n][2 * h], acc[ai][0][m][n][2 * h + 1]}, au = {acc[ai][1][m][n][2 * h], acc[ai][1][m][n][2 * h + 1]};
                        const f2 bg2 = {bgv[n][2 * h], bgv[n][2 * h + 1]}, bu2 = {buv[n][2 * h], buv[n][2 * h + 1]};
                        f2 gv = ag * rr + bg2, uv = au * rr + bu2;
                        gv.x = fminf(gv.x, 7.0f); gv.y = fminf(gv.y, 7.0f); uv.x = __builtin_amdgcn_fmed3f(uv.x, -7.0f, 7.0f); uv.y = __builtin_amdgcn_fmed3f(uv.y, -7.0f, 7.0f);
                        const f2 t = gv * (-1.702f * 1.44269504f); f2 e; e.x = __builtin_amdgcn_exp2f(t.x); e.y = __builtin_amdgcn_exp2f(t.y);
                        const f2 d = e + 1.0f; f2 r; r.x = __builtin_amdgcn_rcpf(d.x); r.y = __builtin_amdgcn_rcpf(d.y);
                        const f2 res = ((uv + 1.0f) * gv) * r; o[4 * n + 2 * h] = res.x; o[4 * n + 2 * h + 1] = res.y; } }
                int w0 = 0, w1 = 0; w0 = __builtin_amdgcn_cvt_pk_fp8_f32(o[0], o[1], w0, false); w0 = __builtin_amdgcn_cvt_pk_fp8_f32(o[2], o[3], w0, true); w1 = __builtin_amdgcn_cvt_pk_fp8_f32(o[4], o[5], w1, false); w1 = __builtin_amdgcn_cvt_pk_fp8_f32(o[6], o[7], w1, true);
                typedef int i2v __attribute__((ext_vector_type(2))); *(i2v*)rowp = (i2v){w0, w1}; }
    }
};
struct EpiDown {
    static constexpr bool PERM = true; static constexpr int MIDT = -1;
    __device__ __forceinline__ void mid(f32x4 (&)[2][2][4][2], const Unit&, int, int) const {}
    static constexpr bool GATHER = false; const int* rowtok;
    unsigned char* eo; const float* bdn; const float* row_gate;
    __device__ __forceinline__ const float* rowtab(const Unit& u) const { return row_gate + (size_t)u.pm * BM; }
    __device__ __forceinline__ const float* coltab(const Unit& u, int q) const { return bdn + (size_t)u.e * 1024 + u.pn * BM + q * 64; }
    __device__ __forceinline__ void operator()(const f32x4 (&acc)[2][2][4][2], const Unit& u, int wr, int wc, int fr, int fq, const PG8_LAS float* tab) const {
        const int row0 = u.pm * BM + wr * 64 + fr, col0 = u.pn * BM + wc * 32 + 8 * fq;
        const PG8_LAS float* ct = tab + 256 + wc * 32 + 8 * fq;
        f32x4 bv[2][2];
#pragma unroll
        for (int bj = 0; bj < 2; ++bj)
#pragma unroll
            for (int n = 0; n < 2; ++n) bv[bj][n] = *(const PG8_LAS f32x4*)(ct + bj * HALF + 4 * n);
#pragma unroll
        for (int ai = 0; ai < 2; ++ai)
#pragma unroll
            for (int m = 0; m < 4; ++m) { const int row = row0 + ai * HALF + m * 16; const float gt = tab[ai * HALF + wr * 64 + m * 16 + fr] * 16.0f; unsigned char* rowp = eo + (size_t)row * 1024 + col0;
#pragma unroll
                for (int bj = 0; bj < 2; ++bj) { f32x4 v0 = (acc[ai][bj][m][0] + bv[bj][0]) * gt, v1 = (acc[ai][bj][m][1] + bv[bj][1]) * gt;
#pragma unroll
                    for (int i = 0; i < 4; ++i) { v0[i] = __builtin_amdgcn_fmed3f(v0[i], -448.0f, 448.0f); v1[i] = __builtin_amdgcn_fmed3f(v1[i], -448.0f, 448.0f); }
                    int w0 = 0, w1 = 0; w0 = __builtin_amdgcn_cvt_pk_fp8_f32(v0[0], v0[1], w0, false); w0 = __builtin_amdgcn_cvt_pk_fp8_f32(v0[2], v0[3], w0, true); w1 = __builtin_amdgcn_cvt_pk_fp8_f32(v1[0], v1[1], w1, false); w1 = __builtin_amdgcn_cvt_pk_fp8_f32(v1[2], v1[3], w1, true);
                    typedef int i2v __attribute__((ext_vector_type(2))); *(i2v*)(rowp + bj * HALF) = (i2v){w0, w1}; } }
    }
};

typedef int v8i_t __attribute__((ext_vector_type(8)));
typedef int v4i_t __attribute__((ext_vector_type(4)));
template <class Epi, class Sched>
__device__ __forceinline__ void gemm_phase(PG8_LAS unsigned char* lds, const Gemm g, const Sched& S, const Epi& E, int wid) {
    const int lane = lane_id(), tid = wid * 64 + lane, wr = wid >> 2, wc = wid & 3, fr = lane & 15, fq = lane >> 4;
    const int K = g.K, nt = K / BK;
    unsigned voffA[2], voffB[2];
#pragma unroll
    for (int i = 0; i < 2; ++i) { int R, C; stage_rc(tid * 16 + i * 8192, R, C); const int Rb = Epi::PERM ? ((R & ~31) + perm32(R & 31)) : R;
        voffA[i] = (unsigned)(R * K + C) * 2u; voffB[i] = (unsigned)(Rb * K + C) * 2u; }
    const size_t kstep = (size_t)(BK * 2);
    const size_t hstep = (size_t)HALF * K * 2;
    const size_t tstep = 2 * hstep;
    const unsigned ldsw = (unsigned)wid * 1024u;
    const int aoff = lds_byte(wr * 64 + fr, fq * 8), boff = lds_byte(wc * 32 + fr, fq * 8);
#define PG8_SA(b, h) (((b) * 2 + (h)) * HTB)
#define PG8_SB(b, h) ((4 + (b) * 2 + (h)) * HTB)
#define PG8_STAGE(bufoff, gbase, voff) do { _Pragma("unroll") for (int _i = 0; _i < 2; ++_i) \
        __builtin_amdgcn_global_load_lds((const unsigned*)((const char*)(gbase) + (voff)[_i]), (PG8_LAS unsigned*)(lds + (bufoff) + ldsw + _i * 8192), 16, 0, 0); } while (0)
#define PG8_LDA(dst, b, h) do { _Pragma("unroll") for (int m = 0; m < 4; ++m) _Pragma("unroll") for (int k = 0; k < 2; ++k) dst[m][k] = *(const PG8_LAS bf16x8*)(lds + PG8_SA(b, h) + aoff + m * 2048 + k * 1024); } while (0)
#define PG8_LDB(dst, b, h) do { _Pragma("unroll") for (int n = 0; n < 2; ++n) _Pragma("unroll") for (int k = 0; k < 2; ++k) dst[n][k] = *(const PG8_LAS bf16x8*)(lds + PG8_SB(b, h) + boff + n * 2048 + k * 1024); } while (0)
#define PG8_MMA(ai, bj, At, Bt) do { __builtin_amdgcn_s_setprio(1); _Pragma("unroll") for (int m = 0; m < 4; ++m) _Pragma("unroll") for (int n = 0; n < 2; ++n) _Pragma("unroll") for (int k = 0; k < 2; ++k) \
        acc[ai][bj][m][n] = __builtin_amdgcn_mfma_f32_16x16x32_bf16(Bt[n][k], At[m][k], acc[ai][bj][m][n], 0, 0, 0); __builtin_amdgcn_s_setprio(0); } while (0)
#define PG8_WAIT_V(n) asm volatile("s_waitcnt vmcnt(" #n ")" ::: "memory")
#define PG8_WAIT_L(n) asm volatile("s_waitcnt lgkmcnt(" #n ")" ::: "memory")
#define PG8_BAR __builtin_amdgcn_s_barrier()
#define PG8_SCHED __builtin_amdgcn_sched_barrier(0)
    Unit cur, nxt; int ui = 0;
    if (!S.next(0, cur)) return;
    f32x4 acc[2][2][4][2];
#pragma unroll
    for (int a = 0; a < 2; ++a)
#pragma unroll
        for (int b = 0; b < 2; ++b)
#pragma unroll
            for (int m = 0; m < 4; ++m)
#pragma unroll
                for (int n = 0; n < 2; ++n) acc[a][b][m][n] = (f32x4){0.f, 0.f, 0.f, 0.f};
    bf16x8 At[4][2], B0[2][2], B1[2][2];
    const char* cA = uni_ptr((const char*)g.A + (size_t)cur.pm * tstep); const char* cB = uni_ptr((const char*)g.Bt + (size_t)cur.pb * tstep);
#define PG8_ROWTAB(u_, slot_) do { if (Epi::HAS_ROWTAB && wid < 4) __builtin_amdgcn_global_load_lds((const unsigned*)(E.rowtab(u_) + wid * 64 + lane), (PG8_LAS unsigned*)(lds + STAGE_BYTES + (slot_) * 1024 + wid * 256), 4, 0, 0); } while (0)
    PG8_ROWTAB(cur, 0);
    PG8_STAGE(PG8_SB(0, 0), cB, voffB); PG8_STAGE(PG8_SB(0, 1), cB + hstep, voffB); PG8_STAGE(PG8_SA(0, 0), cA, voffA); PG8_STAGE(PG8_SA(0, 1), cA + hstep, voffA);
    if (wr == 1) PG8_BAR;
    PG8_WAIT_V(2); PG8_BAR;
    PG8_STAGE(PG8_SB(1, 0), cB + kstep, voffB); PG8_STAGE(PG8_SA(1, 0), cA + kstep, voffA); PG8_STAGE(PG8_SB(1, 1), cB + hstep + kstep, voffB);
    PG8_WAIT_V(6); PG8_BAR;
    for (;;) {
        const bool has_next = S.next(ui + 1, nxt);
        const char* nA = uni_ptr(has_next ? (const char*)g.A + (size_t)nxt.pm * tstep : cA); const char* nB = uni_ptr(has_next ? (const char*)g.Bt + (size_t)nxt.pb * tstep : cB);
        for (int t = 0; t < nt; t += 2) {
            const bool last = (t == nt - 2);
            const char* a1 = cA + (size_t)(t + 1) * kstep;
            const char* a2 = last ? nA : cA + (size_t)(t + 2) * kstep; const char* b2 = last ? nB : cB + (size_t)(t + 2) * kstep;
            const char* a3 = a2 + kstep; const char* b3 = b2 + kstep;
            if constexpr (Epi::MIDT >= 0) { if (t == Epi::MIDT) E.mid(acc, cur, wr, fr); }
            PG8_LDB(B0, 0, 0); PG8_LDB(B1, 0, 1); PG8_SCHED; PG8_LDA(At, 0, 0); PG8_STAGE(PG8_SA(1, 1), a1 + hstep, voffA);
            PG8_WAIT_V(8); PG8_WAIT_L(0); PG8_BAR; PG8_MMA(0, 0, At, B0); PG8_MMA(0, 1, At, B1); PG8_BAR; PG8_SCHED;
            PG8_LDA(At, 0, 1); PG8_STAGE(PG8_SB(0, 0), b2, voffB); PG8_STAGE(PG8_SB(0, 1), b2 + hstep, voffB); PG8_STAGE(PG8_SA(0, 0), a2, voffA);
            PG8_WAIT_V(8); PG8_WAIT_L(0); PG8_BAR; PG8_MMA(1, 0, At, B0); PG8_MMA(1, 1, At, B1); PG8_BAR; PG8_SCHED;
            PG8_LDB(B0, 1, 0); PG8_LDB(B1, 1, 1); PG8_SCHED; PG8_LDA(At, 1, 0); PG8_STAGE(PG8_SA(0, 1), a2 + hstep, voffA);
            PG8_WAIT_V(8); PG8_WAIT_L(0); PG8_BAR; PG8_MMA(0, 0, At, B0); PG8_MMA(0, 1, At, B1); PG8_BAR; PG8_SCHED;
            PG8_LDA(At, 1, 1); PG8_STAGE(PG8_SB(1, 0), b3, voffB); PG8_STAGE(PG8_SB(1, 1), b3 + hstep, voffB); PG8_STAGE(PG8_SA(1, 0), a3, voffA);
            PG8_WAIT_V(8); PG8_WAIT_L(0); PG8_BAR; PG8_MMA(1, 0, At, B0); PG8_MMA(1, 1, At, B1); PG8_BAR; PG8_SCHED;
        }
        if (wr == 0) PG8_BAR;
        E(acc, cur, wr, wc, fr, fq, (const PG8_LAS float*)(lds + STAGE_BYTES + (ui & 1) * 1024));
        if (!has_next) break;
#pragma unroll
        for (int a = 0; a < 2; ++a)
#pragma unroll
            for (int b = 0; b < 2; ++b)
#pragma unroll
                for (int m = 0; m < 4; ++m)
#pragma unroll
                    for (int n = 0; n < 2; ++n) acc[a][b][m][n] = (f32x4){0.f, 0.f, 0.f, 0.f};
        cur = nxt; cA = nA; cB = nB; ++ui;
        PG8_ROWTAB(cur, ui & 1);
        if (wr == 1) PG8_BAR;
    }
    PG8_WAIT_V(0);
    PG8_BAR;
#undef PG8_ROWTAB
#undef PG8_SA
#undef PG8_SB
#undef PG8_STAGE
#undef PG8_LDA
#undef PG8_LDB
#undef PG8_MMA
#undef PG8_WAIT_V
#undef PG8_WAIT_L
#undef PG8_BAR
#undef PG8_SCHED
}
template <class Epi, class Sched>
__device__ __forceinline__ void gemm_phase_f8(PG8_LAS unsigned char* lds, const Gemm g, const Sched& S, const Epi& E, int wid, int var = 0) {
    const int lane = lane_id(), tid = wid * 64 + lane, wr = wid >> 2, wc = wid & 3, fr = lane & 15, fq = lane >> 4;
    int Kq = g.K; asm volatile("" : "+s"(Kq));
    const int K = Kq, nt = K / BK;
    unsigned voffA[2], voffB[2];
#pragma unroll
    for (int i = 0; i < 2; ++i) { int R, C; stage_rc(tid * 16 + i * 8192, R, C); const int Rb = Epi::PERM ? ((R & ~31) + perm32(R & 31)) : R;
        voffA[i] = (unsigned)(R * K + C) * 2u; voffB[i] = (unsigned)(Rb * K + C) * 2u; }
    const size_t kstep = (size_t)(BK * 2);
    const size_t hstep = (size_t)HALF * K * 2;
    const size_t tstep = 2 * hstep;
    const unsigned ldsw = (unsigned)wid * 1024u;
    const unsigned ldsb = (unsigned)__builtin_amdgcn_readfirstlane((int)((unsigned)(size_t)lds + ldsw));
    const int aoff = lds_byte(wr * 64 + fr, fq * 8), boff = lds_byte(wc * 32 + fr, fq * 8);
#define PG8_SA(b, h) (((b) * 2 + (h)) * HTB)
#define PG8_SB(b, h) ((4 + (b) * 2 + (h)) * HTB)
#define PG8_STAGE(bufoff, gbase, voff) do { _Pragma("unroll") for (int _i = 0; _i < 2; ++_i) { unsigned _keep; \
        asm volatile("s_mov_b32 %0, m0\n\ts_mov_b32 m0, %3\n\ts_nop 0\n\tglobal_load_lds_dwordx4 %1, %2\n\ts_mov_b32 m0, %0" : "=&s"(_keep) : "v"((voff)[_i]), "s"((const char*)(gbase)), "s"(ldsb + (unsigned)((bufoff) + _i * 8192)) : "memory"); } } while (0)
#define PG8_STAGE_A(b, h, ka) do { if constexpr (Epi::GATHER) { _Pragma("unroll") for (int _i = 0; _i < 2; ++_i) { unsigned _keep; const unsigned _vo = (((voffA[_i] >> (16 * (h))) & 0xffffu) << 10) + cbA; \
        asm volatile("s_mov_b32 %0, m0\n\ts_mov_b32 m0, %3\n\ts_nop 0\n\tglobal_load_lds_dwordx4 %1, %2\n\ts_mov_b32 m0, %0" : "=&s"(_keep) : "v"(_vo), "s"((const char*)(ka)), "s"(ldsb + (unsigned)(PG8_SA(b, h) + _i * 8192)) : "memory"); } } \
    else PG8_STAGE(PG8_SA(b, h), (ka) + (h) * hstep, voffA); } while (0)
#define PG8_LDA(dst, b, h) do { _Pragma("unroll") for (int m = 0; m < 4; ++m) { const v4i_t _lo = *(const PG8_LAS v4i_t*)(lds + PG8_SA(b, h) + aoff + m * 2048), _hi = *(const PG8_LAS v4i_t*)(lds + PG8_SA(b, h) + aoff + m * 2048 + 1024); dst[m] = __builtin_shufflevector(_lo, _hi, 0, 1, 2, 3, 4, 5, 6, 7); } } while (0)
#define PG8_LDB(dst, b, h) do { _Pragma("unroll") for (int n = 0; n < 2; ++n) { const v4i_t _lo = *(const PG8_LAS v4i_t*)(lds + PG8_SB(b, h) + boff + n * 2048), _hi = *(const PG8_LAS v4i_t*)(lds + PG8_SB(b, h) + boff + n * 2048 + 1024); dst[n] = __builtin_shufflevector(_lo, _hi, 0, 1, 2, 3, 4, 5, 6, 7); } } while (0)
#define PG8_MMA(ai, bj, At, Bt) do { __builtin_amdgcn_s_setprio(1); _Pragma("unroll") for (int m = 0; m < 4; ++m) _Pragma("unroll") for (int n = 0; n < 2; ++n) \
        acc[ai][bj][m][n] = __builtin_amdgcn_mfma_scale_f32_16x16x128_f8f6f4(Bt[n], At[m], acc[ai][bj][m][n], 0, 0, 0, 0x79797979, 0, 0x7f7f7f7f); __builtin_amdgcn_s_setprio(0); } while (0)
#define PG8_WAIT_V(n) asm volatile("s_waitcnt vmcnt(" #n ")" ::: "memory")
#define PG8_WAIT_L(n) asm volatile("s_waitcnt lgkmcnt(" #n ")" ::: "memory")
#define PG8_BAR __builtin_amdgcn_s_barrier()
#define PG8_SCHED __builtin_amdgcn_sched_barrier(0)
#ifdef PROBE_GEMM
    unsigned long long p_acc = 0;
#endif
    Unit cur, nxt; int ui = 0;
    if (!S.next(0, cur)) return;
    f32x4 acc[2][2][4][2];
#pragma unroll
    for (int a = 0; a < 2; ++a)
#pragma unroll
        for (int b = 0; b < 2; ++b)
#pragma unroll
            for (int m = 0; m < 4; ++m)
#pragma unroll
                for (int n = 0; n < 2; ++n) acc[a][b][m][n] = (f32x4){0.f, 0.f, 0.f, 0.f};
    v8i_t At[4], B0[2], B1[2];
    const char* cA = uni_ptr((const char*)g.A + (Epi::GATHER ? (size_t)0 : (size_t)cur.pm * tstep)); const char* cB = uni_ptr((const char*)g.Bt + (size_t)cur.pb * tstep);
    unsigned cbA = 0;
    if constexpr (Epi::GATHER) { int R, C; stage_rc(tid * 16, R, C); cbA = (unsigned)C * 2u; const int* rt = E.rowtok + (size_t)cur.pm * BM + R;
        const int t00 = rt[0], t01 = rt[64], t10 = rt[128], t11 = rt[192]; voffA[0] = (unsigned)t00 | ((unsigned)t10 << 16); voffA[1] = (unsigned)t01 | ((unsigned)t11 << 16); }
#define PG8_TABS(u_, slot_) do { const char* _src = uni_ptr(wid < 4 ? E.rowtab(u_) + wid * 64 : E.coltab(u_, wid - 4)); unsigned _keep; \
        asm volatile("s_mov_b32 %0, m0\n\ts_mov_b32 m0, %3\n\ts_nop 0\n\tglobal_load_lds_dword %1, %2\n\ts_mov_b32 m0, %0" : "=&s"(_keep) : "v"(lane_id() * 4), "s"(_src), "s"(ldsb - ldsw + (unsigned)(STAGE_BYTES + (slot_) * 2048) + (unsigned)wid * 256u) : "memory"); } while (0)
    PG8_TABS(cur, 0);
    PG8_STAGE(PG8_SB(0, 0), cB, voffB); PG8_STAGE(PG8_SB(0, 1), cB + hstep, voffB); PG8_STAGE_A(0, 0, cA); PG8_STAGE_A(0, 1, cA);
    if (wr == 1) PG8_BAR;
    PG8_WAIT_V(2); PG8_BAR;
    PG8_STAGE(PG8_SB(1, 0), cB + kstep, voffB); PG8_STAGE_A(1, 0, cA + kstep); PG8_STAGE(PG8_SB(1, 1), cB + hstep + kstep, voffB);
    PG8_WAIT_V(6); PG8_BAR;
    for (;;) {
        const bool has_next = S.next(ui + 1, nxt);
        const char* nA = uni_ptr(has_next && !Epi::GATHER ? (const char*)g.A + (size_t)nxt.pm * tstep : cA); const char* nB = uni_ptr(has_next ? (const char*)g.Bt + (size_t)nxt.pb * tstep : cB);
        if constexpr (Epi::GATHER) { if (has_next && wid < 4) { const char* _src = uni_ptr(E.rowtok + (size_t)nxt.pm * BM + wid * 64); unsigned _keep;
            asm volatile("s_mov_b32 %0, m0\n\ts_mov_b32 m0, %3\n\ts_nop 0\n\tglobal_load_lds_dword %1, %2\n\ts_mov_b32 m0, %0" : "=&s"(_keep) : "v"(lane_id() * 4), "s"(_src), "s"(ldsb - ldsw + (unsigned)(STAGE_BYTES + 4096) + (unsigned)wid * 256u) : "memory"); } }
#ifdef PROBE_GEMM
        unsigned long long pt0 = 0; if (var && PROBE_GEMM == 1) pt0 = __builtin_amdgcn_s_memrealtime();
#endif
        for (int t = 0; t < nt; t += 2) {
            const bool last = (t == nt - 2);
            const char* a1 = cA + (size_t)(t + 1) * kstep;
            const char* a2 = last ? nA : cA + (size_t)(t + 2) * kstep; const char* b2 = last ? nB : cB + (size_t)(t + 2) * kstep;
            const char* a3 = a2 + kstep; const char* b3 = b2 + kstep;
            if constexpr (Epi::MIDT >= 0) { if (t == Epi::MIDT) E.mid(acc, cur, wr, fr); }
            PG8_LDB(B0, 0, 0); PG8_LDB(B1, 0, 1); PG8_SCHED; PG8_LDA(At, 0, 0); PG8_STAGE_A(1, 1, a1);
            PG8_WAIT_V(8); PG8_WAIT_L(0); PG8_BAR; PG8_MMA(0, 0, At, B0); PG8_MMA(0, 1, At, B1); PG8_BAR; PG8_SCHED;
            if constexpr (Epi::GATHER) { if (last && has_next) {
                const PG8_LAS int* tk = (const PG8_LAS int*)(lds + STAGE_BYTES + 4096) + (wid >> 1) * 16 + (lane_id() >> 2);
                const int t00 = tk[0], t01 = tk[64], t10 = tk[128], t11 = tk[192]; voffA[0] = (unsigned)t00 | ((unsigned)t10 << 16); voffA[1] = (unsigned)t01 | ((unsigned)t11 << 16); } }
            PG8_LDA(At, 0, 1); PG8_STAGE(PG8_SB(0, 0), b2, voffB); PG8_STAGE(PG8_SB(0, 1), b2 + hstep, voffB); PG8_STAGE_A(0, 0, a2);
            PG8_WAIT_V(8); PG8_WAIT_L(0); PG8_BAR; PG8_MMA(1, 0, At, B0); PG8_MMA(1, 1, At, B1); PG8_BAR; PG8_SCHED;
            PG8_LDB(B0, 1, 0); PG8_LDB(B1, 1, 1); PG8_SCHED; PG8_LDA(At, 1, 0); PG8_STAGE_A(0, 1, a2);
            PG8_WAIT_V(8); PG8_WAIT_L(0); PG8_BAR; PG8_MMA(0, 0, At, B0); PG8_MMA(0, 1, At, B1); PG8_BAR; PG8_SCHED;
            PG8_LDA(At, 1, 1); PG8_STAGE(PG8_SB(1, 0), b3, voffB); PG8_STAGE(PG8_SB(1, 1), b3 + hstep, voffB); PG8_STAGE_A(1, 0, a3);
            PG8_WAIT_V(8); PG8_WAIT_L(0); PG8_BAR; PG8_MMA(1, 0, At, B0); PG8_MMA(1, 1, At, B1); PG8_BAR; PG8_SCHED;
        }
#ifdef PROBE_GEMM
        if (var && PROBE_GEMM == 1) p_acc += __builtin_amdgcn_s_memrealtime() - pt0;
        if (var && PROBE_GEMM == 2) pt0 = __builtin_amdgcn_s_memrealtime();
#endif
        if (wr == 0) PG8_BAR;
        { const int l2 = lane_id(); E(acc, cur, wr, wc, l2 & 15, l2 >> 4, (const PG8_LAS float*)(lds + STAGE_BYTES + (ui & 1) * 2048)); }
#ifdef PROBE_GEMM
        if (var && PROBE_GEMM == 2) p_acc += __builtin_amdgcn_s_memrealtime() - pt0;
        if (var && PROBE_GEMM == 3) p_acc += 1000;
#endif
        if (!has_next) break;
#pragma unroll
        for (int a = 0; a < 2; ++a)
#pragma unroll
            for (int b = 0; b < 2; ++b)
#pragma unroll
                for (int m = 0; m < 4; ++m)
#pragma unroll
                    for (int n = 0; n < 2; ++n) acc[a][b][m][n] = (f32x4){0.f, 0.f, 0.f, 0.f};
        cur = nxt; cA = nA; cB = nB; ++ui;
        PG8_TABS(cur, ui & 1);
        if (wr == 1) PG8_BAR;
    }
    PG8_WAIT_V(0);
    PG8_BAR;
#ifdef PROBE_GEMM
    if (var && blockIdx.x == 0 && wid == 0) probe_spin(p_acc * 16);
#endif
#undef PG8_TABS
#undef PG8_STAGE_A
#undef PG8_SA
#undef PG8_SB
#undef PG8_STAGE
#undef PG8_LDA
#undef PG8_LDB
#undef PG8_MMA
#undef PG8_WAIT_V
#undef PG8_WAIT_L
#undef PG8_BAR
#undef PG8_SCHED
}
}

constexpr int BATCH = 16, SEQ = 2048, T = BATCH * SEQ, D = 1024;
constexpr int NPROJ = 6656;
constexpr int C_Z = 0, C_XBC = 1024, C_Q = 2560, C_K = 3584, C_V = 4608, C_O = 5632;
constexpr int WIN_LD = 6688;
constexpr int NE = 32, TOPK = 4;
constexpr int NASSIGN = T * TOPK, MAXBLK = NASSIGN / 256 + NE, MAXROWS = MAXBLK * 256;
constexpr float RMS_EPS = 1e-6f;
constexpr int NWAVES = 8, NTHR = 512;

constexpr size_t MiB = 1u << 20;
constexpr size_t WS_CTL = 0, CTL_ZERO_BYTES = 1 * MiB;
constexpr size_t WS_WIN = 1 * MiB, WS_WOUT = 14 * MiB, WS_WGU = 18 * MiB, WS_WDN = 146 * MiB;
constexpr size_t WS_XN = 210 * MiB, WS_H = 274 * MiB, WS_GATES = 402 * MiB, WS_ROUTE = 406 * MiB, WS_PROJ = 412 * MiB, WS_MIX = 828 * MiB, WS_END = 956 * MiB;
constexpr size_t WS_XBC = WS_H;
constexpr size_t WS_SSQ = WS_ROUTE + 3 * MiB;
constexpr size_t WS_XG = WS_PROJ, WS_ACT = WS_PROJ + 272 * MiB;
static_assert((size_t)MAXROWS * 1024 * 2 == 272 * MiB && WS_ACT + 272 * MiB == WS_END, "overlay map");
constexpr size_t R_TOPI = 0, R_TOPG = 512 * 1024, R_TOKROW = 1024 * 1024, R_ROWTOK = 1536 * 1024, R_ROWGATE = 2176 * 1024, R_BLKCNT = 2816 * 1024, R_BLKEXP = 2880 * 1024, R_NBLK = 2944 * 1024;
constexpr int CW_BAR = 4096;

constexpr int WL_LD = 36;
constexpr int WL_BYTES = 1024 * WL_LD * 4;
constexpr int MISC_OFF = 150528, LDS_BYTES = MISC_OFF + 1024;

#define GAS __attribute__((address_space(1)))
#define LAS __attribute__((address_space(3)))
typedef unsigned short bf16;
typedef unsigned v4u __attribute__((ext_vector_type(4)));
typedef unsigned v2u __attribute__((ext_vector_type(2)));
typedef float f32x4 __attribute__((ext_vector_type(4)));
#define LDS_WAIT() asm volatile("s_waitcnt lgkmcnt(0)" ::: "memory")
__device__ __forceinline__ unsigned f2bf(float f) { return (unsigned)__builtin_bit_cast(unsigned short, (__bf16)f); }
typedef __bf16 bf2_t __attribute__((ext_vector_type(2)));
__device__ __forceinline__ unsigned pk2(float lo, float hi) { const bf2_t v = {(__bf16)lo, (__bf16)hi}; return __builtin_bit_cast(unsigned, v); }
__device__ __forceinline__ float bf2f(unsigned short b) { return __builtin_bit_cast(float, (unsigned)b << 16); }
__device__ __forceinline__ float bflo(unsigned w) { return __builtin_bit_cast(float, w << 16); }
__device__ __forceinline__ float bfhi(unsigned w) { return __builtin_bit_cast(float, w & 0xffff0000u); }
__device__ __forceinline__ float wave_sum(float v) {
#pragma unroll
    for (int o = 1; o < 64; o <<= 1) v += __shfl_xor(v, o);
    return v;
}
__device__ __forceinline__ float silu_f(float x) { return x * __builtin_amdgcn_rcpf(1.0f + __expf(-x)); }
__device__ __forceinline__ float sigmoid_f(float x) { return __builtin_amdgcn_rcpf(1.0f + __expf(-x)); }
__device__ __forceinline__ float rsqrt_f(float x) { return __builtin_amdgcn_rsqf(x); }
__device__ __forceinline__ float softplus_f(float x) { return x > 20.0f ? x : log1pf(__expf(x)); }


#define XB_TMO      128
#define XB_XCNT(j)  (256  + 64 * (j))
#define XB_XSUB(j)  (1280 + 64 * (j))
#define XB_XGEN(j)  (2304 + 64 * (j))
#define XB_TOP      3328
#define XB_TOPGEN   3392
#define XCD_BAR_WORDS 3456
#define XB_SPIN_CAP (1u << 18)
__device__ __forceinline__ unsigned xb_ld(unsigned* p)              { return __hip_atomic_load(p, __ATOMIC_RELAXED, __HIP_MEMORY_SCOPE_AGENT); }
__device__ __forceinline__ unsigned xb_add(unsigned* p, unsigned v) { return __hip_atomic_fetch_add(p, v, __ATOMIC_RELAXED, __HIP_MEMORY_SCOPE_AGENT); }
__device__ __forceinline__ unsigned xb_xcc_id() { return (unsigned)__builtin_amdgcn_s_getreg((3 << 11) | 20) & 0xFu; }
#define XB_SPIN(cond, bar) do { unsigned _sp = 0; while (cond) { __builtin_amdgcn_s_sleep(1); \
    if ((++_sp & 255u) == 0u) { if (xb_ld(&(bar)[XB_TMO])) break; if (_sp > XB_SPIN_CAP) { atomicAdd(&(bar)[XB_TMO], 1u); break; } } } } while (0)
struct XcdBarrier { unsigned* bar; unsigned x; volatile LAS unsigned* st; };
__device__ __forceinline__ XcdBarrier xcd_barrier_post(unsigned* bar, volatile LAS unsigned* st, bool t0  ) {
    XcdBarrier b; b.bar = bar; b.x = xb_xcc_id(); b.st = st;
    if (t0) (void)xb_add(&bar[XB_XCNT(b.x)], 1u);
    return b;
}
__device__ __forceinline__ void xcd_barrier_complete(unsigned* bar, unsigned x, unsigned& nloc, unsigned& nx) {
    const unsigned G = gridDim.x * gridDim.y * gridDim.z;
    unsigned sum, cnt, mine, sp = 0u;
    for (;;) {
        sum = 0u; cnt = 0u; mine = 0u;
#pragma unroll
        for (unsigned j = 0; j < 16; ++j) { const unsigned c = xb_ld(&bar[XB_XCNT(j)]); sum += c; cnt += (c > 0u) ? 1u : 0u; mine = (j == x) ? c : mine; }
        if (sum == G) break;
        __builtin_amdgcn_s_sleep(1);
        if ((++sp & 255u) == 0u) { if (xb_ld(&bar[XB_TMO])) break; if (sp > XB_SPIN_CAP) { atomicAdd(&bar[XB_TMO], 1u); break; } }
    }
    nloc = mine > 0u ? mine : 1u; nx = cnt > 0u ? cnt : 1u;
}
__device__ __forceinline__ void xcd_barrier(const XcdBarrier& b, bool t0  ) {
    asm volatile("s_waitcnt vmcnt(0)" ::: "memory");
    __syncthreads();
    if (t0) {
        unsigned* bar = b.bar;
        __builtin_amdgcn_s_waitcnt(0);
        unsigned nloc = b.st[0], nx = b.st[1];
        if (nloc == 0u) { xcd_barrier_complete(bar, b.x, nloc, nx); b.st[0] = nloc; b.st[1] = nx; }
        const unsigned old = xb_add(&bar[XB_XSUB(b.x)], 1u);
        const unsigned gen = old / nloc;
        if (old + 1u == (gen + 1u) * nloc) {
            __builtin_amdgcn_fence(__ATOMIC_RELEASE, "agent");
            asm volatile("s_waitcnt vmcnt(0)" ::: "memory");
            const unsigned og = xb_add(&bar[XB_TOP], 1u);
            const unsigned tg = og / nx;
            if (og + 1u == (tg + 1u) * nx) xb_add(&bar[XB_TOPGEN], 1u);
            else XB_SPIN(xb_ld(&bar[XB_TOPGEN]) == tg, bar);
            __builtin_amdgcn_fence(__ATOMIC_ACQUIRE, "agent");
            xb_add(&bar[XB_XGEN(b.x)], 1u);
            asm volatile("s_waitcnt vmcnt(0)" ::: "memory");
        } else {
            XB_SPIN(xb_ld(&bar[XB_XGEN(b.x)]) == gen, bar);
            __builtin_amdgcn_fence(__ATOMIC_ACQUIRE, "agent");
            asm volatile("s_waitcnt vmcnt(0)" ::: "memory");
        }
    }
    __syncthreads();
}

__device__ __forceinline__ int fresh_tid(int wave) { int t = wave * 64 + lane_id(); asm volatile("" : "+v"(t)); return t; }
struct Args { const float* in[21]; float* out; unsigned char* ws; int ph_lo, ph_hi, variant, pad; };

__device__ __forceinline__ void transpose_item(const float* W, int ld_src, int n0s, int k0, bf16* WT, int K, int n0d, float cscale, const float* kscale, LAS float* scr, int lane) {
#pragma unroll
    for (int i = 0; i < 32; ++i) { const int kk = 2 * i + (lane >> 5); float v = W[(size_t)(k0 + kk) * ld_src + n0s + (lane & 31)] * cscale; if (kscale) v *= kscale[k0 + kk]; scr[kk * 33 + (lane & 31)] = v; }
    LDS_WAIT(); asm volatile("" ::: "memory");
    const int c = lane & 7;
#pragma unroll
    for (int j = 0; j < 4; ++j) { const int n = (lane >> 3) + 8 * j; const LAS float* s = scr + (8 * c) * 33 + n;
        v4u o; o.x = pk2(s[0 * 33], s[1 * 33]); o.y = pk2(s[2 * 33], s[3 * 33]); o.z = pk2(s[4 * 33], s[5 * 33]); o.w = pk2(s[6 * 33], s[7 * 33]);
        *(v4u*)(WT + (size_t)(n0d + n) * K + k0 + 8 * c) = o; }
    LDS_WAIT(); asm volatile("" ::: "memory");
}

__device__ __forceinline__ int pk4_fp8(float a, float b, float c, float d) { int w = 0; w = __builtin_amdgcn_cvt_pk_fp8_f32(a, b, w, false); w = __builtin_amdgcn_cvt_pk_fp8_f32(c, d, w, true); return w; }
__device__ __forceinline__ void transpose_item_f8(const float* W, int ld_src, int n0s, int k0, unsigned char* WT, int K, int n0d, float cscale, const float* kscale, LAS float* scr, int lane) {
#pragma unroll
    for (int i = 0; i < 32; ++i) { const int kk = 2 * i + (lane >> 5); float v = W[(size_t)(k0 + kk) * ld_src + n0s + (lane & 31)] * cscale; if (kscale) v *= kscale[k0 + kk]; scr[kk * 33 + (lane & 31)] = v; }
    LDS_WAIT(); asm volatile("" ::: "memory");
    const int c = lane & 3;
#pragma unroll
    for (int j = 0; j < 2; ++j) { const int n = (lane >> 2) + 16 * j; const LAS float* s = scr + (16 * c) * 33 + n;
        v4u o; o.x = (unsigned)pk4_fp8(s[0 * 33], s[1 * 33], s[2 * 33], s[3 * 33]); o.y = (unsigned)pk4_fp8(s[4 * 33], s[5 * 33], s[6 * 33], s[7 * 33]);
        o.z = (unsigned)pk4_fp8(s[8 * 33], s[9 * 33], s[10 * 33], s[11 * 33]); o.w = (unsigned)pk4_fp8(s[12 * 33], s[13 * 33], s[14 * 33], s[15 * 33]);
        *(v4u*)(WT + (size_t)(n0d + n) * K + k0 + 16 * c) = o; }
    LDS_WAIT(); asm volatile("" ::: "memory");
}

__device__ __forceinline__ void transpose_item_f8_128(const float* __restrict__ W, int ld_src, int n0s, int k0, unsigned char* __restrict__ WT, int K, int n0d, float cscale, LAS float* scr, int lane) {
#pragma unroll 1
    for (int i0 = 0; i0 < 64; i0 += 32) { float v[32];
#pragma unroll
        for (int i = 0; i < 32; ++i) v[i] = W[(size_t)(k0 + 2 * (i0 + i) + (lane >> 5)) * ld_src + n0s + (lane & 31)];
#pragma unroll
        for (int i = 0; i < 32; ++i) scr[(2 * (i0 + i) + (lane >> 5)) * 33 + (lane & 31)] = v[i] * cscale; }
    LDS_WAIT(); asm volatile("" ::: "memory");
    const int c = lane & 7;
#pragma unroll
    for (int j = 0; j < 4; ++j) { const int n = (lane >> 3) + 8 * j; const LAS float* s = scr + (16 * c) * 33 + n;
        v4u o; o.x = (unsigned)pk4_fp8(s[0 * 33], s[1 * 33], s[2 * 33], s[3 * 33]); o.y = (unsigned)pk4_fp8(s[4 * 33], s[5 * 33], s[6 * 33], s[7 * 33]);
        o.z = (unsigned)pk4_fp8(s[8 * 33], s[9 * 33], s[10 * 33], s[11 * 33]); o.w = (unsigned)pk4_fp8(s[12 * 33], s[13 * 33], s[14 * 33], s[15 * 33]);
        *(v4u*)(WT + (size_t)(n0d + n) * K + k0 + 16 * c) = o; }
    LDS_WAIT(); asm volatile("" ::: "memory");
}

constexpr int PT_LD = 2064, PT_HALF = 32 * PT_LD;
typedef short s8v_t __attribute__((ext_vector_type(8)));
constexpr int PT_WN = 2 * PT_HALF;
__device__ __forceinline__ void pt_fill(LAS unsigned char* tab, const float* W, int ldw, int tid, bool gate_cols, const float* wn) {
    ((LAS float*)(tab + PT_WN))[tid] = wn[tid]; ((LAS float*)(tab + PT_WN))[512 + tid] = wn[512 + tid];
    const int c = tid & 31; const int sc = gate_cols ? (c < 16 ? 2560 + c : (c < 24 ? 6672 + (c - 16) : 6680 + (c - 24))) : c;
#pragma unroll 1
    for (int j0 = 0; j0 < 64; j0 += 32) { float v[32];
#pragma unroll
        for (int j = 0; j < 32; ++j) v[j] = W[(size_t)((tid >> 5) + 16 * (j0 + j)) * ldw + sc];
#pragma unroll
        for (int j = 0; j < 32; ++j) { const int k = (tid >> 5) + 16 * (j0 + j); const unsigned h = f2bf(v[j]); const float hf = __builtin_bit_cast(float, h << 16);
            *(LAS unsigned short*)(tab + c * PT_LD + k * 2) = (unsigned short)h; *(LAS unsigned short*)(tab + PT_HALF + c * PT_LD + k * 2) = (unsigned short)f2bf(v[j] - hf); } }
}
template <bool IN_BF16, bool OUT_F8>
__device__ __forceinline__ float rowproj16(const void* __restrict__ srcv, void* __restrict__ dstv, const float* __restrict__ wn, const LAS unsigned char* tab, int row0, int lane, f32x4 (&acc)[2]) {
    const int g = lane >> 4, c16 = lane & 15;
    acc[0] = (f32x4){0.f, 0.f, 0.f, 0.f}; acc[1] = acc[0]; float ss = 0.f;
    const LAS unsigned char* tb = tab + c16 * PT_LD + g * 16;
    v4u ra[4], rb[4];
#define RP_LOAD(dstA, dstB, s_) do { if constexpr (IN_BF16) { dstA = *(const v4u*)((const bf16*)srcv + (size_t)(row0 + c16) * 1024 + 32 * (s_) + 8 * g); } \
        else { const float* p_ = (const float*)srcv + (size_t)(row0 + c16) * 1024 + 32 * (s_) + 8 * g; dstA = *(const v4u*)p_; dstB = *(const v4u*)(p_ + 4); } } while (0)
#pragma unroll
    for (int i = 0; i < 4; ++i) RP_LOAD(ra[i], rb[i], i);
#pragma unroll 1
    for (int s0 = 0; s0 < 32; s0 += 4) {
        v4u na[4], nb[4];
#pragma unroll
        for (int i = 0; i < 4; ++i) { na[i] = ra[i]; nb[i] = rb[i]; }
        if (s0 + 4 < 32) {
#pragma unroll
            for (int i = 0; i < 4; ++i) RP_LOAD(na[i], nb[i], s0 + 4 + i);
        }
        f32x4 gw0[4], gw1[4];
#pragma unroll
        for (int i = 0; i < 4; ++i) { gw0[i] = *(const LAS f32x4*)(tab + PT_WN + (32 * (s0 + i) + 8 * g) * 4); gw1[i] = *(const LAS f32x4*)(tab + PT_WN + (32 * (s0 + i) + 8 * g) * 4 + 16); }
#pragma unroll
        for (int i = 0; i < 4; ++i) { const int s = s0 + i;
        f32x4 a, b;
        if constexpr (IN_BF16) { const v4u w = ra[i]; a = (f32x4){bflo(w.x), bfhi(w.x), bflo(w.y), bfhi(w.y)}; b = (f32x4){bflo(w.z), bfhi(w.z), bflo(w.w), bfhi(w.w)}; }
        else { a = __builtin_bit_cast(f32x4, ra[i]); b = __builtin_bit_cast(f32x4, rb[i]); }
        ss += (a[0] * a[0] + a[1] * a[1]) + (a[2] * a[2] + a[3] * a[3]) + (b[0] * b[0] + b[1] * b[1]) + (b[2] * b[2] + b[3] * b[3]);
        a = a * gw0[i]; b = b * gw1[i];
        v4u hw; hw.x = pk2(a[0], a[1]); hw.y = pk2(a[2], a[3]); hw.z = pk2(b[0], b[1]); hw.w = pk2(b[2], b[3]);
        v4u lw; lw.x = pk2(a[0] - bflo(hw.x), a[1] - bfhi(hw.x)); lw.y = pk2(a[2] - bflo(hw.y), a[3] - bfhi(hw.y)); lw.z = pk2(b[0] - bflo(hw.z), b[1] - bfhi(hw.z)); lw.w = pk2(b[2] - bflo(hw.w), b[3] - bfhi(hw.w));
        if constexpr (OUT_F8) { v2u o; o.x = (unsigned)pk4_fp8(a[0], a[1], a[2], a[3]); o.y = (unsigned)pk4_fp8(b[0], b[1], b[2], b[3]); *(v2u*)((unsigned char*)dstv + (size_t)(row0 + c16) * 1024 + 32 * s + 8 * g) = o; }
        else *(v4u*)((bf16*)dstv + (size_t)(row0 + c16) * 1024 + 32 * s + 8 * g) = hw;
        const s8v_t xh = __builtin_bit_cast(s8v_t, hw), xl = __builtin_bit_cast(s8v_t, lw);
#pragma unroll
        for (int nt = 0; nt < 2; ++nt) { const s8v_t wh = *(const LAS s8v_t*)(tb + nt * 16 * PT_LD + s * 64), wl = *(const LAS s8v_t*)(tb + PT_HALF + nt * 16 * PT_LD + s * 64);
            acc[nt] = __builtin_amdgcn_mfma_f32_16x16x32_bf16(xh, wh, acc[nt], 0, 0, 0); acc[nt] = __builtin_amdgcn_mfma_f32_16x16x32_bf16(xl, wh, acc[nt], 0, 0, 0); acc[nt] = __builtin_amdgcn_mfma_f32_16x16x32_bf16(xh, wl, acc[nt], 0, 0, 0); }
        }
#pragma unroll
        for (int i = 0; i < 4; ++i) { ra[i] = na[i]; rb[i] = nb[i]; }
    }
#undef RP_LOAD
    ss += __shfl_xor(ss, 16); ss += __shfl_xor(ss, 32);
    return 1.0f / sqrtf(ss * (1.0f / 1024.0f) + RMS_EPS);
}

namespace mx {
typedef short s8v __attribute__((ext_vector_type(8)));
typedef short s4v __attribute__((ext_vector_type(4)));
#define MX_MFMA(a, b, c) __builtin_amdgcn_mfma_f32_16x16x32_bf16(a, b, c, 0, 0, 0)
#define MX_SB() __builtin_amdgcn_sched_barrier(0)
#define MX_BAR() do { MX_SB(); asm volatile("s_waitcnt lgkmcnt(0)" ::: "memory"); __builtin_amdgcn_s_barrier(); asm volatile("" ::: "memory"); } while (0)
constexpr int TS = 288, TILE = 64 * TS, PS = 144, PTILE = 64 * PS, BUF = 3 * TILE;
struct LaneBase { unsigned row, perm, tr, prow; };
__device__ __forceinline__ LaneBase lane_base(int lane) { LaneBase L; const unsigned g = lane >> 4, i = lane & 15, q = i >> 2, p = lane & 3;
    L.row = i * TS + g * 16; L.perm = i * TS + g * 8; L.tr = (8 * g + q) * TS + p * 8; L.prow = i * PS + g * 16; return L; }
#define LD_ROW(t, L, rb, s) (*(const LAS mx::s8v*)((t) + (L).row + (rb) * 16 * mx::TS + (s) * 64))
#define LD_ROWP(t, L, rb, s) (*(const LAS mx::s8v*)((t) + (L).prow + (rb) * 16 * mx::PS + (s) * 64))
__device__ __forceinline__ s8v ld_perm2(const LAS unsigned char* p) { const s4v lo = *(const LAS s4v*)p, hi = *(const LAS s4v*)(p + 32); return (s8v){lo[0], lo[1], lo[2], lo[3], hi[0], hi[1], hi[2], hi[3]}; }
#define LD_PERM(t, L, rb, s) mx::ld_perm2((t) + (L).perm + (rb) * 16 * mx::TS + (s) * 64)
__device__ __forceinline__ s8v ld_tr2(const LAS unsigned char* p) {
    const s4v a = __builtin_amdgcn_ds_read_tr16_b64_v4i16((LAS s4v*)p), b = __builtin_amdgcn_ds_read_tr16_b64_v4i16((LAS s4v*)(p + 4 * TS));
    return (s8v){a[0], a[1], a[2], a[3], b[0], b[1], b[2], b[3]}; }
#define LD_TR(t, L, c, ks) mx::ld_tr2((t) + (L).tr + (ks) * 32 * mx::TS + (c) * 32)
__device__ __forceinline__ void dma_tiles(LAS unsigned char* buf, const bf16* g0, int gstride, int co0, int co1, int co2, int wave, int lane) {
#pragma unroll
    for (int pp = 0; pp < 7; ++pp) { const int piece = wave + 8 * pp; if (piece < 54) { const unsigned o = piece * 1024 + lane * 16, tl = o / TILE, ot = o - tl * TILE, row = ot / TS, wb = ot - row * TS;
        const int co = tl == 0 ? co0 : (tl == 1 ? co1 : co2);
        __builtin_amdgcn_global_load_lds((const unsigned*)(g0 + (size_t)row * gstride + co + (wb < 256 ? wb >> 1 : 0)), (LAS unsigned*)(buf + piece * 1024), 16, 0, 0); } }
}
#define MX_DPPF(old, src, ctrl, rm) __builtin_bit_cast(float, __builtin_amdgcn_update_dpp(__builtin_bit_cast(int, (float)(old)), __builtin_bit_cast(int, (float)(src)), ctrl, rm, 0xf, false))
__device__ __forceinline__ float scan_add(float x) {
    x += MX_DPPF(0.f, x, 0x111, 0xf); x += MX_DPPF(0.f, x, 0x112, 0xf); x += MX_DPPF(0.f, x, 0x114, 0xf); x += MX_DPPF(0.f, x, 0x118, 0xf);
    x += MX_DPPF(0.f, x, 0x142, 0xa); x += MX_DPPF(0.f, x, 0x143, 0xc); return x; }
__device__ __forceinline__ float scan_max(float x) { const float ninf = -INFINITY;
    x = fmaxf(x, MX_DPPF(ninf, x, 0x111, 0xf)); x = fmaxf(x, MX_DPPF(ninf, x, 0x112, 0xf)); x = fmaxf(x, MX_DPPF(ninf, x, 0x114, 0xf)); x = fmaxf(x, MX_DPPF(ninf, x, 0x118, 0xf));
    x = fmaxf(x, MX_DPPF(ninf, x, 0x142, 0xa)); x = fmaxf(x, MX_DPPF(ninf, x, 0x143, 0xc)); return x; }
__device__ __forceinline__ float lane63(float x) { return __builtin_bit_cast(float, __builtin_amdgcn_readlane(__builtin_bit_cast(int, x), 63)); }
__device__ __forceinline__ float softplus_fast(float x) { const float e = __expf(-fabsf(x)); return fmaxf(x, 0.f) + (e < 1e-6f ? e : __logf(1.0f + e)); }
__device__ __forceinline__ s8v pack_acc(const f32x4& a, const f32x4& b) {
    const unsigned w0 = pk2(a[0], a[1]), w1 = pk2(a[2], a[3]), w2 = pk2(b[0], b[1]), w3 = pk2(b[2], b[3]);
    v4u w = {w0, w1, w2, w3}; return __builtin_bit_cast(s8v, w);
}
__device__ __forceinline__ void unpack8(const v4u& w, float (&f)[8]) { f[0] = bflo(w.x); f[1] = bfhi(w.x); f[2] = bflo(w.y); f[3] = bfhi(w.y); f[4] = bflo(w.z); f[5] = bfhi(w.z); f[6] = bflo(w.w); f[7] = bfhi(w.w); }

__device__ __forceinline__ void mlstm_item(LAS unsigned char* lds, int item, int var, int wave, const bf16* __restrict__ PROJ, const float* __restrict__ GATES, const float* __restrict__ lnw, bf16* __restrict__ MIX) {
    const int lane = lane_id(), tid = wave * 64 + lane, g = lane >> 4, c16 = lane & 15;
    const int b = item >> 3, h = item & 7;
    const LaneBase L = lane_base(lane);
    LAS unsigned char* TP = lds + 2 * BUF; LAS unsigned char* TO = TP + PTILE;
    LAS float* denP = (LAS float*)(TO + TILE); LAS float* qnp = denP + 128; LAS float* nsh = qnp + 512;
    LAS float* Au = nsh + 128; LAS float* Avv = Au + 64; LAS float* Awi = Avv + 64; LAS float* Akw = Awi + 64; LAS float* Aid = Akw + 64;
    f32x4 Cst[8];
#pragma unroll
    for (int i = 0; i < 8; ++i) Cst[i] = (f32x4){0.f, 0.f, 0.f, 0.f};
    float nreg = 0.f, m_prev = 0.f;
    if (lane < 16) nsh[wave * 16 + lane] = 0.f;
    const int srow = tid >> 3, sch = tid & 7;
    const bf16* qbase = PROJ + (size_t)(b * SEQ) * NPROJ + h * 128;
    dma_tiles(lds, qbase, NPROJ, C_Q, C_K, C_V, wave, lane);
    float fnext = GATES[(size_t)(b * SEQ + lane) * 32 + 24 + h], inext = GATES[(size_t)(b * SEQ + lane) * 32 + 16 + h];
    asm volatile("s_waitcnt vmcnt(0)" ::: "memory"); MX_BAR();
#pragma unroll 1
    for (int c = 0; c < SEQ / 64; ++c) {
        const int cur = c & 1; const int t0 = b * SEQ + c * 64;
        LAS unsigned char* TQ = lds + cur * BUF; LAS unsigned char* TK = TQ + TILE; LAS unsigned char* TV = TQ + 2 * TILE;
        float fraw = fnext, iraw = inext; asm volatile("" : "+v"(fraw), "+v"(iraw));
        MX_SB();
        const v4u ov0 = *(const v4u*)(PROJ + (size_t)(t0 + srow) * NPROJ + C_O + h * 128 + 8 * sch), ov1 = *(const v4u*)(PROJ + (size_t)(t0 + srow) * NPROJ + C_O + h * 128 + 64 + 8 * sch);
        { const int tn = (c + 1 < SEQ / 64 ? t0 + 64 : t0) + lane; fnext = GATES[(size_t)tn * 32 + 24 + h]; inext = GATES[(size_t)tn * 32 + 16 + h]; }
        const float lf = -softplus_fast(-fraw), cf = scan_add(lf), chunk_f = lane63(cf);
        const float u = iraw - cf, Mx = scan_max(u);
        const float m_row = cf + fmaxf(m_prev, Mx), vv = cf - m_row;
        const float m_loc = chunk_f + lane63(Mx), m_new = fmaxf(chunk_f + m_prev, m_loc);
        const float w_inter = __expf(vv + m_prev), floorv = __expf(-m_row), kw = __expf(chunk_f + u - m_new), s_old = __expf(chunk_f + m_prev - m_new);
        Au[lane] = u; Avv[lane] = vv; Awi[lane] = w_inter; Akw[lane] = kw;
        if (!(var & 2)) { const int lt = wave & 3, jt0 = 2 * (wave >> 2); const float vv_l = Avv[16 * lt + c16]; float rsum = 0.f;
#pragma unroll
          for (int jj = 0; jj < 2; ++jj) { const int jt = jt0 + jj; float pv[4] = {0.f, 0.f, 0.f, 0.f};
            if (jt <= lt) { f32x4 acc = {0.f, 0.f, 0.f, 0.f};
#pragma unroll
                for (int ks = 0; ks < 4; ++ks) acc = MX_MFMA(LD_ROW(TK, L, jt, ks), LD_ROW(TQ, L, lt, ks), acc);
                const f32x4 uj = *(const LAS f32x4*)(Au + 16 * jt + 4 * g);
#pragma unroll
                for (int r = 0; r < 4; ++r) { const int j = 16 * jt + 4 * g + r, l = 16 * lt + c16; const float val = (j <= l) ? acc[r] * __expf(vv_l + uj[r]) : 0.f; rsum += val; pv[r] = val; } }
            v2u w; w.x = pk2(pv[0], pv[1]); w.y = pk2(pv[2], pv[3]);
            *(LAS v2u*)(TP + (16 * lt + c16) * PS + (16 * jt + 4 * g) * 2) = w; }
          rsum += __shfl_xor(rsum, 16); rsum += __shfl_xor(rsum, 32);
          if (g == 0) denP[(wave >> 2) * 64 + 16 * lt + c16] = rsum;
          v4u q0 = *(const LAS v4u*)(TQ + lane * TS + wave * 32), q1 = *(const LAS v4u*)(TQ + lane * TS + wave * 32 + 16); float qf[16]; { float t8[8]; unpack8(q0, t8);
#pragma unroll
            for (int e = 0; e < 8; ++e) qf[e] = t8[e]; unpack8(q1, t8);
#pragma unroll
            for (int e = 0; e < 8; ++e) qf[8 + e] = t8[e]; }
          float part = 0.f;
#pragma unroll
          for (int e4 = 0; e4 < 4; ++e4) { const f32x4 nv = *(const LAS f32x4*)(nsh + wave * 16 + 4 * e4); part += qf[4 * e4] * nv[0] + qf[4 * e4 + 1] * nv[1] + qf[4 * e4 + 2] * nv[2] + qf[4 * e4 + 3] * nv[3]; }
          qnp[wave * 64 + lane] = part; }
        if (c + 1 < SEQ / 64 && !(var & 1)) { int lv = lane; asm volatile("" : "+v"(lv)); dma_tiles(lds + (cur ^ 1) * BUF, qbase + (size_t)(c + 1) * 64 * NPROJ, NPROJ, C_Q, C_K, C_V, wave, lv); }
        MX_SB();
        f32x4 acc[4];
        { s8v sf[4];
#pragma unroll
          for (int ks = 0; ks < 4; ++ks) sf[ks] = pack_acc(Cst[2 * ks], Cst[2 * ks + 1]);
#pragma unroll
          for (int lt = 0; lt < 4; ++lt) acc[lt] = (f32x4){0.f, 0.f, 0.f, 0.f};
          if (!(var & 4)) {
#pragma unroll
            for (int ks = 0; ks < 4; ++ks)
#pragma unroll
                for (int lt = 0; lt < 4; ++lt) acc[lt] = MX_MFMA(sf[ks], LD_PERM(TQ, L, lt, ks), acc[lt]);
#pragma unroll
            for (int lt = 0; lt < 4; ++lt) acc[lt] = acc[lt] * Awi[16 * lt + c16]; } }
        const s8v vf0 = LD_TR(TV + wave * 32, L, 0, 0), vf1 = LD_TR(TV + wave * 32, L, 0, 1);
        {
#pragma unroll
          for (int i = 0; i < 8; ++i) Cst[i] = Cst[i] * s_old;
          if (!(var & 8))
#pragma unroll
          for (int ks = 0; ks < 2; ++ks) { const s8v vf = ks ? vf1 : vf0; const v4u vw = __builtin_bit_cast(v4u, vf); float f[8]; unpack8(vw, f);
            { const f32x4 k0 = *(const LAS f32x4*)(Akw + 32 * ks + 8 * g), k1 = *(const LAS f32x4*)(Akw + 32 * ks + 8 * g + 4);
#pragma unroll
              for (int e = 0; e < 4; ++e) { f[e] *= k0[e]; f[4 + e] *= k1[e]; } }
            v4u pw = {pk2(f[0], f[1]), pk2(f[2], f[3]), pk2(f[4], f[5]), pk2(f[6], f[7])}; const s8v vwf = __builtin_bit_cast(s8v, pw);
#pragma unroll
            for (int dkt = 0; dkt < 8; ++dkt) Cst[dkt] = MX_MFMA(LD_TR(TK, L, dkt, ks), vwf, Cst[dkt]); }
          float part = 0.f;
#pragma unroll
          for (int e4 = 0; e4 < 4; ++e4) { const f32x4 kk = *(const LAS f32x4*)(Akw + 16 * g + 4 * e4);
#pragma unroll
            for (int e = 0; e < 4; ++e) { const int j = 16 * g + 4 * e4 + e; part += bf2f(*(const LAS unsigned short*)(TK + j * TS + (16 * wave + c16) * 2)) * kk[e]; } }
          part += __shfl_xor(part, 16); part += __shfl_xor(part, 32);
          nreg = s_old * nreg + part; if (g == 0) nsh[wave * 16 + c16] = nreg;
        }
        MX_BAR();
        float inv_den; { float qn = 0.f;
#pragma unroll
          for (int w = 0; w < 8; ++w) qn += qnp[w * 64 + lane];
          float den = denP[lane] + denP[64 + lane] + w_inter * qn; den = fmaxf(fabsf(den), floorv); inv_den = __builtin_amdgcn_rcpf(den); Aid[lane] = inv_den; }
        { if (!(var & 4))
#pragma unroll
          for (int lt = 0; lt < 4; ++lt) { f32x4 a4 = MX_MFMA(vf0, LD_ROWP(TP, L, lt, 0), acc[lt]);
            if (lt >= 2) a4 = MX_MFMA(vf1, LD_ROWP(TP, L, lt, 1), a4);
            a4 = a4 * Aid[16 * lt + c16];
            v2u w; w.x = pk2(a4[0], a4[1]); w.y = pk2(a4[2], a4[3]);
            *(LAS v2u*)(TO + (16 * lt + c16) * TS + (16 * wave + 4 * g) * 2) = w; }
          m_prev = m_new; }
        asm volatile("s_waitcnt vmcnt(0)" ::: "memory"); MX_BAR();
        if (!(var & 16)) { const v4u a = *(const LAS v4u*)(TO + srow * TS + sch * 16), bq = *(const LAS v4u*)(TO + srow * TS + sch * 16 + 128); float f[16], of[16]; { float t8[8]; unpack8(a, t8);
#pragma unroll
            for (int e = 0; e < 8; ++e) f[e] = t8[e]; unpack8(bq, t8);
#pragma unroll
            for (int e = 0; e < 8; ++e) f[8 + e] = t8[e]; unpack8(ov0, t8);
#pragma unroll
            for (int e = 0; e < 8; ++e) of[e] = t8[e]; unpack8(ov1, t8);
#pragma unroll
            for (int e = 0; e < 8; ++e) of[8 + e] = t8[e]; }
          float ss = 0.f;
#pragma unroll
          for (int e = 0; e < 16; ++e) ss += f[e] * f[e];
          ss += __shfl_xor(ss, 1); ss += __shfl_xor(ss, 2); ss += __shfl_xor(ss, 4);
          const float rs = rsqrt_f(ss * (1.0f / 128.0f) + RMS_EPS);
          float wn[16]; { const f32x4 w0 = *(const f32x4*)(lnw + h * 128 + 8 * sch), w1 = *(const f32x4*)(lnw + h * 128 + 8 * sch + 4), w2 = *(const f32x4*)(lnw + h * 128 + 64 + 8 * sch), w3 = *(const f32x4*)(lnw + h * 128 + 64 + 8 * sch + 4);
#pragma unroll
            for (int e = 0; e < 4; ++e) { wn[e] = w0[e]; wn[4 + e] = w1[e]; wn[8 + e] = w2[e]; wn[12 + e] = w3[e]; } }
#pragma unroll
          for (int e = 0; e < 16; ++e) f[e] = f[e] * rs * wn[e] * sigmoid_f(of[e]);
          v4u o0 = {pk2(f[0], f[1]), pk2(f[2], f[3]), pk2(f[4], f[5]), pk2(f[6], f[7])}, o1 = {pk2(f[8], f[9]), pk2(f[10], f[11]), pk2(f[12], f[13]), pk2(f[14], f[15])};
          bf16* mp = MIX + (size_t)(t0 + srow) * 2048 + 1024 + h * 128 + 8 * sch; *(v4u*)mp = o0; *(v4u*)(mp + 64) = o1; }
    }
    MX_BAR();
}

__device__ __forceinline__ void ssd_item(LAS unsigned char* lds, int item, int var, int wave, const bf16* __restrict__ XBC, const bf16* __restrict__ PROJ, const float* __restrict__ GATES, const float* __restrict__ a_log,
                                         const float* __restrict__ d_skip, bf16* __restrict__ MIX, float* __restrict__ SSQ) {
    const int lane = lane_id(), tid = wave * 64 + lane, g = lane >> 4, c16 = lane & 15;
    const int b = item >> 3, hp = item & 7, grp = hp >> 2, hh = wave >> 2, ps = wave & 3;
    const LaneBase L = lane_base(lane);
    LAS unsigned char* TG = lds + 2 * BUF;
    LAS unsigned char* TO = TG + 2 * PTILE;
    LAS float* Aacs = (LAS float*)(TO + TILE); LAS float* Adinv = Aacs + 128; LAS float* Adt = Adinv + 128; LAS float* Awd = Adt + 128; LAS float* Aea = Awd + 128;
    f32x4 RT[8];
#pragma unroll
    for (int i = 0; i < 8; ++i) RT[i] = (f32x4){0.f, 0.f, 0.f, 0.f};
    const float an0 = -__expf(a_log[2 * hp]), an1 = -__expf(a_log[2 * hp + 1]), dk0 = d_skip[2 * hp], dk1 = d_skip[2 * hp + 1];
    const int srow = tid >> 3, sch = tid & 7;
    const bf16* xb = XBC + (size_t)(b * SEQ) * 1536;
    dma_tiles(lds, xb, 1536, 1280 + grp * 128, 1024 + grp * 128, hp * 128, wave, lane);
    float dn0 = GATES[(size_t)(b * SEQ + lane) * 32 + 2 * hp], dn1 = GATES[(size_t)(b * SEQ + lane) * 32 + 2 * hp + 1];
    asm volatile("s_waitcnt vmcnt(0)" ::: "memory"); MX_BAR();
#pragma unroll 1
    for (int c = 0; c < SEQ / 64; ++c) {
        const int cur = c & 1; const int t0 = b * SEQ + c * 64;
        LAS unsigned char* TC = lds + cur * BUF; LAS unsigned char* TB = TC + TILE; LAS unsigned char* TX = TC + 2 * TILE;
        float dr0 = dn0, dr1 = dn1; asm volatile("" : "+v"(dr0), "+v"(dr1));
        MX_SB();
        const v4u zv0 = *(const v4u*)(PROJ + (size_t)(t0 + srow) * NPROJ + C_Z + hp * 128 + 8 * sch), zv1 = *(const v4u*)(PROJ + (size_t)(t0 + srow) * NPROJ + C_Z + hp * 128 + 64 + 8 * sch);
        { const int tn = (c + 1 < SEQ / 64 ? t0 + 64 : t0) + lane; dn0 = GATES[(size_t)tn * 32 + 2 * hp]; dn1 = GATES[(size_t)tn * 32 + 2 * hp + 1]; }
        const float dt0 = softplus_fast(dr0), dt1 = softplus_fast(dr1);
        const float acs0 = scan_add(dt0 * an0), acs1 = scan_add(dt1 * an1);
        const float aend0 = lane63(acs0), aend1 = lane63(acs1);
        Aacs[lane] = acs0; Aacs[64 + lane] = acs1; Adinv[lane] = dk0 * __builtin_amdgcn_rcpf(dt0); Adinv[64 + lane] = dk1 * __builtin_amdgcn_rcpf(dt1); Adt[lane] = dt0; Adt[64 + lane] = dt1;
        Awd[lane] = __expf(aend0 - acs0); Awd[64 + lane] = __expf(aend1 - acs1); Aea[lane] = __expf(acs0); Aea[64 + lane] = __expf(acs1);
        const float aend = hh ? aend1 : aend0;
        if (!(var & 2)) { const int lt = wave & 3, st0 = 2 * (wave >> 2); const int l = 16 * lt + c16;
          const float al0 = Aacs[l], al1 = Aacs[64 + l], di0 = Adinv[l], di1 = Adinv[64 + l];
#pragma unroll
          for (int ss = 0; ss < 2; ++ss) { const int st = st0 + ss; float p0[4] = {0.f, 0.f, 0.f, 0.f}, p1[4] = {0.f, 0.f, 0.f, 0.f};
            if (st <= lt) { f32x4 acc = {0.f, 0.f, 0.f, 0.f};
#pragma unroll
                for (int ks = 0; ks < 4; ++ks) acc = MX_MFMA(LD_ROW(TB, L, st, ks), LD_ROW(TC, L, lt, ks), acc);
                const f32x4 as0 = *(const LAS f32x4*)(Aacs + 16 * st + 4 * g), as1 = *(const LAS f32x4*)(Aacs + 64 + 16 * st + 4 * g);
#pragma unroll
                for (int r = 0; r < 4; ++r) { const int sidx = 16 * st + 4 * g + r;
                    float v0 = (sidx <= l) ? acc[r] * __expf(al0 - as0[r]) : 0.f, v1 = (sidx <= l) ? acc[r] * __expf(al1 - as1[r]) : 0.f;
                    if (sidx == l) { v0 += di0; v1 += di1; } p0[r] = v0; p1[r] = v1; } }
            v2u w0, w1; w0.x = pk2(p0[0], p0[1]); w0.y = pk2(p0[2], p0[3]); w1.x = pk2(p1[0], p1[1]); w1.y = pk2(p1[2], p1[3]);
            const unsigned o = l * PS + (16 * st + 4 * g) * 2;
            *(LAS v2u*)(TG + o) = w0; *(LAS v2u*)(TG + PTILE + o) = w1; } }
        if (c + 1 < SEQ / 64 && !(var & 1)) { int lv = lane; asm volatile("" : "+v"(lv)); dma_tiles(lds + (cur ^ 1) * BUF, xb + (size_t)(c + 1) * 64 * 1536, 1536, 1280 + grp * 128, 1024 + grp * 128, hp * 128, wave, lv); }
        MX_SB();
        f32x4 acc[4];
        { s8v sf[4];
#pragma unroll
          for (int ks = 0; ks < 4; ++ks) sf[ks] = pack_acc(RT[2 * ks], RT[2 * ks + 1]);
#pragma unroll
          for (int lt = 0; lt < 4; ++lt) acc[lt] = (f32x4){0.f, 0.f, 0.f, 0.f};
          if (!(var & 4)) {
#pragma unroll
            for (int ks = 0; ks < 4; ++ks)
#pragma unroll
                for (int lt = 0; lt < 4; ++lt) acc[lt] = MX_MFMA(sf[ks], LD_PERM(TC, L, lt, ks), acc[lt]);
#pragma unroll
            for (int lt = 0; lt < 4; ++lt) acc[lt] = acc[lt] * Aea[64 * hh + 16 * lt + c16]; } }
          s8v xd[2], xw[2];
#pragma unroll
          for (int ks = 0; ks < 2; ++ks) { const s8v xf = LD_TR(TX + (4 * hh + ps) * 32, L, 0, ks); const v4u xv = __builtin_bit_cast(v4u, xf); float f[8], fw[8]; unpack8(xv, f);
            { const LAS float* pd = Adt + 64 * hh + 32 * ks + 8 * g; const LAS float* pw = Awd + 64 * hh + 32 * ks + 8 * g; const f32x4 d0 = *(const LAS f32x4*)pd, d1 = *(const LAS f32x4*)(pd + 4), w0 = *(const LAS f32x4*)pw, w1 = *(const LAS f32x4*)(pw + 4);
#pragma unroll
              for (int e = 0; e < 4; ++e) { f[e] *= d0[e]; fw[e] = f[e] * w0[e]; f[4 + e] *= d1[e]; fw[4 + e] = f[4 + e] * w1[e]; } }
            v4u a = {pk2(f[0], f[1]), pk2(f[2], f[3]), pk2(f[4], f[5]), pk2(f[6], f[7])}, bw = {pk2(fw[0], fw[1]), pk2(fw[2], fw[3]), pk2(fw[4], fw[5]), pk2(fw[6], fw[7])};
            xd[ks] = __builtin_bit_cast(s8v, a); xw[ks] = __builtin_bit_cast(s8v, bw); }
        {
          const float ea = __expf(aend);
#pragma unroll
          for (int i = 0; i < 8; ++i) RT[i] = RT[i] * ea;
          if (!(var & 8))
#pragma unroll
          for (int ks = 0; ks < 2; ++ks)
#pragma unroll
            for (int nt = 0; nt < 8; ++nt) RT[nt] = MX_MFMA(LD_TR(TB, L, nt, ks), xw[ks], RT[nt]);
        }
        MX_BAR();
        {
          const LAS unsigned char* TGm = TG + hh * PTILE;
          if (!(var & 4))
#pragma unroll
          for (int lt = 0; lt < 4; ++lt) { f32x4 a4 = MX_MFMA(xd[0], LD_ROWP(TGm, L, lt, 0), acc[lt]);
            if (lt >= 2) a4 = MX_MFMA(xd[1], LD_ROWP(TGm, L, lt, 1), a4);
            v2u w; w.x = pk2(a4[0], a4[1]); w.y = pk2(a4[2], a4[3]);
            *(LAS v2u*)(TO + (16 * lt + c16) * TS + (64 * hh + 16 * ps + 4 * g) * 2) = w; }
        }
        asm volatile("s_waitcnt vmcnt(0)" ::: "memory"); MX_BAR();
        if (!(var & 16)) { const v4u a = *(const LAS v4u*)(TO + srow * TS + sch * 16), bq = *(const LAS v4u*)(TO + srow * TS + sch * 16 + 128); float f[16], zf[16]; { float t8[8]; unpack8(a, t8);
#pragma unroll
            for (int e = 0; e < 8; ++e) f[e] = t8[e]; unpack8(bq, t8);
#pragma unroll
            for (int e = 0; e < 8; ++e) f[8 + e] = t8[e]; unpack8(zv0, t8);
#pragma unroll
            for (int e = 0; e < 8; ++e) zf[e] = t8[e]; unpack8(zv1, t8);
#pragma unroll
            for (int e = 0; e < 8; ++e) zf[8 + e] = t8[e]; }
          float ss = 0.f;
#pragma unroll
          for (int e = 0; e < 16; ++e) { f[e] = f[e] * silu_f(zf[e]); ss += f[e] * f[e]; }
          ss += __shfl_xor(ss, 1); ss += __shfl_xor(ss, 2); ss += __shfl_xor(ss, 4);
          if (sch == 0) SSQ[(size_t)(t0 + srow) * 8 + hp] = ss;
          v4u o0 = {pk2(f[0], f[1]), pk2(f[2], f[3]), pk2(f[4], f[5]), pk2(f[6], f[7])}, o1 = {pk2(f[8], f[9]), pk2(f[10], f[11]), pk2(f[12], f[13]), pk2(f[14], f[15])};
          bf16* mp = MIX + (size_t)(t0 + srow) * 2048 + hp * 128 + 8 * sch; *(v4u*)mp = o0; *(v4u*)(mp + 64) = o1; }
    }
    MX_BAR();
}
}

__global__ void __launch_bounds__(NTHR, 2) mega(Args args) {
    extern __shared__ __attribute__((aligned(16))) unsigned char lds_raw[];
    LAS unsigned char* lds = (LAS unsigned char*)lds_raw;
    const int wave = __builtin_amdgcn_readfirstlane((int)threadIdx.x >> 6);
    const int lane = lane_id(), tid = wave * 64 + lane;
    const int G = gridDim.x, bx = blockIdx.x;
    unsigned char* ws = args.ws;
#define INP(k) ({ int _k = (k); asm volatile("" : "+s"(_k)); args.in[_k]; })
#define XIN INP(0)
#define Win_t ((bf16*)(ws + WS_WIN))
#define Wout_t ((bf16*)(ws + WS_WOUT))
#define XN ((bf16*)(ws + WS_XN))
#define H ((bf16*)(ws + WS_H))
#define GATES ((float*)(ws + WS_GATES))
#define PROJ ((bf16*)(ws + WS_PROJ))
#define MIX ((bf16*)(ws + WS_MIX))
#define EO8 (ws + WS_XG + 136 * MiB)
#define TOPI ((int*)(ws + WS_ROUTE + R_TOPI))
#define TOPG ((float*)(ws + WS_ROUTE + R_TOPG))
#define TOKROW ((int*)(ws + WS_ROUTE + R_TOKROW))
#define ROWTOK ((int*)(ws + WS_ROUTE + R_ROWTOK))
#define ROWGATE ((float*)(ws + WS_ROUTE + R_ROWGATE))
#define BLKCNT ((int*)(ws + WS_ROUTE + R_BLKCNT))
#define BLKEXP ((int*)(ws + WS_ROUTE + R_BLKEXP))
#define NBLK ((int*)(ws + WS_ROUTE + R_NBLK))
#define XBC ((bf16*)(ws + WS_XBC))
#define SSQ ((float*)(ws + WS_SSQ))
#define RS1 ((float*)(ws + WS_SSQ + 1 * MiB))
#define RS2 ((float*)(ws + WS_SSQ + 1 * MiB + 128 * 1024))
#define ROWRS ((float*)(ws + WS_SSQ + 1 * MiB + 256 * 1024))
#define XN8 (ws + WS_XN)
#define XG8 (ws + WS_XG)
#define ACT8 (ws + WS_ACT)
#define Wgu8 (ws + WS_WGU)
#define Wdn8 (ws + WS_WDN)
    const int lo = args.ph_lo, hi = args.ph_hi;
    if (tid < 64) ((LAS unsigned*)(lds + MISC_OFF))[tid] = 0u;
    __syncthreads();
    XcdBarrier bar = xcd_barrier_post((unsigned*)(ws + WS_CTL) + CW_BAR, (volatile LAS unsigned*)(lds + MISC_OFF), tid == 0);
#define GRID_BAR(k) do { if (IN(k) && IN((k) + 1)) xcd_barrier(bar, wave == 0 && lane_id() == 0); } while (0)
#ifndef PH_MASK
#define PH_MASK 0xffff
#endif
#define IN(k) (((PH_MASK >> (k)) & 1) && lo <= (k) && (k) < hi)


    if (IN(0)) {
        const int tid = fresh_tid(wave), lane = tid & 63; (void)lane;
        LAS float* scr = (LAS float*)(lds + wave * 17408);
        const int gw = bx * NWAVES + wave, NGW = G * NWAVES;
        constexpr int I_IN = 16 * (NPROJ / 32), I_OUT = 32 * 32, I_GU = 8 * 64, I_DN = 8 * 32;
        constexpr int NITEMS = I_IN + I_OUT + NE * I_GU + NE * I_DN;
        if (!(args.variant & 32))
        for (int it = gw; it < I_IN + I_OUT; it += NGW) {
            int r = it;
            if (r < I_IN) { const int nb = r % (NPROJ / 32), kb = r / (NPROJ / 32), n0 = nb * 32; const int n0s = n0 + (n0 >= C_Q ? 16 : 0);
                const float cs = (n0 >= C_K && n0 < C_V) ? 0.08838834764831845f : 1.0f;
                transpose_item(INP(2), WIN_LD, n0s, kb * 64, Win_t, 1024, n0, cs, nullptr, scr, lane); continue; } r -= I_IN;
            if (r < I_OUT) { const int nb = r % 32, kb = r / 32; transpose_item(INP(12), 1024, nb * 32, kb * 64, Wout_t, 2048, nb * 32, 1.0f, kb < 16 ? INP(8) : nullptr, scr, lane); continue; } r -= I_OUT;
        }
        __syncthreads();
        if (!(args.variant & 32)) {
            constexpr int T_GU = NE * 8 * 16, T_DN = NE * 8 * 8;
            struct MoeTile { const float* src; unsigned char* dst; int ld; int pad; };
            auto tdecode = [&](int t) -> MoeTile {
                if (t < T_GU) { const int e = t >> 7, q = t & 127, nbk = q & 15, kb = q >> 4, rho0 = nbk * 128; const int n0s = ((rho0 >> 7) & 1) * 1024 + (rho0 >> 8) * 128;
                    return MoeTile{INP(16) + (size_t)e * 1024 * 2048 + (size_t)(kb * 128) * 2048 + n0s, Wgu8 + (size_t)e * 2048 * 1024 + (size_t)rho0 * 1024 + kb * 128, 2048, 0}; }
                t -= T_GU; const int e = t >> 6, q = t & 63, nbk = q & 7, kb = q >> 3;
                return MoeTile{INP(18) + (size_t)e * 1024 * 1024 + (size_t)(kb * 128) * 1024 + nbk * 128, Wdn8 + (size_t)e * 1024 * 1024 + (size_t)(nbk * 128) * 1024 + kb * 128, 1024, 0}; };
            LAS float* tb = (LAS float*)lds;
            const int lrow = 16 * wave + (lane >> 5), lch = lane & 31;
            f32x4 v[8]; MoeTile cur = tdecode(bx);
#pragma unroll
            for (int i = 0; i < 8; ++i) v[i] = *(const f32x4*)(cur.src + (size_t)(lrow + 2 * i) * cur.ld + 4 * lch);
#pragma unroll 1
            for (int t = bx; t < T_GU + T_DN; t += G) {
                f32x4 nv[8]; MoeTile nx = cur;
                if (t + G < T_GU + T_DN) { nx = tdecode(t + G);
#pragma unroll
                    for (int i = 0; i < 8; ++i) nv[i] = *(const f32x4*)(nx.src + (size_t)(lrow + 2 * i) * nx.ld + 4 * lch); }
                else {
#pragma unroll
                    for (int i = 0; i < 8; ++i) nv[i] = v[i]; }
#pragma unroll
                for (int i = 0; i < 8; ++i) { const int k = lrow + 2 * i; *(LAS f32x4*)(tb + k * 132 + 4 * (lch ^ (k >> 4))) = v[i] * 64.0f; }
                __syncthreads();
                { const int c = lane & 7;
#pragma unroll
                  for (int p = 0; p < 2; ++p) { const int n = 16 * wave + 8 * p + (lane >> 3); const LAS float* sp = tb + (16 * c) * 132 + ((((n >> 2) ^ c) << 2) | (n & 3));
                    v4u o; o.x = (unsigned)pk4_fp8(sp[0 * 132], sp[1 * 132], sp[2 * 132], sp[3 * 132]); o.y = (unsigned)pk4_fp8(sp[4 * 132], sp[5 * 132], sp[6 * 132], sp[7 * 132]);
                    o.z = (unsigned)pk4_fp8(sp[8 * 132], sp[9 * 132], sp[10 * 132], sp[11 * 132]); o.w = (unsigned)pk4_fp8(sp[12 * 132], sp[13 * 132], sp[14 * 132], sp[15 * 132]);
                    *(v4u*)(cur.dst + (size_t)n * 1024 + 16 * c) = o; } }
                __syncthreads();
#pragma unroll
                for (int i = 0; i < 8; ++i) v[i] = nv[i];
                cur = nx;
            }
        }
        __syncthreads();
        pt_fill(lds, INP(2), WIN_LD, tid, true, INP(1));
        __syncthreads();
        { const int c16 = lane & 15, g = lane >> 4;
          const float* wnp = INP(1); const float* bi_ = INP(9); const float* bf_ = INP(10); const float gb0 = INP(5)[c16], gb1 = *(c16 < 8 ? bi_ + c16 : bf_ + (c16 - 8));
          if (!(args.variant & 64))
#pragma unroll 1
          for (int task = gw; task < T / 16; task += NGW) { const int row0 = task * 16; f32x4 acc[2];
            const float rs = rowproj16<false, false>(XIN, XN, wnp, lds, row0, lane, acc);
            if (g == 0) RS1[row0 + c16] = rs;
#pragma unroll
            for (int r = 0; r < 4; ++r) { const float rr = __shfl(rs, 4 * g + r); float* gp = GATES + (size_t)(row0 + 4 * g + r) * 32; gp[c16] = rr * acc[0][r] + gb0; gp[16 + c16] = rr * acc[1][r] + gb1; } } }
        __syncthreads();
    }
    GRID_BAR(0);

    if (IN(1)) {
        pg8::Gemm g{XN, Win_t, T, NPROJ, 1024}; pg8::StaticOrder S; S.init(T, NPROJ, G, bx);
        pg8::EpiBf16 E{PROJ, NPROJ, RS1};
        pg8::gemm_phase<pg8::EpiBf16, pg8::StaticOrder>(lds, g, S, E, wave);
    }
    GRID_BAR(1);

    if (IN(2)) {
        const int tid = fresh_tid(wave), lane = tid & 63; (void)lane;
        const float* cw = INP(3); const float* cb = INP(4);
#pragma unroll 1
        for (int it = bx * NTHR + tid; it < (T / 16) * 192; it += G * NTHR) {
            const int ch = it % 192, t0 = (it / 192) * 16, c0 = ch * 8;
            float w[4][8], bs[8], r0[8], r1[8], r2[8];
#pragma unroll
            for (int k = 0; k < 4; ++k) { const f32x4 a = *(const f32x4*)(cw + k * 1536 + c0), b2 = *(const f32x4*)(cw + k * 1536 + c0 + 4);
#pragma unroll
                for (int e = 0; e < 4; ++e) { w[k][e] = a[e]; w[k][4 + e] = b2[e]; } }
            { const f32x4 a = *(const f32x4*)(cb + c0), b2 = *(const f32x4*)(cb + c0 + 4);
#pragma unroll
              for (int e = 0; e < 4; ++e) { bs[e] = a[e]; bs[4 + e] = b2[e]; } }
            const bf16* src = PROJ + (size_t)t0 * NPROJ + C_XBC + c0;
            if ((t0 & (SEQ - 1)) == 0) {
#pragma unroll
                for (int e = 0; e < 8; ++e) { r0[e] = 0.f; r1[e] = 0.f; r2[e] = 0.f; }
            } else { mx::unpack8(*(const v4u*)(src - 3 * (size_t)NPROJ), r0); mx::unpack8(*(const v4u*)(src - 2 * (size_t)NPROJ), r1); mx::unpack8(*(const v4u*)(src - (size_t)NPROJ), r2); }
            v4u raw[16];
#pragma unroll
            for (int i = 0; i < 16; ++i) raw[i] = *(const v4u*)(src + (size_t)i * NPROJ);
#pragma unroll
            for (int i = 0; i < 16; ++i) { float cu[8], o[8]; mx::unpack8(raw[i], cu);
#pragma unroll
                for (int e = 0; e < 8; ++e) { o[e] = silu_f(bs[e] + w[0][e] * r0[e] + w[1][e] * r1[e] + w[2][e] * r2[e] + w[3][e] * cu[e]); r0[e] = r1[e]; r1[e] = r2[e]; r2[e] = cu[e]; }
                v4u ov = {pk2(o[0], o[1]), pk2(o[2], o[3]), pk2(o[4], o[5]), pk2(o[6], o[7])};
                *(v4u*)(XBC + (size_t)(t0 + i) * 1536 + c0) = ov; }
        }
    }
    GRID_BAR(2);

    if (IN(3)) {
#pragma unroll 1
        for (int it = bx; it < 256; it += G) if ((it >> 3) & 1) mx::mlstm_item(lds, ((it >> 4) << 3) | (it & 7), args.variant, wave, PROJ, GATES, INP(11), MIX);
#pragma unroll 1
        for (int it = bx; it < 256; it += G) if (!((it >> 3) & 1)) mx::ssd_item(lds, ((it >> 4) << 3) | (it & 7), args.variant, wave, XBC, PROJ, GATES, INP(6), INP(7), MIX, SSQ);
    }
    GRID_BAR(3);
    if (IN(4)) {
        pg8::Gemm g{MIX, Wout_t, T, 1024, 2048}; pg8::StaticOrder S; S.init(T, 1024, G, bx);
        pg8::EpiResF32 E{XIN, H, 1024, SSQ};
        pg8::gemm_phase<pg8::EpiResF32, pg8::StaticOrder>(lds, g, S, E, wave);
    }

    GRID_BAR(4);
    if (IN(5)) {
        const int tid = fresh_tid(wave), lane = tid & 63; (void)lane;
        LAS int* hist = (LAS int*)(lds + MISC_OFF + 256);
        pt_fill(lds, INP(14), 32, tid, false, INP(13));
        if (tid < 32) hist[tid] = 0;
        __syncthreads();
        const int c16 = lane & 15, g = lane >> 4; const float* wnp = INP(13); const float rb0 = INP(15)[c16], rb1 = INP(15)[16 + c16];
        for (int blk = bx; blk < T / 128; blk += G) {
            const int row0 = blk * 128 + wave * 16; f32x4 acc[2];
            const float rs = rowproj16<true, true>(H, XN8, wnp, lds, row0, lane, acc);
            if (g == 0) RS2[row0 + c16] = rs;
#pragma unroll
            for (int r = 0; r < 4; ++r) { const float rr = __shfl(rs, 4 * g + r); float v0 = rr * acc[0][r] + rb0, v1 = rr * acc[1][r] + rb1; float tv[4]; int ti[4];
#pragma unroll
                for (int k = 0; k < 4; ++k) { float bv = v0 >= v1 ? v0 : v1; int bi = v0 >= v1 ? c16 : c16 + 16;
#define TK_STEP(ctrl) do { const float ov = __builtin_bit_cast(float, __builtin_amdgcn_update_dpp(0, __builtin_bit_cast(int, bv), ctrl, 0xf, 0xf, false)); const int oi = __builtin_amdgcn_update_dpp(0, bi, ctrl, 0xf, 0xf, false); \
                        if (ov > bv || (ov == bv && oi < bi)) { bv = ov; bi = oi; } } while (0)
                    TK_STEP(0xB1); TK_STEP(0x4E); TK_STEP(0x141); TK_STEP(0x140);
#undef TK_STEP
                    tv[k] = bv; ti[k] = bi; if (bi == c16) v0 = -INFINITY; if (bi == c16 + 16) v1 = -INFINITY; }
                const float e1 = __expf(tv[1] - tv[0]), e2 = __expf(tv[2] - tv[0]), e3 = __expf(tv[3] - tv[0]); const float inv = 1.0f / (1.0f + e1 + e2 + e3);
                if (c16 == 0) { const size_t o = (size_t)(row0 + 4 * g + r) * 4; TOPI[o] = ti[0]; TOPI[o + 1] = ti[1]; TOPI[o + 2] = ti[2]; TOPI[o + 3] = ti[3];
                    TOPG[o] = inv; TOPG[o + 1] = e1 * inv; TOPG[o + 2] = e2 * inv; TOPG[o + 3] = e3 * inv;
                    __hip_atomic_fetch_add(hist + ti[0], 1, __ATOMIC_RELAXED, __HIP_MEMORY_SCOPE_WORKGROUP); __hip_atomic_fetch_add(hist + ti[1], 1, __ATOMIC_RELAXED, __HIP_MEMORY_SCOPE_WORKGROUP); __hip_atomic_fetch_add(hist + ti[2], 1, __ATOMIC_RELAXED, __HIP_MEMORY_SCOPE_WORKGROUP); __hip_atomic_fetch_add(hist + ti[3], 1, __ATOMIC_RELAXED, __HIP_MEMORY_SCOPE_WORKGROUP); } }
            __syncthreads();
            if (tid < 32) { BLKCNT[blk * 32 + tid] = hist[tid]; hist[tid] = 0; }
            __syncthreads();
        }
    }
    GRID_BAR(5);
    if (IN(6)) {
        const int tid = fresh_tid(wave), lane = tid & 63; (void)lane;
        LAS int* tot = (LAS int*)lds; LAS int* base = tot + 32; LAS int* pstart = base + 32; LAS int* wcnt = pstart + 33;
        LAS int* arow = wcnt + 256;
        LAS int* psum = arow + 512;
        for (int blk = bx; blk < T / 128; blk += G) {
            { const int e = tid & 31, part = tid >> 5; int v[16], t = 0, b = 0;
#pragma unroll
              for (int j = 0; j < 16; ++j) v[j] = BLKCNT[(part * 16 + j) * 32 + e];
#pragma unroll
              for (int j = 0; j < 16; ++j) { t += v[j]; if (part * 16 + j < blk) b += v[j]; }
              psum[part * 32 + e] = t; psum[512 + part * 32 + e] = b; }
            __syncthreads();
            if (tid < 32) { int t = 0, b = 0;
#pragma unroll
              for (int p = 0; p < 16; ++p) { t += psum[p * 32 + tid]; b += psum[512 + p * 32 + tid]; } tot[tid] = t; base[tid] = b; }
            __syncthreads();
            if (tid == 0) { int s = 0; for (int e = 0; e < 32; ++e) { pstart[e] = s; s += (tot[e] + 255) / 256 * 256; } pstart[32] = s; }
            __syncthreads();
            const int token = blk * 128 + (tid >> 2), k = tid & 3; const int e = TOPI[(size_t)token * 4 + k];
            int rank = 0;
#pragma unroll 1
            for (int ee = 0; ee < 32; ++ee) { const unsigned long long m = __ballot(e == ee); if (e == ee) rank = __popcll(m & ((1ull << lane) - 1ull)); if (lane == 0) wcnt[wave * 32 + ee] = __popcll(m); }
            __syncthreads();
            int off = 0; for (int w = 0; w < wave; ++w) off += wcnt[w * 32 + e];
            const int row = pstart[e] + base[e] + off + rank;
            ROWTOK[row] = token; ROWGATE[row] = TOPG[(size_t)token * 4 + k]; ROWRS[row] = RS2[token]; TOKROW[(size_t)token * 4 + k] = row; arow[tid] = row;
            __syncthreads();
            if (blk < 32) { const int ps = pstart[blk] + tot[blk], pe = pstart[blk + 1];
                for (int r = ps + tid; r < pe; r += NTHR) { ROWTOK[r] = 0; ROWGATE[r] = 0.f; ROWRS[r] = 0.f; } }
            if (blk == 0) { const int nb = pstart[32] / 256; if (tid == 0) NBLK[0] = nb;
                for (int b = tid; b < nb; b += NTHR) { int e2 = 0; while (e2 < 31 && b * 256 >= pstart[e2 + 1]) ++e2; BLKEXP[b] = e2; } }
            __syncthreads();
        }
    }

    GRID_BAR(6);
    if (IN(7)) {
        pg8::Gemm g{(const bf16*)XN8, (const bf16*)Wgu8, MAXROWS, 2048, 512}; pg8::MoeOrder S{BLKEXP, __builtin_amdgcn_readfirstlane(NBLK[0]), 8, G, bx};
        pg8::EpiSwiglu E{ROWTOK, ACT8, INP(17), ROWRS};
        pg8::gemm_phase_f8<pg8::EpiSwiglu, pg8::MoeOrder>(lds, g, S, E, wave, args.variant);
    }
    GRID_BAR(7);
    if (IN(8)) {
        pg8::Gemm g{(const bf16*)ACT8, (const bf16*)Wdn8, MAXROWS, 1024, 512}; pg8::MoeOrder S{BLKEXP, __builtin_amdgcn_readfirstlane(NBLK[0]), 4, G, bx};
        pg8::EpiDown E{nullptr, EO8, INP(19), ROWGATE};
        pg8::gemm_phase_f8<pg8::EpiDown, pg8::MoeOrder>(lds, g, S, E, wave);
    }
    GRID_BAR(8);
    if (IN(9)) {
        const int tid = fresh_tid(wave), lane = tid & 63; (void)lane;
        const int gw = bx * NWAVES + wave, NGW = G * NWAVES;
        f32x4 wf[4];
#pragma unroll
        for (int j = 0; j < 4; ++j) wf[j] = *(const f32x4*)(INP(20) + 4 * lane + 256 * j);
#pragma unroll 1
        for (int row = gw; row < T; row += 2 * NGW) {
            int er[2][4];
#pragma unroll
            for (int q = 0; q < 2; ++q) { const typeof(*(const v4u*)0) t4 = *(const v4u*)(TOKROW + (size_t)(row + q * NGW) * 4); er[q][0] = (int)t4.x; er[q][1] = (int)t4.y; er[q][2] = (int)t4.z; er[q][3] = (int)t4.w; }
            v2u hw[2][4]; int ew[2][4][4];
#pragma unroll
            for (int q = 0; q < 2; ++q)
#pragma unroll
                for (int j = 0; j < 4; ++j) hw[q][j] = *(const v2u*)(H + (size_t)(row + q * NGW) * 1024 + 4 * lane + 256 * j);
#pragma unroll
            for (int q = 0; q < 2; ++q)
#pragma unroll
                for (int k = 0; k < 4; ++k)
#pragma unroll
                    for (int j = 0; j < 4; ++j) ew[q][k][j] = *(const int*)(EO8 + (size_t)er[q][k] * 1024 + 4 * lane + 256 * j);
#pragma unroll
            for (int q = 0; q < 2; ++q) { f32x4 v[4], ya[4]; typedef float f2v __attribute__((ext_vector_type(2)));
#pragma unroll
                for (int j = 0; j < 4; ++j) { v[j] = (f32x4){bflo(hw[q][j].x), bfhi(hw[q][j].x), bflo(hw[q][j].y), bfhi(hw[q][j].y)}; ya[j] = (f32x4){0.f, 0.f, 0.f, 0.f}; }
#pragma unroll
                for (int k = 0; k < 4; ++k)
#pragma unroll
                    for (int j = 0; j < 4; ++j) { const f2v lo = __builtin_amdgcn_cvt_pk_f32_fp8(ew[q][k][j], false), hi = __builtin_amdgcn_cvt_pk_f32_fp8(ew[q][k][j], true); ya[j][0] += lo[0]; ya[j][1] += lo[1]; ya[j][2] += hi[0]; ya[j][3] += hi[1]; }
                float ss = 0.f;
#pragma unroll
                for (int j = 0; j < 4; ++j) { v[j] = v[j] + ya[j] * 0.0625f; ss += (v[j][0] * v[j][0] + v[j][1] * v[j][1]) + (v[j][2] * v[j][2] + v[j][3] * v[j][3]); }
                ss = wave_sum(ss); const float rs = rsqrt_f(ss * (1.0f / 1024.0f) + RMS_EPS);
#pragma unroll
                for (int j = 0; j < 4; ++j) *(f32x4*)(args.out + (size_t)(row + q * NGW) * 1024 + 4 * lane + 256 * j) = v[j] * rs * wf[j]; }
        }
    }
#undef IN
}

extern "C" void kernel_launch(void* const* d_in, const int* in_sizes, int n_in, void* d_out, int out_size, void* d_ws, size_t ws_size, hipStream_t stream) {
    static int grid = 0;
    if (grid == 0) {
        if (n_in != 21 || in_sizes[0] != T * D || out_size != T * D || ws_size < WS_END) { fprintf(stderr, "kernel_launch: unexpected shapes/workspace (n_in %d, ws %zu, need %zu)\n", n_in, ws_size, (size_t)WS_END); grid = -1; return; }
        if (hipFuncSetAttribute((const void*)mega, hipFuncAttributeMaxDynamicSharedMemorySize, LDS_BYTES) != hipSuccess) { fprintf(stderr, "kernel_launch: hipFuncSetAttribute failed\n"); grid = -1; return; }
        int dev = 0, cus = 0, per_cu = 0;
        if (hipGetDevice(&dev) != hipSuccess || hipDeviceGetAttribute(&cus, hipDeviceAttributeMultiprocessorCount, dev) != hipSuccess) { grid = -1; return; }
        if (hipOccupancyMaxActiveBlocksPerMultiprocessor(&per_cu, (const void*)mega, NTHR, LDS_BYTES) != hipSuccess || per_cu < 1) { fprintf(stderr, "kernel_launch: occupancy query says %d blocks per CU\n", per_cu); grid = -1; return; }
        (void)hipGetLastError();
        grid = cus;
    }
    if (grid < 0) return;
    (void)hipMemsetAsync((char*)d_ws + WS_CTL + (size_t)CW_BAR * 4, 0, (size_t)XCD_BAR_WORDS * 4, stream);
    Args a{};
    for (int i = 0; i < 21; ++i) a.in[i] = (const float*)d_in[i];
    a.out = (float*)d_out; a.ws = (unsigned char*)d_ws;
    a.ph_lo = 0; a.ph_hi = 10;
    hipLaunchKernelGGL(mega, dim3(grid), dim3(NTHR), LDS_BYTES, stream, a);
#ifdef PROBE_PHASE
    a.ph_lo = PROBE_PHASE; a.ph_hi = PROBE_PHASE + 1;
#ifdef PROBE_VARIANT
    a.variant = PROBE_VARIANT;
#endif
    hipLaunchKernelGGL(mega, dim3(grid), dim3(NTHR), LDS_BYTES, stream, a);
#endif
}
```

```cpp
#define WGM_SET 2
#include <hip/hip_runtime.h>
#include <cstdio>
#include <cstdint>

__device__ __forceinline__ int lane_id() { int l; asm volatile("v_mbcnt_lo_u32_b32 %0, -1, 0\n\tv_mbcnt_hi_u32_b32 %0, -1, %0" : "=v"(l)); return l; }
__device__ __forceinline__ void probe_spin(unsigned long long ticks) { const unsigned long long t0 = __builtin_amdgcn_s_memrealtime(); while (__builtin_amdgcn_s_memrealtime() - t0 < ticks) __builtin_amdgcn_s_sleep(8); }
namespace pg8 {
#define PG8_LAS __attribute__((address_space(3)))
typedef unsigned short bf16_t;
typedef short bf16x8 __attribute__((ext_vector_type(8)));
typedef float f32x4 __attribute__((ext_vector_type(4)));
typedef unsigned u32x4 __attribute__((ext_vector_type(4)));
#ifndef WGM_SET
#define WGM_SET 8
#endif
constexpr int BM = 256, BK = 64, HALF = 128, HTB = HALF * BK * 2, STAGE_BYTES = 8 * HTB, NXCD = 8, WGM = WGM_SET;

__host__ __device__ __forceinline__ int lds_byte(int r, int c) { const int st = (r >> 4) * 2 + (c >> 5), rr = r & 15, cc = c & 31, ob = rr * 64 + cc * 2; return st * 1024 + (ob ^ (((ob >> 9) & 1) << 5)); }
__host__ __device__ __forceinline__ void stage_rc(int b, int& R, int& C) { const int st = b / 1024, sb = b % 1024, swz = sb ^ (((sb >> 9) & 1) << 5); R = (st >> 1) * 16 + swz / 64; C = (st & 1) * 32 + (swz % 64) / 2; }
__host__ __device__ __forceinline__ int perm32(int rho) { const int n = rho >> 4, i = rho & 15; return 8 * (i >> 2) + 4 * n + (i & 3); }

__device__ __forceinline__ const char* uni_ptr(const void* p) { const unsigned long long v = (unsigned long long)p; const unsigned lo = __builtin_amdgcn_readfirstlane((unsigned)v), hi = __builtin_amdgcn_readfirstlane((unsigned)(v >> 32)); return (const char*)(((unsigned long long)hi << 32) | lo); }
struct Unit { int pm, pn, pb, e; };
struct Gemm { const bf16_t* A; const bf16_t* Bt; int M, N, K; };

struct StaticOrder {
    int nM, nN, nwg, G, c;
    __host__ __device__ void init(int M, int N, int G_, int c_) { nM = M / BM; nN = N / BM; nwg = nM * nN; G = G_; c = c_; }
    __host__ __device__ bool next(int i, Unit& u) const {
        const long L = (long)i * G + c; if (L >= nwg) return false;
        int wgid = (int)L; { const int q = nwg / NXCD, r = nwg % NXCD, xcd = wgid % NXCD, off = wgid / NXCD; wgid = (xcd < r ? xcd * (q + 1) : r * (q + 1) + (xcd - r) * q) + off; }
        const int nig = WGM * nN, gid = wgid / nig, fm = gid * WGM, gsz = (nM - fm) < WGM ? (nM - fm) : WGM;
        u.pm = fm + ((wgid % nig) % gsz); u.pn = (wgid % nig) / gsz; u.pb = u.pn; u.e = 0; return true;
    }
};
struct MoeOrder {
    const int* blk_expert; int nblk, ntn, G, c;
    __device__ bool next(int i, Unit& u) const {
        const int xcd = c % NXCD, s = i * (G / NXCD) + c / NXCD;
        const int rb = (s / ntn) * NXCD + xcd; if (rb >= nblk) return false;
        u.pm = rb; u.pn = s % ntn; u.e = __builtin_amdgcn_readfirstlane(blk_expert[rb]); u.pb = u.e * ntn + u.pn; return true;
    }
};

__device__ __forceinline__ unsigned cvt_pk_bf16(float lo, float hi) { unsigned r; asm volatile("v_cvt_pk_bf16_f32 %0, %1, %2" : "=v"(r) : "v"(lo), "v"(hi)); return r; }

struct EpiBf16 {
    static constexpr bool PERM = true; static constexpr int MIDT = -1;
    __device__ __forceinline__ void mid(f32x4 (&)[2][2][4][2], const Unit&, int, int) const {}
    bf16_t* O; int ldc; const float* rs;
    static constexpr bool HAS_ROWTAB = true;
    __device__ __forceinline__ const float* rowtab(const Unit& u) const { return rs + (size_t)u.pm * BM; }
    __device__ __forceinline__ void operator()(const f32x4 (&acc)[2][2][4][2], const Unit& u, int wr, int wc, int fr, int fq, const PG8_LAS float* rt) const {
        const int row0 = u.pm * BM + wr * 64 + fr, col0 = u.pn * BM + wc * 32 + 8 * fq;
#pragma unroll
        for (int ai = 0; ai < 2; ++ai)
#pragma unroll
            for (int m = 0; m < 4; ++m) { const int row = row0 + ai * HALF + m * 16; const float rr = rt[ai * HALF + wr * 64 + m * 16 + fr]; bf16_t* rowp = O + (size_t)row * ldc + col0;
#pragma unroll
                for (int bj = 0; bj < 2; ++bj) { const f32x4 v0 = acc[ai][bj][m][0] * rr, v1 = acc[ai][bj][m][1] * rr;
                    u32x4 w; w.x = cvt_pk_bf16(v0[0], v0[1]); w.y = cvt_pk_bf16(v0[2], v0[3]); w.z = cvt_pk_bf16(v1[0], v1[1]); w.w = cvt_pk_bf16(v1[2], v1[3]);
                    *(u32x4*)(rowp + bj * HALF) = w; } }
    }
};
struct EpiResF32 {
    static constexpr bool PERM = true; static constexpr int MIDT = 16;
    const float* base; bf16_t* C; int ldc; const float* ssq;
    __device__ __forceinline__ void mid(f32x4 (&acc)[2][2][4][2], const Unit& u, int wr, int fr) const {
#pragma unroll
        for (int ai = 0; ai < 2; ++ai)
#pragma unroll
            for (int m = 0; m < 4; ++m) { const int row = u.pm * BM + ai * HALF + wr * 64 + m * 16 + fr; const f32x4 a = *(const f32x4*)(ssq + (size_t)row * 8), b = *(const f32x4*)(ssq + (size_t)row * 8 + 4);
                const float rs = 1.0f / sqrtf(((a[0] + a[1]) + (a[2] + a[3]) + (b[0] + b[1]) + (b[2] + b[3])) * (1.0f / 1024.0f) + 1e-6f);
#pragma unroll
                for (int bj = 0; bj < 2; ++bj)
#pragma unroll
                    for (int n = 0; n < 2; ++n) acc[ai][bj][m][n] = acc[ai][bj][m][n] * rs;
                asm volatile("" ::: "memory"); }
    }
    static constexpr bool HAS_ROWTAB = false;
    __device__ __forceinline__ const float* rowtab(const Unit&) const { return nullptr; }
    __device__ __forceinline__ void operator()(const f32x4 (&acc)[2][2][4][2], const Unit& u, int wr, int wc, int fr, int fq, const PG8_LAS float*) const {
        const int row0 = u.pm * BM + wr * 64 + fr, col0 = u.pn * BM + wc * 32 + 8 * fq;
#pragma unroll
        for (int ai = 0; ai < 2; ++ai)
#pragma unroll
            for (int m = 0; m < 4; ++m) { const size_t off = (size_t)(row0 + ai * HALF + m * 16) * ldc + col0;
#pragma unroll
                for (int bj = 0; bj < 2; ++bj) { const f32x4 b0 = *(const f32x4*)(base + off + bj * HALF), b1 = *(const f32x4*)(base + off + bj * HALF + 4);
                    const f32x4 v0 = acc[ai][bj][m][0] + b0, v1 = acc[ai][bj][m][1] + b1;
                    u32x4 w; w.x = cvt_pk_bf16(v0[0], v0[1]); w.y = cvt_pk_bf16(v0[2], v0[3]); w.z = cvt_pk_bf16(v1[0], v1[1]); w.w = cvt_pk_bf16(v1[2], v1[3]);
                    *(u32x4*)(C + off + bj * HALF) = w; } }
    }
};
struct EpiSwiglu {
    static constexpr bool PERM = true; static constexpr int MIDT = -1;
    __device__ __forceinline__ void mid(f32x4 (&)[2][2][4][2], const Unit&, int, int) const {}
    static constexpr bool GATHER = true; const int* rowtok;
    unsigned char* act; const float* bgu; const float* rs;
    __device__ __forceinline__ const float* rowtab(const Unit& u) const { return rs + (size_t)u.pm * BM; }
    __device__ __forceinline__ const float* coltab(const Unit& u, int q) const { return bgu + (size_t)u.e * 2048 + u.pn * HALF + (q >> 1) * 1024 + (q & 1) * 64; }
    __device__ __forceinline__ void operator()(const f32x4 (&acc)[2][2][4][2], const Unit& u, int wr, int wc, int fr, int fq, const PG8_LAS float* tab) const {
        const int row0 = u.pm * BM + wr * 64 + fr, col0 = u.pn * HALF + wc * 32 + 8 * fq;
        const PG8_LAS float* ct = tab + 256 + wc * 32 + 8 * fq;
        f32x4 bgv[2], buv[2];
#pragma unroll
        for (int n = 0; n < 2; ++n) { bgv[n] = *(const PG8_LAS f32x4*)(ct + 4 * n); buv[n] = *(const PG8_LAS f32x4*)(ct + 128 + 4 * n); }
#pragma unroll
        for (int ai = 0; ai < 2; ++ai)
#pragma unroll
            for (int m = 0; m < 4; ++m) { const int row = row0 + ai * HALF + m * 16; const float rr = tab[ai * HALF + wr * 64 + m * 16 + fr]; unsigned char* rowp = act + (size_t)row * 1024 + col0;
                float o[8];
#pragma unroll
                for (int n = 0; n < 2; ++n) { typedef float f2 __attribute__((ext_vector_type(2)));
#pragma unroll
                    for (int h = 0; h < 2; ++h) { const f2 ag = {acc[ai][0][m][n][2 * h], acc[ai][0][m][n][2 * h + 1]}, au = {acc[ai][1][m][n][2 * h], acc[ai][1][m][n][2 * h + 1]};
                        const f2 bg2 = {bgv[n][2 * h], bgv[n][2 * h + 1]}, bu2 = {buv[n][2 * h], buv[n][2 * h + 1]};
                        f2 gv = ag * rr + bg2, uv = au * rr + bu2;
                        gv.x = fminf(gv.x, 7.0f); gv.y = fminf(gv.y, 7.0f); uv.x = __builtin_amdgcn_fmed3f(uv.x, -7.0f, 7.0f); uv.y = __builtin_amdgcn_fmed3f(uv.y, -7.0f, 7.0f);
                        const f2 t = gv * (-1.702f * 1.44269504f); f2 e; e.x = __builtin_amdgcn_exp2f(t.x); e.y = __builtin_amdgcn_exp2f(t.y);
                        const f2 d = e + 1.0f; f2 r; r.x = __builtin_amdgcn_rcpf(d.x); r.y = __builtin_amdgcn_rcpf(d.y);
                        const f2 res = ((uv + 1.0f) * gv) * r; o[4 * n + 2 * h] = res.x; o[4 * n + 2 * h + 1] = res.y; } }
                int w0 = 0, w1 = 0; w0 = __builtin_amdgcn_cvt_pk_fp8_f32(o[0], o[1], w0, false); w0 = __builtin_amdgcn_cvt_pk_fp8_f32(o[2], o[3], w0, true); w1 = __builtin_amdgcn_cvt_pk_fp8_f32(o[4], o[5], w1, false); w1 = __builtin_amdgcn_cvt_pk_fp8_f32(o[6], o[7], w1, true);
                typedef int i2v __attribute__((ext_vector_type(2))); *(i2v*)rowp = (i2v){w0, w1}; }
    }
};
struct EpiDown {
    static constexpr bool PERM = true; static constexpr int MIDT = -1;
    __device__ __forceinline__ void mid(f32x4 (&)[2][2][4][2], const Unit&, int, int) const {}
    static constexpr bool GATHER = false; const int* rowtok;
    unsigned char* eo; const float* bdn; const float* row_gate;
    __device__ __forceinline__ const float* rowtab(const Unit& u) const { return row_gate + (size_t)u.pm * BM; }
    __device__ __forceinline__ const float* coltab(const Unit& u, int q) const { return bdn + (size_t)u.e * 1024 + u.pn * BM + q * 64; }
    __device__ __forceinline__ void operator()(const f32x4 (&acc)[2][2][4][2], const Unit& u, int wr, int wc, int fr, int fq, const PG8_LAS float* tab) const {
        const int row0 = u.pm * BM + wr * 64 + fr, col0 = u.pn * BM + wc * 32 + 8 * fq;
        const PG8_LAS float* ct = tab + 256 + wc * 32 + 8 * fq;
        f32x4 bv[2][2];
#pragma unroll
        for (int bj = 0; bj < 2; ++bj)
#pragma unroll
            for (int n = 0; n < 2; ++n) bv[bj][n] = *(const PG8_LAS f32x4*)(ct + bj * HALF + 4 * n);
#pragma unroll
        for (int ai = 0; ai < 2; ++ai)
#pragma unroll
            for (int m = 0; m < 4; ++m) { const int row = row0 + ai * HALF + m * 16; const float gt = tab[ai * HALF + wr * 64 + m * 16 + fr] * 16.0f; unsigned char* rowp = eo + (size_t)row * 1024 + col0;
#pragma unroll
                for (int bj = 0; bj < 2; ++bj) { f32x4 v0 = (acc[ai][bj][m][0] + bv[bj][0]) * gt, v1 = (acc[ai][bj][m][1] + bv[bj][1]) * gt;
#pragma unroll
                    for (int i = 0; i < 4; ++i) { v0[i] = __builtin_amdgcn_fmed3f(v0[i], -448.0f, 448.0f); v1[i] = __builtin_amdgcn_fmed3f(v1[i], -448.0f, 448.0f); }
                    int w0 = 0, w1 = 0; w0 = __builtin_amdgcn_cvt_pk_fp8_f32(v0[0], v0[1], w0, false); w0 = __builtin_amdgcn_cvt_pk_fp8_f32(v0[2], v0[3], w0, true); w1 = __builtin_amdgcn_cvt_pk_fp8_f32(v1[0], v1[1], w1, false); w1 = __builtin_amdgcn_cvt_pk_fp8_f32(v1[2], v1[3], w1, true);
                    typedef int i2v __attribute__((ext_vector_type(2))); *(i2v*)(rowp + bj * HALF) = (i2v){w0, w1}; } }
    }
};

typedef int v8i_t __attribute__((ext_vector_type(8)));
typedef int v4i_t __attribute__((ext_vector_type(4)));
template <class Epi, class Sched>
__device__ __forceinline__ void gemm_phase(PG8_LAS unsigned char* lds, const Gemm g, const Sched& S, const Epi& E, int wid) {
    const int lane = lane_id(), tid = wid * 64 + lane, wr = wid >> 2, wc = wid & 3, fr = lane & 15, fq = lane >> 4;
    const int K = g.K, nt = K / BK;
    unsigned voffA[2], voffB[2];
#pragma unroll
    for (int i = 0; i < 2; ++i) { int R, C; stage_rc(tid * 16 + i * 8192, R, C); const int Rb = Epi::PERM ? ((R & ~31) + perm32(R & 31)) : R;
        voffA[i] = (unsigned)(R * K + C) * 2u; voffB[i] = (unsigned)(Rb * K + C) * 2u; }
    const size_t kstep = (size_t)(BK * 2);
    const size_t hstep = (size_t)HALF * K * 2;
    const size_t tstep = 2 * hstep;
    const unsigned ldsw = (unsigned)wid * 1024u;
    const int aoff = lds_byte(wr * 64 + fr, fq * 8), boff = lds_byte(wc * 32 + fr, fq * 8);
#define PG8_SA(b, h) (((b) * 2 + (h)) * HTB)
#define PG8_SB(b, h) ((4 + (b) * 2 + (h)) * HTB)
#define PG8_STAGE(bufoff, gbase, voff) do { _Pragma("unroll") for (int _i = 0; _i < 2; ++_i) \
        __builtin_amdgcn_global_load_lds((const unsigned*)((const char*)(gbase) + (voff)[_i]), (PG8_LAS unsigned*)(lds + (bufoff) + ldsw + _i * 8192), 16, 0, 0); } while (0)
#define PG8_LDA(dst, b, h) do { _Pragma("unroll") for (int m = 0; m < 4; ++m) _Pragma("unroll") for (int k = 0; k < 2; ++k) dst[m][k] = *(const PG8_LAS bf16x8*)(lds + PG8_SA(b, h) + aoff + m * 2048 + k * 1024); } while (0)
#define PG8_LDB(dst, b, h) do { _Pragma("unroll") for (int n = 0; n < 2; ++n) _Pragma("unroll") for (int k = 0; k < 2; ++k) dst[n][k] = *(const PG8_LAS bf16x8*)(lds + PG8_SB(b, h) + boff + n * 2048 + k * 1024); } while (0)
#define PG8_MMA(ai, bj, At, Bt) do { __builtin_amdgcn_s_setprio(1); _Pragma("unroll") for (int m = 0; m < 4; ++m) _Pragma("unroll") for (int n = 0; n < 2; ++n) _Pragma("unroll") for (int k = 0; k < 2; ++k) \
        acc[ai][bj][m][n] = __builtin_amdgcn_mfma_f32_16x16x32_bf16(Bt[n][k], At[m][k], acc[ai][bj][m][n], 0, 0, 0); __builtin_amdgcn_s_setprio(0); } while (0)
#define PG8_WAIT_V(n) asm volatile("s_waitcnt vmcnt(" #n ")" ::: "memory")
#define PG8_WAIT_L(n) asm volatile("s_waitcnt lgkmcnt(" #n ")" ::: "memory")
#define PG8_BAR __builtin_amdgcn_s_barrier()
#define PG8_SCHED __builtin_amdgcn_sched_barrier(0)
    Unit cur, nxt; int ui = 0;
    if (!S.next(0, cur)) return;
    f32x4 acc[2][2][4][2];
#pragma unroll
    for (int a = 0; a < 2; ++a)
#pragma unroll
        for (int b = 0; b < 2; ++b)
#pragma unroll
            for (int m = 0; m < 4; ++m)
#pragma unroll
                for (int n = 0; n < 2; ++n) acc[a][b][m][n] = (f32x4){0.f, 0.f, 0.f, 0.f};
    bf16x8 At[4][2], B0[2][2], B1[2][2];
    const char* cA = uni_ptr((const char*)g.A + (size_t)cur.pm * tstep); const char* cB = uni_ptr((const char*)g.Bt + (size_t)cur.pb * tstep);
#define PG8_ROWTAB(u_, slot_) do { if (Epi::HAS_ROWTAB && wid < 4) __builtin_amdgcn_global_load_lds((const unsigned*)(E.rowtab(u_) + wid * 64 + lane), (PG8_LAS unsigned*)(lds + STAGE_BYTES + (slot_) * 1024 + wid * 256), 4, 0, 0); } while (0)
    PG8_ROWTAB(cur, 0);
    PG8_STAGE(PG8_SB(0, 0), cB, voffB); PG8_STAGE(PG8_SB(0, 1), cB + hstep, voffB); PG8_STAGE(PG8_SA(0, 0), cA, voffA); PG8_STAGE(PG8_SA(0, 1), cA + hstep, voffA);
    if (wr == 1) PG8_BAR;
    PG8_WAIT_V(2); PG8_BAR;
    PG8_STAGE(PG8_SB(1, 0), cB + kstep, voffB); PG8_STAGE(PG8_SA(1, 0), cA + kstep, voffA); PG8_STAGE(PG8_SB(1, 1), cB + hstep + kstep, voffB);
    PG8_WAIT_V(6); PG8_BAR;
    for (;;) {
        const bool has_next = S.next(ui + 1, nxt);
        const char* nA = uni_ptr(has_next ? (const char*)g.A + (size_t)nxt.pm * tstep : cA); const char* nB = uni_ptr(has_next ? (const char*)g.Bt + (size_t)nxt.pb * tstep : cB);
        for (int t = 0; t < nt; t += 2) {
            const bool last = (t == nt - 2);
            const char* a1 = cA + (size_t)(t + 1) * kstep;
            const char* a2 = last ? nA : cA + (size_t)(t + 2) * kstep; const char* b2 = last ? nB : cB + (size_t)(t + 2) * kstep;
            const char* a3 = a2 + kstep; const char* b3 = b2 + kstep;
            if constexpr (Epi::MIDT >= 0) { if (t == Epi::MIDT) E.mid(acc, cur, wr, fr); }
            PG8_LDB(B0, 0, 0); PG8_LDB(B1, 0, 1); PG8_SCHED; PG8_LDA(At, 0, 0); PG8_STAGE(PG8_SA(1, 1), a1 + hstep, voffA);
            PG8_WAIT_V(8); PG8_WAIT_L(0); PG8_BAR; PG8_MMA(0, 0, At, B0); PG8_MMA(0, 1, At, B1); PG8_BAR; PG8_SCHED;
            PG8_LDA(At, 0, 1); PG8_STAGE(PG8_SB(0, 0), b2, voffB); PG8_STAGE(PG8_SB(0, 1), b2 + hstep, voffB); PG8_STAGE(PG8_SA(0, 0), a2, voffA);
            PG8_WAIT_V(8); PG8_WAIT_L(0); PG8_BAR; PG8_MMA(1, 0, At, B0); PG8_MMA(1, 1, At, B1); PG8_BAR; PG8_SCHED;
            PG8_LDB(B0, 1, 0); PG8_LDB(B1, 1, 1); PG8_SCHED; PG8_LDA(At, 1, 0); PG8_STAGE(PG8_SA(0, 1), a2 + hstep, voffA);
            PG8_WAIT_V(8); PG8_WAIT_L(0); PG8_BAR; PG8_MMA(0, 0, At, B0); PG8_MMA(0, 1, At, B1); PG8_BAR; PG8_SCHED;
            PG8_LDA(At, 1, 1); PG8_STAGE(PG8_SB(1, 0), b3, voffB); PG8_STAGE(PG8_SB(1, 1), b3 + hstep, voffB); PG8_STAGE(PG8_SA(1, 0), a3, voffA);
            PG8_WAIT_V(8); PG8_WAIT_L(0); PG8_BAR; PG8_MMA(1, 0, At, B0); PG8_MMA(1, 1, At, B1); PG8_BAR; PG8_SCHED;
        }
        if (wr == 0) PG8_BAR;
        E(acc, cur, wr, wc, fr, fq, (const PG8_LAS float*)(lds + STAGE_BYTES + (ui & 1) * 1024));
        if (!has_next) break;
#pragma unroll
        for (int a = 0; a < 2; ++a)
#pragma unroll
            for (int b = 0; b < 2; ++b)
#pragma unroll
                for (int m = 0; m < 4; ++m)
#pragma unroll
                    for (int n = 0; n < 2; ++n) acc[a][b][m][n] = (f32x4){0.f, 0.f, 0.f, 0.f};
        cur = nxt; cA = nA; cB = nB; ++ui;
        PG8_ROWTAB(cur, ui & 1);
        if (wr == 1) PG8_BAR;
    }
    PG8_WAIT_V(0);
    PG8_BAR;
#undef PG8_ROWTAB
#undef PG8_SA
#undef PG8_SB
#undef PG8_STAGE
#undef PG8_LDA
#undef PG8_LDB
#undef PG8_MMA
#undef PG8_WAIT_V
#undef PG8_WAIT_L
#undef PG8_BAR
#undef PG8_SCHED
}
template <class Epi, class Sched>
__device__ __forceinline__ void gemm_phase_f8(PG8_LAS unsigned char* lds, const Gemm g, const Sched& S, const Epi& E, int wid, int var = 0) {
    const int lane = lane_id(), tid = wid * 64 + lane, wr = wid >> 2, wc = wid & 3, fr = lane & 15, fq = lane >> 4;
    int Kq = g.K; asm volatile("" : "+s"(Kq));
    const int K = Kq, nt = K / BK;
    unsigned voffA[2], voffB[2];
#pragma unroll
    for (int i = 0; i < 2; ++i) { int R, C; stage_rc(tid * 16 + i * 8192, R, C); const int Rb = Epi::PERM ? ((R & ~31) + perm32(R & 31)) : R;
        voffA[i] = (unsigned)(R * K + C) * 2u; voffB[i] = (unsigned)(Rb * K + C) * 2u; }
    const size_t kstep = (size_t)(BK * 2);
    const size_t hstep = (size_t)HALF * K * 2;
    const size_t tstep = 2 * hstep;
    const unsigned ldsw = (unsigned)wid * 1024u;
    const unsigned ldsb = (unsigned)__builtin_amdgcn_readfirstlane((int)((unsigned)(size_t)lds + ldsw));
    const int aoff = lds_byte(wr * 64 + fr, fq * 8), boff = lds_byte(wc * 32 + fr, fq * 8);
#define PG8_SA(b, h) (((b) * 2 + (h)) * HTB)
#define PG8_SB(b, h) ((4 + (b) * 2 + (h)) * HTB)
#define PG8_STAGE(bufoff, gbase, voff) do { _Pragma("unroll") for (int _i = 0; _i < 2; ++_i) { unsigned _keep; \
        asm volatile("s_mov_b32 %0, m0\n\ts_mov_b32 m0, %3\n\ts_nop 0\n\tglobal_load_lds_dwordx4 %1, %2\n\ts_mov_b32 m0, %0" : "=&s"(_keep) : "v"((voff)[_i]), "s"((const char*)(gbase)), "s"(ldsb + (unsigned)((bufoff) + _i * 8192)) : "memory"); } } while (0)
#define PG8_STAGE_A(b, h, ka) do { if constexpr (Epi::GATHER) { _Pragma("unroll") for (int _i = 0; _i < 2; ++_i) { unsigned _keep; const unsigned _vo = (((voffA[_i] >> (16 * (h))) & 0xffffu) << 10) + cbA; \
        asm volatile("s_mov_b32 %0, m0\n\ts_mov_b32 m0, %3\n\ts_nop 0\n\tglobal_load_lds_dwordx4 %1, %2\n\ts_mov_b32 m0, %0" : "=&s"(_keep) : "v"(_vo), "s"((const char*)(ka)), "s"(ldsb + (unsigned)(PG8_SA(b, h) + _i * 8192)) : "memory"); } } \
    else PG8_STAGE(PG8_SA(b, h), (ka) + (h) * hstep, voffA); } while (0)
#define PG8_LDA(dst, b, h) do { _Pragma("unroll") for (int m = 0; m < 4; ++m) { const v4i_t _lo = *(const PG8_LAS v4i_t*)(lds + PG8_SA(b, h) + aoff + m * 2048), _hi = *(const PG8_LAS v4i_t*)(lds + PG8_SA(b, h) + aoff + m * 2048 + 1024); dst[m] = __builtin_shufflevector(_lo, _hi, 0, 1, 2, 3, 4, 5, 6, 7); } } while (0)
#define PG8_LDB(dst, b, h) do { _Pragma("unroll") for (int n = 0; n < 2; ++n) { const v4i_t _lo = *(const PG8_LAS v4i_t*)(lds + PG8_SB(b, h) + boff + n * 2048), _hi = *(const PG8_LAS v4i_t*)(lds + PG8_SB(b, h) + boff + n * 2048 + 1024); dst[n] = __builtin_shufflevector(_lo, _hi, 0, 1, 2, 3, 4, 5, 6, 7); } } while (0)
#define PG8_MMA(ai, bj, At, Bt) do { __builtin_amdgcn_s_setprio(1); _Pragma("unroll") for (int m = 0; m < 4; ++m) _Pragma("unroll") for (int n = 0; n < 2; ++n) \
        acc[ai][bj][m][n] = __builtin_amdgcn_mfma_scale_f32_16x16x128_f8f6f4(Bt[n], At[m], acc[ai][bj][m][n], 0, 0, 0, 0x79797979, 0, 0x7f7f7f7f); __builtin_amdgcn_s_setprio(0); } while (0)
#define PG8_WAIT_V(n) asm volatile("s_waitcnt vmcnt(" #n ")" ::: "memory")
#define PG8_WAIT_L(n) asm volatile("s_waitcnt lgkmcnt(" #n ")" ::: "memory")
#define PG8_BAR __builtin_amdgcn_s_barrier()
#define PG8_SCHED __builtin_amdgcn_sched_barrier(0)
#ifdef PROBE_GEMM
    unsigned long long p_acc = 0;
#endif
    Unit cur, nxt; int ui = 0;
    if (!S.next(0, cur)) return;
    f32x4 acc[2][2][4][2];
#pragma unroll
    for (int a = 0; a < 2; ++a)
#pragma unroll
        for (int b = 0; b < 2; ++b)
#pragma unroll
            for (int m = 0; m < 4; ++m)
#pragma unroll
                for (int n = 0; n < 2; ++n) acc[a][b][m][n] = (f32x4){0.f, 0.f, 0.f, 0.f};
    v8i_t At[4], B0[2], B1[2];
    const char* cA = uni_ptr((const char*)g.A + (Epi::GATHER ? (size_t)0 : (size_t)cur.pm * tstep)); const char* cB = uni_ptr((const char*)g.Bt + (size_t)cur.pb * tstep);
    unsigned cbA = 0;
    if constexpr (Epi::GATHER) { int R, C; stage_rc(tid * 16, R, C); cbA = (unsigned)C * 2u; const int* rt = E.rowtok + (size_t)cur.pm * BM + R;
        const int t00 = rt[0], t01 = rt[64], t10 = rt[128], t11 = rt[192]; voffA[0] = (unsigned)t00 | ((unsigned)t10 << 16); voffA[1] = (unsigned)t01 | ((unsigned)t11 << 16); }
#define PG8_TABS(u_, slot_) do { const char* _src = uni_ptr(wid < 4 ? E.rowtab(u_) + wid * 64 : E.coltab(u_, wid - 4)); unsigned _keep; \
        asm volatile("s_mov_b32 %0, m0\n\ts_mov_b32 m0, %3\n\ts_nop 0\n\tglobal_load_lds_dword %1, %2\n\ts_mov_b32 m0, %0" : "=&s"(_keep) : "v"(lane_id() * 4), "s"(_src), "s"(ldsb - ldsw + (unsigned)(STAGE_BYTES + (slot_) * 2048) + (unsigned)wid * 256u) : "memory"); } while (0)
    PG8_TABS(cur, 0);
    PG8_STAGE(PG8_SB(0, 0), cB, voffB); PG8_STAGE(PG8_SB(0, 1), cB + hstep, voffB); PG8_STAGE_A(0, 0, cA); PG8_STAGE_A(0, 1, cA);
    if (wr == 1) PG8_BAR;
    PG8_WAIT_V(2); PG8_BAR;
    PG8_STAGE(PG8_SB(1, 0), cB + kstep, voffB); PG8_STAGE_A(1, 0, cA + kstep); PG8_STAGE(PG8_SB(1, 1), cB + hstep + kstep, voffB);
    PG8_WAIT_V(6); PG8_BAR;
    for (;;) {
        const bool has_next = S.next(ui + 1, nxt);
        const char* nA = uni_ptr(has_next && !Epi::GATHER ? (const char*)g.A + (size_t)nxt.pm * tstep : cA); const char* nB = uni_ptr(has_next ? (const char*)g.Bt + (size_t)nxt.pb * tstep : cB);
        if constexpr (Epi::GATHER) { if (has_next && wid < 4) { const char* _src = uni_ptr(E.rowtok + (size_t)nxt.pm * BM + wid * 64); unsigned _keep;
            asm volatile("s_mov_b32 %0, m0\n\ts_mov_b32 m0, %3\n\ts_nop 0\n\tglobal_load_lds_dword %1, %2\n\ts_mov_b32 m0, %0" : "=&s"(_keep) : "v"(lane_id() * 4), "s"(_src), "s"(ldsb - ldsw + (unsigned)(STAGE_BYTES + 4096) + (unsigned)wid * 256u) : "memory"); } }
#ifdef PROBE_GEMM
        unsigned long long pt0 = 0; if (var && PROBE_GEMM == 1) pt0 = __builtin_amdgcn_s_memrealtime();
#endif
        for (int t = 0; t < nt; t += 2) {
            const bool last = (t == nt - 2);
            const char* a1 = cA + (size_t)(t + 1) * kstep;
            const char* a2 = last ? nA : cA + (size_t)(t + 2) * kstep; const char* b2 = last ? nB : cB + (size_t)(t + 2) * kstep;
            const char* a3 = a2 + kstep; const char* b3 = b2 + kstep;
            if constexpr (Epi::MIDT >= 0) { if (t == Epi::MIDT) E.mid(acc, cur, wr, fr); }
            PG8_LDB(B0, 0, 0); PG8_LDB(B1, 0, 1); PG8_SCHED; PG8_LDA(At, 0, 0); PG8_STAGE_A(1, 1, a1);
            PG8_WAIT_V(8); PG8_WAIT_L(0); PG8_BAR; PG8_MMA(0, 0, At, B0); PG8_MMA(0, 1, At, B1); PG8_BAR; PG8_SCHED;
            if constexpr (Epi::GATHER) { if (last && has_next) {
                const PG8_LAS int* tk = (const PG8_LAS int*)(lds + STAGE_BYTES + 4096) + (wid >> 1) * 16 + (lane_id() >> 2);
                const int t00 = tk[0], t01 = tk[64], t10 = tk[128], t11 = tk[192]; voffA[0] = (unsigned)t00 | ((unsigned)t10 << 16); voffA[1] = (unsigned)t01 | ((unsigned)t11 << 16); } }
            PG8_LDA(At, 0, 1); PG8_STAGE(PG8_SB(0, 0), b2, voffB); PG8_STAGE(PG8_SB(0, 1), b2 + hstep, voffB); PG8_STAGE_A(0, 0, a2);
            PG8_WAIT_V(8); PG8_WAIT_L(0); PG8_BAR; PG8_MMA(1, 0, At, B0); PG8_MMA(1, 1, At, B1); PG8_BAR; PG8_SCHED;
            PG8_LDB(B0, 1, 0); PG8_LDB(B1, 1, 1); PG8_SCHED; PG8_LDA(At, 1, 0); PG8_STAGE_A(0, 1, a2);
            PG8_WAIT_V(8); PG8_WAIT_L(0); PG8_BAR; PG8_MMA(0, 0, At, B0); PG8_MMA(0, 1, At, B1); PG8_BAR; PG8_SCHED;
            PG8_LDA(At, 1, 1); PG8_STAGE(PG8_SB(1, 0), b3, voffB); PG8_STAGE(PG8_SB(1, 1), b3 + hstep, voffB); PG8_STAGE_A(1, 0, a3);
            PG8_WAIT_V(8); PG8_WAIT_L(0); PG8_BAR; PG8_MMA(1, 0, At, B0); PG8_MMA(1, 1, At, B1); PG8_BAR; PG8_SCHED;
        }
#ifdef PROBE_GEMM
        if (var && PROBE_GEMM == 1) p_acc += __builtin_amdgcn_s_memrealtime() - pt0;
        if (var && PROBE_GEMM == 2) pt0 = __builtin_amdgcn_s_memrealtime();
#endif
        if (wr == 0) PG8_BAR;
        { const int l2 = lane_id(); E(acc, cur, wr, wc, l2 & 15, l2 >> 4, (const PG8_LAS float*)(lds + STAGE_BYTES + (ui & 1) * 2048)); }
#ifdef PROBE_GEMM
        if (var && PROBE_GEMM == 2) p_acc += __builtin_amdgcn_s_memrealtime() - pt0;
        if (var && PROBE_GEMM == 3) p_acc += 1000;
#endif
        if (!has_next) break;
#pragma unroll
        for (int a = 0; a < 2; ++a)
#pragma unroll
            for (int b = 0; b < 2; ++b)
#pragma unroll
                for (int m = 0; m < 4; ++m)
#pragma unroll
                    for (int n = 0; n < 2; ++n) acc[a][b][m][n] = (f32x4){0.f, 0.f, 0.f, 0.f};
        cur = nxt; cA = nA; cB = nB; ++ui;
        PG8_TABS(cur, ui & 1);
        if (wr == 1) PG8_BAR;
    }
    PG8_WAIT_V(0);
    PG8_BAR;
#ifdef PROBE_GEMM
    if (var && blockIdx.x == 0 && wid == 0) probe_spin(p_acc * 16);
#endif
#undef PG8_TABS
#undef PG8_STAGE_A
#undef PG8_SA
#undef PG8_SB
#undef PG8_STAGE
#undef PG8_LDA
#undef PG8_LDB
#undef PG8_MMA
#undef PG8_WAIT_V
#undef PG8_WAIT_L
#undef PG8_BAR
#undef PG8_SCHED
}
}

constexpr int BATCH = 16, SEQ = 2048, T = BATCH * SEQ, D = 1024;
constexpr int NPROJ = 6656;
constexpr int C_Z = 0, C_XBC = 1024, C_Q = 2560, C_K = 3584, C_V = 4608, C_O = 5632;
constexpr int WIN_LD = 6688;
constexpr int NE = 32, TOPK = 4;
constexpr int NASSIGN = T * TOPK, MAXBLK = NASSIGN / 256 + NE, MAXROWS = MAXBLK * 256;
constexpr float RMS_EPS = 1e-6f;
constexpr int NWAVES = 8, NTHR = 512;

constexpr size_t MiB = 1u << 20;
constexpr size_t WS_CTL = 0, CTL_ZERO_BYTES = 1 * MiB;
constexpr size_t WS_WIN = 1 * MiB, WS_WOUT = 14 * MiB, WS_WGU = 18 * MiB, WS_WDN = 146 * MiB;
constexpr size_t WS_XN = 210 * MiB, WS_H = 274 * MiB, WS_GATES = 402 * MiB, WS_ROUTE = 406 * MiB, WS_PROJ = 412 * MiB, WS_MIX = 828 * MiB, WS_END = 956 * MiB;
constexpr size_t WS_XBC = WS_H;
constexpr size_t WS_SSQ = WS_ROUTE + 3 * MiB;
constexpr size_t WS_XG = WS_PROJ, WS_ACT = WS_PROJ + 272 * MiB;
static_assert((size_t)MAXROWS * 1024 * 2 == 272 * MiB && WS_ACT + 272 * MiB == WS_END, "overlay map");
constexpr size_t R_TOPI = 0, R_TOPG = 512 * 1024, R_TOKROW = 1024 * 1024, R_ROWTOK = 1536 * 1024, R_ROWGATE = 2176 * 1024, R_BLKCNT = 2816 * 1024, R_BLKEXP = 2880 * 1024, R_NBLK = 2944 * 1024;
constexpr int CW_BAR = 4096;

constexpr int WL_LD = 36;
constexpr int WL_BYTES = 1024 * WL_LD * 4;
constexpr int MISC_OFF = 150528, LDS_BYTES = MISC_OFF + 1024;

#define GAS __attribute__((address_space(1)))
#define LAS __attribute__((address_space(3)))
typedef unsigned short bf16;
typedef unsigned v4u __attribute__((ext_vector_type(4)));
typedef unsigned v2u __attribute__((ext_vector_type(2)));
typedef float f32x4 __attribute__((ext_vector_type(4)));
#define LDS_WAIT() asm volatile("s_waitcnt lgkmcnt(0)" ::: "memory")
__device__ __forceinline__ unsigned f2bf(float f) { return (unsigned)__builtin_bit_cast(unsigned short, (__bf16)f); }
typedef __bf16 bf2_t __attribute__((ext_vector_type(2)));
__device__ __forceinline__ unsigned pk2(float lo, float hi) { const bf2_t v = {(__bf16)lo, (__bf16)hi}; return __builtin_bit_cast(unsigned, v); }
__device__ __forceinline__ float bf2f(unsigned short b) { return __builtin_bit_cast(float, (unsigned)b << 16); }
__device__ __forceinline__ float bflo(unsigned w) { return __builtin_bit_cast(float, w << 16); }
__device__ __forceinline__ float bfhi(unsigned w) { return __builtin_bit_cast(float, w & 0xffff0000u); }
__device__ __forceinline__ float wave_sum(float v) {
#pragma unroll
    for (int o = 1; o < 64; o <<= 1) v += __shfl_xor(v, o);
    return v;
}
__device__ __forceinline__ float silu_f(float x) { return x * __builtin_amdgcn_rcpf(1.0f + __expf(-x)); }
__device__ __forceinline__ float sigmoid_f(float x) { return __builtin_amdgcn_rcpf(1.0f + __expf(-x)); }
__device__ __forceinline__ float rsqrt_f(float x) { return __builtin_amdgcn_rsqf(x); }
__device__ __forceinline__ float softplus_f(float x) { return x > 20.0f ? x : log1pf(__expf(x)); }


#define XB_TMO      128
#define XB_XCNT(j)  (256  + 64 * (j))
#define XB_XSUB(j)  (1280 + 64 * (j))
#define XB_XGEN(j)  (2304 + 64 * (j))
#define XB_TOP      3328
#define XB_TOPGEN   3392
#define XCD_BAR_WORDS 3456
#define XB_SPIN_CAP (1u << 18)
__device__ __forceinline__ unsigned xb_ld(unsigned* p)              { return __hip_atomic_load(p, __ATOMIC_RELAXED, __HIP_MEMORY_SCOPE_AGENT); }
__device__ __forceinline__ unsigned xb_add(unsigned* p, unsigned v) { return __hip_atomic_fetch_add(p, v, __ATOMIC_RELAXED, __HIP_MEMORY_SCOPE_AGENT); }
__device__ __forceinline__ unsigned xb_xcc_id() { return (unsigned)__builtin_amdgcn_s_getreg((3 << 11) | 20) & 0xFu; }
#define XB_SPIN(cond, bar) do { unsigned _sp = 0; while (cond) { __builtin_amdgcn_s_sleep(1); \
    if ((++_sp & 255u) == 0u) { if (xb_ld(&(bar)[XB_TMO])) break; if (_sp > XB_SPIN_CAP) { atomicAdd(&(bar)[XB_TMO], 1u); break; } } } } while (0)
struct XcdBarrier { unsigned* bar; unsigned x; volatile LAS unsigned* st; };
__device__ __forceinline__ XcdBarrier xcd_barrier_post(unsigned* bar, volatile LAS unsigned* st, bool t0  ) {
    XcdBarrier b; b.bar = bar; b.x = xb_xcc_id(); b.st = st;
    if (t0) (void)xb_add(&bar[XB_XCNT(b.x)], 1u);
    return b;
}
__device__ __forceinline__ void xcd_barrier_complete(unsigned* bar, unsigned x, unsigned& nloc, unsigned& nx) {
    const unsigned G = gridDim.x * gridDim.y * gridDim.z;
    unsigned sum, cnt, mine, sp = 0u;
    for (;;) {
        sum = 0u; cnt = 0u; mine = 0u;
#pragma unroll
        for (unsigned j = 0; j < 16; ++j) { const unsigned c = xb_ld(&bar[XB_XCNT(j)]); sum += c; cnt += (c > 0u) ? 1u : 0u; mine = (j == x) ? c : mine; }
        if (sum == G) break;
        __builtin_amdgcn_s_sleep(1);
        if ((++sp & 255u) == 0u) { if (xb_ld(&bar[XB_TMO])) break; if (sp > XB_SPIN_CAP) { atomicAdd(&bar[XB_TMO], 1u); break; } }
    }
    nloc = mine > 0u ? mine : 1u; nx = cnt > 0u ? cnt : 1u;
}
__device__ __forceinline__ void xcd_barrier(const XcdBarrier& b, bool t0  ) {
    asm volatile("s_waitcnt vmcnt(0)" ::: "memory");
    __syncthreads();
    if (t0) {
        unsigned* bar = b.bar;
        __builtin_amdgcn_s_waitcnt(0);
        unsigned nloc = b.st[0], nx = b.st[1];
        if (nloc == 0u) { xcd_barrier_complete(bar, b.x, nloc, nx); b.st[0] = nloc; b.st[1] = nx; }
        const unsigned old = xb_add(&bar[XB_XSUB(b.x)], 1u);
        const unsigned gen = old / nloc;
        if (old + 1u == (gen + 1u) * nloc) {
            __builtin_amdgcn_fence(__ATOMIC_RELEASE, "agent");
            asm volatile("s_waitcnt vmcnt(0)" ::: "memory");
            const unsigned og = xb_add(&bar[XB_TOP], 1u);
            const unsigned tg = og / nx;
            if (og + 1u == (tg + 1u) * nx) xb_add(&bar[XB_TOPGEN], 1u);
            else XB_SPIN(xb_ld(&bar[XB_TOPGEN]) == tg, bar);
            __builtin_amdgcn_fence(__ATOMIC_ACQUIRE, "agent");
            xb_add(&bar[XB_XGEN(b.x)], 1u);
            asm volatile("s_waitcnt vmcnt(0)" ::: "memory");
        } else {
            XB_SPIN(xb_ld(&bar[XB_XGEN(b.x)]) == gen, bar);
            __builtin_amdgcn_fence(__ATOMIC_ACQUIRE, "agent");
            asm volatile("s_waitcnt vmcnt(0)" ::: "memory");
        }
    }
    __syncthreads();
}

__device__ __forceinline__ int fresh_tid(int wave) { int t = wave * 64 + lane_id(); asm volatile("" : "+v"(t)); return t; }
constexpr int MOE_LATE_PER_WAVE = 1, MOE_LATE = MOE_LATE_PER_WAVE * 1024;
struct Args { const float* in[21]; float* out; unsigned char* ws; int ph_lo, ph_hi, variant, pad; };

__device__ __forceinline__ void transpose_item(const float* W, int ld_src, int n0s, int k0, bf16* WT, int K, int n0d, float cscale, const float* kscale, LAS float* scr, int lane) {
#pragma unroll
    for (int i = 0; i < 32; ++i) { const int kk = 2 * i + (lane >> 5); float v = W[(size_t)(k0 + kk) * ld_src + n0s + (lane & 31)] * cscale; if (kscale) v *= kscale[k0 + kk]; scr[kk * 33 + (lane & 31)] = v; }
    LDS_WAIT(); asm volatile("" ::: "memory");
    const int c = lane & 7;
#pragma unroll
    for (int j = 0; j < 4; ++j) { const int n = (lane >> 3) + 8 * j; const LAS float* s = scr + (8 * c) * 33 + n;
        v4u o; o.x = pk2(s[0 * 33], s[1 * 33]); o.y = pk2(s[2 * 33], s[3 * 33]); o.z = pk2(s[4 * 33], s[5 * 33]); o.w = pk2(s[6 * 33], s[7 * 33]);
        *(v4u*)(WT + (size_t)(n0d + n) * K + k0 + 8 * c) = o; }
    LDS_WAIT(); asm volatile("" ::: "memory");
}

__device__ __forceinline__ int pk4_fp8(float a, float b, float c, float d) { int w = 0; w = __builtin_amdgcn_cvt_pk_fp8_f32(a, b, w, false); w = __builtin_amdgcn_cvt_pk_fp8_f32(c, d, w, true); return w; }
__device__ __forceinline__ void transpose_item_f8(const float* W, int ld_src, int n0s, int k0, unsigned char* WT, int K, int n0d, float cscale, const float* kscale, LAS float* scr, int lane) {
#pragma unroll
    for (int i = 0; i < 32; ++i) { const int kk = 2 * i + (lane >> 5); float v = W[(size_t)(k0 + kk) * ld_src + n0s + (lane & 31)] * cscale; if (kscale) v *= kscale[k0 + kk]; scr[kk * 33 + (lane & 31)] = v; }
    LDS_WAIT(); asm volatile("" ::: "memory");
    const int c = lane & 3;
#pragma unroll
    for (int j = 0; j < 2; ++j) { const int n = (lane >> 2) + 16 * j; const LAS float* s = scr + (16 * c) * 33 + n;
        v4u o; o.x = (unsigned)pk4_fp8(s[0 * 33], s[1 * 33], s[2 * 33], s[3 * 33]); o.y = (unsigned)pk4_fp8(s[4 * 33], s[5 * 33], s[6 * 33], s[7 * 33]);
        o.z = (unsigned)pk4_fp8(s[8 * 33], s[9 * 33], s[10 * 33], s[11 * 33]); o.w = (unsigned)pk4_fp8(s[12 * 33], s[13 * 33], s[14 * 33], s[15 * 33]);
        *(v4u*)(WT + (size_t)(n0d + n) * K + k0 + 16 * c) = o; }
    LDS_WAIT(); asm volatile("" ::: "memory");
}

__device__ __forceinline__ void transpose_item_f8_128(const float* __restrict__ W, int ld_src, int n0s, int k0, unsigned char* __restrict__ WT, int K, int n0d, float cscale, LAS float* scr, int lane) {
#pragma unroll 1
    for (int i0 = 0; i0 < 64; i0 += 32) { float v[32];
#pragma unroll
        for (int i = 0; i < 32; ++i) v[i] = W[(size_t)(k0 + 2 * (i0 + i) + (lane >> 5)) * ld_src + n0s + (lane & 31)];
#pragma unroll
        for (int i = 0; i < 32; ++i) scr[(2 * (i0 + i) + (lane >> 5)) * 33 + (lane & 31)] = v[i] * cscale; }
    LDS_WAIT(); asm volatile("" ::: "memory");
    const int c = lane & 7;
#pragma unroll
    for (int j = 0; j < 4; ++j) { const int n = (lane >> 3) + 8 * j; const LAS float* s = scr + (16 * c) * 33 + n;
        v4u o; o.x = (unsigned)pk4_fp8(s[0 * 33], s[1 * 33], s[2 * 33], s[3 * 33]); o.y = (unsigned)pk4_fp8(s[4 * 33], s[5 * 33], s[6 * 33], s[7 * 33]);
        o.z = (unsigned)pk4_fp8(s[8 * 33], s[9 * 33], s[10 * 33], s[11 * 33]); o.w = (unsigned)pk4_fp8(s[12 * 33], s[13 * 33], s[14 * 33], s[15 * 33]);
        *(v4u*)(WT + (size_t)(n0d + n) * K + k0 + 16 * c) = o; }
    LDS_WAIT(); asm volatile("" ::: "memory");
}

constexpr int PT_LD = 2064, PT_HALF = 32 * PT_LD;
typedef short s8v_t __attribute__((ext_vector_type(8)));
constexpr int PT_WN = 2 * PT_HALF;
__device__ __forceinline__ void pt_fill(LAS unsigned char* tab, const float* W, int ldw, int tid, bool gate_cols, const float* wn) {
    ((LAS float*)(tab + PT_WN))[tid] = wn[tid]; ((LAS float*)(tab + PT_WN))[512 + tid] = wn[512 + tid];
    const int c = tid & 31; const int sc = gate_cols ? (c < 16 ? 2560 + c : (c < 24 ? 6672 + (c - 16) : 6680 + (c - 24))) : c;
#pragma unroll 1
    for (int j0 = 0; j0 < 64; j0 += 32) { float v[32];
#pragma unroll
        for (int j = 0; j < 32; ++j) v[j] = W[(size_t)((tid >> 5) + 16 * (j0 + j)) * ldw + sc];
#pragma unroll
        for (int j = 0; j < 32; ++j) { const int k = (tid >> 5) + 16 * (j0 + j); const unsigned h = f2bf(v[j]); const float hf = __builtin_bit_cast(float, h << 16);
            *(LAS unsigned short*)(tab + c * PT_LD + k * 2) = (unsigned short)h; *(LAS unsigned short*)(tab + PT_HALF + c * PT_LD + k * 2) = (unsigned short)f2bf(v[j] - hf); } }
}
template <bool IN_BF16, bool OUT_F8>
__device__ __forceinline__ float rowproj16(const void* __restrict__ srcv, void* __restrict__ dstv, const float* __restrict__ wn, const LAS unsigned char* tab, int row0, int lane, f32x4 (&acc)[2]) {
    const int g = lane >> 4, c16 = lane & 15;
    acc[0] = (f32x4){0.f, 0.f, 0.f, 0.f}; acc[1] = acc[0]; float ss = 0.f;
    const LAS unsigned char* tb = tab + c16 * PT_LD + g * 16;
    v4u ra[4], rb[4];
#define RP_LOAD(dstA, dstB, s_) do { if constexpr (IN_BF16) { dstA = *(const v4u*)((const bf16*)srcv + (size_t)(row0 + c16) * 1024 + 32 * (s_) + 8 * g); } \
        else { const float* p_ = (const float*)srcv + (size_t)(row0 + c16) * 1024 + 32 * (s_) + 8 * g; dstA = *(const v4u*)p_; dstB = *(const v4u*)(p_ + 4); } } while (0)
#pragma unroll
    for (int i = 0; i < 4; ++i) RP_LOAD(ra[i], rb[i], i);
#pragma unroll 1
    for (int s0 = 0; s0 < 32; s0 += 4) {
        v4u na[4], nb[4];
#pragma unroll
        for (int i = 0; i < 4; ++i) { na[i] = ra[i]; nb[i] = rb[i]; }
        if (s0 + 4 < 32) {
#pragma unroll
            for (int i = 0; i < 4; ++i) RP_LOAD(na[i], nb[i], s0 + 4 + i);
        }
        f32x4 gw0[4], gw1[4];
#pragma unroll
        for (int i = 0; i < 4; ++i) { gw0[i] = *(const LAS f32x4*)(tab + PT_WN + (32 * (s0 + i) + 8 * g) * 4); gw1[i] = *(const LAS f32x4*)(tab + PT_WN + (32 * (s0 + i) + 8 * g) * 4 + 16); }
#pragma unroll
        for (int i = 0; i < 4; ++i) { const int s = s0 + i;
        f32x4 a, b;
        if constexpr (IN_BF16) { const v4u w = ra[i]; a = (f32x4){bflo(w.x), bfhi(w.x), bflo(w.y), bfhi(w.y)}; b = (f32x4){bflo(w.z), bfhi(w.z), bflo(w.w), bfhi(w.w)}; }
        else { a = __builtin_bit_cast(f32x4, ra[i]); b = __builtin_bit_cast(f32x4, rb[i]); }
        ss += (a[0] * a[0] + a[1] * a[1]) + (a[2] * a[2] + a[3] * a[3]) + (b[0] * b[0] + b[1] * b[1]) + (b[2] * b[2] + b[3] * b[3]);
        a = a * gw0[i]; b = b * gw1[i];
        v4u hw; hw.x = pk2(a[0], a[1]); hw.y = pk2(a[2], a[3]); hw.z = pk2(b[0], b[1]); hw.w = pk2(b[2], b[3]);
        v4u lw; lw.x = pk2(a[0] - bflo(hw.x), a[1] - bfhi(hw.x)); lw.y = pk2(a[2] - bflo(hw.y), a[3] - bfhi(hw.y)); lw.z = pk2(b[0] - bflo(hw.z), b[1] - bfhi(hw.z)); lw.w = pk2(b[2] - bflo(hw.w), b[3] - bfhi(hw.w));
        if constexpr (OUT_F8) { v2u o; o.x = (unsigned)pk4_fp8(a[0], a[1], a[2], a[3]); o.y = (unsigned)pk4_fp8(b[0], b[1], b[2], b[3]); *(v2u*)((unsigned char*)dstv + (size_t)(row0 + c16) * 1024 + 32 * s + 8 * g) = o; }
        else *(v4u*)((bf16*)dstv + (size_t)(row0 + c16) * 1024 + 32 * s + 8 * g) = hw;
        const s8v_t xh = __builtin_bit_cast(s8v_t, hw), xl = __builtin_bit_cast(s8v_t, lw);
#pragma unroll
        for (int nt = 0; nt < 2; ++nt) { const s8v_t wh = *(const LAS s8v_t*)(tb + nt * 16 * PT_LD + s * 64), wl = *(const LAS s8v_t*)(tb + PT_HALF + nt * 16 * PT_LD + s * 64);
            acc[nt] = __builtin_amdgcn_mfma_f32_16x16x32_bf16(xh, wh, acc[nt], 0, 0, 0); acc[nt] = __builtin_amdgcn_mfma_f32_16x16x32_bf16(xl, wh, acc[nt], 0, 0, 0); acc[nt] = __builtin_amdgcn_mfma_f32_16x16x32_bf16(xh, wl, acc[nt], 0, 0, 0); }
        }
#pragma unroll
        for (int i = 0; i < 4; ++i) { ra[i] = na[i]; rb[i] = nb[i]; }
    }
#undef RP_LOAD
    ss += __shfl_xor(ss, 16); ss += __shfl_xor(ss, 32);
    return 1.0f / sqrtf(ss * (1.0f / 1024.0f) + RMS_EPS);
}

namespace mx {
typedef short s8v __attribute__((ext_vector_type(8)));
typedef short s4v __attribute__((ext_vector_type(4)));
#define MX_MFMA(a, b, c) __builtin_amdgcn_mfma_f32_16x16x32_bf16(a, b, c, 0, 0, 0)
#define MX_SB() __builtin_amdgcn_sched_barrier(0)
#define MX_BAR() do { MX_SB(); asm volatile("s_waitcnt lgkmcnt(0)" ::: "memory"); __builtin_amdgcn_s_barrier(); asm volatile("" ::: "memory"); } while (0)
constexpr int TS = 288, TILE = 64 * TS, PS = 144, PTILE = 64 * PS, BUF = 3 * TILE;
struct LaneBase { unsigned row, perm, tr, prow; };
__device__ __forceinline__ LaneBase lane_base(int lane) { LaneBase L; const unsigned g = lane >> 4, i = lane & 15, q = i >> 2, p = lane & 3;
    L.row = i * TS + g * 16; L.perm = i * TS + g * 8; L.tr = (8 * g + q) * TS + p * 8; L.prow = i * PS + g * 16; return L; }
#define LD_ROW(t, L, rb, s) (*(const LAS mx::s8v*)((t) + (L).row + (rb) * 16 * mx::TS + (s) * 64))
#define LD_ROWP(t, L, rb, s) (*(const LAS mx::s8v*)((t) + (L).prow + (rb) * 16 * mx::PS + (s) * 64))
__device__ __forceinline__ s8v ld_perm2(const LAS unsigned char* p) { const s4v lo = *(const LAS s4v*)p, hi = *(const LAS s4v*)(p + 32); return (s8v){lo[0], lo[1], lo[2], lo[3], hi[0], hi[1], hi[2], hi[3]}; }
#define LD_PERM(t, L, rb, s) mx::ld_perm2((t) + (L).perm + (rb) * 16 * mx::TS + (s) * 64)
__device__ __forceinline__ s8v ld_tr2(const LAS unsigned char* p) {
    const s4v a = __builtin_amdgcn_ds_read_tr16_b64_v4i16((LAS s4v*)p), b = __builtin_amdgcn_ds_read_tr16_b64_v4i16((LAS s4v*)(p + 4 * TS));
    return (s8v){a[0], a[1], a[2], a[3], b[0], b[1], b[2], b[3]}; }
#define LD_TR(t, L, c, ks) mx::ld_tr2((t) + (L).tr + (ks) * 32 * mx::TS + (c) * 32)
__device__ __forceinline__ void dma_tiles(LAS unsigned char* buf, const bf16* g0, int gstride, int co0, int co1, int co2, int wave, int lane) {
#pragma unroll
    for (int pp = 0; pp < 7; ++pp) { const int piece = wave + 8 * pp; if (piece < 54) { const unsigned o = piece * 1024 + lane * 16, tl = o / TILE, ot = o - tl * TILE, row = ot / TS, wb = ot - row * TS;
        const int co = tl == 0 ? co0 : (tl == 1 ? co1 : co2);
        __builtin_amdgcn_global_load_lds((const unsigned*)(g0 + (size_t)row * gstride + co + (wb < 256 ? wb >> 1 : 0)), (LAS unsigned*)(buf + piece * 1024), 16, 0, 0); } }
}
#define MX_DPPF(old, src, ctrl, rm) __builtin_bit_cast(float, __builtin_amdgcn_update_dpp(__builtin_bit_cast(int, (float)(old)), __builtin_bit_cast(int, (float)(src)), ctrl, rm, 0xf, false))
__device__ __forceinline__ float scan_add(float x) {
    x += MX_DPPF(0.f, x, 0x111, 0xf); x += MX_DPPF(0.f, x, 0x112, 0xf); x += MX_DPPF(0.f, x, 0x114, 0xf); x += MX_DPPF(0.f, x, 0x118, 0xf);
    x += MX_DPPF(0.f, x, 0x142, 0xa); x += MX_DPPF(0.f, x, 0x143, 0xc); return x; }
__device__ __forceinline__ float scan_max(float x) { const float ninf = -INFINITY;
    x = fmaxf(x, MX_DPPF(ninf, x, 0x111, 0xf)); x = fmaxf(x, MX_DPPF(ninf, x, 0x112, 0xf)); x = fmaxf(x, MX_DPPF(ninf, x, 0x114, 0xf)); x = fmaxf(x, MX_DPPF(ninf, x, 0x118, 0xf));
    x = fmaxf(x, MX_DPPF(ninf, x, 0x142, 0xa)); x = fmaxf(x, MX_DPPF(ninf, x, 0x143, 0xc)); return x; }
__device__ __forceinline__ float lane63(float x) { return __builtin_bit_cast(float, __builtin_amdgcn_readlane(__builtin_bit_cast(int, x), 63)); }
__device__ __forceinline__ float softplus_fast(float x) { const float e = __expf(-fabsf(x)); return fmaxf(x, 0.f) + (e < 1e-6f ? e : __logf(1.0f + e)); }
__device__ __forceinline__ s8v pack_acc(const f32x4& a, const f32x4& b) {
    const unsigned w0 = pk2(a[0], a[1]), w1 = pk2(a[2], a[3]), w2 = pk2(b[0], b[1]), w3 = pk2(b[2], b[3]);
    v4u w = {w0, w1, w2, w3}; return __builtin_bit_cast(s8v, w);
}
__device__ __forceinline__ void unpack8(const v4u& w, float (&f)[8]) { f[0] = bflo(w.x); f[1] = bfhi(w.x); f[2] = bflo(w.y); f[3] = bfhi(w.y); f[4] = bflo(w.z); f[5] = bfhi(w.z); f[6] = bflo(w.w); f[7] = bfhi(w.w); }

__device__ __forceinline__ void mlstm_item(LAS unsigned char* lds, int item, int var, int wave, const bf16* __restrict__ PROJ, const float* __restrict__ GATES, const float* __restrict__ lnw, bf16* __restrict__ MIX) {
    const int lane = lane_id(), tid = wave * 64 + lane, g = lane >> 4, c16 = lane & 15;
    const int b = item >> 3, h = item & 7;
    const LaneBase L = lane_base(lane);
    LAS unsigned char* TP = lds + 2 * BUF; LAS unsigned char* TO = TP + PTILE;
    LAS float* denP = (LAS float*)(TO + TILE); LAS float* qnp = denP + 128; LAS float* nsh = qnp + 512;
    LAS float* Au = nsh + 128; LAS float* Avv = Au + 64; LAS float* Awi = Avv + 64; LAS float* Akw = Awi + 64; LAS float* Aid = Akw + 64;
    f32x4 Cst[8];
#pragma unroll
    for (int i = 0; i < 8; ++i) Cst[i] = (f32x4){0.f, 0.f, 0.f, 0.f};
    float nreg = 0.f, m_prev = 0.f;
    if (lane < 16) nsh[wave * 16 + lane] = 0.f;
    const int srow = tid >> 3, sch = tid & 7;
    const bf16* qbase = PROJ + (size_t)(b * SEQ) * NPROJ + h * 128;
    dma_tiles(lds, qbase, NPROJ, C_Q, C_K, C_V, wave, lane);
    float fnext = GATES[(size_t)(b * SEQ + lane) * 32 + 24 + h], inext = GATES[(size_t)(b * SEQ + lane) * 32 + 16 + h];
    asm volatile("s_waitcnt vmcnt(0)" ::: "memory"); MX_BAR();
#pragma unroll 1
    for (int c = 0; c < SEQ / 64; ++c) {
        const int cur = c & 1; const int t0 = b * SEQ + c * 64;
        LAS unsigned char* TQ = lds + cur * BUF; LAS unsigned char* TK = TQ + TILE; LAS unsigned char* TV = TQ + 2 * TILE;
        float fraw = fnext, iraw = inext; asm volatile("" : "+v"(fraw), "+v"(iraw));
        MX_SB();
        const v4u ov0 = *(const v4u*)(PROJ + (size_t)(t0 + srow) * NPROJ + C_O + h * 128 + 8 * sch), ov1 = *(const v4u*)(PROJ + (size_t)(t0 + srow) * NPROJ + C_O + h * 128 + 64 + 8 * sch);
        { const int tn = (c + 1 < SEQ / 64 ? t0 + 64 : t0) + lane; fnext = GATES[(size_t)tn * 32 + 24 + h]; inext = GATES[(size_t)tn * 32 + 16 + h]; }
        const float lf = -softplus_fast(-fraw), cf = scan_add(lf), chunk_f = lane63(cf);
        const float u = iraw - cf, Mx = scan_max(u);
        const float m_row = cf + fmaxf(m_prev, Mx), vv = cf - m_row;
        const float m_loc = chunk_f + lane63(Mx), m_new = fmaxf(chunk_f + m_prev, m_loc);
        const float w_inter = __expf(vv + m_prev), floorv = __expf(-m_row), kw = __expf(chunk_f + u - m_new), s_old = __expf(chunk_f + m_prev - m_new);
        Au[lane] = u; Avv[lane] = vv; Awi[lane] = w_inter; Akw[lane] = kw;
        if (!(var & 2)) { const int lt = wave & 3, jt0 = 2 * (wave >> 2); const float vv_l = Avv[16 * lt + c16]; float rsum = 0.f;
#pragma unroll
          for (int jj = 0; jj < 2; ++jj) { const int jt = jt0 + jj; float pv[4] = {0.f, 0.f, 0.f, 0.f};
            if (jt <= lt) { f32x4 acc = {0.f, 0.f, 0.f, 0.f};
#pragma unroll
                for (int ks = 0; ks < 4; ++ks) acc = MX_MFMA(LD_ROW(TK, L, jt, ks), LD_ROW(TQ, L, lt, ks), acc);
                const f32x4 uj = *(const LAS f32x4*)(Au + 16 * jt + 4 * g);
#pragma unroll
                for (int r = 0; r < 4; ++r) { const int j = 16 * jt + 4 * g + r, l = 16 * lt + c16; const float val = (j <= l) ? acc[r] * __expf(vv_l + uj[r]) : 0.f; rsum += val; pv[r] = val; } }
            v2u w; w.x = pk2(pv[0], pv[1]); w.y = pk2(pv[2], pv[3]);
            *(LAS v2u*)(TP + (16 * lt + c16) * PS + (16 * jt + 4 * g) * 2) = w; }
          rsum += __shfl_xor(rsum, 16); rsum += __shfl_xor(rsum, 32);
          if (g == 0) denP[(wave >> 2) * 64 + 16 * lt + c16] = rsum;
          v4u q0 = *(const LAS v4u*)(TQ + lane * TS + wave * 32), q1 = *(const LAS v4u*)(TQ + lane * TS + wave * 32 + 16); float qf[16]; { float t8[8]; unpack8(q0, t8);
#pragma unroll
            for (int e = 0; e < 8; ++e) qf[e] = t8[e]; unpack8(q1, t8);
#pragma unroll
            for (int e = 0; e < 8; ++e) qf[8 + e] = t8[e]; }
          float part = 0.f;
#pragma unroll
          for (int e4 = 0; e4 < 4; ++e4) { const f32x4 nv = *(const LAS f32x4*)(nsh + wave * 16 + 4 * e4); part += qf[4 * e4] * nv[0] + qf[4 * e4 + 1] * nv[1] + qf[4 * e4 + 2] * nv[2] + qf[4 * e4 + 3] * nv[3]; }
          qnp[wave * 64 + lane] = part; }
        if (c + 1 < SEQ / 64 && !(var & 1)) { int lv = lane; asm volatile("" : "+v"(lv)); dma_tiles(lds + (cur ^ 1) * BUF, qbase + (size_t)(c + 1) * 64 * NPROJ, NPROJ, C_Q, C_K, C_V, wave, lv); }
        MX_SB();
        f32x4 acc[4];
        { s8v sf[4];
#pragma unroll
          for (int ks = 0; ks < 4; ++ks) sf[ks] = pack_acc(Cst[2 * ks], Cst[2 * ks + 1]);
#pragma unroll
          for (int lt = 0; lt < 4; ++lt) acc[lt] = (f32x4){0.f, 0.f, 0.f, 0.f};
          if (!(var & 4)) {
#pragma unroll
            for (int ks = 0; ks < 4; ++ks)
#pragma unroll
                for (int lt = 0; lt < 4; ++lt) acc[lt] = MX_MFMA(sf[ks], LD_PERM(TQ, L, lt, ks), acc[lt]);
#pragma unroll
            for (int lt = 0; lt < 4; ++lt) acc[lt] = acc[lt] * Awi[16 * lt + c16]; } }
        const s8v vf0 = LD_TR(TV + wave * 32, L, 0, 0), vf1 = LD_TR(TV + wave * 32, L, 0, 1);
        {
#pragma unroll
          for (int i = 0; i < 8; ++i) Cst[i] = Cst[i] * s_old;
          if (!(var & 8))
#pragma unroll
          for (int ks = 0; ks < 2; ++ks) { const s8v vf = ks ? vf1 : vf0; const v4u vw = __builtin_bit_cast(v4u, vf); float f[8]; unpack8(vw, f);
            { const f32x4 k0 = *(const LAS f32x4*)(Akw + 32 * ks + 8 * g), k1 = *(const LAS f32x4*)(Akw + 32 * ks + 8 * g + 4);
#pragma unroll
              for (int e = 0; e < 4; ++e) { f[e] *= k0[e]; f[4 + e] *= k1[e]; } }
            v4u pw = {pk2(f[0], f[1]), pk2(f[2], f[3]), pk2(f[4], f[5]), pk2(f[6], f[7])}; const s8v vwf = __builtin_bit_cast(s8v, pw);
#pragma unroll
            for (int dkt = 0; dkt < 8; ++dkt) Cst[dkt] = MX_MFMA(LD_TR(TK, L, dkt, ks), vwf, Cst[dkt]); }
          float part = 0.f;
#pragma unroll
          for (int e4 = 0; e4 < 4; ++e4) { const f32x4 kk = *(const LAS f32x4*)(Akw + 16 * g + 4 * e4);
#pragma unroll
            for (int e = 0; e < 4; ++e) { const int j = 16 * g + 4 * e4 + e; part += bf2f(*(const LAS unsigned short*)(TK + j * TS + (16 * wave + c16) * 2)) * kk[e]; } }
          part += __shfl_xor(part, 16); part += __shfl_xor(part, 32);
          nreg = s_old * nreg + part; if (g == 0) nsh[wave * 16 + c16] = nreg;
        }
        MX_BAR();
        float inv_den; { float qn = 0.f;
#pragma unroll
          for (int w = 0; w < 8; ++w) qn += qnp[w * 64 + lane];
          float den = denP[lane] + denP[64 + lane] + w_inter * qn; den = fmaxf(fabsf(den), floorv); inv_den = __builtin_amdgcn_rcpf(den); Aid[lane] = inv_den; }
        { if (!(var & 4))
#pragma unroll
          for (int lt = 0; lt < 4; ++lt) { f32x4 a4 = MX_MFMA(vf0, LD_ROWP(TP, L, lt, 0), acc[lt]);
            if (lt >= 2) a4 = MX_MFMA(vf1, LD_ROWP(TP, L, lt, 1), a4);
            a4 = a4 * Aid[16 * lt + c16];
            v2u w; w.x = pk2(a4[0], a4[1]); w.y = pk2(a4[2], a4[3]);
            *(LAS v2u*)(TO + (16 * lt + c16) * TS + (16 * wave + 4 * g) * 2) = w; }
          m_prev = m_new; }
        asm volatile("s_waitcnt vmcnt(0)" ::: "memory"); MX_BAR();
        if (!(var & 16)) { const v4u a = *(const LAS v4u*)(TO + srow * TS + sch * 16), bq = *(const LAS v4u*)(TO + srow * TS + sch * 16 + 128); float f[16], of[16]; { float t8[8]; unpack8(a, t8);
#pragma unroll
            for (int e = 0; e < 8; ++e) f[e] = t8[e]; unpack8(bq, t8);
#pragma unroll
            for (int e = 0; e < 8; ++e) f[8 + e] = t8[e]; unpack8(ov0, t8);
#pragma unroll
            for (int e = 0; e < 8; ++e) of[e] = t8[e]; unpack8(ov1, t8);
#pragma unroll
            for (int e = 0; e < 8; ++e) of[8 + e] = t8[e]; }
          float ss = 0.f;
#pragma unroll
          for (int e = 0; e < 16; ++e) ss += f[e] * f[e];
          ss += __shfl_xor(ss, 1); ss += __shfl_xor(ss, 2); ss += __shfl_xor(ss, 4);
          const float rs = rsqrt_f(ss * (1.0f / 128.0f) + RMS_EPS);
          float wn[16]; { const f32x4 w0 = *(const f32x4*)(lnw + h * 128 + 8 * sch), w1 = *(const f32x4*)(lnw + h * 128 + 8 * sch + 4), w2 = *(const f32x4*)(lnw + h * 128 + 64 + 8 * sch), w3 = *(const f32x4*)(lnw + h * 128 + 64 + 8 * sch + 4);
#pragma unroll
            for (int e = 0; e < 4; ++e) { wn[e] = w0[e]; wn[4 + e] = w1[e]; wn[8 + e] = w2[e]; wn[12 + e] = w3[e]; } }
#pragma unroll
          for (int e = 0; e < 16; ++e) f[e] = f[e] * rs * wn[e] * sigmoid_f(of[e]);
          v4u o0 = {pk2(f[0], f[1]), pk2(f[2], f[3]), pk2(f[4], f[5]), pk2(f[6], f[7])}, o1 = {pk2(f[8], f[9]), pk2(f[10], f[11]), pk2(f[12], f[13]), pk2(f[14], f[15])};
          bf16* mp = MIX + (size_t)(t0 + srow) * 2048 + 1024 + h * 128 + 8 * sch; *(v4u*)mp = o0; *(v4u*)(mp + 64) = o1; }
    }
    MX_BAR();
}

__device__ __forceinline__ void ssd_item(LAS unsigned char* lds, int item, int var, int wave, const bf16* __restrict__ XBC, const bf16* __restrict__ PROJ, const float* __restrict__ GATES, const float* __restrict__ a_log,
                                         const float* __restrict__ d_skip, bf16* __restrict__ MIX, float* __restrict__ SSQ) {
    const int lane = lane_id(), tid = wave * 64 + lane, g = lane >> 4, c16 = lane & 15;
    const int b = item >> 3, hp = item & 7, grp = hp >> 2, hh = wave >> 2, ps = wave & 3;
    const LaneBase L = lane_base(lane);
    LAS unsigned char* TG = lds + 2 * BUF;
    LAS unsigned char* TO = TG + 2 * PTILE;
    LAS float* Aacs = (LAS float*)(TO + TILE); LAS float* Adinv = Aacs + 128; LAS float* Adt = Adinv + 128; LAS float* Awd = Adt + 128; LAS float* Aea = Awd + 128;
    f32x4 RT[8];
#pragma unroll
    for (int i = 0; i < 8; ++i) RT[i] = (f32x4){0.f, 0.f, 0.f, 0.f};
    const float an0 = -__expf(a_log[2 * hp]), an1 = -__expf(a_log[2 * hp + 1]), dk0 = d_skip[2 * hp], dk1 = d_skip[2 * hp + 1];
    const int srow = tid >> 3, sch = tid & 7;
    const bf16* xb = XBC + (size_t)(b * SEQ) * 1536;
    dma_tiles(lds, xb, 1536, 1280 + grp * 128, 1024 + grp * 128, hp * 128, wave, lane);
    float dn0 = GATES[(size_t)(b * SEQ + lane) * 32 + 2 * hp], dn1 = GATES[(size_t)(b * SEQ + lane) * 32 + 2 * hp + 1];
    asm volatile("s_waitcnt vmcnt(0)" ::: "memory"); MX_BAR();
#pragma unroll 1
    for (int c = 0; c < SEQ / 64; ++c) {
        const int cur = c & 1; const int t0 = b * SEQ + c * 64;
        LAS unsigned char* TC = lds + cur * BUF; LAS unsigned char* TB = TC + TILE; LAS unsigned char* TX = TC + 2 * TILE;
        float dr0 = dn0, dr1 = dn1; asm volatile("" : "+v"(dr0), "+v"(dr1));
        MX_SB();
        const v4u zv0 = *(const v4u*)(PROJ + (size_t)(t0 + srow) * NPROJ + C_Z + hp * 128 + 8 * sch), zv1 = *(const v4u*)(PROJ + (size_t)(t0 + srow) * NPROJ + C_Z + hp * 128 + 64 + 8 * sch);
        { const int tn = (c + 1 < SEQ / 64 ? t0 + 64 : t0) + lane; dn0 = GATES[(size_t)tn * 32 + 2 * hp]; dn1 = GATES[(size_t)tn * 32 + 2 * hp + 1]; }
        const float dt0 = softplus_fast(dr0), dt1 = softplus_fast(dr1);
        const float acs0 = scan_add(dt0 * an0), acs1 = scan_add(dt1 * an1);
        const float aend0 = lane63(acs0), aend1 = lane63(acs1);
        Aacs[lane] = acs0; Aacs[64 + lane] = acs1; Adinv[lane] = dk0 * __builtin_amdgcn_rcpf(dt0); Adinv[64 + lane] = dk1 * __builtin_amdgcn_rcpf(dt1); Adt[lane] = dt0; Adt[64 + lane] = dt1;
        Awd[lane] = __expf(aend0 - acs0); Awd[64 + lane] = __expf(aend1 - acs1); Aea[lane] = __expf(acs0); Aea[64 + lane] = __expf(acs1);
        const float aend = hh ? aend1 : aend0;
        if (!(var & 2)) { const int lt = wave & 3, st0 = 2 * (wave >> 2); const int l = 16 * lt + c16;
          const float al0 = Aacs[l], al1 = Aacs[64 + l], di0 = Adinv[l], di1 = Adinv[64 + l];
#pragma unroll
          for (int ss = 0; ss < 2; ++ss) { const int st = st0 + ss; float p0[4] = {0.f, 0.f, 0.f, 0.f}, p1[4] = {0.f, 0.f, 0.f, 0.f};
            if (st <= lt) { f32x4 acc = {0.f, 0.f, 0.f, 0.f};
#pragma unroll
                for (int ks = 0; ks < 4; ++ks) acc = MX_MFMA(LD_ROW(TB, L, st, ks), LD_ROW(TC, L, lt, ks), acc);
                const f32x4 as0 = *(const LAS f32x4*)(Aacs + 16 * st + 4 * g), as1 = *(const LAS f32x4*)(Aacs + 64 + 16 * st + 4 * g);
#pragma unroll
                for (int r = 0; r < 4; ++r) { const int sidx = 16 * st + 4 * g + r;
                    float v0 = (sidx <= l) ? acc[r] * __expf(al0 - as0[r]) : 0.f, v1 = (sidx <= l) ? acc[r] * __expf(al1 - as1[r]) : 0.f;
                    if (sidx == l) { v0 += di0; v1 += di1; } p0[r] = v0; p1[r] = v1; } }
            v2u w0, w1; w0.x = pk2(p0[0], p0[1]); w0.y = pk2(p0[2], p0[3]); w1.x = pk2(p1[0], p1[1]); w1.y = pk2(p1[2], p1[3]);
            const unsigned o = l * PS + (16 * st + 4 * g) * 2;
            *(LAS v2u*)(TG + o) = w0; *(LAS v2u*)(TG + PTILE + o) = w1; } }
        if (c + 1 < SEQ / 64 && !(var & 1)) { int lv = lane; asm volatile("" : "+v"(lv)); dma_tiles(lds + (cur ^ 1) * BUF, xb + (size_t)(c + 1) * 64 * 1536, 1536, 1280 + grp * 128, 1024 + grp * 128, hp * 128, wave, lv); }
        MX_SB();
        f32x4 acc[4];
        { s8v sf[4];
#pragma unroll
          for (int ks = 0; ks < 4; ++ks) sf[ks] = pack_acc(RT[2 * ks], RT[2 * ks + 1]);
#pragma unroll
          for (int lt = 0; lt < 4; ++lt) acc[lt] = (f32x4){0.f, 0.f, 0.f, 0.f};
          if (!(var & 4)) {
#pragma unroll
            for (int ks = 0; ks < 4; ++ks)
#pragma unroll
                for (int lt = 0; lt < 4; ++lt) acc[lt] = MX_MFMA(sf[ks], LD_PERM(TC, L, lt, ks), acc[lt]);
#pragma unroll
            for (int lt = 0; lt < 4; ++lt) acc[lt] = acc[lt] * Aea[64 * hh + 16 * lt + c16]; } }
          s8v xd[2], xw[2];
#pragma unroll
          for (int ks = 0; ks < 2; ++ks) { const s8v xf = LD_TR(TX + (4 * hh + ps) * 32, L, 0, ks); const v4u xv = __builtin_bit_cast(v4u, xf); float f[8], fw[8]; unpack8(xv, f);
            { const LAS float* pd = Adt + 64 * hh + 32 * ks + 8 * g; const LAS float* pw = Awd + 64 * hh + 32 * ks + 8 * g; const f32x4 d0 = *(const LAS f32x4*)pd, d1 = *(const LAS f32x4*)(pd + 4), w0 = *(const LAS f32x4*)pw, w1 = *(const LAS f32x4*)(pw + 4);
#pragma unroll
              for (int e = 0; e < 4; ++e) { f[e] *= d0[e]; fw[e] = f[e] * w0[e]; f[4 + e] *= d1[e]; fw[4 + e] = f[4 + e] * w1[e]; } }
            v4u a = {pk2(f[0], f[1]), pk2(f[2], f[3]), pk2(f[4], f[5]), pk2(f[6], f[7])}, bw = {pk2(fw[0], fw[1]), pk2(fw[2], fw[3]), pk2(fw[4], fw[5]), pk2(fw[6], fw[7])};
            xd[ks] = __builtin_bit_cast(s8v, a); xw[ks] = __builtin_bit_cast(s8v, bw); }
        {
          const float ea = __expf(aend);
#pragma unroll
          for (int i = 0; i < 8; ++i) RT[i] = RT[i] * ea;
          if (!(var & 8))
#pragma unroll
          for (int ks = 0; ks < 2; ++ks)
#pragma unroll
            for (int nt = 0; nt < 8; ++nt) RT[nt] = MX_MFMA(LD_TR(TB, L, nt, ks), xw[ks], RT[nt]);
        }
        MX_BAR();
        {
          const LAS unsigned char* TGm = TG + hh * PTILE;
          if (!(var & 4))
#pragma unroll
          for (int lt = 0; lt < 4; ++lt) { f32x4 a4 = MX_MFMA(xd[0], LD_ROWP(TGm, L, lt, 0), acc[lt]);
            if (lt >= 2) a4 = MX_MFMA(xd[1], LD_ROWP(TGm, L, lt, 1), a4);
            v2u w; w.x = pk2(a4[0], a4[1]); w.y = pk2(a4[2], a4[3]);
            *(LAS v2u*)(TO + (16 * lt + c16) * TS + (64 * hh + 16 * ps + 4 * g) * 2) = w; }
        }
        asm volatile("s_waitcnt vmcnt(0)" ::: "memory"); MX_BAR();
        if (!(var & 16)) { const v4u a = *(const LAS v4u*)(TO + srow * TS + sch * 16), bq = *(const LAS v4u*)(TO + srow * TS + sch * 16 + 128); float f[16], zf[16]; { float t8[8]; unpack8(a, t8);
#pragma unroll
            for (int e = 0; e < 8; ++e) f[e] = t8[e]; unpack8(bq, t8);
#pragma unroll
            for (int e = 0; e < 8; ++e) f[8 + e] = t8[e]; unpack8(zv0, t8);
#pragma unroll
            for (int e = 0; e < 8; ++e) zf[e] = t8[e]; unpack8(zv1, t8);
#pragma unroll
            for (int e = 0; e < 8; ++e) zf[8 + e] = t8[e]; }
          float ss = 0.f;
#pragma unroll
          for (int e = 0; e < 16; ++e) { f[e] = f[e] * silu_f(zf[e]); ss += f[e] * f[e]; }
          ss += __shfl_xor(ss, 1); ss += __shfl_xor(ss, 2); ss += __shfl_xor(ss, 4);
          if (sch == 0) SSQ[(size_t)(t0 + srow) * 8 + hp] = ss;
          v4u o0 = {pk2(f[0], f[1]), pk2(f[2], f[3]), pk2(f[4], f[5]), pk2(f[6], f[7])}, o1 = {pk2(f[8], f[9]), pk2(f[10], f[11]), pk2(f[12], f[13]), pk2(f[14], f[15])};
          bf16* mp = MIX + (size_t)(t0 + srow) * 2048 + hp * 128 + 8 * sch; *(v4u*)mp = o0; *(v4u*)(mp + 64) = o1; }
    }
    MX_BAR();
}
}

__global__ void __launch_bounds__(NTHR, 2) mega(Args args) {
    extern __shared__ __attribute__((aligned(16))) unsigned char lds_raw[];
    LAS unsigned char* lds = (LAS unsigned char*)lds_raw;
    const int wave = __builtin_amdgcn_readfirstlane((int)threadIdx.x >> 6);
    const int lane = lane_id(), tid = wave * 64 + lane;
    const int G = gridDim.x, bx = blockIdx.x;
    unsigned char* ws = args.ws;
#define INP(k) ({ int _k = (k); asm volatile("" : "+s"(_k)); args.in[_k]; })
#define XIN INP(0)
#define Win_t ((bf16*)(ws + WS_WIN))
#define Wout_t ((bf16*)(ws + WS_WOUT))
#define XN ((bf16*)(ws + WS_XN))
#define H ((bf16*)(ws + WS_H))
#define GATES ((float*)(ws + WS_GATES))
#define PROJ ((bf16*)(ws + WS_PROJ))
#define MIX ((bf16*)(ws + WS_MIX))
#define EO8 (ws + WS_XG + 136 * MiB)
#define TOPI ((int*)(ws + WS_ROUTE + R_TOPI))
#define TOPG ((float*)(ws + WS_ROUTE + R_TOPG))
#define TOKROW ((int*)(ws + WS_ROUTE + R_TOKROW))
#define ROWTOK ((int*)(ws + WS_ROUTE + R_ROWTOK))
#define ROWGATE ((float*)(ws + WS_ROUTE + R_ROWGATE))
#define BLKCNT ((int*)(ws + WS_ROUTE + R_BLKCNT))
#define BLKEXP ((int*)(ws + WS_ROUTE + R_BLKEXP))
#define NBLK ((int*)(ws + WS_ROUTE + R_NBLK))
#define XBC ((bf16*)(ws + WS_XBC))
#define SSQ ((float*)(ws + WS_SSQ))
#define RS1 ((float*)(ws + WS_SSQ + 1 * MiB))
#define RS2 ((float*)(ws + WS_SSQ + 1 * MiB + 128 * 1024))
#define ROWRS ((float*)(ws + WS_SSQ + 1 * MiB + 256 * 1024))
#define XN8 (ws + WS_XN)
#define XG8 (ws + WS_XG)
#define ACT8 (ws + WS_ACT)
#define Wgu8 (ws + WS_WGU)
#define Wdn8 (ws + WS_WDN)
    const int lo = args.ph_lo, hi = args.ph_hi;
    if (tid < 64) ((LAS unsigned*)(lds + MISC_OFF))[tid] = 0u;
    __syncthreads();
    XcdBarrier bar = xcd_barrier_post((unsigned*)(ws + WS_CTL) + CW_BAR, (volatile LAS unsigned*)(lds + MISC_OFF), tid == 0);
#define GRID_BAR(k) do { if (IN(k) && IN((k) + 1)) xcd_barrier(bar, wave == 0 && lane_id() == 0); } while (0)
#ifndef PH_MASK
#define PH_MASK 0xffff
#endif
#define IN(k) (((PH_MASK >> (k)) & 1) && lo <= (k) && (k) < hi)


    if (IN(0)) {
        const int tid = fresh_tid(wave), lane = tid & 63; (void)lane;
        LAS float* scr = (LAS float*)(lds + wave * 17408);
        const int gw = bx * NWAVES + wave, NGW = G * NWAVES;
        constexpr int I_IN = 16 * (NPROJ / 32), I_OUT = 32 * 32, I_GU = 8 * 64, I_DN = 8 * 32;
        constexpr int NITEMS = I_IN + I_OUT + NE * I_GU + NE * I_DN;
        if (!(args.variant & 32))
        for (int it = gw; it < NITEMS - MOE_LATE; it += NGW) {
            int r = it;
            if (r < I_IN) { const int nb = r % (NPROJ / 32), kb = r / (NPROJ / 32), n0 = nb * 32; const int n0s = n0 + (n0 >= C_Q ? 16 : 0);
                const float cs = (n0 >= C_K && n0 < C_V) ? 0.08838834764831845f : 1.0f;
                transpose_item(INP(2), WIN_LD, n0s, kb * 64, Win_t, 1024, n0, cs, nullptr, scr, lane); continue; } r -= I_IN;
            if (r < I_OUT) { const int nb = r % 32, kb = r / 32; transpose_item(INP(12), 1024, nb * 32, kb * 64, Wout_t, 2048, nb * 32, 1.0f, kb < 16 ? INP(8) : nullptr, scr, lane); continue; } r -= I_OUT;
            if (r < NE * I_GU) { const int e = r / I_GU, q = r % I_GU, nb = q % 64, kb = q / 64, rho = nb * 32; const int n0s = ((rho >> 7) & 1) * 1024 + (rho >> 8) * 128 + (rho & 127);
                transpose_item_f8_128(INP(16) + (size_t)e * 1024 * 2048, 2048, n0s, kb * 128, Wgu8 + (size_t)e * 2048 * 1024, 1024, rho, 64.0f, scr, lane); continue; } r -= NE * I_GU;
            { const int e = r / I_DN, q = r % I_DN, nb = q % 32, kb = q / 32;
                transpose_item_f8_128(INP(18) + (size_t)e * 1024 * 1024, 1024, nb * 32, kb * 128, Wdn8 + (size_t)e * 1024 * 1024, 1024, nb * 32, 64.0f, scr, lane); }
        }
        __syncthreads();
        pt_fill(lds, INP(2), WIN_LD, tid, true, INP(1));
        __syncthreads();
        { const int c16 = lane & 15, g = lane >> 4;
          const float* wnp = INP(1); const float* bi_ = INP(9); const float* bf_ = INP(10); const float gb0 = INP(5)[c16], gb1 = *(c16 < 8 ? bi_ + c16 : bf_ + (c16 - 8));
          if (!(args.variant & 64))
#pragma unroll 1
          for (int task = gw; task < T / 16; task += NGW) { const int row0 = task * 16; f32x4 acc[2];
            const float rs = rowproj16<false, false>(XIN, XN, wnp, lds, row0, lane, acc);
            if (g == 0) RS1[row0 + c16] = rs;
#pragma unroll
            for (int r = 0; r < 4; ++r) { const float rr = __shfl(rs, 4 * g + r); float* gp = GATES + (size_t)(row0 + 4 * g + r) * 32; gp[c16] = rr * acc[0][r] + gb0; gp[16 + c16] = rr * acc[1][r] + gb1; } } }
        __syncthreads();
    }
    GRID_BAR(0);

    if (IN(1)) {
        pg8::Gemm g{XN, Win_t, T, NPROJ, 1024}; pg8::StaticOrder S; S.init(T, NPROJ, G, bx);
        pg8::EpiBf16 E{PROJ, NPROJ, RS1};
        pg8::gemm_phase<pg8::EpiBf16, pg8::StaticOrder>(lds, g, S, E, wave);
    }
    GRID_BAR(1);

    if (IN(2)) {
        const int tid = fresh_tid(wave), lane = tid & 63; (void)lane;
        const float* cw = INP(3); const float* cb = INP(4);
#pragma unroll 1
        for (int it = bx * NTHR + tid; it < (T / 16) * 192; it += G * NTHR) {
            const int ch = it % 192, t0 = (it / 192) * 16, c0 = ch * 8;
            float w[4][8], bs[8], r0[8], r1[8], r2[8];
#pragma unroll
            for (int k = 0; k < 4; ++k) { const f32x4 a = *(const f32x4*)(cw + k * 1536 + c0), b2 = *(const f32x4*)(cw + k * 1536 + c0 + 4);
#pragma unroll
                for (int e = 0; e < 4; ++e) { w[k][e] = a[e]; w[k][4 + e] = b2[e]; } }
            { const f32x4 a = *(const f32x4*)(cb + c0), b2 = *(const f32x4*)(cb + c0 + 4);
#pragma unroll
              for (int e = 0; e < 4; ++e) { bs[e] = a[e]; bs[4 + e] = b2[e]; } }
            const bf16* src = PROJ + (size_t)t0 * NPROJ + C_XBC + c0;
            if ((t0 & (SEQ - 1)) == 0) {
#pragma unroll
                for (int e = 0; e < 8; ++e) { r0[e] = 0.f; r1[e] = 0.f; r2[e] = 0.f; }
            } else { mx::unpack8(*(const v4u*)(src - 3 * (size_t)NPROJ), r0); mx::unpack8(*(const v4u*)(src - 2 * (size_t)NPROJ), r1); mx::unpack8(*(const v4u*)(src - (size_t)NPROJ), r2); }
            v4u raw[16];
#pragma unroll
            for (int i = 0; i < 16; ++i) raw[i] = *(const v4u*)(src + (size_t)i * NPROJ);
#pragma unroll
            for (int i = 0; i < 16; ++i) { float cu[8], o[8]; mx::unpack8(raw[i], cu);
#pragma unroll
                for (int e = 0; e < 8; ++e) { o[e] = silu_f(bs[e] + w[0][e] * r0[e] + w[1][e] * r1[e] + w[2][e] * r2[e] + w[3][e] * cu[e]); r0[e] = r1[e]; r1[e] = r2[e]; r2[e] = cu[e]; }
                v4u ov = {pk2(o[0], o[1]), pk2(o[2], o[3]), pk2(o[4], o[5]), pk2(o[6], o[7])};
                *(v4u*)(XBC + (size_t)(t0 + i) * 1536 + c0) = ov; }
        }
    }
    GRID_BAR(2);

    if (IN(3)) {
#pragma unroll 1
        for (int it = bx; it < 256; it += G) if ((it >> 3) & 1) mx::mlstm_item(lds, ((it >> 4) << 3) | (it & 7), args.variant, wave, PROJ, GATES, INP(11), MIX);
#pragma unroll 1
        for (int it = bx; it < 256; it += G) if (!((it >> 3) & 1)) {
            { const int lane = lane_id(); LAS float* scr = (LAS float*)(lds + wave * 17408); const int sw = ((((it >> 4) << 3) | (it & 7)) << 3) + wave;
              constexpr int I_DN = 8 * 32, N_DN = NE * I_DN;
#pragma unroll 1
              for (int j = 0; j < MOE_LATE_PER_WAVE; ++j) { const int r = N_DN - MOE_LATE + j * 1024 + sw; const int e = r / I_DN, q = r % I_DN, nb = q % 32, kb = q / 32;
                  transpose_item_f8_128(INP(18) + (size_t)e * 1024 * 1024, 1024, nb * 32, kb * 128, Wdn8 + (size_t)e * 1024 * 1024, 1024, nb * 32, 64.0f, scr, lane); }
              __syncthreads(); }
            mx::ssd_item(lds, ((it >> 4) << 3) | (it & 7), args.variant, wave, XBC, PROJ, GATES, INP(6), INP(7), MIX, SSQ); }
    }
    GRID_BAR(3);
    if (IN(4)) {
        pg8::Gemm g{MIX, Wout_t, T, 1024, 2048}; pg8::StaticOrder S; S.init(T, 1024, G, bx);
        pg8::EpiResF32 E{XIN, H, 1024, SSQ};
        pg8::gemm_phase<pg8::EpiResF32, pg8::StaticOrder>(lds, g, S, E, wave);
    }

    GRID_BAR(4);
    if (IN(5)) {
        const int tid = fresh_tid(wave), lane = tid & 63; (void)lane;
        LAS int* hist = (LAS int*)(lds + MISC_OFF + 256);
        pt_fill(lds, INP(14), 32, tid, false, INP(13));
        if (tid < 32) hist[tid] = 0;
        __syncthreads();
        const int c16 = lane & 15, g = lane >> 4; const float* wnp = INP(13); const float rb0 = INP(15)[c16], rb1 = INP(15)[16 + c16];
        for (int blk = bx; blk < T / 128; blk += G) {
            const int row0 = blk * 128 + wave * 16; f32x4 acc[2];
            const float rs = rowproj16<true, true>(H, XN8, wnp, lds, row0, lane, acc);
            if (g == 0) RS2[row0 + c16] = rs;
#pragma unroll
            for (int r = 0; r < 4; ++r) { const float rr = __shfl(rs, 4 * g + r); float v0 = rr * acc[0][r] + rb0, v1 = rr * acc[1][r] + rb1; float tv[4]; int ti[4];
#pragma unroll
                for (int k = 0; k < 4; ++k) { float bv = v0 >= v1 ? v0 : v1; int bi = v0 >= v1 ? c16 : c16 + 16;
#define TK_STEP(ctrl) do { const float ov = __builtin_bit_cast(float, __builtin_amdgcn_update_dpp(0, __builtin_bit_cast(int, bv), ctrl, 0xf, 0xf, false)); const int oi = __builtin_amdgcn_update_dpp(0, bi, ctrl, 0xf, 0xf, false); \
                        if (ov > bv || (ov == bv && oi < bi)) { bv = ov; bi = oi; } } while (0)
                    TK_STEP(0xB1); TK_STEP(0x4E); TK_STEP(0x141); TK_STEP(0x140);
#undef TK_STEP
                    tv[k] = bv; ti[k] = bi; if (bi == c16) v0 = -INFINITY; if (bi == c16 + 16) v1 = -INFINITY; }
                const float e1 = __expf(tv[1] - tv[0]), e2 = __expf(tv[2] - tv[0]), e3 = __expf(tv[3] - tv[0]); const float inv = 1.0f / (1.0f + e1 + e2 + e3);
                if (c16 == 0) { const size_t o = (size_t)(row0 + 4 * g + r) * 4; TOPI[o] = ti[0]; TOPI[o + 1] = ti[1]; TOPI[o + 2] = ti[2]; TOPI[o + 3] = ti[3];
                    TOPG[o] = inv; TOPG[o + 1] = e1 * inv; TOPG[o + 2] = e2 * inv; TOPG[o + 3] = e3 * inv;
                    __hip_atomic_fetch_add(hist + ti[0], 1, __ATOMIC_RELAXED, __HIP_MEMORY_SCOPE_WORKGROUP); __hip_atomic_fetch_add(hist + ti[1], 1, __ATOMIC_RELAXED, __HIP_MEMORY_SCOPE_WORKGROUP); __hip_atomic_fetch_add(hist + ti[2], 1, __ATOMIC_RELAXED, __HIP_MEMORY_SCOPE_WORKGROUP); __hip_atomic_fetch_add(hist + ti[3], 1, __ATOMIC_RELAXED, __HIP_MEMORY_SCOPE_WORKGROUP); } }
            __syncthreads();
            if (tid < 32) { BLKCNT[blk * 32 + tid] = hist[tid]; hist[tid] = 0; }
            __syncthreads();
        }
    }
    GRID_BAR(5);
    if (IN(6)) {
        const int tid = fresh_tid(wave), lane = tid & 63; (void)lane;
        LAS int* tot = (LAS int*)lds; LAS int* base = tot + 32; LAS int* pstart = base + 32; LAS int* wcnt = pstart + 33;
        LAS int* arow = wcnt + 256;
        LAS int* psum = arow + 512;
        for (int blk = bx; blk < T / 128; blk += G) {
            { const int e = tid & 31, part = tid >> 5; int v[16], t = 0, b = 0;
#pragma unroll
              for (int j = 0; j < 16; ++j) v[j] = BLKCNT[(part * 16 + j) * 32 + e];
#pragma unroll
              for (int j = 0; j < 16; ++j) { t += v[j]; if (part * 16 + j < blk) b += v[j]; }
              psum[part * 32 + e] = t; psum[512 + part * 32 + e] = b; }
            __syncthreads();
            if (tid < 32) { int t = 0, b = 0;
#pragma unroll
              for (int p = 0; p < 16; ++p) { t += psum[p * 32 + tid]; b += psum[512 + p * 32 + tid]; } tot[tid] = t; base[tid] = b; }
            __syncthreads();
            if (tid == 0) { int s = 0; for (int e = 0; e < 32; ++e) { pstart[e] = s; s += (tot[e] + 255) / 256 * 256; } pstart[32] = s; }
            __syncthreads();
            const int token = blk * 128 + (tid >> 2), k = tid & 3; const int e = TOPI[(size_t)token * 4 + k];
            int rank = 0;
#pragma unroll 1
            for (int ee = 0; ee < 32; ++ee) { const unsigned long long m = __ballot(e == ee); if (e == ee) rank = __popcll(m & ((1ull << lane) - 1ull)); if (lane == 0) wcnt[wave * 32 + ee] = __popcll(m); }
            __syncthreads();
            int off = 0; for (int w = 0; w < wave; ++w) off += wcnt[w * 32 + e];
            const int row = pstart[e] + base[e] + off + rank;
            ROWTOK[row] = token; ROWGATE[row] = TOPG[(size_t)token * 4 + k]; ROWRS[row] = RS2[token]; TOKROW[(size_t)token * 4 + k] = row; arow[tid] = row;
            __syncthreads();
            if (blk < 32) { const int ps = pstart[blk] + tot[blk], pe = pstart[blk + 1];
                for (int r = ps + tid; r < pe; r += NTHR) { ROWTOK[r] = 0; ROWGATE[r] = 0.f; ROWRS[r] = 0.f; } }
            if (blk == 0) { const int nb = pstart[32] / 256; if (tid == 0) NBLK[0] = nb;
                for (int b = tid; b < nb; b += NTHR) { int e2 = 0; while (e2 < 31 && b * 256 >= pstart[e2 + 1]) ++e2; BLKEXP[b] = e2; } }
            __syncthreads();
        }
    }

    GRID_BAR(6);
    if (IN(7)) {
        pg8::Gemm g{(const bf16*)XN8, (const bf16*)Wgu8, MAXROWS, 2048, 512}; pg8::MoeOrder S{BLKEXP, __builtin_amdgcn_readfirstlane(NBLK[0]), 8, G, bx};
        pg8::EpiSwiglu E{ROWTOK, ACT8, INP(17), ROWRS};
        pg8::gemm_phase_f8<pg8::EpiSwiglu, pg8::MoeOrder>(lds, g, S, E, wave, args.variant);
    }
    GRID_BAR(7);
    if (IN(8)) {
        pg8::Gemm g{(const bf16*)ACT8, (const bf16*)Wdn8, MAXROWS, 1024, 512}; pg8::MoeOrder S{BLKEXP, __builtin_amdgcn_readfirstlane(NBLK[0]), 4, G, bx};
        pg8::EpiDown E{nullptr, EO8, INP(19), ROWGATE};
        pg8::gemm_phase_f8<pg8::EpiDown, pg8::MoeOrder>(lds, g, S, E, wave);
    }
    GRID_BAR(8);
    if (IN(9)) {
        const int tid = fresh_tid(wave), lane = tid & 63; (void)lane;
        const int gw = bx * NWAVES + wave, NGW = G * NWAVES;
        f32x4 wf[4];
#pragma unroll
        for (int j = 0; j < 4; ++j) wf[j] = *(const f32x4*)(INP(20) + 4 * lane + 256 * j);
#pragma unroll 1
        for (int row = gw; row < T; row += 2 * NGW) {
            int er[2][4];
#pragma unroll
            for (int q = 0; q < 2; ++q) { const typeof(*(const v4u*)0) t4 = *(const v4u*)(TOKROW + (size_t)(row + q * NGW) * 4); er[q][0] = (int)t4.x; er[q][1] = (int)t4.y; er[q][2] = (int)t4.z; er[q][3] = (int)t4.w; }
            v2u hw[2][4]; int ew[2][4][4];
#pragma unroll
            for (int q = 0; q < 2; ++q)
#pragma unroll
                for (int j = 0; j < 4; ++j) hw[q][j] = *(const v2u*)(H + (size_t)(row + q * NGW) * 1024 + 4 * lane + 256 * j);
#pragma unroll
            for (int q = 0; q < 2; ++q)
#pragma unroll
                for (int k = 0; k < 4; ++k)
#pragma unroll
                    for (int j = 0; j < 4; ++j) ew[q][k][j] = *(const int*)(EO8 + (size_t)er[q][k] * 1024 + 4 * lane + 256 * j);
#pragma unroll
            for (int q = 0; q < 2; ++q) { f32x4 v[4], ya[4]; typedef float f2v __attribute__((ext_vector_type(2)));
#pragma unroll
                for (int j = 0; j < 4; ++j) { v[j] = (f32x4){bflo(hw[q][j].x), bfhi(hw[q][j].x), bflo(hw[q][j].y), bfhi(hw[q][j].y)}; ya[j] = (f32x4){0.f, 0.f, 0.f, 0.f}; }
#pragma unroll
                for (int k = 0; k < 4; ++k)
#pragma unroll
                    for (int j = 0; j < 4; ++j) { const f2v lo = __builtin_amdgcn_cvt_pk_f32_fp8(ew[q][k][j], false), hi = __builtin_amdgcn_cvt_pk_f32_fp8(ew[q][k][j], true); ya[j][0] += lo[0]; ya[j][1] += lo[1]; ya[j][2] += hi[0]; ya[j][3] += hi[1]; }
                float ss = 0.f;
#pragma unroll
                for (int j = 0; j < 4; ++j) { v[j] = v[j] + ya[j] * 0.0625f; ss += (v[j][0] * v[j][0] + v[j][1] * v[j][1]) + (v[j][2] * v[j][2] + v[j][3] * v[j][3]); }
                ss = wave_sum(ss); const float rs = rsqrt_f(ss * (1.0f / 1024.0f) + RMS_EPS);
#pragma unroll
                for (int j = 0; j < 4; ++j) *(f32x4*)(args.out + (size_t)(row + q * NGW) * 1024 + 4 * lane + 256 * j) = v[j] * rs * wf[j]; }
        }
    }
#undef IN
}

extern "C" void kernel_launch(void* const* d_in, const int* in_sizes, int n_in, void* d_out, int out_size, void* d_ws, size_t ws_size, hipStream_t stream) {
    static int grid = 0;
    if (grid == 0) {
        if (n_in != 21 || in_sizes[0] != T * D || out_size != T * D || ws_size < WS_END) { fprintf(stderr, "kernel_launch: unexpected shapes/workspace (n_in %d, ws %zu, need %zu)\n", n_in, ws_size, (size_t)WS_END); grid = -1; return; }
        if (hipFuncSetAttribute((const void*)mega, hipFuncAttributeMaxDynamicSharedMemorySize, LDS_BYTES) != hipSuccess) { fprintf(stderr, "kernel_launch: hipFuncSetAttribute failed\n"); grid = -1; return; }
        int dev = 0, cus = 0, per_cu = 0;
        if (hipGetDevice(&dev) != hipSuccess || hipDeviceGetAttribute(&cus, hipDeviceAttributeMultiprocessorCount, dev) != hipSuccess) { grid = -1; return; }
        if (hipOccupancyMaxActiveBlocksPerMultiprocessor(&per_cu, (const void*)mega, NTHR, LDS_BYTES) != hipSuccess || per_cu < 1) { fprintf(stderr, "kernel_launch: occupancy query says %d blocks per CU\n", per_cu); grid = -1; return; }
        (void)hipGetLastError();
        grid = cus;
    }
    if (grid < 0) return;
    (void)hipMemsetAsync((char*)d_ws + WS_CTL + (size_t)CW_BAR * 4, 0, (size_t)XCD_BAR_WORDS * 4, stream);
    Args a{};
    for (int i = 0; i < 21; ++i) a.in[i] = (const float*)d_in[i];
    a.out = (float*)d_out; a.ws = (unsigned char*)d_ws;
    a.ph_lo = 0; a.ph_hi = 10;
    hipLaunchKernelGGL(mega, dim3(grid), dim3(NTHR), LDS_BYTES, stream, a);
#ifdef PROBE_PHASE
    a.ph_lo = PROBE_PHASE; a.ph_hi = PROBE_PHASE + 1;
#ifdef PROBE_VARIANT
    a.variant = PROBE_VARIANT;
#endif
    hipLaunchKernelGGL(mega, dim3(grid), dim3(NTHR), LDS_BYTES, stream, a);
#endif
}
```

```cpp
#define WGM_SET 2
#include <hip/hip_runtime.h>
#include <cstdio>
#include <cstdint>

__device__ __forceinline__ int lane_id() { int l; asm volatile("v_mbcnt_lo_u32_b32 %0, -1, 0\n\tv_mbcnt_hi_u32_b32 %0, -1, %0" : "=v"(l)); return l; }
__device__ __forceinline__ void probe_spin(unsigned long long ticks) { const unsigned long long t0 = __builtin_amdgcn_s_memrealtime(); while (__builtin_amdgcn_s_memrealtime() - t0 < ticks) __builtin_amdgcn_s_sleep(8); }
namespace pg8 {
#define PG8_LAS __attribute__((address_space(3)))
typedef unsigned short bf16_t;
typedef short bf16x8 __attribute__((ext_vector_type(8)));
typedef float f32x4 __attribute__((ext_vector_type(4)));
typedef unsigned u32x4 __attribute__((ext_vector_type(4)));
#ifndef WGM_SET
#define WGM_SET 8
#endif
constexpr int BM = 256, BK = 64, HALF = 128, HTB = HALF * BK * 2, STAGE_BYTES = 8 * HTB, NXCD = 8, WGM = WGM_SET;

__host__ __device__ __forceinline__ int lds_byte(int r, int c) { const int st = (r >> 4) * 2 + (c >> 5), rr = r & 15, cc = c & 31, ob = rr * 64 + cc * 2; return st * 1024 + (ob ^ (((ob >> 9) & 1) << 5)); }
__host__ __device__ __forceinline__ void stage_rc(int b, int& R, int& C) { const int st = b / 1024, sb = b % 1024, swz = sb ^ (((sb >> 9) & 1) << 5); R = (st >> 1) * 16 + swz / 64; C = (st & 1) * 32 + (swz % 64) / 2; }
__host__ __device__ __forceinline__ int perm32(int rho) { const int n = rho >> 4, i = rho & 15; return 8 * (i >> 2) + 4 * n + (i & 3); }

__device__ __forceinline__ const char* uni_ptr(const void* p) { const unsigned long long v = (unsigned long long)p; const unsigned lo = __builtin_amdgcn_readfirstlane((unsigned)v), hi = __builtin_amdgcn_readfirstlane((unsigned)(v >> 32)); return (const char*)(((unsigned long long)hi << 32) | lo); }
struct Unit { int pm, pn, pb, e; };
struct Gemm { const bf16_t* A; const bf16_t* Bt; int M, N, K; };

struct StaticOrder {
    int nM, nN, nwg, G, c;
    __host__ __device__ void init(int M, int N, int G_, int c_) { nM = M / BM; nN = N / BM; nwg = nM * nN; G = G_; c = c_; }
    __host__ __device__ bool next(int i, Unit& u) const {
        const long L = (long)i * G + c; if (L >= nwg) return false;
        int wgid = (int)L; { const int q = nwg / NXCD, r = nwg % NXCD, xcd = wgid % NXCD, off = wgid / NXCD; wgid = (xcd < r ? xcd * (q + 1) : r * (q + 1) + (xcd - r) * q) + off; }
        const int nig = WGM * nN, gid = wgid / nig, fm = gid * WGM, gsz = (nM - fm) < WGM ? (nM - fm) : WGM;
        u.pm = fm + ((wgid % nig) % gsz); u.pn = (wgid % nig) / gsz; u.pb = u.pn; u.e = 0; return true;
    }
};
struct MoeOrder {
    const int* blk_expert; int nblk, ntn, G, c;
    __device__ bool next(int i, Unit& u) const {
        const int xcd = c % NXCD, s = i * (G / NXCD) + c / NXCD;
        const int rb = (s / ntn) * NXCD + xcd; if (rb >= nblk) return false;
        u.pm = rb; u.pn = s % ntn; u.e = __builtin_amdgcn_readfirstlane(blk_expert[rb]); u.pb = u.e * ntn + u.pn; return true;
    }
};

__device__ __forceinline__ unsigned cvt_pk_bf16(float lo, float hi) { unsigned r; asm volatile("v_cvt_pk_bf16_f32 %0, %1, %2" : "=v"(r) : "v"(lo), "v"(hi)); return r; }

struct EpiBf16 {
    static constexpr bool PERM = true; static constexpr int MIDT = -1;
    __device__ __forceinline__ void mid(f32x4 (&)[2][2][4][2], const Unit&, int, int) const {}
    bf16_t* O; int ldc; const float* rs;
    static constexpr bool HAS_ROWTAB = true;
    __device__ __forceinline__ const float* rowtab(const Unit& u) const { return rs + (size_t)u.pm * BM; }
    __device__ __forceinline__ void operator()(const f32x4 (&acc)[2][2][4][2], const Unit& u, int wr, int wc, int fr, int fq, const PG8_LAS float* rt) const {
        const int row0 = u.pm * BM + wr * 64 + fr, col0 = u.pn * BM + wc * 32 + 8 * fq;
#pragma unroll
        for (int ai = 0; ai < 2; ++ai)
#pragma unroll
            for (int m = 0; m < 4; ++m) { const int row = row0 + ai * HALF + m * 16; const float rr = rt[ai * HALF + wr * 64 + m * 16 + fr]; bf16_t* rowp = O + (size_t)row * ldc + col0;
#pragma unroll
                for (int bj = 0; bj < 2; ++bj) { const f32x4 v0 = acc[ai][bj][m][0] * rr, v1 = acc[ai][bj][m][1] * rr;
                    u32x4 w; w.x = cvt_pk_bf16(v0[0], v0[1]); w.y = cvt_pk_bf16(v0[2], v0[3]); w.z = cvt_pk_bf16(v1[0], v1[1]); w.w = cvt_pk_bf16(v1[2], v1[3]);
                    *(u32x4*)(rowp + bj * HALF) = w; } }
    }
};
struct EpiResF32 {
    static constexpr bool PERM = true; static constexpr int MIDT = 16;
    const float* base; bf16_t* C; int ldc; const float* ssq;
    __device__ __forceinline__ void mid(f32x4 (&acc)[2][2][4][2], const Unit& u, int wr, int fr) const {
#pragma unroll
        for (int ai = 0; ai < 2; ++ai)
#pragma unroll
            for (int m = 0; m < 4; ++m) { const int row = u.pm * BM + ai * HALF + wr * 64 + m * 16 + fr; const f32x4 a = *(const f32x4*)(ssq + (size_t)row * 8), b = *(const f32x4*)(ssq + (size_t)row * 8 + 4);
                const float rs = 1.0f / sqrtf(((a[0] + a[1]) + (a[2] + a[3]) + (b[0] + b[1]) + (b[2] + b[3])) * (1.0f / 1024.0f) + 1e-6f);
#pragma unroll
                for (int bj = 0; bj < 2; ++bj)
#pragma unroll
                    for (int n = 0; n < 2; ++n) acc[ai][bj][m][n] = acc[ai][bj][m][n] * rs;
                asm volatile("" ::: "memory"); }
    }
    static constexpr bool HAS_ROWTAB = false;
    __device__ __forceinline__ const float* rowtab(const Unit&) const { return nullptr; }
    __device__ __forceinline__ void operator()(const f32x4 (&acc)[2][2][4][2], const Unit& u, int wr, int wc, int fr, int fq, const PG8_LAS float*) const {
        const int row0 = u.pm * BM + wr * 64 + fr, col0 = u.pn * BM + wc * 32 + 8 * fq;
#pragma unroll
        for (int ai = 0; ai < 2; ++ai)
#pragma unroll
            for (int m = 0; m < 4; ++m) { const size_t off = (size_t)(row0 + ai * HALF + m * 16) * ldc + col0;
#pragma unroll
                for (int bj = 0; bj < 2; ++bj) { const f32x4 b0 = *(const f32x4*)(base + off + bj * HALF), b1 = *(const f32x4*)(base + off + bj * HALF + 4);
                    const f32x4 v0 = acc[ai][bj][m][0] + b0, v1 = acc[ai][bj][m][1] + b1;
                    u32x4 w; w.x = cvt_pk_bf16(v0[0], v0[1]); w.y = cvt_pk_bf16(v0[2], v0[3]); w.z = cvt_pk_bf16(v1[0], v1[1]); w.w = cvt_pk_bf16(v1[2], v1[3]);
                    *(u32x4*)(C + off + bj * HALF) = w; } }
    }
};
struct EpiSwiglu {
    static constexpr bool PERM = true; static constexpr int MIDT = -1;
    __device__ __forceinline__ void mid(f32x4 (&)[2][2][4][2], const Unit&, int, int) const {}
    static constexpr bool GATHER = true; const int* rowtok;
    unsigned char* act; const float* bgu; const float* rs;
    __device__ __forceinline__ const float* rowtab(const Unit& u) const { return rs + (size_t)u.pm * BM; }
    __device__ __forceinline__ const float* coltab(const Unit& u, int q) const { return bgu + (size_t)u.e * 2048 + u.pn * HALF + (q >> 1) * 1024 + (q & 1) * 64; }
    __device__ __forceinline__ void operator()(const f32x4 (&acc)[2][2][4][2], const Unit& u, int wr, int wc, int fr, int fq, const PG8_LAS float* tab) const {
        const int row0 = u.pm * BM + wr * 64 + fr, col0 = u.pn * HALF + wc * 32 + 8 * fq;
        const PG8_LAS float* ct = tab + 256 + wc * 32 + 8 * fq;
        f32x4 bgv[2], buv[2];
#pragma unroll
        for (int n = 0; n < 2; ++n) { bgv[n] = *(const PG8_LAS f32x4*)(ct + 4 * n); buv[n] = *(const PG8_LAS f32x4*)(ct + 128 + 4 * n); }
#pragma unroll
        for (int ai = 0; ai < 2; ++ai)
#pragma unroll
            for (int m = 0; m < 4; ++m) { const int row = row0 + ai * HALF + m * 16; const float rr = tab[ai * HALF + wr * 64 + m * 16 + fr]; unsigned char* rowp = act + (size_t)row * 1024 + col0;
                float o[8];
#pragma unroll
                for (int n = 0; n < 2; ++n) { typedef float f2 __attribute__((ext_vector_type(2)));
#pragma unroll
                    for (int h = 0; h < 2; ++h) { const f2 ag = {acc[ai][0][m][n][2 * h], acc[ai][0][m][n][2 * h + 1]}, au = {acc[ai][1][m][n][2 * h], acc[ai][1][m][n][2 * h + 1]};
                        const f2 bg2 = {bgv[n][2 * h], bgv[n][2 * h + 1]}, bu2 = {buv[n][2 * h], buv[n][2 * h + 1]};
                        f2 gv = ag * rr + bg2, uv = au * rr + bu2;
                        gv.x = fminf(gv.x, 7.0f); gv.y = fminf(gv.y, 7.0f); uv.x = __builtin_amdgcn_fmed3f(uv.x, -7.0f, 7.0f); uv.y = __builtin_amdgcn_fmed3f(uv.y, -7.0f, 7.0f);
                        const f2 t = gv * (-1.702f * 1.44269504f); f2 e; e.x = __builtin_amdgcn_exp2f(t.x); e.y = __builtin_amdgcn_exp2f(t.y);
                        const f2 d = e + 1.0f; f2 r; r.x = __builtin_amdgcn_rcpf(d.x); r.y = __builtin_amdgcn_rcpf(d.y);
                        const f2 res = ((uv + 1.0f) * gv) * r; o[4 * n + 2 * h] = res.x; o[4 * n + 2 * h + 1] = res.y; } }
                int w0 = 0, w1 = 0; w0 = __builtin_amdgcn_cvt_pk_fp8_f32(o[0], o[1], w0, false); w0 = __builtin_amdgcn_cvt_pk_fp8_f32(o[2], o[3], w0, true); w1 = __builtin_amdgcn_cvt_pk_fp8_f32(o[4], o[5], w1, false); w1 = __builtin_amdgcn_cvt_pk_fp8_f32(o[6], o[7], w1, true);
                typedef int i2v __attribute__((ext_vector_type(2))); *(i2v*)rowp = (i2v){w0, w1}; }
    }
};
struct EpiDown {
    static constexpr bool PERM = true; static constexpr int MIDT = -1;
    __device__ __forceinline__ void mid(f32x4 (&)[2][2][4][2], const Unit&, int, int) const {}
    static constexpr bool GATHER = false; const int* rowtok;
    unsigned char* eo; const float* bdn; const float* row_gate;
    __device__ __forceinline__ const float* rowtab(const Unit& u) const { return row_gate + (size_t)u.pm * BM; }
    __device__ __forceinline__ const float* coltab(const Unit& u, int q) const { return bdn + (size_t)u.e * 1024 + u.pn * BM + q * 64; }
    __device__ __forceinline__ void operator()(const f32x4 (&acc)[2][2][4][2], const Unit& u, int wr, int wc, int fr, int fq, const PG8_LAS float* tab) const {
        const int row0 = u.pm * BM + wr * 64 + fr, col0 = u.pn * BM + wc * 32 + 8 * fq;
        const PG8_LAS float* ct = tab + 256 + wc * 32 + 8 * fq;
        f32x4 bv[2][2];
#pragma unroll
        for (int bj = 0; bj < 2; ++bj)
#pragma unroll
            for (int n = 0; n < 2; ++n) bv[bj][n] = *(const PG8_LAS f32x4*)(ct + bj * HALF + 4 * n);
#pragma unroll
        for (int ai = 0; ai < 2; ++ai)
#pragma unroll
            for (int m = 0; m < 4; ++m) { const int row = row0 + ai * HALF + m * 16; const float gt = tab[ai * HALF + wr * 64 + m * 16 + fr] * 16.0f; unsigned char* rowp = eo + (size_t)row * 1024 + col0;
#pragma unroll
                for (int bj = 0; bj < 2; ++bj) { f32x4 v0 = (acc[ai][bj][m][0] + bv[bj][0]) * gt, v1 = (acc[ai][bj][m][1] + bv[bj][1]) * gt;
#pragma unroll
                    for (int i = 0; i < 4; ++i) { v0[i] = __builtin_amdgcn_fmed3f(v0[i], -448.0f, 448.0f); v1[i] = __builtin_amdgcn_fmed3f(v1[i], -448.0f, 448.0f); }
                    int w0 = 0, w1 = 0; w0 = __builtin_amdgcn_cvt_pk_fp8_f32(v0[0], v0[1], w0, false); w0 = __builtin_amdgcn_cvt_pk_fp8_f32(v0[2], v0[3], w0, true); w1 = __builtin_amdgcn_cvt_pk_fp8_f32(v1[0], v1[1], w1, false); w1 = __builtin_amdgcn_cvt_pk_fp8_f32(v1[2], v1[3], w1, true);
                    typedef int i2v __attribute__((ext_vector_type(2))); *(i2v*)(rowp + bj * HALF) = (i2v){w0, w1}; } }
    }
};

typedef int v8i_t __attribute__((ext_vector_type(8)));
typedef int v4i_t __attribute__((ext_vector_type(4)));
template <class Epi, class Sched>
__device__ __forceinline__ void gemm_phase(PG8_LAS unsigned char* lds, const Gemm g, const Sched& S, const Epi& E, int wid) {
    const int lane = lane_id(), tid = wid * 64 + lane, wr = wid >> 2, wc = wid & 3, fr = lane & 15, fq = lane >> 4;
    const int K = g.K, nt = K / BK;
    unsigned voffA[2], voffB[2];
#pragma unroll
    for (int i = 0; i < 2; ++i) { int R, C; stage_rc(tid * 16 + i * 8192, R, C); const int Rb = Epi::PERM ? ((R & ~31) + perm32(R & 31)) : R;
        voffA[i] = (unsigned)(R * K + C) * 2u; voffB[i] = (unsigned)(Rb * K + C) * 2u; }
    const size_t kstep = (size_t)(BK * 2);
    const size_t hstep = (size_t)HALF * K * 2;
    const size_t tstep = 2 * hstep;
    const unsigned ldsw = (unsigned)wid * 1024u;
    const int aoff = lds_byte(wr * 64 + fr, fq * 8), boff = lds_byte(wc * 32 + fr, fq * 8);
#define PG8_SA(b, h) (((b) * 2 + (h)) * HTB)
#define PG8_SB(b, h) ((4 + (b) * 2 + (h)) * HTB)
#define PG8_STAGE(bufoff, gbase, voff) do { _Pragma("unroll") for (int _i = 0; _i < 2; ++_i) \
        __builtin_amdgcn_global_load_lds((const unsigned*)((const char*)(gbase) + (voff)[_i]), (PG8_LAS unsigned*)(lds + (bufoff) + ldsw + _i * 8192), 16, 0, 0); } while (0)
#define PG8_LDA(dst, b, h) do { _Pragma("unroll") for (int m = 0; m < 4; ++m) _Pragma("unroll") for (int k = 0; k < 2; ++k) dst[m][k] = *(const PG8_LAS bf16x8*)(lds + PG8_SA(b, h) + aoff + m * 2048 + k * 1024); } while (0)
#define PG8_LDB(dst, b, h) do { _Pragma("unroll") for (int n = 0; n < 2; ++n) _Pragma("unroll") for (int k = 0; k < 2; ++k) dst[n][k] = *(const PG8_LAS bf16x8*)(lds + PG8_SB(b, h) + boff + n * 2048 + k * 1024); } while (0)
#define PG8_MMA(ai, bj, At, Bt) do { __builtin_amdgcn_s_setprio(1); _Pragma("unroll") for (int m = 0; m < 4; ++m) _Pragma("unroll") for (int n = 0; n < 2; ++n) _Pragma("unroll") for (int k = 0; k < 2; ++k) \
        acc[ai][bj][m][n] = __builtin_amdgcn_mfma_f32_16x16x32_bf16(Bt[n][k], At[m][k], acc[ai][bj][m][n], 0, 0, 0); __builtin_amdgcn_s_setprio(0); } while (0)
#define PG8_WAIT_V(n) asm volatile("s_waitcnt vmcnt(" #n ")" ::: "memory")
#define PG8_WAIT_L(n) asm volatile("s_waitcnt lgkmcnt(" #n ")" ::: "memory")
#define PG8_BAR __builtin_amdgcn_s_barrier()
#define PG8_SCHED __builtin_amdgcn_sched_barrier(0)
    Unit cur, nxt; int ui = 0;
    if (!S.next(0, cur)) return;
    f32x4 acc[2][2][4][2];
#pragma unroll
    for (int a = 0; a < 2; ++a)
#pragma unroll
        for (int b = 0; b < 2; ++b)
#pragma unroll
            for (int m = 0; m < 4; ++m)
#pragma unroll
                for (int n = 0; n < 2; ++n) acc[a][b][m][n] = (f32x4){0.f, 0.f, 0.f, 0.f};
    bf16x8 At[4][2], B0[2][2], B1[2][2];
    const char* cA = uni_ptr((const char*)g.A + (size_t)cur.pm * tstep); const char* cB = uni_ptr((const char*)g.Bt + (size_t)cur.pb * tstep);
#define PG8_ROWTAB(u_, slot_) do { if (Epi::HAS_ROWTAB && wid < 4) __builtin_amdgcn_global_load_lds((const unsigned*)(E.rowtab(u_) + wid * 64 + lane), (PG8_LAS unsigned*)(lds + STAGE_BYTES + (slot_) * 1024 + wid * 256), 4, 0, 0); } while (0)
    PG8_ROWTAB(cur, 0);
    PG8_STAGE(PG8_SB(0, 0), cB, voffB); PG8_STAGE(PG8_SB(0, 1), cB + hstep, voffB); PG8_STAGE(PG8_SA(0, 0), cA, voffA); PG8_STAGE(PG8_SA(0, 1), cA + hstep, voffA);
    if (wr == 1) PG8_BAR;
    PG8_WAIT_V(2); PG8_BAR;
    PG8_STAGE(PG8_SB(1, 0), cB + kstep, voffB); PG8_STAGE(PG8_SA(1, 0), cA + kstep, voffA); PG8_STAGE(PG8_SB(1, 1), cB + hstep + kstep, voffB);
    PG8_WAIT_V(6); PG8_BAR;
    for (;;) {
        const bool has_next = S.next(ui + 1, nxt);
        const char* nA = uni_ptr(has_next ? (const char*)g.A + (size_t)nxt.pm * tstep : cA); const char* nB = uni_ptr(has_next ? (const char*)g.Bt + (size_t)nxt.pb * tstep : cB);
        for (int t = 0; t < nt; t += 2) {
            const bool last = (t == nt - 2);
            const char* a1 = cA + (size_t)(t + 1) * kstep;
            const char* a2 = last ? nA : cA + (size_t)(t + 2) * kstep; const char* b2 = last ? nB : cB + (size_t)(t + 2) * kstep;
            const char* a3 = a2 + kstep; const char* b3 = b2 + kstep;
            if constexpr (Epi::MIDT >= 0) { if (t == Epi::MIDT) E.mid(acc, cur, wr, fr); }
            PG8_LDB(B0, 0, 0); PG8_LDB(B1, 0, 1); PG8_SCHED; PG8_LDA(At, 0, 0); PG8_STAGE(PG8_SA(1, 1), a1 + hstep, voffA);
            PG8_WAIT_V(8); PG8_WAIT_L(0); PG8_BAR; PG8_MMA(0, 0, At, B0); PG8_MMA(0, 1, At, B1); PG8_BAR; PG8_SCHED;
            PG8_LDA(At, 0, 1); PG8_STAGE(PG8_SB(0, 0), b2, voffB); PG8_STAGE(PG8_SB(0, 1), b2 + hstep, voffB); PG8_STAGE(PG8_SA(0, 0), a2, voffA);
            PG8_WAIT_V(8); PG8_WAIT_L(0); PG8_BAR; PG8_MMA(1, 0, At, B0); PG8_MMA(1, 1, At, B1); PG8_BAR; PG8_SCHED;
            PG8_LDB(B0, 1, 0); PG8_LDB(B1, 1, 1); PG8_SCHED; PG8_LDA(At, 1, 0); PG8_STAGE(PG8_SA(0, 1), a2 + hstep, voffA);
            PG8_WAIT_V(8); PG8_WAIT_L(0); PG8_BAR; PG8_MMA(0, 0, At, B0); PG8_MMA(0, 1, At, B1); PG8_BAR; PG8_SCHED;
            PG8_LDA(At, 1, 1); PG8_STAGE(PG8_SB(1, 0), b3, voffB); PG8_STAGE(PG8_SB(1, 1), b3 + hstep, voffB); PG8_STAGE(PG8_SA(1, 0), a3, voffA);
            PG8_WAIT_V(8); PG8_WAIT_L(0); PG8_BAR; PG8_MMA(1, 0, At, B0); PG8_MMA(1, 1, At, B1); PG8_BAR; PG8_SCHED;
        }
        if (wr == 0) PG8_BAR;
        E(acc, cur, wr, wc, fr, fq, (const PG8_LAS float*)(lds + STAGE_BYTES + (ui & 1) * 1024));
        if (!has_next) break;
#pragma unroll
        for (int a = 0; a < 2; ++a)
#pragma unroll
            for (int b = 0; b < 2; ++b)
#pragma unroll
                for (int m = 0; m < 4; ++m)
#pragma unroll
                    for (int n = 0; n < 2; ++n) acc[a][b][m][n] = (f32x4){0.f, 0.f, 0.f, 0.f};
        cur = nxt; cA = nA; cB = nB; ++ui;
        PG8_ROWTAB(cur, ui & 1);
        if (wr == 1) PG8_BAR;
    }
    PG8_WAIT_V(0);
    PG8_BAR;
#undef PG8_ROWTAB
#undef PG8_SA
#undef PG8_SB
#undef PG8_STAGE
#undef PG8_LDA
#undef PG8_LDB
#undef PG8_MMA
#undef PG8_WAIT_V
#undef PG8_WAIT_L
#undef PG8_BAR
#undef PG8_SCHED
}
template <class Epi, class Sched>
__device__ __forceinline__ void gemm_phase_f8(PG8_LAS unsigned char* lds, const Gemm g, const Sched& S, const Epi& E, int wid, int var = 0) {
    const int lane = lane_id(), tid = wid * 64 + lane, wr = wid >> 2, wc = wid & 3, fr = lane & 15, fq = lane >> 4;
    int Kq = g.K; asm volatile("" : "+s"(Kq));
    const int K = Kq, nt = K / BK;
    unsigned voffA[2], voffB[2];
#pragma unroll
    for (int i = 0; i < 2; ++i) { int R, C; stage_rc(tid * 16 + i * 8192, R, C); const int Rb = Epi::PERM ? ((R & ~31) + perm32(R & 31)) : R;
        voffA[i] = (unsigned)(R * K + C) * 2u; voffB[i] = (unsigned)(Rb * K + C) * 2u; }
    const size_t kstep = (size_t)(BK * 2);
    const size_t hstep = (size_t)HALF * K * 2;
    const size_t tstep = 2 * hstep;
    const unsigned ldsw = (unsigned)wid * 1024u;
    const unsigned ldsb = (unsigned)__builtin_amdgcn_readfirstlane((int)((unsigned)(size_t)lds + ldsw));
    const int aoff = lds_byte(wr * 64 + fr, fq * 8), boff = lds_byte(wc * 32 + fr, fq * 8);
#define PG8_SA(b, h) (((b) * 2 + (h)) * HTB)
#define PG8_SB(b, h) ((4 + (b) * 2 + (h)) * HTB)
#define PG8_STAGE(bufoff, gbase, voff) do { _Pragma("unroll") for (int _i = 0; _i < 2; ++_i) { unsigned _keep; \
        asm volatile("s_mov_b32 %0, m0\n\ts_mov_b32 m0, %3\n\ts_nop 0\n\tglobal_load_lds_dwordx4 %1, %2\n\ts_mov_b32 m0, %0" : "=&s"(_keep) : "v"((voff)[_i]), "s"((const char*)(gbase)), "s"(ldsb + (unsigned)((bufoff) + _i * 8192)) : "memory"); } } while (0)
#define PG8_STAGE_A(b, h, ka) do { if constexpr (Epi::GATHER) { _Pragma("unroll") for (int _i = 0; _i < 2; ++_i) { unsigned _keep; const unsigned _vo = (((voffA[_i] >> (16 * (h))) & 0xffffu) << 10) + cbA; \
        asm volatile("s_mov_b32 %0, m0\n\ts_mov_b32 m0, %3\n\ts_nop 0\n\tglobal_load_lds_dwordx4 %1, %2\n\ts_mov_b32 m0, %0" : "=&s"(_keep) : "v"(_vo), "s"((const char*)(ka)), "s"(ldsb + (unsigned)(PG8_SA(b, h) + _i * 8192)) : "memory"); } } \
    else PG8_STAGE(PG8_SA(b, h), (ka) + (h) * hstep, voffA); } while (0)
#define PG8_LDA(dst, b, h) do { _Pragma("unroll") for (int m = 0; m < 4; ++m) { const v4i_t _lo = *(const PG8_LAS v4i_t*)(lds + PG8_SA(b, h) + aoff + m * 2048), _hi = *(const PG8_LAS v4i_t*)(lds + PG8_SA(b, h) + aoff + m * 2048 + 1024); dst[m] = __builtin_shufflevector(_lo, _hi, 0, 1, 2, 3, 4, 5, 6, 7); } } while (0)
#define PG8_LDB(dst, b, h) do { _Pragma("unroll") for (int n = 0; n < 2; ++n) { const v4i_t _lo = *(const PG8_LAS v4i_t*)(lds + PG8_SB(b, h) + boff + n * 2048), _hi = *(const PG8_LAS v4i_t*)(lds + PG8_SB(b, h) + boff + n * 2048 + 1024); dst[n] = __builtin_shufflevector(_lo, _hi, 0, 1, 2, 3, 4, 5, 6, 7); } } while (0)
#define PG8_MMA(ai, bj, At, Bt) do { __builtin_amdgcn_s_setprio(1); _Pragma("unroll") for (int m = 0; m < 4; ++m) _Pragma("unroll") for (int n = 0; n < 2; ++n) \
        acc[ai][bj][m][n] = __builtin_amdgcn_mfma_scale_f32_16x16x128_f8f6f4(Bt[n], At[m], acc[ai][bj][m][n], 0, 0, 0, 0x79797979, 0, 0x7f7f7f7f); __builtin_amdgcn_s_setprio(0); } while (0)
#define PG8_WAIT_V(n) asm volatile("s_waitcnt vmcnt(" #n ")" ::: "memory")
#define PG8_WAIT_L(n) asm volatile("s_waitcnt lgkmcnt(" #n ")" ::: "memory")
#define PG8_BAR __builtin_amdgcn_s_barrier()
#define PG8_SCHED __builtin_amdgcn_sched_barrier(0)
#ifdef PROBE_GEMM
    unsigned long long p_acc = 0;
#endif
    Unit cur, nxt; int ui = 0;
    if (!S.next(0, cur)) return;
    f32x4 acc[2][2][4][2];
#pragma unroll
    for (int a = 0; a < 2; ++a)
#pragma unroll
        for (int b = 0; b < 2; ++b)
#pragma unroll
            for (int m = 0; m < 4; ++m)
#pragma unroll
                for (int n = 0; n < 2; ++n) acc[a][b][m][n] = (f32x4){0.f, 0.f, 0.f, 0.f};
    v8i_t At[4], B0[2], B1[2];
    const char* cA = uni_ptr((const char*)g.A + (Epi::GATHER ? (size_t)0 : (size_t)cur.pm * tstep)); const char* cB = uni_ptr((const char*)g.Bt + (size_t)cur.pb * tstep);
    unsigned cbA = 0;
    if constexpr (Epi::GATHER) { int R, C; stage_rc(tid * 16, R, C); cbA = (unsigned)C * 2u; const int* rt = E.rowtok + (size_t)cur.pm * BM + R;
        const int t00 = rt[0], t01 = rt[64], t10 = rt[128], t11 = rt[192]; voffA[0] = (unsigned)t00 | ((unsigned)t10 << 16); voffA[1] = (unsigned)t01 | ((unsigned)t11 << 16); }
#define PG8_TABS(u_, slot_) do { const char* _src = uni_ptr(wid < 4 ? E.rowtab(u_) + wid * 64 : E.coltab(u_, wid - 4)); unsigned _keep; \
        asm volatile("s_mov_b32 %0, m0\n\ts_mov_b32 m0, %3\n\ts_nop 0\n\tglobal_load_lds_dword %1, %2\n\ts_mov_b32 m0, %0" : "=&s"(_keep) : "v"(lane_id() * 4), "s"(_src), "s"(ldsb - ldsw + (unsigned)(STAGE_BYTES + (slot_) * 2048) + (unsigned)wid * 256u) : "memory"); } while (0)
    PG8_TABS(cur, 0);
    PG8_STAGE(PG8_SB(0, 0), cB, voffB); PG8_STAGE(PG8_SB(0, 1), cB + hstep, voffB); PG8_STAGE_A(0, 0, cA); PG8_STAGE_A(0, 1, cA);
    if (wr == 1) PG8_BAR;
    PG8_WAIT_V(2); PG8_BAR;
    PG8_STAGE(PG8_SB(1, 0), cB + kstep, voffB); PG8_STAGE_A(1, 0, cA + kstep); PG8_STAGE(PG8_SB(1, 1), cB + hstep + kstep, voffB);
    PG8_WAIT_V(6); PG8_BAR;
    for (;;) {
        const bool has_next = S.next(ui + 1, nxt);
        const char* nA = uni_ptr(has_next && !Epi::GATHER ? (const char*)g.A + (size_t)nxt.pm * tstep : cA); const char* nB = uni_ptr(has_next ? (const char*)g.Bt + (size_t)nxt.pb * tstep : cB);
        if constexpr (Epi::GATHER) { if (has_next && wid < 4) { const char* _src = uni_ptr(E.rowtok + (size_t)nxt.pm * BM + wid * 64); unsigned _keep;
            asm volatile("s_mov_b32 %0, m0\n\ts_mov_b32 m0, %3\n\ts_nop 0\n\tglobal_load_lds_dword %1, %2\n\ts_mov_b32 m0, %0" : "=&s"(_keep) : "v"(lane_id() * 4), "s"(_src), "s"(ldsb - ldsw + (unsigned)(STAGE_BYTES + 4096) + (unsigned)wid * 256u) : "memory"); } }
#ifdef PROBE_GEMM
        unsigned long long pt0 = 0; if (var && PROBE_GEMM == 1) pt0 = __builtin_amdgcn_s_memrealtime();
#endif
        for (int t = 0; t < nt; t += 2) {
            const bool last = (t == nt - 2);
            const char* a1 = cA + (size_t)(t + 1) * kstep;
            const char* a2 = last ? nA : cA + (size_t)(t + 2) * kstep; const char* b2 = last ? nB : cB + (size_t)(t + 2) * kstep;
            const char* a3 = a2 + kstep; const char* b3 = b2 + kstep;
            if constexpr (Epi::MIDT >= 0) { if (t == Epi::MIDT) E.mid(acc, cur, wr, fr); }
            PG8_LDB(B0, 0, 0); PG8_LDB(B1, 0, 1); PG8_SCHED; PG8_LDA(At, 0, 0); PG8_STAGE_A(1, 1, a1);
            PG8_WAIT_V(8); PG8_WAIT_L(0); PG8_BAR; PG8_MMA(0, 0, At, B0); PG8_MMA(0, 1, At, B1); PG8_BAR; PG8_SCHED;
            if constexpr (Epi::GATHER) { if (last && has_next) {
                const PG8_LAS int* tk = (const PG8_LAS int*)(lds + STAGE_BYTES + 4096) + (wid >> 1) * 16 + (lane_id() >> 2);
                const int t00 = tk[0], t01 = tk[64], t10 = tk[128], t11 = tk[192]; voffA[0] = (unsigned)t00 | ((unsigned)t10 << 16); voffA[1] = (unsigned)t01 | ((unsigned)t11 << 16); } }
            PG8_LDA(At, 0, 1); PG8_STAGE(PG8_SB(0, 0), b2, voffB); PG8_STAGE(PG8_SB(0, 1), b2 + hstep, voffB); PG8_STAGE_A(0, 0, a2);
            PG8_WAIT_V(8); PG8_WAIT_L(0); PG8_BAR; PG8_MMA(1, 0, At, B0); PG8_MMA(1, 1, At, B1); PG8_BAR; PG8_SCHED;
            PG8_LDB(B0, 1, 0); PG8_LDB(B1, 1, 1); PG8_SCHED; PG8_LDA(At, 1, 0); PG8_STAGE_A(0, 1, a2);
            PG8_WAIT_V(8); PG8_WAIT_L(0); PG8_BAR; PG8_MMA(0, 0, At, B0); PG8_MMA(0, 1, At, B1); PG8_BAR; PG8_SCHED;
            PG8_LDA(At, 1, 1); PG8_STAGE(PG8_SB(1, 0), b3, voffB); PG8_STAGE(PG8_SB(1, 1), b3 + hstep, voffB); PG8_STAGE_A(1, 0, a3);
            PG8_WAIT_V(8); PG8_WAIT_L(0); PG8_BAR; PG8_MMA(1, 0, At, B0); PG8_MMA(1, 1, At, B1); PG8_BAR; PG8_SCHED;
        }
#ifdef PROBE_GEMM
        if (var && PROBE_GEMM == 1) p_acc += __builtin_amdgcn_s_memrealtime() - pt0;
        if (var && PROBE_GEMM == 2) pt0 = __builtin_amdgcn_s_memrealtime();
#endif
        if (wr == 0) PG8_BAR;
        { const int l2 = lane_id(); E(acc, cur, wr, wc, l2 & 15, l2 >> 4, (const PG8_LAS float*)(lds + STAGE_BYTES + (ui & 1) * 2048)); }
#ifdef PROBE_GEMM
        if (var && PROBE_GEMM == 2) p_acc += __builtin_amdgcn_s_memrealtime() - pt0;
        if (var && PROBE_GEMM == 3) p_acc += 1000;
#endif
        if (!has_next) break;
#pragma unroll
        for (int a = 0; a < 2; ++a)
#pragma unroll
            for (int b = 0; b < 2; ++b)
#pragma unroll
                for (int m = 0; m < 4; ++m)
#pragma unroll
                    for (int n = 0; n < 2; ++n) acc[a][b][m][n] = (f32x4){0.f, 0.f, 0.f, 0.f};
        cur = nxt; cA = nA; cB = nB; ++ui;
        PG8_TABS(cur, ui & 1);
        if (wr == 1) PG8_BAR;
    }
    PG8_WAIT_V(0);
    PG8_BAR;
#ifdef PROBE_GEMM
    if (var && blockIdx.x == 0 && wid == 0) probe_spin(p_acc * 16);
#endif
#undef PG8_TABS
#undef PG8_STAGE_A
#undef PG8_SA
#undef PG8_SB
#undef PG8_STAGE
#undef PG8_LDA
#undef PG8_LDB
#undef PG8_MMA
#undef PG8_WAIT_V
#undef PG8_WAIT_L
#undef PG8_BAR
#undef PG8_SCHED
}
}

constexpr int BATCH = 16, SEQ = 2048, T = BATCH * SEQ, D = 1024;
constexpr int NPROJ = 6656;
constexpr int C_Z = 0, C_XBC = 1024, C_Q = 2560, C_K = 3584, C_V = 4608, C_O = 5632;
constexpr int WIN_LD = 6688;
constexpr int NE = 32, TOPK = 4;
constexpr int NASSIGN = T * TOPK, MAXBLK = NASSIGN / 256 + NE, MAXROWS = MAXBLK * 256;
constexpr float RMS_EPS = 1e-6f;
constexpr int NWAVES = 8, NTHR = 512;

constexpr size_t MiB = 1u << 20;
constexpr size_t WS_CTL = 0, CTL_ZERO_BYTES = 1 * MiB;
constexpr size_t WS_WIN = 1 * MiB, WS_WOUT = 14 * MiB, WS_WGU = 18 * MiB, WS_WDN = 146 * MiB;
constexpr size_t WS_XN = 210 * MiB, WS_H = 274 * MiB, WS_GATES = 402 * MiB, WS_ROUTE = 406 * MiB, WS_PROJ = 412 * MiB, WS_MIX = 828 * MiB, WS_END = 956 * MiB;
constexpr size_t WS_XBC = WS_H;
constexpr size_t WS_SSQ = WS_ROUTE + 3 * MiB;
constexpr size_t WS_XG = WS_PROJ, WS_ACT = WS_PROJ + 272 * MiB;
static_assert((size_t)MAXROWS * 1024 * 2 == 272 * MiB && WS_ACT + 272 * MiB == WS_END, "overlay map");
constexpr size_t R_TOPI = 0, R_TOPG = 512 * 1024, R_TOKROW = 1024 * 1024, R_ROWTOK = 1536 * 1024, R_ROWGATE = 2176 * 1024, R_BLKCNT = 2816 * 1024, R_BLKEXP = 2880 * 1024, R_NBLK = 2944 * 1024;
constexpr int CW_BAR = 4096;

constexpr int WL_LD = 36;
constexpr int WL_BYTES = 1024 * WL_LD * 4;
constexpr int MISC_OFF = 150528, LDS_BYTES = MISC_OFF + 1024;

#define GAS __attribute__((address_space(1)))
#define LAS __attribute__((address_space(3)))
typedef unsigned short bf16;
typedef unsigned v4u __attribute__((ext_vector_type(4)));
typedef unsigned v2u __attribute__((ext_vector_type(2)));
typedef float f32x4 __attribute__((ext_vector_type(4)));
#define LDS_WAIT() asm volatile("s_waitcnt lgkmcnt(0)" ::: "memory")
__device__ __forceinline__ unsigned f2bf(float f) { return (unsigned)__builtin_bit_cast(unsigned short, (__bf16)f); }
typedef __bf16 bf2_t __attribute__((ext_vector_type(2)));
__device__ __forceinline__ unsigned pk2(float lo, float hi) { const bf2_t v = {(__bf16)lo, (__bf16)hi}; return __builtin_bit_cast(unsigned, v); }
__device__ __forceinline__ float bf2f(unsigned short b) { return __builtin_bit_cast(float, (unsigned)b << 16); }
__device__ __forceinline__ float bflo(unsigned w) { return __builtin_bit_cast(float, w << 16); }
__device__ __forceinline__ float bfhi(unsigned w) { return __builtin_bit_cast(float, w & 0xffff0000u); }
__device__ __forceinline__ float wave_sum(float v) {
#pragma unroll
    for (int o = 1; o < 64; o <<= 1) v += __shfl_xor(v, o);
    return v;
}
__device__ __forceinline__ float silu_f(float x) { return x * __builtin_amdgcn_rcpf(1.0f + __expf(-x)); }
__device__ __forceinline__ float sigmoid_f(float x) { return __builtin_amdgcn_rcpf(1.0f + __expf(-x)); }
__device__ __forceinline__ float rsqrt_f(float x) { return __builtin_amdgcn_rsqf(x); }
__device__ __forceinline__ float softplus_f(float x) { return x > 20.0f ? x : log1pf(__expf(x)); }


#define XB_TMO      128
#define XB_XCNT(j)  (256  + 64 * (j))
#define XB_XSUB(j)  (1280 + 64 * (j))
#define XB_XGEN(j)  (2304 + 64 * (j))
#define XB_TOP      3328
#define XB_TOPGEN   3392
#define XCD_BAR_WORDS 3456
#define XB_SPIN_CAP (1u << 18)
__device__ __forceinline__ unsigned xb_ld(unsigned* p)              { return __hip_atomic_load(p, __ATOMIC_RELAXED, __HIP_MEMORY_SCOPE_AGENT); }
__device__ __forceinline__ unsigned xb_add(unsigned* p, unsigned v) { return __hip_atomic_fetch_add(p, v, __ATOMIC_RELAXED, __HIP_MEMORY_SCOPE_AGENT); }
__device__ __forceinline__ unsigned xb_xcc_id() { return (unsigned)__builtin_amdgcn_s_getreg((3 << 11) | 20) & 0xFu; }
#define XB_SPIN(cond, bar) do { unsigned _sp = 0; while (cond) { __builtin_amdgcn_s_sleep(1); \
    if ((++_sp & 255u) == 0u) { if (xb_ld(&(bar)[XB_TMO])) break; if (_sp > XB_SPIN_CAP) { atomicAdd(&(bar)[XB_TMO], 1u); break; } } } } while (0)
struct XcdBarrier { unsigned* bar; unsigned x; volatile LAS unsigned* st; };
__device__ __forceinline__ XcdBarrier xcd_barrier_post(unsigned* bar, volatile LAS unsigned* st, bool t0  ) {
    XcdBarrier b; b.bar = bar; b.x = xb_xcc_id(); b.st = st;
    if (t0) (void)xb_add(&bar[XB_XCNT(b.x)], 1u);
    return b;
}
__device__ __forceinline__ void xcd_barrier_complete(unsigned* bar, unsigned x, unsigned& nloc, unsigned& nx) {
    const unsigned G = gridDim.x * gridDim.y * gridDim.z;
    unsigned sum, cnt, mine, sp = 0u;
    for (;;) {
        sum = 0u; cnt = 0u; mine = 0u;
#pragma unroll
        for (unsigned j = 0; j < 16; ++j) { const unsigned c = xb_ld(&bar[XB_XCNT(j)]); sum += c; cnt += (c > 0u) ? 1u : 0u; mine = (j == x) ? c : mine; }
        if (sum == G) break;
        __builtin_amdgcn_s_sleep(1);
        if ((++sp & 255u) == 0u) { if (xb_ld(&bar[XB_TMO])) break; if (sp > XB_SPIN_CAP) { atomicAdd(&bar[XB_TMO], 1u); break; } }
    }
    nloc = mine > 0u ? mine : 1u; nx = cnt > 0u ? cnt : 1u;
}
__device__ __forceinline__ void xcd_barrier(const XcdBarrier& b, bool t0  ) {
    asm volatile("s_waitcnt vmcnt(0)" ::: "memory");
    __syncthreads();
    if (t0) {
        unsigned* bar = b.bar;
        __builtin_amdgcn_s_waitcnt(0);
        unsigned nloc = b.st[0], nx = b.st[1];
        if (nloc == 0u) { xcd_barrier_complete(bar, b.x, nloc, nx); b.st[0] = nloc; b.st[1] = nx; }
        const unsigned old = xb_add(&bar[XB_XSUB(b.x)], 1u);
        const unsigned gen = old / nloc;
        if (old + 1u == (gen + 1u) * nloc) {
            __builtin_amdgcn_fence(__ATOMIC_RELEASE, "agent");
            asm volatile("s_waitcnt vmcnt(0)" ::: "memory");
            const unsigned og = xb_add(&bar[XB_TOP], 1u);
            const unsigned tg = og / nx;
            if (og + 1u == (tg + 1u) * nx) xb_add(&bar[XB_TOPGEN], 1u);
            else XB_SPIN(xb_ld(&bar[XB_TOPGEN]) == tg, bar);
            __builtin_amdgcn_fence(__ATOMIC_ACQUIRE, "agent");
            xb_add(&bar[XB_XGEN(b.x)], 1u);
            asm volatile("s_waitcnt vmcnt(0)" ::: "memory");
        } else {
            XB_SPIN(xb_ld(&bar[XB_XGEN(b.x)]) == gen, bar);
            __builtin_amdgcn_fence(__ATOMIC_ACQUIRE, "agent");
            asm volatile("s_waitcnt vmcnt(0)" ::: "memory");
        }
    }
    __syncthreads();
}

__device__ __forceinline__ int fresh_tid(int wave) { int t = wave * 64 + lane_id(); asm volatile("" : "+v"(t)); return t; }
struct Args { const float* in[21]; float* out; unsigned char* ws; int ph_lo, ph_hi, variant, pad; };

__device__ __forceinline__ void transpose_item(const float* W, int ld_src, int n0s, int k0, bf16* WT, int K, int n0d, float cscale, const float* kscale, LAS float* scr, int lane) {
#pragma unroll
    for (int i = 0; i < 32; ++i) { const int kk = 2 * i + (lane >> 5); float v = W[(size_t)(k0 + kk) * ld_src + n0s + (lane & 31)] * cscale; if (kscale) v *= kscale[k0 + kk]; scr[kk * 33 + (lane & 31)] = v; }
    LDS_WAIT(); asm volatile("" ::: "memory");
    const int c = lane & 7;
#pragma unroll
    for (int j = 0; j < 4; ++j) { const int n = (lane >> 3) + 8 * j; const LAS float* s = scr + (8 * c) * 33 + n;
        v4u o; o.x = pk2(s[0 * 33], s[1 * 33]); o.y = pk2(s[2 * 33], s[3 * 33]); o.z = pk2(s[4 * 33], s[5 * 33]); o.w = pk2(s[6 * 33], s[7 * 33]);
        *(v4u*)(WT + (size_t)(n0d + n) * K + k0 + 8 * c) = o; }
    LDS_WAIT(); asm volatile("" ::: "memory");
}

__device__ __forceinline__ int pk4_fp8(float a, float b, float c, float d) { int w = 0; w = __builtin_amdgcn_cvt_pk_fp8_f32(a, b, w, false); w = __builtin_amdgcn_cvt_pk_fp8_f32(c, d, w, true); return w; }
__device__ __forceinline__ void transpose_item_f8(const float* W, int ld_src, int n0s, int k0, unsigned char* WT, int K, int n0d, float cscale, const float* kscale, LAS float* scr, int lane) {
#pragma unroll
    for (int i = 0; i < 32; ++i) { const int kk = 2 * i + (lane >> 5); float v = W[(size_t)(k0 + kk) * ld_src + n0s + (lane & 31)] * cscale; if (kscale) v *= kscale[k0 + kk]; scr[kk * 33 + (lane & 31)] = v; }
    LDS_WAIT(); asm volatile("" ::: "memory");
    const int c = lane & 3;
#pragma unroll
    for (int j = 0; j < 2; ++j) { const int n = (lane >> 2) + 16 * j; const LAS float* s = scr + (16 * c) * 33 + n;
        v4u o; o.x = (unsigned)pk4_fp8(s[0 * 33], s[1 * 33], s[2 * 33], s[3 * 33]); o.y = (unsigned)pk4_fp8(s[4 * 33], s[5 * 33], s[6 * 33], s[7 * 33]);
        o.z = (unsigned)pk4_fp8(s[8 * 33], s[9 * 33], s[10 * 33], s[11 * 33]); o.w = (unsigned)pk4_fp8(s[12 * 33], s[13 * 33], s[14 * 33], s[15 * 33]);
        *(v4u*)(WT + (size_t)(n0d + n) * K + k0 + 16 * c) = o; }
    LDS_WAIT(); asm volatile("" ::: "memory");
}

__device__ __forceinline__ void transpose_item_f8_128(const float* __restrict__ W, int ld_src, int n0s, int k0, unsigned char* __restrict__ WT, int K, int n0d, float cscale, LAS float* scr, int lane) {
#pragma unroll 1
    for (int i0 = 0; i0 < 64; i0 += 32) { float v[32];
#pragma unroll
        for (int i = 0; i < 32; ++i) v[i] = W[(size_t)(k0 + 2 * (i0 + i) + (lane >> 5)) * ld_src + n0s + (lane & 31)];
#pragma unroll
        for (int i = 0; i < 32; ++i) scr[(2 * (i0 + i) + (lane >> 5)) * 33 + (lane & 31)] = v[i] * cscale; }
    LDS_WAIT(); asm volatile("" ::: "memory");
    const int c = lane & 7;
#pragma unroll
    for (int j = 0; j < 4; ++j) { const int n = (lane >> 3) + 8 * j; const LAS float* s = scr + (16 * c) * 33 + n;
        v4u o; o.x = (unsigned)pk4_fp8(s[0 * 33], s[1 * 33], s[2 * 33], s[3 * 33]); o.y = (unsigned)pk4_fp8(s[4 * 33], s[5 * 33], s[6 * 33], s[7 * 33]);
        o.z = (unsigned)pk4_fp8(s[8 * 33], s[9 * 33], s[10 * 33], s[11 * 33]); o.w = (unsigned)pk4_fp8(s[12 * 33], s[13 * 33], s[14 * 33], s[15 * 33]);
        *(v4u*)(WT + (size_t)(n0d + n) * K + k0 + 16 * c) = o; }
    LDS_WAIT(); asm volatile("" ::: "memory");
}

constexpr int PT_LD = 2064, PT_HALF = 32 * PT_LD;
typedef short s8v_t __attribute__((ext_vector_type(8)));
constexpr int PT_WN = 2 * PT_HALF;
__device__ __forceinline__ void pt_fill(LAS unsigned char* tab, const float* W, int ldw, int tid, bool gate_cols, const float* wn) {
    ((LAS float*)(tab + PT_WN))[tid] = wn[tid]; ((LAS float*)(tab + PT_WN))[512 + tid] = wn[512 + tid];
    const int c = tid & 31; const int sc = gate_cols ? (c < 16 ? 2560 + c : (c < 24 ? 6672 + (c - 16) : 6680 + (c - 24))) : c;
#pragma unroll 1
    for (int j0 = 0; j0 < 64; j0 += 32) { float v[32];
#pragma unroll
        for (int j = 0; j < 32; ++j) v[j] = W[(size_t)((tid >> 5) + 16 * (j0 + j)) * ldw + sc];
#pragma unroll
        for (int j = 0; j < 32; ++j) { const int k = (tid >> 5) + 16 * (j0 + j); const unsigned h = f2bf(v[j]); const float hf = __builtin_bit_cast(float, h << 16);
            *(LAS unsigned short*)(tab + c * PT_LD + k * 2) = (unsigned short)h; *(LAS unsigned short*)(tab + PT_HALF + c * PT_LD + k * 2) = (unsigned short)f2bf(v[j] - hf); } }
}
template <bool IN_BF16, bool OUT_F8>
__device__ __forceinline__ float rowproj16(const void* __restrict__ srcv, void* __restrict__ dstv, const float* __restrict__ wn, const LAS unsigned char* tab, int row0, int lane, f32x4 (&acc)[2]) {
    const int g = lane >> 4, c16 = lane & 15;
    acc[0] = (f32x4){0.f, 0.f, 0.f, 0.f}; acc[1] = acc[0]; float ss = 0.f;
    const LAS unsigned char* tb = tab + c16 * PT_LD + g * 16;
    v4u ra[4], rb[4];
#define RP_LOAD(dstA, dstB, s_) do { if constexpr (IN_BF16) { dstA = *(const v4u*)((const bf16*)srcv + (size_t)(row0 + c16) * 1024 + 32 * (s_) + 8 * g); } \
        else { const float* p_ = (const float*)srcv + (size_t)(row0 + c16) * 1024 + 32 * (s_) + 8 * g; dstA = *(const v4u*)p_; dstB = *(const v4u*)(p_ + 4); } } while (0)
#pragma unroll
    for (int i = 0; i < 4; ++i) RP_LOAD(ra[i], rb[i], i);
#pragma unroll 1
    for (int s0 = 0; s0 < 32; s0 += 4) {
        v4u na[4], nb[4];
#pragma unroll
        for (int i = 0; i < 4; ++i) { na[i] = ra[i]; nb[i] = rb[i]; }
        if (s0 + 4 < 32) {
#pragma unroll
            for (int i = 0; i < 4; ++i) RP_LOAD(na[i], nb[i], s0 + 4 + i);
        }
        f32x4 gw0[4], gw1[4];
#pragma unroll
        for (int i = 0; i < 4; ++i) { gw0[i] = *(const LAS f32x4*)(tab + PT_WN + (32 * (s0 + i) + 8 * g) * 4); gw1[i] = *(const LAS f32x4*)(tab + PT_WN + (32 * (s0 + i) + 8 * g) * 4 + 16); }
#pragma unroll
        for (int i = 0; i < 4; ++i) { const int s = s0 + i;
        f32x4 a, b;
        if constexpr (IN_BF16) { const v4u w = ra[i]; a = (f32x4){bflo(w.x), bfhi(w.x), bflo(w.y), bfhi(w.y)}; b = (f32x4){bflo(w.z), bfhi(w.z), bflo(w.w), bfhi(w.w)}; }
        else { a = __builtin_bit_cast(f32x4, ra[i]); b = __builtin_bit_cast(f32x4, rb[i]); }
        ss += (a[0] * a[0] + a[1] * a[1]) + (a[2] * a[2] + a[3] * a[3]) + (b[0] * b[0] + b[1] * b[1]) + (b[2] * b[2] + b[3] * b[3]);
        a = a * gw0[i]; b = b * gw1[i];
        v4u hw; hw.x = pk2(a[0], a[1]); hw.y = pk2(a[2], a[3]); hw.z = pk2(b[0], b[1]); hw.w = pk2(b[2], b[3]);
        v4u lw; lw.x = pk2(a[0] - bflo(hw.x), a[1] - bfhi(hw.x)); lw.y = pk2(a[2] - bflo(hw.y), a[3] - bfhi(hw.y)); lw.z = pk2(b[0] - bflo(hw.z), b[1] - bfhi(hw.z)); lw.w = pk2(b[2] - bflo(hw.w), b[3] - bfhi(hw.w));
        if constexpr (OUT_F8) { v2u o; o.x = (unsigned)pk4_fp8(a[0], a[1], a[2], a[3]); o.y = (unsigned)pk4_fp8(b[0], b[1], b[2], b[3]); *(v2u*)((unsigned char*)dstv + (size_t)(row0 + c16) * 1024 + 32 * s + 8 * g) = o; }
        else *(v4u*)((bf16*)dstv + (size_t)(row0 + c16) * 1024 + 32 * s + 8 * g) = hw;
        const s8v_t xh = __builtin_bit_cast(s8v_t, hw), xl = __builtin_bit_cast(s8v_t, lw);
#pragma unroll
        for (int nt = 0; nt < 2; ++nt) { const s8v_t wh = *(const LAS s8v_t*)(tb + nt * 16 * PT_LD + s * 64), wl = *(const LAS s8v_t*)(tb + PT_HALF + nt * 16 * PT_LD + s * 64);
            acc[nt] = __builtin_amdgcn_mfma_f32_16x16x32_bf16(xh, wh, acc[nt], 0, 0, 0); acc[nt] = __builtin_amdgcn_mfma_f32_16x16x32_bf16(xl, wh, acc[nt], 0, 0, 0); acc[nt] = __builtin_amdgcn_mfma_f32_16x16x32_bf16(xh, wl, acc[nt], 0, 0, 0); }
        }
#pragma unroll
        for (int i = 0; i < 4; ++i) { ra[i] = na[i]; rb[i] = nb[i]; }
    }
#undef RP_LOAD
    ss += __shfl_xor(ss, 16); ss += __shfl_xor(ss, 32);
    return 1.0f / sqrtf(ss * (1.0f / 1024.0f) + RMS_EPS);
}

namespace mx {
typedef short s8v __attribute__((ext_vector_type(8)));
typedef short s4v __attribute__((ext_vector_type(4)));
#define MX_MFMA(a, b, c) __builtin_amdgcn_mfma_f32_16x16x32_bf16(a, b, c, 0, 0, 0)
#define MX_SB() __builtin_amdgcn_sched_barrier(0)
#define MX_BAR() do { MX_SB(); asm volatile("s_waitcnt lgkmcnt(0)" ::: "memory"); __builtin_amdgcn_s_barrier(); asm volatile("" ::: "memory"); } while (0)
constexpr int TS = 288, TILE = 64 * TS, PS = 144, PTILE = 64 * PS, BUF = 3 * TILE;
struct LaneBase { unsigned row, perm, tr, prow; };
__device__ __forceinline__ LaneBase lane_base(int lane) { LaneBase L; const unsigned g = lane >> 4, i = lane & 15, q = i >> 2, p = lane & 3;
    L.row = i * TS + g * 16; L.perm = i * TS + g * 8; L.tr = (8 * g + q) * TS + p * 8; L.prow = i * PS + g * 16; return L; }
#define LD_ROW(t, L, rb, s) (*(const LAS mx::s8v*)((t) + (L).row + (rb) * 16 * mx::TS + (s) * 64))
#define LD_ROWP(t, L, rb, s) (*(const LAS mx::s8v*)((t) + (L).prow + (rb) * 16 * mx::PS + (s) * 64))
__device__ __forceinline__ s8v ld_perm2(const LAS unsigned char* p) { const s4v lo = *(const LAS s4v*)p, hi = *(const LAS s4v*)(p + 32); return (s8v){lo[0], lo[1], lo[2], lo[3], hi[0], hi[1], hi[2], hi[3]}; }
#define LD_PERM(t, L, rb, s) mx::ld_perm2((t) + (L).perm + (rb) * 16 * mx::TS + (s) * 64)
__device__ __forceinline__ s8v ld_tr2(const LAS unsigned char* p) {
    const s4v a = __builtin_amdgcn_ds_read_tr16_b64_v4i16((LAS s4v*)p), b = __builtin_amdgcn_ds_read_tr16_b64_v4i16((LAS s4v*)(p + 4 * TS));
    return (s8v){a[0], a[1], a[2], a[3], b[0], b[1], b[2], b[3]}; }
#define LD_TR(t, L, c, ks) mx::ld_tr2((t) + (L).tr + (ks) * 32 * mx::TS + (c) * 32)
__device__ __forceinline__ void dma_tiles(LAS unsigned char* buf, const bf16* g0, int gstride, int co0, int co1, int co2, int wave, int lane) {
#pragma unroll
    for (int pp = 0; pp < 7; ++pp) { const int piece = wave + 8 * pp; if (piece < 54) { const unsigned o = piece * 1024 + lane * 16, tl = o / TILE, ot = o - tl * TILE, row = ot / TS, wb = ot - row * TS;
        const int co = tl == 0 ? co0 : (tl == 1 ? co1 : co2);
        __builtin_amdgcn_global_load_lds((const unsigned*)(g0 + (size_t)row * gstride + co + (wb < 256 ? wb >> 1 : 0)), (LAS unsigned*)(buf + piece * 1024), 16, 0, 0); } }
}
#define MX_DPPF(old, src, ctrl, rm) __builtin_bit_cast(float, __builtin_amdgcn_update_dpp(__builtin_bit_cast(int, (float)(old)), __builtin_bit_cast(int, (float)(src)), ctrl, rm, 0xf, false))
__device__ __forceinline__ float scan_add(float x) {
    x += MX_DPPF(0.f, x, 0x111, 0xf); x += MX_DPPF(0.f, x, 0x112, 0xf); x += MX_DPPF(0.f, x, 0x114, 0xf); x += MX_DPPF(0.f, x, 0x118, 0xf);
    x += MX_DPPF(0.f, x, 0x142, 0xa); x += MX_DPPF(0.f, x, 0x143, 0xc); return x; }
__device__ __forceinline__ float scan_max(float x) { const float ninf = -INFINITY;
    x = fmaxf(x, MX_DPPF(ninf, x, 0x111, 0xf)); x = fmaxf(x, MX_DPPF(ninf, x, 0x112, 0xf)); x = fmaxf(x, MX_DPPF(ninf, x, 0x114, 0xf)); x = fmaxf(x, MX_DPPF(ninf, x, 0x118, 0xf));
    x = fmaxf(x, MX_DPPF(ninf, x, 0x142, 0xa)); x = fmaxf(x, MX_DPPF(ninf, x, 0x143, 0xc)); return x; }
__device__ __forceinline__ float lane63(float x) { return __builtin_bit_cast(float, __builtin_amdgcn_readlane(__builtin_bit_cast(int, x), 63)); }
__device__ __forceinline__ float softplus_fast(float x) { const float e = __expf(-fabsf(x)); return fmaxf(x, 0.f) + (e < 1e-6f ? e : __logf(1.0f + e)); }
__device__ __forceinline__ s8v pack_acc(const f32x4& a, const f32x4& b) {
    const unsigned w0 = pk2(a[0], a[1]), w1 = pk2(a[2], a[3]), w2 = pk2(b[0], b[1]), w3 = pk2(b[2], b[3]);
    v4u w = {w0, w1, w2, w3}; return __builtin_bit_cast(s8v, w);
}
__device__ __forceinline__ void unpack8(const v4u& w, float (&f)[8]) { f[0] = bflo(w.x); f[1] = bfhi(w.x); f[2] = bflo(w.y); f[3] = bfhi(w.y); f[4] = bflo(w.z); f[5] = bfhi(w.z); f[6] = bflo(w.w); f[7] = bfhi(w.w); }

__device__ __forceinline__ void mlstm_item(LAS unsigned char* lds, int item, int var, int wave, const bf16* __restrict__ PROJ, const float* __restrict__ GATES, const float* __restrict__ lnw, bf16* __restrict__ MIX) {
    const int lane = lane_id(), tid = wave * 64 + lane, g = lane >> 4, c16 = lane & 15;
    const int b = item >> 3, h = item & 7;
    const LaneBase L = lane_base(lane);
    LAS unsigned char* TP = lds + 2 * BUF; LAS unsigned char* TO = TP + PTILE;
    LAS float* denP = (LAS float*)(TO + TILE); LAS float* qnp = denP + 128; LAS float* nsh = qnp + 512;
    LAS float* Au = nsh + 128; LAS float* Avv = Au + 64; LAS float* Awi = Avv + 64; LAS float* Akw = Awi + 64; LAS float* Aid = Akw + 64;
    f32x4 Cst[8];
#pragma unroll
    for (int i = 0; i < 8; ++i) Cst[i] = (f32x4){0.f, 0.f, 0.f, 0.f};
    float nreg = 0.f, m_prev = 0.f;
    if (lane < 16) nsh[wave * 16 + lane] = 0.f;
    const int srow = tid >> 3, sch = tid & 7;
    const bf16* qbase = PROJ + (size_t)(b * SEQ) * NPROJ + h * 128;
    dma_tiles(lds, qbase, NPROJ, C_Q, C_K, C_V, wave, lane);
    float fnext = GATES[(size_t)(b * SEQ + lane) * 32 + 24 + h], inext = GATES[(size_t)(b * SEQ + lane) * 32 + 16 + h];
    asm volatile("s_waitcnt vmcnt(0)" ::: "memory"); MX_BAR();
#pragma unroll 1
    for (int c = 0; c < SEQ / 64; ++c) {
        const int cur = c & 1; const int t0 = b * SEQ + c * 64;
        LAS unsigned char* TQ = lds + cur * BUF; LAS unsigned char* TK = TQ + TILE; LAS unsigned char* TV = TQ + 2 * TILE;
        float fraw = fnext, iraw = inext; asm volatile("" : "+v"(fraw), "+v"(iraw));
        MX_SB();
        const v4u ov0 = *(const v4u*)(PROJ + (size_t)(t0 + srow) * NPROJ + C_O + h * 128 + 8 * sch), ov1 = *(const v4u*)(PROJ + (size_t)(t0 + srow) * NPROJ + C_O + h * 128 + 64 + 8 * sch);
        { const int tn = (c + 1 < SEQ / 64 ? t0 + 64 : t0) + lane; fnext = GATES[(size_t)tn * 32 + 24 + h]; inext = GATES[(size_t)tn * 32 + 16 + h]; }
        const float lf = -softplus_fast(-fraw), cf = scan_add(lf), chunk_f = lane63(cf);
        const float u = iraw - cf, Mx = scan_max(u);
        const float m_row = cf + fmaxf(m_prev, Mx), vv = cf - m_row;
        const float m_loc = chunk_f + lane63(Mx), m_new = fmaxf(chunk_f + m_prev, m_loc);
        const float w_inter = __expf(vv + m_prev), floorv = __expf(-m_row), kw = __expf(chunk_f + u - m_new), s_old = __expf(chunk_f + m_prev - m_new);
        Au[lane] = u; Avv[lane] = vv; Awi[lane] = w_inter; Akw[lane] = kw;
        if (!(var & 2)) { const int lt = wave & 3, jt0 = 2 * (wave >> 2); const float vv_l = Avv[16 * lt + c16]; float rsum = 0.f;
#pragma unroll
          for (int jj = 0; jj < 2; ++jj) { const int jt = jt0 + jj; float pv[4] = {0.f, 0.f, 0.f, 0.f};
            if (jt <= lt) { f32x4 acc = {0.f, 0.f, 0.f, 0.f};
#pragma unroll
                for (int ks = 0; ks < 4; ++ks) acc = MX_MFMA(LD_ROW(TK, L, jt, ks), LD_ROW(TQ, L, lt, ks), acc);
                const f32x4 uj = *(const LAS f32x4*)(Au + 16 * jt + 4 * g);
#pragma unroll
                for (int r = 0; r < 4; ++r) { const int j = 16 * jt + 4 * g + r, l = 16 * lt + c16; const float val = (j <= l) ? acc[r] * __expf(vv_l + uj[r]) : 0.f; rsum += val; pv[r] = val; } }
            v2u w; w.x = pk2(pv[0], pv[1]); w.y = pk2(pv[2], pv[3]);
            *(LAS v2u*)(TP + (16 * lt + c16) * PS + (16 * jt + 4 * g) * 2) = w; }
          rsum += __shfl_xor(rsum, 16); rsum += __shfl_xor(rsum, 32);
          if (g == 0) denP[(wave >> 2) * 64 + 16 * lt + c16] = rsum;
          v4u q0 = *(const LAS v4u*)(TQ + lane * TS + wave * 32), q1 = *(const LAS v4u*)(TQ + lane * TS + wave * 32 + 16); float qf[16]; { float t8[8]; unpack8(q0, t8);
#pragma unroll
            for (int e = 0; e < 8; ++e) qf[e] = t8[e]; unpack8(q1, t8);
#pragma unroll
            for (int e = 0; e < 8; ++e) qf[8 + e] = t8[e]; }
          float part = 0.f;
#pragma unroll
          for (int e4 = 0; e4 < 4; ++e4) { const f32x4 nv = *(const LAS f32x4*)(nsh + wave * 16 + 4 * e4); part += qf[4 * e4] * nv[0] + qf[4 * e4 + 1] * nv[1] + qf[4 * e4 + 2] * nv[2] + qf[4 * e4 + 3] * nv[3]; }
          qnp[wave * 64 + lane] = part; }
        if (c + 1 < SEQ / 64 && !(var & 1)) { int lv = lane; asm volatile("" : "+v"(lv)); dma_tiles(lds + (cur ^ 1) * BUF, qbase + (size_t)(c + 1) * 64 * NPROJ, NPROJ, C_Q, C_K, C_V, wave, lv); }
        MX_SB();
        f32x4 acc[4];
        { s8v sf[4];
#pragma unroll
          for (int ks = 0; ks < 4; ++ks) sf[ks] = pack_acc(Cst[2 * ks], Cst[2 * ks + 1]);
#pragma unroll
          for (int lt = 0; lt < 4; ++lt) acc[lt] = (f32x4){0.f, 0.f, 0.f, 0.f};
          if (!(var & 4)) {
#pragma unroll
            for (int ks = 0; ks < 4; ++ks)
#pragma unroll
                for (int lt = 0; lt < 4; ++lt) acc[lt] = MX_MFMA(sf[ks], LD_PERM(TQ, L, lt, ks), acc[lt]);
#pragma unroll
            for (int lt = 0; lt < 4; ++lt) acc[lt] = acc[lt] * Awi[16 * lt + c16]; } }
        const s8v vf0 = LD_TR(TV + wave * 32, L, 0, 0), vf1 = LD_TR(TV + wave * 32, L, 0, 1);
        {
#pragma unroll
          for (int i = 0; i < 8; ++i) Cst[i] = Cst[i] * s_old;
          if (!(var & 8))
#pragma unroll
          for (int ks = 0; ks < 2; ++ks) { const s8v vf = ks ? vf1 : vf0; const v4u vw = __builtin_bit_cast(v4u, vf); float f[8]; unpack8(vw, f);
            { const f32x4 k0 = *(const LAS f32x4*)(Akw + 32 * ks + 8 * g), k1 = *(const LAS f32x4*)(Akw + 32 * ks + 8 * g + 4);
#pragma unroll
              for (int e = 0; e < 4; ++e) { f[e] *= k0[e]; f[4 + e] *= k1[e]; } }
            v4u pw = {pk2(f[0], f[1]), pk2(f[2], f[3]), pk2(f[4], f[5]), pk2(f[6], f[7])}; const s8v vwf = __builtin_bit_cast(s8v, pw);
#pragma unroll
            for (int dkt = 0; dkt < 8; ++dkt) Cst[dkt] = MX_MFMA(LD_TR(TK, L, dkt, ks), vwf, Cst[dkt]); }
          float part = 0.f;
#pragma unroll
          for (int e4 = 0; e4 < 4; ++e4) { const f32x4 kk = *(const LAS f32x4*)(Akw + 16 * g + 4 * e4);
#pragma unroll
            for (int e = 0; e < 4; ++e) { const int j = 16 * g + 4 * e4 + e; part += bf2f(*(const LAS unsigned short*)(TK + j * TS + (16 * wave + c16) * 2)) * kk[e]; } }
          part += __shfl_xor(part, 16); part += __shfl_xor(part, 32);
          nreg = s_old * nreg + part; if (g == 0) nsh[wave * 16 + c16] = nreg;
        }
        MX_BAR();
        float inv_den; { float qn = 0.f;
#pragma unroll
          for (int w = 0; w < 8; ++w) qn += qnp[w * 64 + lane];
          float den = denP[lane] + denP[64 + lane] + w_inter * qn; den = fmaxf(fabsf(den), floorv); inv_den = __builtin_amdgcn_rcpf(den); Aid[lane] = inv_den; }
        { if (!(var & 4))
#pragma unroll
          for (int lt = 0; lt < 4; ++lt) { f32x4 a4 = MX_MFMA(vf0, LD_ROWP(TP, L, lt, 0), acc[lt]);
            if (lt >= 2) a4 = MX_MFMA(vf1, LD_ROWP(TP, L, lt, 1), a4);
            a4 = a4 * Aid[16 * lt + c16];
            v2u w; w.x = pk2(a4[0], a4[1]); w.y = pk2(a4[2], a4[3]);
            *(LAS v2u*)(TO + (16 * lt + c16) * TS + (16 * wave + 4 * g) * 2) = w; }
          m_prev = m_new; }
        asm volatile("s_waitcnt vmcnt(0)" ::: "memory"); MX_BAR();
        if (!(var & 16)) { const v4u a = *(const LAS v4u*)(TO + srow * TS + sch * 16), bq = *(const LAS v4u*)(TO + srow * TS + sch * 16 + 128); float f[16], of[16]; { float t8[8]; unpack8(a, t8);
#pragma unroll
            for (int e = 0; e < 8; ++e) f[e] = t8[e]; unpack8(bq, t8);
#pragma unroll
            for (int e = 0; e < 8; ++e) f[8 + e] = t8[e]; unpack8(ov0, t8);
#pragma unroll
            for (int e = 0; e < 8; ++e) of[e] = t8[e]; unpack8(ov1, t8);
#pragma unroll
            for (int e = 0; e < 8; ++e) of[8 + e] = t8[e]; }
          float ss = 0.f;
#pragma unroll
          for (int e = 0; e < 16; ++e) ss += f[e] * f[e];
          ss += __shfl_xor(ss, 1); ss += __shfl_xor(ss, 2); ss += __shfl_xor(ss, 4);
          const float rs = rsqrt_f(ss * (1.0f / 128.0f) + RMS_EPS);
          float wn[16]; { const f32x4 w0 = *(const f32x4*)(lnw + h * 128 + 8 * sch), w1 = *(const f32x4*)(lnw + h * 128 + 8 * sch + 4), w2 = *(const f32x4*)(lnw + h * 128 + 64 + 8 * sch), w3 = *(const f32x4*)(lnw + h * 128 + 64 + 8 * sch + 4);
#pragma unroll
            for (int e = 0; e < 4; ++e) { wn[e] = w0[e]; wn[4 + e] = w1[e]; wn[8 + e] = w2[e]; wn[12 + e] = w3[e]; } }
#pragma unroll
          for (int e = 0; e < 16; ++e) f[e] = f[e] * rs * wn[e] * sigmoid_f(of[e]);
          v4u o0 = {pk2(f[0], f[1]), pk2(f[2], f[3]), pk2(f[4], f[5]), pk2(f[6], f[7])}, o1 = {pk2(f[8], f[9]), pk2(f[10], f[11]), pk2(f[12], f[13]), pk2(f[14], f[15])};
          bf16* mp = MIX + (size_t)(t0 + srow) * 2048 + 1024 + h * 128 + 8 * sch; *(v4u*)mp = o0; *(v4u*)(mp + 64) = o1; }
    }
    MX_BAR();
}

__device__ __forceinline__ void ssd_item(LAS unsigned char* lds, int item, int var, int wave, const bf16* __restrict__ XBC, const bf16* __restrict__ PROJ, const float* __restrict__ GATES, const float* __restrict__ a_log,
                                         const float* __restrict__ d_skip, bf16* __restrict__ MIX, float* __restrict__ SSQ) {
    const int lane = lane_id(), tid = wave * 64 + lane, g = lane >> 4, c16 = lane & 15;
    const int b = item >> 3, hp = item & 7, grp = hp >> 2, hh = wave >> 2, ps = wave & 3;
    const LaneBase L = lane_base(lane);
    LAS unsigned char* TG = lds + 2 * BUF;
    LAS unsigned char* TO = TG + 2 * PTILE;
    LAS float* Aacs = (LAS float*)(TO + TILE); LAS float* Adinv = Aacs + 128; LAS float* Adt = Adinv + 128; LAS float* Awd = Adt + 128; LAS float* Aea = Awd + 128;
    f32x4 RT[8];
#pragma unroll
    for (int i = 0; i < 8; ++i) RT[i] = (f32x4){0.f, 0.f, 0.f, 0.f};
    const float an0 = -__expf(a_log[2 * hp]), an1 = -__expf(a_log[2 * hp + 1]), dk0 = d_skip[2 * hp], dk1 = d_skip[2 * hp + 1];
    const int srow = tid >> 3, sch = tid & 7;
    const bf16* xb = XBC + (size_t)(b * SEQ) * 1536;
    dma_tiles(lds, xb, 1536, 1280 + grp * 128, 1024 + grp * 128, hp * 128, wave, lane);
    float dn0 = GATES[(size_t)(b * SEQ + lane) * 32 + 2 * hp], dn1 = GATES[(size_t)(b * SEQ + lane) * 32 + 2 * hp + 1];
    asm volatile("s_waitcnt vmcnt(0)" ::: "memory"); MX_BAR();
#pragma unroll 1
    for (int c = 0; c < SEQ / 64; ++c) {
        const int cur = c & 1; const int t0 = b * SEQ + c * 64;
        LAS unsigned char* TC = lds + cur * BUF; LAS unsigned char* TB = TC + TILE; LAS unsigned char* TX = TC + 2 * TILE;
        float dr0 = dn0, dr1 = dn1; asm volatile("" : "+v"(dr0), "+v"(dr1));
        MX_SB();
        const v4u zv0 = *(const v4u*)(PROJ + (size_t)(t0 + srow) * NPROJ + C_Z + hp * 128 + 8 * sch), zv1 = *(const v4u*)(PROJ + (size_t)(t0 + srow) * NPROJ + C_Z + hp * 128 + 64 + 8 * sch);
        { const int tn = (c + 1 < SEQ / 64 ? t0 + 64 : t0) + lane; dn0 = GATES[(size_t)tn * 32 + 2 * hp]; dn1 = GATES[(size_t)tn * 32 + 2 * hp + 1]; }
        const float dt0 = softplus_fast(dr0), dt1 = softplus_fast(dr1);
        const float acs0 = scan_add(dt0 * an0), acs1 = scan_add(dt1 * an1);
        const float aend0 = lane63(acs0), aend1 = lane63(acs1);
        Aacs[lane] = acs0; Aacs[64 + lane] = acs1; Adinv[lane] = dk0 * __builtin_amdgcn_rcpf(dt0); Adinv[64 + lane] = dk1 * __builtin_amdgcn_rcpf(dt1); Adt[lane] = dt0; Adt[64 + lane] = dt1;
        Awd[lane] = __expf(aend0 - acs0); Awd[64 + lane] = __expf(aend1 - acs1); Aea[lane] = __expf(acs0); Aea[64 + lane] = __expf(acs1);
        const float aend = hh ? aend1 : aend0;
        if (!(var & 2)) { const int lt = wave & 3, st0 = 2 * (wave >> 2); const int l = 16 * lt + c16;
          const float al0 = Aacs[l], al1 = Aacs[64 + l], di0 = Adinv[l], di1 = Adinv[64 + l];
#pragma unroll
          for (int ss = 0; ss < 2; ++ss) { const int st = st0 + ss; float p0[4] = {0.f, 0.f, 0.f, 0.f}, p1[4] = {0.f, 0.f, 0.f, 0.f};
            if (st <= lt) { f32x4 acc = {0.f, 0.f, 0.f, 0.f};
#pragma unroll
                for (int ks = 0; ks < 4; ++ks) acc = MX_MFMA(LD_ROW(TB, L, st, ks), LD_ROW(TC, L, lt, ks), acc);
                const f32x4 as0 = *(const LAS f32x4*)(Aacs + 16 * st + 4 * g), as1 = *(const LAS f32x4*)(Aacs + 64 + 16 * st + 4 * g);
#pragma unroll
                for (int r = 0; r < 4; ++r) { const int sidx = 16 * st + 4 * g + r;
                    float v0 = (sidx <= l) ? acc[r] * __expf(al0 - as0[r]) : 0.f, v1 = (sidx <= l) ? acc[r] * __expf(al1 - as1[r]) : 0.f;
                    if (sidx == l) { v0 += di0; v1 += di1; } p0[r] = v0; p1[r] = v1; } }
            v2u w0, w1; w0.x = pk2(p0[0], p0[1]); w0.y = pk2(p0[2], p0[3]); w1.x = pk2(p1[0], p1[1]); w1.y = pk2(p1[2], p1[3]);
            const unsigned o = l * PS + (16 * st + 4 * g) * 2;
            *(LAS v2u*)(TG + o) = w0; *(LAS v2u*)(TG + PTILE + o) = w1; } }
        if (c + 1 < SEQ / 64 && !(var & 1)) { int lv = lane; asm volatile("" : "+v"(lv)); dma_tiles(lds + (cur ^ 1) * BUF, xb + (size_t)(c + 1) * 64 * 1536, 1536, 1280 + grp * 128, 1024 + grp * 128, hp * 128, wave, lv); }
        MX_SB();
        f32x4 acc[4];
        { s8v sf[4];
#pragma unroll
          for (int ks = 0; ks < 4; ++ks) sf[ks] = pack_acc(RT[2 * ks], RT[2 * ks + 1]);
#pragma unroll
          for (int lt = 0; lt < 4; ++lt) acc[lt] = (f32x4){0.f, 0.f, 0.f, 0.f};
          if (!(var & 4)) {
#pragma unroll
            for (int ks = 0; ks < 4; ++ks)
#pragma unroll
                for (int lt = 0; lt < 4; ++lt) acc[lt] = MX_MFMA(sf[ks], LD_PERM(TC, L, lt, ks), acc[lt]);
#pragma unroll
            for (int lt = 0; lt < 4; ++lt) acc[lt] = acc[lt] * Aea[64 * hh + 16 * lt + c16]; } }
          s8v xd[2], xw[2];
#pragma unroll
          for (int ks = 0; ks < 2; ++ks) { const s8v xf = LD_TR(TX + (4 * hh + ps) * 32, L, 0, ks); const v4u xv = __builtin_bit_cast(v4u, xf); float f[8], fw[8]; unpack8(xv, f);
            { const LAS float* pd = Adt + 64 * hh + 32 * ks + 8 * g; const LAS float* pw = Awd + 64 * hh + 32 * ks + 8 * g; const f32x4 d0 = *(const LAS f32x4*)pd, d1 = *(const LAS f32x4*)(pd + 4), w0 = *(const LAS f32x4*)pw, w1 = *(const LAS f32x4*)(pw + 4);
#pragma unroll
              for (int e = 0; e < 4; ++e) { f[e] *= d0[e]; fw[e] = f[e] * w0[e]; f[4 + e] *= d1[e]; fw[4 + e] = f[4 + e] * w1[e]; } }
            v4u a = {pk2(f[0], f[1]), pk2(f[2], f[3]), pk2(f[4], f[5]), pk2(f[6], f[7])}, bw = {pk2(fw[0], fw[1]), pk2(fw[2], fw[3]), pk2(fw[4], fw[5]), pk2(fw[6], fw[7])};
            xd[ks] = __builtin_bit_cast(s8v, a); xw[ks] = __builtin_bit_cast(s8v, bw); }
        {
          const float ea = __expf(aend);
#pragma unroll
          for (int i = 0; i < 8; ++i) RT[i] = RT[i] * ea;
          if (!(var & 8))
#pragma unroll
          for (int ks = 0; ks < 2; ++ks)
#pragma unroll
            for (int nt = 0; nt < 8; ++nt) RT[nt] = MX_MFMA(LD_TR(TB, L, nt, ks), xw[ks], RT[nt]);
        }
        MX_BAR();
        {
          const LAS unsigned char* TGm = TG + hh * PTILE;
          if (!(var & 4))
#pragma unroll
          for (int lt = 0; lt < 4; ++lt) { f32x4 a4 = MX_MFMA(xd[0], LD_ROWP(TGm, L, lt, 0), acc[lt]);
            if (lt >= 2) a4 = MX_MFMA(xd[1], LD_ROWP(TGm, L, lt, 1), a4);
            v2u w; w.x = pk2(a4[0], a4[1]); w.y = pk2(a4[2], a4[3]);
            *(LAS v2u*)(TO + (16 * lt + c16) * TS + (64 * hh + 16 * ps + 4 * g) * 2) = w; }
        }
        asm volatile("s_waitcnt vmcnt(0)" ::: "memory"); MX_BAR();
        if (!(var & 16)) { const v4u a = *(const LAS v4u*)(TO + srow * TS + sch * 16), bq = *(const LAS v4u*)(TO + srow * TS + sch * 16 + 128); float f[16], zf[16]; { float t8[8]; unpack8(a, t8);
#pragma unroll
            for (int e = 0; e < 8; ++e) f[e] = t8[e]; unpack8(bq, t8);
#pragma unroll
            for (int e = 0; e < 8; ++e) f[8 + e] = t8[e]; unpack8(zv0, t8);
#pragma unroll
            for (int e = 0; e < 8; ++e) zf[e] = t8[e]; unpack8(zv1, t8);
#pragma unroll
            for (int e = 0; e < 8; ++e) zf[8 + e] = t8[e]; }
          float ss = 0.f;
#pragma unroll
          for (int e = 0; e < 16; ++e) { f[e] = f[e] * silu_f(zf[e]); ss += f[e] * f[e]; }
          ss += __shfl_xor(ss, 1); ss += __shfl_xor(ss, 2); ss += __shfl_xor(ss, 4);
          if (sch == 0) SSQ[(size_t)(t0 + srow) * 8 + hp] = ss;
          v4u o0 = {pk2(f[0], f[1]), pk2(f[2], f[3]), pk2(f[4], f[5]), pk2(f[6], f[7])}, o1 = {pk2(f[8], f[9]), pk2(f[10], f[11]), pk2(f[12], f[13]), pk2(f[14], f[15])};
          bf16* mp = MIX + (size_t)(t0 + srow) * 2048 + hp * 128 + 8 * sch; *(v4u*)mp = o0; *(v4u*)(mp + 64) = o1; }
    }
    MX_BAR();
}
}

__global__ void __launch_bounds__(NTHR, 2) mega(Args args) {
    extern __shared__ __attribute__((aligned(16))) unsigned char lds_raw[];
    LAS unsigned char* lds = (LAS unsigned char*)lds_raw;
    const int wave = __builtin_amdgcn_readfirstlane((int)threadIdx.x >> 6);
    const int lane = lane_id(), tid = wave * 64 + lane;
    const int G = gridDim.x, bx = blockIdx.x;
    unsigned char* ws = args.ws;
#define INP(k) ({ int _k = (k); asm volatile("" : "+s"(_k)); args.in[_k]; })
#define XIN INP(0)
#define Win_t ((bf16*)(ws + WS_WIN))
#define Wout_t ((bf16*)(ws + WS_WOUT))
#define XN ((bf16*)(ws + WS_XN))
#define H ((bf16*)(ws + WS_H))
#define GATES ((float*)(ws + WS_GATES))
#define PROJ ((bf16*)(ws + WS_PROJ))
#define MIX ((bf16*)(ws + WS_MIX))
#define EO8 (ws + WS_XG + 136 * MiB)
#define TOPI ((int*)(ws + WS_ROUTE + R_TOPI))
#define TOPG ((float*)(ws + WS_ROUTE + R_TOPG))
#define TOKROW ((int*)(ws + WS_ROUTE + R_TOKROW))
#define ROWTOK ((int*)(ws + WS_ROUTE + R_ROWTOK))
#define ROWGATE ((float*)(ws + WS_ROUTE + R_ROWGATE))
#define BLKCNT ((int*)(ws + WS_ROUTE + R_BLKCNT))
#define BLKEXP ((int*)(ws + WS_ROUTE + R_BLKEXP))
#define NBLK ((int*)(ws + WS_ROUTE + R_NBLK))
#define XBC ((bf16*)(ws + WS_XBC))
#define SSQ ((float*)(ws + WS_SSQ))
#define RS1 ((float*)(ws + WS_SSQ + 1 * MiB))
#define RS2 ((float*)(ws + WS_SSQ + 1 * MiB + 128 * 1024))
#define ROWRS ((float*)(ws + WS_SSQ + 1 * MiB + 256 * 1024))
#define XN8 (ws + WS_XN)
#define XG8 (ws + WS_XG)
#define ACT8 (ws + WS_ACT)
#define Wgu8 (ws + WS_WGU)
#define Wdn8 (ws + WS_WDN)
    const int lo = args.ph_lo, hi = args.ph_hi;
    if (tid < 64) ((LAS unsigned*)(lds + MISC_OFF))[tid] = 0u;
    __syncthreads();
    XcdBarrier bar = xcd_barrier_post((unsigned*)(ws + WS_CTL) + CW_BAR, (volatile LAS unsigned*)(lds + MISC_OFF), tid == 0);
#define GRID_BAR(k) do { if (IN(k) && IN((k) + 1)) xcd_barrier(bar, wave == 0 && lane_id() == 0); } while (0)
#ifndef PH_MASK
#define PH_MASK 0xffff
#endif
#define IN(k) (((PH_MASK >> (k)) & 1) && lo <= (k) && (k) < hi)


    if (IN(0)) {
        const int tid = fresh_tid(wave), lane = tid & 63; (void)lane;
        LAS float* scr = (LAS float*)(lds + wave * 17408);
        const int gw = bx * NWAVES + wave, NGW = G * NWAVES;
        constexpr int I_IN = 16 * (NPROJ / 32), I_OUT = 32 * 32, I_GU = 8 * 64, I_DN = 8 * 32;
        constexpr int NITEMS = I_IN + I_OUT + NE * I_GU + NE * I_DN;
        if (!(args.variant & 32))
        for (int it = gw; it < NITEMS; it += NGW) {
            int r = it;
            if (r < I_IN) { const int nb = r % (NPROJ / 32), kb = r / (NPROJ / 32), n0 = nb * 32; const int n0s = n0 + (n0 >= C_Q ? 16 : 0);
                const float cs = (n0 >= C_K && n0 < C_V) ? 0.08838834764831845f : 1.0f;
                transpose_item(INP(2), WIN_LD, n0s, kb * 64, Win_t, 1024, n0, cs, nullptr, scr, lane); continue; } r -= I_IN;
            if (r < I_OUT) { const int nb = r % 32, kb = r / 32; transpose_item(INP(12), 1024, nb * 32, kb * 64, Wout_t, 2048, nb * 32, 1.0f, kb < 16 ? INP(8) : nullptr, scr, lane); continue; } r -= I_OUT;
            if (r < NE * I_GU) { const int e = r / I_GU, q = r % I_GU, nb = q % 64, kb = q / 64, rho = nb * 32; const int n0s = ((rho >> 7) & 1) * 1024 + (rho >> 8) * 128 + (rho & 127);
                transpose_item_f8_128(INP(16) + (size_t)e * 1024 * 2048, 2048, n0s, kb * 128, Wgu8 + (size_t)e * 2048 * 1024, 1024, rho, 64.0f, scr, lane); continue; } r -= NE * I_GU;
            { const int e = r / I_DN, q = r % I_DN, nb = q % 32, kb = q / 32;
                transpose_item_f8_128(INP(18) + (size_t)e * 1024 * 1024, 1024, nb * 32, kb * 128, Wdn8 + (size_t)e * 1024 * 1024, 1024, nb * 32, 64.0f, scr, lane); }
        }
        __syncthreads();
        pt_fill(lds, INP(2), WIN_LD, tid, true, INP(1));
        __syncthreads();
        { const int c16 = lane & 15, g = lane >> 4;
          const float* wnp = INP(1); const float* bi_ = INP(9); const float* bf_ = INP(10); const float gb0 = INP(5)[c16], gb1 = *(c16 < 8 ? bi_ + c16 : bf_ + (c16 - 8));
          if (!(args.variant & 64))
#pragma unroll 1
          for (int task = gw; task < T / 16; task += NGW) { const int row0 = task * 16; f32x4 acc[2];
            const float rs = rowproj16<false, false>(XIN, XN, wnp, lds, row0, lane, acc);
            if (g == 0) RS1[row0 + c16] = rs;
#pragma unroll
            for (int r = 0; r < 4; ++r) { const float rr = __shfl(rs, 4 * g + r); float* gp = GATES + (size_t)(row0 + 4 * g + r) * 32; gp[c16] = rr * acc[0][r] + gb0; gp[16 + c16] = rr * acc[1][r] + gb1; } } }
        __syncthreads();
    }
    GRID_BAR(0);

    if (IN(1)) {
        pg8::Gemm g{XN, Win_t, T, NPROJ, 1024}; pg8::StaticOrder S; S.init(T, NPROJ, G, bx);
        pg8::EpiBf16 E{PROJ, NPROJ, RS1};
        pg8::gemm_phase<pg8::EpiBf16, pg8::StaticOrder>(lds, g, S, E, wave);
    }
    GRID_BAR(1);

    if (IN(2)) {
        const int tid = fresh_tid(wave), lane = tid & 63; (void)lane;
        const float* cw = INP(3); const float* cb = INP(4);
#pragma unroll 1
        for (int it = bx * NTHR + tid; it < (T / 16) * 192; it += G * NTHR) {
            const int ch = it % 192, t0 = (it / 192) * 16, c0 = ch * 8;
            float w[4][8], bs[8], r0[8], r1[8], r2[8];
#pragma unroll
            for (int k = 0; k < 4; ++k) { const f32x4 a = *(const f32x4*)(cw + k * 1536 + c0), b2 = *(const f32x4*)(cw + k * 1536 + c0 + 4);
#pragma unroll
                for (int e = 0; e < 4; ++e) { w[k][e] = a[e]; w[k][4 + e] = b2[e]; } }
            { const f32x4 a = *(const f32x4*)(cb + c0), b2 = *(const f32x4*)(cb + c0 + 4);
#pragma unroll
              for (int e = 0; e < 4; ++e) { bs[e] = a[e]; bs[4 + e] = b2[e]; } }
            const bf16* src = PROJ + (size_t)t0 * NPROJ + C_XBC + c0;
            if ((t0 & (SEQ - 1)) == 0) {
#pragma unroll
                for (int e = 0; e < 8; ++e) { r0[e] = 0.f; r1[e] = 0.f; r2[e] = 0.f; }
            } else { mx::unpack8(*(const v4u*)(src - 3 * (size_t)NPROJ), r0); mx::unpack8(*(const v4u*)(src - 2 * (size_t)NPROJ), r1); mx::unpack8(*(const v4u*)(src - (size_t)NPROJ), r2); }
            v4u raw[16];
#pragma unroll
            for (int i = 0; i < 16; ++i) raw[i] = *(const v4u*)(src + (size_t)i * NPROJ);
#pragma unroll
            for (int i = 0; i < 16; ++i) { float cu[8], o[8]; mx::unpack8(raw[i], cu);
#pragma unroll
                for (int e = 0; e < 8; ++e) { o[e] = silu_f(bs[e] + w[0][e] * r0[e] + w[1][e] * r1[e] + w[2][e] * r2[e] + w[3][e] * cu[e]); r0[e] = r1[e]; r1[e] = r2[e]; r2[e] = cu[e]; }
                v4u ov = {pk2(o[0], o[1]), pk2(o[2], o[3]), pk2(o[4], o[5]), pk2(o[6], o[7])};
                *(v4u*)(XBC + (size_t)(t0 + i) * 1536 + c0) = ov; }
        }
    }
    GRID_BAR(2);

    if (IN(3)) {
#pragma unroll 1
        for (int it = bx; it < 256; it += G) if ((it >> 3) & 1) mx::mlstm_item(lds, ((it >> 4) << 3) | (it & 7), args.variant, wave, PROJ, GATES, INP(11), MIX);
#pragma unroll 1
        for (int it = bx; it < 256; it += G) if (!((it >> 3) & 1)) mx::ssd_item(lds, ((it >> 4) << 3) | (it & 7), args.variant, wave, XBC, PROJ, GATES, INP(6), INP(7), MIX, SSQ);
    }
    GRID_BAR(3);
    if (IN(4)) {
        pg8::Gemm g{MIX, Wout_t, T, 1024, 2048}; pg8::StaticOrder S; S.init(T, 1024, G, bx);
        pg8::EpiResF32 E{XIN, H, 1024, SSQ};
        pg8::gemm_phase<pg8::EpiResF32, pg8::StaticOrder>(lds, g, S, E, wave);
    }

    GRID_BAR(4);
    if (IN(5)) {
        const int tid = fresh_tid(wave), lane = tid & 63; (void)lane;
        LAS int* hist = (LAS int*)(lds + MISC_OFF + 256);
        pt_fill(lds, INP(14), 32, tid, false, INP(13));
        if (tid < 32) hist[tid] = 0;
        __syncthreads();
        const int c16 = lane & 15, g = lane >> 4; const float* wnp = INP(13); const float rb0 = INP(15)[c16], rb1 = INP(15)[16 + c16];
        for (int blk = bx; blk < T / 128; blk += G) {
            const int row0 = blk * 128 + wave * 16; f32x4 acc[2];
            const float rs = rowproj16<true, true>(H, XN8, wnp, lds, row0, lane, acc);
            if (g == 0) RS2[row0 + c16] = rs;
#pragma unroll
            for (int r = 0; r < 4; ++r) { const float rr = __shfl(rs, 4 * g + r); float v0 = rr * acc[0][r] + rb0, v1 = rr * acc[1][r] + rb1; float tv[4]; int ti[4];
#pragma unroll
                for (int k = 0; k < 4; ++k) { float bv = v0 >= v1 ? v0 : v1; int bi = v0 >= v1 ? c16 : c16 + 16;
#define TK_STEP(ctrl) do { const float ov = __builtin_bit_cast(float, __builtin_amdgcn_update_dpp(0, __builtin_bit_cast(int, bv), ctrl, 0xf, 0xf, false)); const int oi = __builtin_amdgcn_update_dpp(0, bi, ctrl, 0xf, 0xf, false); \
                        if (ov > bv || (ov == bv && oi < bi)) { bv = ov; bi = oi; } } while (0)
                    TK_STEP(0xB1); TK_STEP(0x4E); TK_STEP(0x141); TK_STEP(0x140);
#undef TK_STEP
                    tv[k] = bv; ti[k] = bi; if (bi == c16) v0 = -INFINITY; if (bi == c16 + 16) v1 = -INFINITY; }
                const float e1 = __expf(tv[1] - tv[0]), e2 = __expf(tv[2] - tv[0]), e3 = __expf(tv[3] - tv[0]); const float inv = 1.0f / (1.0f + e1 + e2 + e3);
                if (c16 == 0) { const size_t o = (size_t)(row0 + 4 * g + r) * 4; TOPI[o] = ti[0]; TOPI[o + 1] = ti[1]; TOPI[o + 2] = ti[2]; TOPI[o + 3] = ti[3];
                    TOPG[o] = inv; TOPG[o + 1] = e1 * inv; TOPG[o + 2] = e2 * inv; TOPG[o + 3] = e3 * inv;
                    __hip_atomic_fetch_add(hist + ti[0], 1, __ATOMIC_RELAXED, __HIP_MEMORY_SCOPE_WORKGROUP); __hip_atomic_fetch_add(hist + ti[1], 1, __ATOMIC_RELAXED, __HIP_MEMORY_SCOPE_WORKGROUP); __hip_atomic_fetch_add(hist + ti[2], 1, __ATOMIC_RELAXED, __HIP_MEMORY_SCOPE_WORKGROUP); __hip_atomic_fetch_add(hist + ti[3], 1, __ATOMIC_RELAXED, __HIP_MEMORY_SCOPE_WORKGROUP); } }
            __syncthreads();
            if (tid < 32) { BLKCNT[blk * 32 + tid] = hist[tid]; hist[tid] = 0; }
            __syncthreads();
        }
    }
    GRID_BAR(5);
    if (IN(6)) {
        const int tid = fresh_tid(wave), lane = tid & 63; (void)lane;
        LAS int* tot = (LAS int*)lds; LAS int* base = tot + 32; LAS int* pstart = base + 32; LAS int* wcnt = pstart + 33;
        LAS int* arow = wcnt + 256;
        LAS int* psum = arow + 512;
        for (int blk = bx; blk < T / 128; blk += G) {
            { const int e = tid & 31, part = tid >> 5; int v[16], t = 0, b = 0;
#pragma unroll
              for (int j = 0; j < 16; ++j) v[j] = BLKCNT[(part * 16 + j) * 32 + e];
#pragma unroll
              for (int j = 0; j < 16; ++j) { t += v[j]; if (part * 16 + j < blk) b += v[j]; }
              psum[part * 32 + e] = t; psum[512 + part * 32 + e] = b; }
            __syncthreads();
            if (tid < 32) { int t = 0, b = 0;
#pragma unroll
              for (int p = 0; p < 16; ++p) { t += psum[p * 32 + tid]; b += psum[512 + p * 32 + tid]; } tot[tid] = t; base[tid] = b; }
            __syncthreads();
            if (tid == 0) { int s = 0; for (int e = 0; e < 32; ++e) { pstart[e] = s; s += (tot[e] + 255) / 256 * 256; } pstart[32] = s; }
            __syncthreads();
            const int token = blk * 128 + (tid >> 2), k = tid & 3; const int e = TOPI[(size_t)token * 4 + k];
            int rank = 0;
#pragma unroll 1
            for (int ee = 0; ee < 32; ++ee) { const unsigned long long m = __ballot(e == ee); if (e == ee) rank = __popcll(m & ((1ull << lane) - 1ull)); if (lane == 0) wcnt[wave * 32 + ee] = __popcll(m); }
            __syncthreads();
            int off = 0; for (int w = 0; w < wave; ++w) off += wcnt[w * 32 + e];
            const int row = pstart[e] + base[e] + off + rank;
            ROWTOK[row] = token; ROWGATE[row] = TOPG[(size_t)token * 4 + k]; ROWRS[row] = RS2[token]; TOKROW[(size_t)token * 4 + k] = row; arow[tid] = row;
            __syncthreads();
            if (blk < 32) { const int ps = pstart[blk] + tot[blk], pe = pstart[blk + 1];
                for (int r = ps + tid; r < pe; r += NTHR) { ROWTOK[r] = 0; ROWGATE[r] = 0.f; ROWRS[r] = 0.f; } }
            if (blk == 0) { const int nb = pstart[32] / 256; if (tid == 0) NBLK[0] = nb;
                for (int b = tid; b < nb; b += NTHR) { int e2 = 0; while (e2 < 31 && b * 256 >= pstart[e2 + 1]) ++e2; BLKEXP[b] = e2; } }
            __syncthreads();
        }
    }

    GRID_BAR(6);
    if (IN(7)) {
        pg8::Gemm g{(const bf16*)XN8, (const bf16*)Wgu8, MAXROWS, 2048, 512}; pg8::MoeOrder S{BLKEXP, __builtin_amdgcn_readfirstlane(NBLK[0]), 8, G, bx};
        pg8::EpiSwiglu E{ROWTOK, ACT8, INP(17), ROWRS};
        pg8::gemm_phase_f8<pg8::EpiSwiglu, pg8::MoeOrder>(lds, g, S, E, wave, args.variant);
    }
    GRID_BAR(7);
    if (IN(8)) {
        pg8::Gemm g{(const bf16*)ACT8, (const bf16*)Wdn8, MAXROWS, 1024, 512}; pg8::MoeOrder S{BLKEXP, __builtin_amdgcn_readfirstlane(NBLK[0]), 4, G, bx};
        pg8::EpiDown E{nullptr, EO8, INP(19), ROWGATE};
        pg8::gemm_phase_f8<pg8::EpiDown, pg8::MoeOrder>(lds, g, S, E, wave);
    }
    GRID_BAR(8);
    if (IN(9)) {
        const int tid = fresh_tid(wave), lane = tid & 63; (void)lane;
        const int gw = bx * NWAVES + wave, NGW = G * NWAVES;
        f32x4 wf[4];
#pragma unroll
        for (int j = 0; j < 4; ++j) wf[j] = *(const f32x4*)(INP(20) + 4 * lane + 256 * j);
#pragma unroll 1
        for (int row = gw; row < T; row += 2 * NGW) {
            int er[2][4];
#pragma unroll
            for (int q = 0; q < 2; ++q) { const typeof(*(const v4u*)0) t4 = *(const v4u*)(TOKROW + (size_t)(row + q * NGW) * 4); er[q][0] = (int)t4.x; er[q][1] = (int)t4.y; er[q][2] = (int)t4.z; er[q][3] = (int)t4.w; }
            v2u hw[2][4]; int ew[2][4][4];
#pragma unroll
            for (int q = 0; q < 2; ++q)
#pragma unroll
                for (int j = 0; j < 4; ++j) hw[q][j] = *(const v2u*)(H + (size_t)(row + q * NGW) * 1024 + 4 * lane + 256 * j);
#pragma unroll
            for (int q = 0; q < 2; ++q)
#pragma unroll
                for (int k = 0; k < 4; ++k)
#pragma unroll
                    for (int j = 0; j < 4; ++j) ew[q][k][j] = *(const int*)(EO8 + (size_t)er[q][k] * 1024 + 4 * lane + 256 * j);
#pragma unroll
            for (int q = 0; q < 2; ++q) { f32x4 v[4], ya[4]; typedef float f2v __attribute__((ext_vector_type(2)));
#pragma unroll
                for (int j = 0; j < 4; ++j) { v[j] = (f32x4){bflo(hw[q][j].x), bfhi(hw[q][j].x), bflo(hw[q][j].y), bfhi(hw[q][j].y)}; ya[j] = (f32x4){0.f, 0.f, 0.f, 0.f}; }
#pragma unroll
                for (int k = 0; k < 4; ++k)
#pragma unroll
                    for (int j = 0; j < 4; ++j) { const f2v lo = __builtin_amdgcn_cvt_pk_f32_fp8(ew[q][k][j], false), hi = __builtin_amdgcn_cvt_pk_f32_fp8(ew[q][k][j], true); ya[j][0] += lo[0]; ya[j][1] += lo[1]; ya[j][2] += hi[0]; ya[j][3] += hi[1]; }
                float ss = 0.f;
#pragma unroll
                for (int j = 0; j < 4; ++j) { v[j] = v[j] + ya[j] * 0.0625f; ss += (v[j][0] * v[j][0] + v[j][1] * v[j][1]) + (v[j][2] * v[j][2] + v[j][3] * v[j][3]); }
                ss = wave_sum(ss); const float rs = rsqrt_f(ss * (1.0f / 1024.0f) + RMS_EPS);
#pragma unroll
                for (int j = 0; j < 4; ++j) *(f32x4*)(args.out + (size_t)(row + q * NGW) * 1024 + 4 * lane + 256 * j) = v[j] * rs * wf[j]; }
        }
    }
#undef IN
}

extern "C" void kernel_launch(void* const* d_in, const int* in_sizes, int n_in, void* d_out, int out_size, void* d_ws, size_t ws_size, hipStream_t stream) {
    static int grid = 0;
    if (grid == 0) {
        if (n_in != 21 || in_sizes[0] != T * D || out_size != T * D || ws_size < WS_END) { fprintf(stderr, "kernel_launch: unexpected shapes/workspace (n_in %d, ws %zu, need %zu)\n", n_in, ws_size, (size_t)WS_END); grid = -1; return; }
        if (hipFuncSetAttribute((const void*)mega, hipFuncAttributeMaxDynamicSharedMemorySize, LDS_BYTES) != hipSuccess) { fprintf(stderr, "kernel_launch: hipFuncSetAttribute failed\n"); grid = -1; return; }
        int dev = 0, cus = 0, per_cu = 0;
        if (hipGetDevice(&dev) != hipSuccess || hipDeviceGetAttribute(&cus, hipDeviceAttributeMultiprocessorCount, dev) != hipSuccess) { grid = -1; return; }
        if (hipOccupancyMaxActiveBlocksPerMultiprocessor(&per_cu, (const void*)mega, NTHR, LDS_BYTES) != hipSuccess || per_cu < 1) { fprintf(stderr, "kernel_launch: occupancy query says %d blocks per CU\n", per_cu); grid = -1; return; }
        (void)hipGetLastError();
        grid = cus;
    }
    if (grid < 0) return;
    (void)hipMemsetAsync((char*)d_ws + WS_CTL + (size_t)CW_BAR * 4, 0, (size_t)XCD_BAR_WORDS * 4, stream);
    Args a{};
    for (int i = 0; i < 21; ++i) a.in[i] = (const float*)d_in[i];
    a.out = (float*)d_out; a.ws = (unsigned char*)d_ws;
    a.ph_lo = 0; a.ph_hi = 10;
    hipLaunchKernelGGL(mega, dim3(grid), dim3(NTHR), LDS_BYTES, stream, a);
#ifdef PROBE_PHASE
    a.ph_lo = PROBE_PHASE; a.ph_hi = PROBE_PHASE + 1;
#ifdef PROBE_VARIANT
    a.variant = PROBE_VARIANT;
#endif
    hipLaunchKernelGGL(mega, dim3(grid), dim3(NTHR), LDS_BYTES, stream, a);
#endif
}
```

```cpp
#define WGM_SET 2
#include <hip/hip_runtime.h>
#include <cstdio>
#include <cstdint>

__device__ __forceinline__ int lane_id() { int l; asm volatile("v_mbcnt_lo_u32_b32 %0, -1, 0\n\tv_mbcnt_hi_u32_b32 %0, -1, %0" : "=v"(l)); return l; }
__device__ __forceinline__ void probe_spin(unsigned long long ticks) { const unsigned long long t0 = __builtin_amdgcn_s_memrealtime(); while (__builtin_amdgcn_s_memrealtime() - t0 < ticks) __builtin_amdgcn_s_sleep(8); }
namespace pg8 {
#define PG8_LAS __attribute__((address_space(3)))
typedef unsigned short bf16_t;
typedef short bf16x8 __attribute__((ext_vector_type(8)));
typedef float f32x4 __attribute__((ext_vector_type(4)));
typedef unsigned u32x4 __attribute__((ext_vector_type(4)));
#ifndef WGM_SET
#define WGM_SET 8
#endif
constexpr int BM = 256, BK = 64, HALF = 128, HTB = HALF * BK * 2, STAGE_BYTES = 8 * HTB, NXCD = 8, WGM = WGM_SET;

__host__ __device__ __forceinline__ int lds_byte(int r, int c) { const int st = (r >> 4) * 2 + (c >> 5), rr = r & 15, cc = c & 31, ob = rr * 64 + cc * 2; return st * 1024 + (ob ^ (((ob >> 9) & 1) << 5)); }
__host__ __device__ __forceinline__ void stage_rc(int b, int& R, int& C) { const int st = b / 1024, sb = b % 1024, swz = sb ^ (((sb >> 9) & 1) << 5); R = (st >> 1) * 16 + swz / 64; C = (st & 1) * 32 + (swz % 64) / 2; }
__host__ __device__ __forceinline__ int perm32(int rho) { const int n = rho >> 4, i = rho & 15; return 8 * (i >> 2) + 4 * n + (i & 3); }

__device__ __forceinline__ const char* uni_ptr(const void* p) { const unsigned long long v = (unsigned long long)p; const unsigned lo = __builtin_amdgcn_readfirstlane((unsigned)v), hi = __builtin_amdgcn_readfirstlane((unsigned)(v >> 32)); return (const char*)(((unsigned long long)hi << 32) | lo); }
struct Unit { int pm, pn, pb, e; };
struct Gemm { const bf16_t* A; const bf16_t* Bt; int M, N, K; };

struct StaticOrder {
    int nM, nN, nwg, G, c;
    __host__ __device__ void init(int M, int N, int G_, int c_) { nM = M / BM; nN = N / BM; nwg = nM * nN; G = G_; c = c_; }
    __host__ __device__ bool next(int i, Unit& u) const {
        const long L = (long)i * G + c; if (L >= nwg) return false;
        int wgid = (int)L; { const int q = nwg / NXCD, r = nwg % NXCD, xcd = wgid % NXCD, off = wgid / NXCD; wgid = (xcd < r ? xcd * (q + 1) : r * (q + 1) + (xcd - r) * q) + off; }
        const int nig = WGM * nN, gid = wgid / nig, fm = gid * WGM, gsz = (nM - fm) < WGM ? (nM - fm) : WGM;
        u.pm = fm + ((wgid % nig) % gsz); u.pn = (wgid % nig) / gsz; u.pb = u.pn; u.e = 0; return true;
    }
};
struct MoeOrder {
    const int* blk_expert; int nblk, ntn, G, c;
    __device__ bool next(int i, Unit& u) const {
        const int xcd = c % NXCD, s = i * (G / NXCD) + c / NXCD;
        const int rb = (s / ntn) * NXCD + xcd; if (rb >= nblk) return false;
        u.pm = rb; u.pn = s % ntn; u.e = __builtin_amdgcn_readfirstlane(blk_expert[rb]); u.pb = u.e * ntn + u.pn; return true;
    }
};

__device__ __forceinline__ unsigned cvt_pk_bf16(float lo, float hi) { unsigned r; asm volatile("v_cvt_pk_bf16_f32 %0, %1, %2" : "=v"(r) : "v"(lo), "v"(hi)); return r; }

struct EpiBf16 {
    static constexpr bool PERM = true; static constexpr int MIDT = -1;
    __device__ __forceinline__ void mid(f32x4 (&)[2][2][4][2], const Unit&, int, int) const {}
    bf16_t* O; int ldc; const float* rs;
    static constexpr bool HAS_ROWTAB = true;
    __device__ __forceinline__ const float* rowtab(const Unit& u) const { return rs + (size_t)u.pm * BM; }
    __device__ __forceinline__ void operator()(const f32x4 (&acc)[2][2][4][2], const Unit& u, int wr, int wc, int fr, int fq, const PG8_LAS float* rt) const {
        const int row0 = u.pm * BM + wr * 64 + fr, col0 = u.pn * BM + wc * 32 + 8 * fq;
#pragma unroll
        for (int ai = 0; ai < 2; ++ai)
#pragma unroll
            for (int m = 0; m < 4; ++m) { const int row = row0 + ai * HALF + m * 16; const float rr = rt[ai * HALF + wr * 64 + m * 16 + fr]; bf16_t* rowp = O + (size_t)row * ldc + col0;
#pragma unroll
                for (int bj = 0; bj < 2; ++bj) { const f32x4 v0 = acc[ai][bj][m][0] * rr, v1 = acc[ai][bj][m][1] * rr;
                    u32x4 w; w.x = cvt_pk_bf16(v0[0], v0[1]); w.y = cvt_pk_bf16(v0[2], v0[3]); w.z = cvt_pk_bf16(v1[0], v1[1]); w.w = cvt_pk_bf16(v1[2], v1[3]);
                    *(u32x4*)(rowp + bj * HALF) = w; } }
    }
};
struct EpiResF32 {
    static constexpr bool PERM = true; static constexpr int MIDT = 16;
    const float* base; bf16_t* C; int ldc; const float* ssq;
    __device__ __forceinline__ void mid(f32x4 (&acc)[2][2][4][2], const Unit& u, int wr, int fr) const {
#pragma unroll
        for (int ai = 0; ai < 2; ++ai)
#pragma unroll
            for (int m = 0; m < 4; ++m) { const int row = u.pm * BM + ai * HALF + wr * 64 + m * 16 + fr; const f32x4 a = *(const f32x4*)(ssq + (size_t)row * 8), b = *(const f32x4*)(ssq + (size_t)row * 8 + 4);
                const float rs = 1.0f / sqrtf(((a[0] + a[1]) + (a[2] + a[3]) + (b[0] + b[1]) + (b[2] + b[3])) * (1.0f / 1024.0f) + 1e-6f);
#pragma unroll
                for (int bj = 0; bj < 2; ++bj)
#pragma unroll
                    for (int n = 0; n < 2; ++n) acc[ai][bj][m][n] = acc[ai][bj][m][n] * rs;
                asm volatile("" ::: "memory"); }
    }
    static constexpr bool HAS_ROWTAB = false;
    __device__ __forceinline__ const float* rowtab(const Unit&) const { return nullptr; }
    __device__ __forceinline__ void operator()(const f32x4 (&acc)[2][2][4][2], const Unit& u, int wr, int wc, int fr, int fq, const PG8_LAS float*) const {
        const int row0 = u.pm * BM + wr * 64 + fr, col0 = u.pn * BM + wc * 32 + 8 * fq;
#pragma unroll
        for (int ai = 0; ai < 2; ++ai)
#pragma unroll
            for (int m = 0; m < 4; ++m) { const size_t off = (size_t)(row0 + ai * HALF + m * 16) * ldc + col0;
#pragma unroll
                for (int bj = 0; bj < 2; ++bj) { const f32x4 b0 = *(const f32x4*)(base + off + bj * HALF), b1 = *(const f32x4*)(base + off + bj * HALF + 4);
                    const f32x4 v0 = acc[ai][bj][m][0] + b0, v1 = acc[ai][bj][m][1] + b1;
                    u32x4 w; w.x = cvt_pk_bf16(v0[0], v0[1]); w.y = cvt_pk_bf16(v0[2], v0[3]); w.z = cvt_pk_bf16(v1[0], v1[1]); w.w = cvt_pk_bf16(v1[2], v1[3]);
                    *(u32x4*)(C + off + bj * HALF) = w; } }
    }
};
struct EpiSwiglu {
    static constexpr bool PERM = true; static constexpr int MIDT = -1;
    __device__ __forceinline__ void mid(f32x4 (&)[2][2][4][2], const Unit&, int, int) const {}
    static constexpr bool GATHER = true; const int* rowtok;
    unsigned char* act; const float* bgu; const float* rs;
    __device__ __forceinline__ const float* rowtab(const Unit& u) const { return rs + (size_t)u.pm * BM; }
    __device__ __forceinline__ const float* coltab(const Unit& u, int q) const { return bgu + (size_t)u.e * 2048 + u.pn * HALF + (q >> 1) * 1024 + (q & 1) * 64; }
    __device__ __forceinline__ void operator()(const f32x4 (&acc)[2][2][4][2], const Unit& u, int wr, int wc, int fr, int fq, const PG8_LAS float* tab) const {
        const int row0 = u.pm * BM + wr * 64 + fr, col0 = u.pn * HALF + wc * 32 + 8 * fq;
        const PG8_LAS float* ct = tab + 256 + wc * 32 + 8 * fq;
        f32x4 bgv[2], buv[2];
#pragma unroll
        for (int n = 0; n < 2; ++n) { bgv[n] = *(const PG8_LAS f32x4*)(ct + 4 * n); buv[n] = *(const PG8_LAS f32x4*)(ct + 128 + 4 * n); }
#pragma unroll
        for (int ai = 0; ai < 2; ++ai)
#pragma unroll
            for (int m = 0; m < 4; ++m) { const int row = row0 + ai * HALF + m * 16; const float rr = tab[ai * HALF + wr * 64 + m * 16 + fr]; unsigned char* rowp = act + (size_t)row * 1024 + col0;
                float o[8];
#pragma unroll
                for (int n = 0; n < 2; ++n) { typedef float f2 __attribute__((ext_vector_type(2)));
#pragma unroll
                    for (int h = 0; h < 2; ++h) { const f2 ag = {acc[ai][0][m][n][2 * h], acc[ai][0][m][n][2 * h + 1]}, au = {acc[ai][1][m][n][2 * h], acc[ai][1][m][n][2 * h + 1]};
                        const f2 bg2 = {bgv[n][2 * h], bgv[n][2 * h + 1]}, bu2 = {buv[n][2 * h], buv[n][2 * h + 1]};
                        f2 gv = ag * rr + bg2, uv = au * rr + bu2;
                        gv.x = fminf(gv.x, 7.0f); gv.y = fminf(gv.y, 7.0f); uv.x = __builtin_amdgcn_fmed3f(uv.x, -7.0f, 7.0f); uv.y = __builtin_amdgcn_fmed3f(uv.y, -7.0f, 7.0f);
                        const f2 t = gv * (-1.702f * 1.44269504f); f2 e; e.x = __builtin_amdgcn_exp2f(t.x); e.y = __builtin_amdgcn_exp2f(t.y);
                        const f2 d = e + 1.0f; f2 r; r.x = __builtin_amdgcn_rcpf(d.x); r.y = __builtin_amdgcn_rcpf(d.y);
                        const f2 res = ((uv + 1.0f) * gv) * r; o[4 * n + 2 * h] = res.x; o[4 * n + 2 * h + 1] = res.y; } }
                int w0 = 0, w1 = 0; w0 = __builtin_amdgcn_cvt_pk_fp8_f32(o[0], o[1], w0, false); w0 = __builtin_amdgcn_cvt_pk_fp8_f32(o[2], o[3], w0, true); w1 = __builtin_amdgcn_cvt_pk_fp8_f32(o[4], o[5], w1, false); w1 = __builtin_amdgcn_cvt_pk_fp8_f32(o[6], o[7], w1, true);
                typedef int i2v __attribute__((ext_vector_type(2))); *(i2v*)rowp = (i2v){w0, w1}; }
    }
};
struct EpiDown {
    static constexpr bool PERM = true; static constexpr int MIDT = -1;
    __device__ __forceinline__ void mid(f32x4 (&)[2][2][4][2], const Unit&, int, int) const {}
    static constexpr bool GATHER = false; const int* rowtok;
    unsigned char* eo; const float* bdn; const float* row_gate;
    __device__ __forceinline__ const float* rowtab(const Unit& u) const { return row_gate + (size_t)u.pm * BM; }
    __device__ __forceinline__ const float* coltab(const Unit& u, int q) const { return bdn + (size_t)u.e * 1024 + u.pn * BM + q * 64; }
    __device__ __forceinline__ void operator()(const f32x4 (&acc)[2][2][4][2], const Unit& u, int wr, int wc, int fr, int fq, const PG8_LAS float* tab) const {
        const int row0 = u.pm * BM + wr * 64 + fr, col0 = u.pn * BM + wc * 32 + 8 * fq;
        const PG8_LAS float* ct = tab + 256 + wc * 32 + 8 * fq;
        f32x4 bv[2][2];
#pragma unroll
        for (int bj = 0; bj < 2; ++bj)
#pragma unroll
            for (int n = 0; n < 2; ++n) bv[bj][n] = *(const PG8_LAS f32x4*)(ct + bj * HALF + 4 * n);
#pragma unroll
        for (int ai = 0; ai < 2; ++ai)
#pragma unroll
            for (int m = 0; m < 4; ++m) { const int row = row0 + ai * HALF + m * 16; const float gt = tab[ai * HALF + wr * 64 + m * 16 + fr] * 16.0f; unsigned char* rowp = eo + (size_t)row * 1024 + col0;
#pragma unroll
                for (int bj = 0; bj < 2; ++bj) { f32x4 v0 = (acc[ai][bj][m][0] + bv[bj][0]) * gt, v1 = (acc[ai][bj][m][1] + bv[bj][1]) * gt;
#pragma unroll
                    for (int i = 0; i < 4; ++i) { v0[i] = __builtin_amdgcn_fmed3f(v0[i], -448.0f, 448.0f); v1[i] = __builtin_amdgcn_fmed3f(v1[i], -448.0f, 448.0f); }
                    int w0 = 0, w1 = 0; w0 = __builtin_amdgcn_cvt_pk_fp8_f32(v0[0], v0[1], w0, false); w0 = __builtin_amdgcn_cvt_pk_fp8_f32(v0[2], v0[3], w0, true); w1 = __builtin_amdgcn_cvt_pk_fp8_f32(v1[0], v1[1], w1, false); w1 = __builtin_amdgcn_cvt_pk_fp8_f32(v1[2], v1[3], w1, true);
                    typedef int i2v __attribute__((ext_vector_type(2))); *(i2v*)(rowp + bj * HALF) = (i2v){w0, w1}; } }
    }
};

struct NoBetween { static constexpr bool ACTIVE = false; __device__ __forceinline__ void run(PG8_LAS unsigned char*, int) const {} };
typedef int v8i_t __attribute__((ext_vector_type(8)));
typedef int v4i_t __attribute__((ext_vector_type(4)));
template <class Epi, class Sched, class Between = NoBetween>
__device__ __forceinline__ void gemm_phase(PG8_LAS unsigned char* lds, const Gemm g, const Sched& S, const Epi& E, int wid, const Between& B = Between(), int bslot = 0) {
    bool between_done = false, restage = false; (void)between_done; (void)restage;
    const int lane = lane_id(), tid = wid * 64 + lane, wr = wid >> 2, wc = wid & 3, fr = lane & 15, fq = lane >> 4;
    const int K = g.K, nt = K / BK;
    unsigned voffA[2], voffB[2];
#pragma unroll
    for (int i = 0; i < 2; ++i) { int R, C; stage_rc(tid * 16 + i * 8192, R, C); const int Rb = Epi::PERM ? ((R & ~31) + perm32(R & 31)) : R;
        voffA[i] = (unsigned)(R * K + C) * 2u; voffB[i] = (unsigned)(Rb * K + C) * 2u; }
    const size_t kstep = (size_t)(BK * 2);
    const size_t hstep = (size_t)HALF * K * 2;
    const size_t tstep = 2 * hstep;
    const unsigned ldsw = (unsigned)wid * 1024u;
    const int aoff = lds_byte(wr * 64 + fr, fq * 8), boff = lds_byte(wc * 32 + fr, fq * 8);
#define PG8_SA(b, h) (((b) * 2 + (h)) * HTB)
#define PG8_SB(b, h) ((4 + (b) * 2 + (h)) * HTB)
#define PG8_STAGE(bufoff, gbase, voff) do { _Pragma("unroll") for (int _i = 0; _i < 2; ++_i) \
        __builtin_amdgcn_global_load_lds((const unsigned*)((const char*)(gbase) + (voff)[_i]), (PG8_LAS unsigned*)(lds + (bufoff) + ldsw + _i * 8192), 16, 0, 0); } while (0)
#define PG8_LDA(dst, b, h) do { _Pragma("unroll") for (int m = 0; m < 4; ++m) _Pragma("unroll") for (int k = 0; k < 2; ++k) dst[m][k] = *(const PG8_LAS bf16x8*)(lds + PG8_SA(b, h) + aoff + m * 2048 + k * 1024); } while (0)
#define PG8_LDB(dst, b, h) do { _Pragma("unroll") for (int n = 0; n < 2; ++n) _Pragma("unroll") for (int k = 0; k < 2; ++k) dst[n][k] = *(const PG8_LAS bf16x8*)(lds + PG8_SB(b, h) + boff + n * 2048 + k * 1024); } while (0)
#define PG8_MMA(ai, bj, At, Bt) do { __builtin_amdgcn_s_setprio(1); _Pragma("unroll") for (int m = 0; m < 4; ++m) _Pragma("unroll") for (int n = 0; n < 2; ++n) _Pragma("unroll") for (int k = 0; k < 2; ++k) \
        acc[ai][bj][m][n] = __builtin_amdgcn_mfma_f32_16x16x32_bf16(Bt[n][k], At[m][k], acc[ai][bj][m][n], 0, 0, 0); __builtin_amdgcn_s_setprio(0); } while (0)
#define PG8_WAIT_V(n) asm volatile("s_waitcnt vmcnt(" #n ")" ::: "memory")
#define PG8_WAIT_L(n) asm volatile("s_waitcnt lgkmcnt(" #n ")" ::: "memory")
#define PG8_BAR __builtin_amdgcn_s_barrier()
#define PG8_SCHED __builtin_amdgcn_sched_barrier(0)
    Unit cur, nxt; int ui = 0;
    if (!S.next(0, cur)) return;
    f32x4 acc[2][2][4][2];
#pragma unroll
    for (int a = 0; a < 2; ++a)
#pragma unroll
        for (int b = 0; b < 2; ++b)
#pragma unroll
            for (int m = 0; m < 4; ++m)
#pragma unroll
                for (int n = 0; n < 2; ++n) acc[a][b][m][n] = (f32x4){0.f, 0.f, 0.f, 0.f};
    bf16x8 At[4][2], B0[2][2], B1[2][2];
    const char* cA = uni_ptr((const char*)g.A + (size_t)cur.pm * tstep); const char* cB = uni_ptr((const char*)g.Bt + (size_t)cur.pb * tstep);
#define PG8_ROWTAB(u_, slot_) do { if (Epi::HAS_ROWTAB && wid < 4) __builtin_amdgcn_global_load_lds((const unsigned*)(E.rowtab(u_) + wid * 64 + lane), (PG8_LAS unsigned*)(lds + STAGE_BYTES + (slot_) * 1024 + wid * 256), 4, 0, 0); } while (0)
    PG8_ROWTAB(cur, 0);
#define PG8_PROLOGUE do { PG8_STAGE(PG8_SB(0, 0), cB, voffB); PG8_STAGE(PG8_SB(0, 1), cB + hstep, voffB); PG8_STAGE(PG8_SA(0, 0), cA, voffA); PG8_STAGE(PG8_SA(0, 1), cA + hstep, voffA); \
    if (wr == 1) PG8_BAR; \
    PG8_WAIT_V(2); PG8_BAR; \
    PG8_STAGE(PG8_SB(1, 0), cB + kstep, voffB); PG8_STAGE(PG8_SA(1, 0), cA + kstep, voffA); PG8_STAGE(PG8_SB(1, 1), cB + hstep + kstep, voffB); \
    PG8_WAIT_V(6); PG8_BAR; } while (0)
    PG8_PROLOGUE;
    for (;;) {
        const bool has_next = S.next(ui + 1, nxt);
        const char* nA = uni_ptr(has_next ? (const char*)g.A + (size_t)nxt.pm * tstep : cA); const char* nB = uni_ptr(has_next ? (const char*)g.Bt + (size_t)nxt.pb * tstep : cB);
        for (int t = 0; t < nt; t += 2) {
            const bool last = (t == nt - 2);
            const char* a1 = cA + (size_t)(t + 1) * kstep;
            const char* a2 = last ? nA : cA + (size_t)(t + 2) * kstep; const char* b2 = last ? nB : cB + (size_t)(t + 2) * kstep;
            const char* a3 = a2 + kstep; const char* b3 = b2 + kstep;
            if constexpr (Epi::MIDT >= 0) { if (t == Epi::MIDT) E.mid(acc, cur, wr, fr); }
            PG8_LDB(B0, 0, 0); PG8_LDB(B1, 0, 1); PG8_SCHED; PG8_LDA(At, 0, 0); PG8_STAGE(PG8_SA(1, 1), a1 + hstep, voffA);
            PG8_WAIT_V(8); PG8_WAIT_L(0); PG8_BAR; PG8_MMA(0, 0, At, B0); PG8_MMA(0, 1, At, B1); PG8_BAR; PG8_SCHED;
            PG8_LDA(At, 0, 1); PG8_STAGE(PG8_SB(0, 0), b2, voffB); PG8_STAGE(PG8_SB(0, 1), b2 + hstep, voffB); PG8_STAGE(PG8_SA(0, 0), a2, voffA);
            PG8_WAIT_V(8); PG8_WAIT_L(0); PG8_BAR; PG8_MMA(1, 0, At, B0); PG8_MMA(1, 1, At, B1); PG8_BAR; PG8_SCHED;
            PG8_LDB(B0, 1, 0); PG8_LDB(B1, 1, 1); PG8_SCHED; PG8_LDA(At, 1, 0); PG8_STAGE(PG8_SA(0, 1), a2 + hstep, voffA);
            PG8_WAIT_V(8); PG8_WAIT_L(0); PG8_BAR; PG8_MMA(0, 0, At, B0); PG8_MMA(0, 1, At, B1); PG8_BAR; PG8_SCHED;
            PG8_LDA(At, 1, 1); PG8_STAGE(PG8_SB(1, 0), b3, voffB); PG8_STAGE(PG8_SB(1, 1), b3 + hstep, voffB); PG8_STAGE(PG8_SA(1, 0), a3, voffA);
            PG8_WAIT_V(8); PG8_WAIT_L(0); PG8_BAR; PG8_MMA(1, 0, At, B0); PG8_MMA(1, 1, At, B1); PG8_BAR; PG8_SCHED;
        }
        if (wr == 0) PG8_BAR;
        E(acc, cur, wr, wc, fr, fq, (const PG8_LAS float*)(lds + STAGE_BYTES + (ui & 1) * 1024));
        if constexpr (Between::ACTIVE) { if (!between_done && (ui == bslot || !has_next)) {
            between_done = true; restage = has_next;
            PG8_WAIT_V(0); PG8_BAR;
            B.run(lds, wid);
            PG8_WAIT_L(0); PG8_BAR; } }
        if (!has_next) break;
#pragma unroll
        for (int a = 0; a < 2; ++a)
#pragma unroll
            for (int b = 0; b < 2; ++b)
#pragma unroll
                for (int m = 0; m < 4; ++m)
#pragma unroll
                    for (int n = 0; n < 2; ++n) acc[a][b][m][n] = (f32x4){0.f, 0.f, 0.f, 0.f};
        cur = nxt; cA = nA; cB = nB; ++ui;
        PG8_ROWTAB(cur, ui & 1);
        if (Between::ACTIVE && restage) { restage = false; PG8_PROLOGUE; }
        else if (wr == 1) PG8_BAR;
    }
    PG8_WAIT_V(0);
    PG8_BAR;
#undef PG8_ROWTAB
#undef PG8_PROLOGUE
#undef PG8_SA
#undef PG8_SB
#undef PG8_STAGE
#undef PG8_LDA
#undef PG8_LDB
#undef PG8_MMA
#undef PG8_WAIT_V
#undef PG8_WAIT_L
#undef PG8_BAR
#undef PG8_SCHED
}
template <class Epi, class Sched>
__device__ __forceinline__ void gemm_phase_f8(PG8_LAS unsigned char* lds, const Gemm g, const Sched& S, const Epi& E, int wid, int var = 0) {
    const int lane = lane_id(), tid = wid * 64 + lane, wr = wid >> 2, wc = wid & 3, fr = lane & 15, fq = lane >> 4;
    int Kq = g.K; asm volatile("" : "+s"(Kq));
    const int K = Kq, nt = K / BK;
    unsigned voffA[2], voffB[2];
#pragma unroll
    for (int i = 0; i < 2; ++i) { int R, C; stage_rc(tid * 16 + i * 8192, R, C); const int Rb = Epi::PERM ? ((R & ~31) + perm32(R & 31)) : R;
        voffA[i] = (unsigned)(R * K + C) * 2u; voffB[i] = (unsigned)(Rb * K + C) * 2u; }
    const size_t kstep = (size_t)(BK * 2);
    const size_t hstep = (size_t)HALF * K * 2;
    const size_t tstep = 2 * hstep;
    const unsigned ldsw = (unsigned)wid * 1024u;
    const unsigned ldsb = (unsigned)__builtin_amdgcn_readfirstlane((int)((unsigned)(size_t)lds + ldsw));
    const int aoff = lds_byte(wr * 64 + fr, fq * 8), boff = lds_byte(wc * 32 + fr, fq * 8);
#define PG8_SA(b, h) (((b) * 2 + (h)) * HTB)
#define PG8_SB(b, h) ((4 + (b) * 2 + (h)) * HTB)
#define PG8_STAGE(bufoff, gbase, voff) do { _Pragma("unroll") for (int _i = 0; _i < 2; ++_i) { unsigned _keep; \
        asm volatile("s_mov_b32 %0, m0\n\ts_mov_b32 m0, %3\n\ts_nop 0\n\tglobal_load_lds_dwordx4 %1, %2\n\ts_mov_b32 m0, %0" : "=&s"(_keep) : "v"((voff)[_i]), "s"((const char*)(gbase)), "s"(ldsb + (unsigned)((bufoff) + _i * 8192)) : "memory"); } } while (0)
#define PG8_STAGE_A(b, h, ka) do { if constexpr (Epi::GATHER) { _Pragma("unroll") for (int _i = 0; _i < 2; ++_i) { unsigned _keep; const unsigned _vo = (((voffA[_i] >> (16 * (h))) & 0xffffu) << 10) + cbA; \
        asm volatile("s_mov_b32 %0, m0\n\ts_mov_b32 m0, %3\n\ts_nop 0\n\tglobal_load_lds_dwordx4 %1, %2\n\ts_mov_b32 m0, %0" : "=&s"(_keep) : "v"(_vo), "s"((const char*)(ka)), "s"(ldsb + (unsigned)(PG8_SA(b, h) + _i * 8192)) : "memory"); } } \
    else PG8_STAGE(PG8_SA(b, h), (ka) + (h) * hstep, voffA); } while (0)
#define PG8_LDA(dst, b, h) do { _Pragma("unroll") for (int m = 0; m < 4; ++m) { const v4i_t _lo = *(const PG8_LAS v4i_t*)(lds + PG8_SA(b, h) + aoff + m * 2048), _hi = *(const PG8_LAS v4i_t*)(lds + PG8_SA(b, h) + aoff + m * 2048 + 1024); dst[m] = __builtin_shufflevector(_lo, _hi, 0, 1, 2, 3, 4, 5, 6, 7); } } while (0)
#define PG8_LDB(dst, b, h) do { _Pragma("unroll") for (int n = 0; n < 2; ++n) { const v4i_t _lo = *(const PG8_LAS v4i_t*)(lds + PG8_SB(b, h) + boff + n * 2048), _hi = *(const PG8_LAS v4i_t*)(lds + PG8_SB(b, h) + boff + n * 2048 + 1024); dst[n] = __builtin_shufflevector(_lo, _hi, 0, 1, 2, 3, 4, 5, 6, 7); } } while (0)
#define PG8_MMA(ai, bj, At, Bt) do { __builtin_amdgcn_s_setprio(1); _Pragma("unroll") for (int m = 0; m < 4; ++m) _Pragma("unroll") for (int n = 0; n < 2; ++n) \
        acc[ai][bj][m][n] = __builtin_amdgcn_mfma_scale_f32_16x16x128_f8f6f4(Bt[n], At[m], acc[ai][bj][m][n], 0, 0, 0, 0x79797979, 0, 0x7f7f7f7f); __builtin_amdgcn_s_setprio(0); } while (0)
#define PG8_WAIT_V(n) asm volatile("s_waitcnt vmcnt(" #n ")" ::: "memory")
#define PG8_WAIT_L(n) asm volatile("s_waitcnt lgkmcnt(" #n ")" ::: "memory")
#define PG8_BAR __builtin_amdgcn_s_barrier()
#define PG8_SCHED __builtin_amdgcn_sched_barrier(0)
#ifdef PROBE_GEMM
    unsigned long long p_acc = 0;
#endif
    Unit cur, nxt; int ui = 0;
    if (!S.next(0, cur)) return;
    f32x4 acc[2][2][4][2];
#pragma unroll
    for (int a = 0; a < 2; ++a)
#pragma unroll
        for (int b = 0; b < 2; ++b)
#pragma unroll
            for (int m = 0; m < 4; ++m)
#pragma unroll
                for (int n = 0; n < 2; ++n) acc[a][b][m][n] = (f32x4){0.f, 0.f, 0.f, 0.f};
    v8i_t At[4], B0[2], B1[2];
    const char* cA = uni_ptr((const char*)g.A + (Epi::GATHER ? (size_t)0 : (size_t)cur.pm * tstep)); const char* cB = uni_ptr((const char*)g.Bt + (size_t)cur.pb * tstep);
    unsigned cbA = 0;
    if constexpr (Epi::GATHER) { int R, C; stage_rc(tid * 16, R, C); cbA = (unsigned)C * 2u; const int* rt = E.rowtok + (size_t)cur.pm * BM + R;
        const int t00 = rt[0], t01 = rt[64], t10 = rt[128], t11 = rt[192]; voffA[0] = (unsigned)t00 | ((unsigned)t10 << 16); voffA[1] = (unsigned)t01 | ((unsigned)t11 << 16); }
#define PG8_TABS(u_, slot_) do { const char* _src = uni_ptr(wid < 4 ? E.rowtab(u_) + wid * 64 : E.coltab(u_, wid - 4)); unsigned _keep; \
        asm volatile("s_mov_b32 %0, m0\n\ts_mov_b32 m0, %3\n\ts_nop 0\n\tglobal_load_lds_dword %1, %2\n\ts_mov_b32 m0, %0" : "=&s"(_keep) : "v"(lane_id() * 4), "s"(_src), "s"(ldsb - ldsw + (unsigned)(STAGE_BYTES + (slot_) * 2048) + (unsigned)wid * 256u) : "memory"); } while (0)
    PG8_TABS(cur, 0);
    PG8_STAGE(PG8_SB(0, 0), cB, voffB); PG8_STAGE(PG8_SB(0, 1), cB + hstep, voffB); PG8_STAGE_A(0, 0, cA); PG8_STAGE_A(0, 1, cA);
    if (wr == 1) PG8_BAR;
    PG8_WAIT_V(2); PG8_BAR;
    PG8_STAGE(PG8_SB(1, 0), cB + kstep, voffB); PG8_STAGE_A(1, 0, cA + kstep); PG8_STAGE(PG8_SB(1, 1), cB + hstep + kstep, voffB);
    PG8_WAIT_V(6); PG8_BAR;
    for (;;) {
        const bool has_next = S.next(ui + 1, nxt);
        const char* nA = uni_ptr(has_next && !Epi::GATHER ? (const char*)g.A + (size_t)nxt.pm * tstep : cA); const char* nB = uni_ptr(has_next ? (const char*)g.Bt + (size_t)nxt.pb * tstep : cB);
        if constexpr (Epi::GATHER) { if (has_next && wid < 4) { const char* _src = uni_ptr(E.rowtok + (size_t)nxt.pm * BM + wid * 64); unsigned _keep;
            asm volatile("s_mov_b32 %0, m0\n\ts_mov_b32 m0, %3\n\ts_nop 0\n\tglobal_load_lds_dword %1, %2\n\ts_mov_b32 m0, %0" : "=&s"(_keep) : "v"(lane_id() * 4), "s"(_src), "s"(ldsb - ldsw + (unsigned)(STAGE_BYTES + 4096) + (unsigned)wid * 256u) : "memory"); } }
#ifdef PROBE_GEMM
        unsigned long long pt0 = 0; if (var && PROBE_GEMM == 1) pt0 = __builtin_amdgcn_s_memrealtime();
#endif
        for (int t = 0; t < nt; t += 2) {
            const bool last = (t == nt - 2);
            const char* a1 = cA + (size_t)(t + 1) * kstep;
            const char* a2 = last ? nA : cA + (size_t)(t + 2) * kstep; const char* b2 = last ? nB : cB + (size_t)(t + 2) * kstep;
            const char* a3 = a2 + kstep; const char* b3 = b2 + kstep;
            if constexpr (Epi::MIDT >= 0) { if (t == Epi::MIDT) E.mid(acc, cur, wr, fr); }
            PG8_LDB(B0, 0, 0); PG8_LDB(B1, 0, 1); PG8_SCHED; PG8_LDA(At, 0, 0); PG8_STAGE_A(1, 1, a1);
            PG8_WAIT_V(8); PG8_WAIT_L(0); PG8_BAR; PG8_MMA(0, 0, At, B0); PG8_MMA(0, 1, At, B1); PG8_BAR; PG8_SCHED;
            if constexpr (Epi::GATHER) { if (last && has_next) {
                const PG8_LAS int* tk = (const PG8_LAS int*)(lds + STAGE_BYTES + 4096) + (wid >> 1) * 16 + (lane_id() >> 2);
                const int t00 = tk[0], t01 = tk[64], t10 = tk[128], t11 = tk[192]; voffA[0] = (unsigned)t00 | ((unsigned)t10 << 16); voffA[1] = (unsigned)t01 | ((unsigned)t11 << 16); } }
            PG8_LDA(At, 0, 1); PG8_STAGE(PG8_SB(0, 0), b2, voffB); PG8_STAGE(PG8_SB(0, 1), b2 + hstep, voffB); PG8_STAGE_A(0, 0, a2);
            PG8_WAIT_V(8); PG8_WAIT_L(0); PG8_BAR; PG8_MMA(1, 0, At, B0); PG8_MMA(1, 1, At, B1); PG8_BAR; PG8_SCHED;
            PG8_LDB(B0, 1, 0); PG8_LDB(B1, 1, 1); PG8_SCHED; PG8_LDA(At, 1, 0); PG8_STAGE_A(0, 1, a2);
            PG8_WAIT_V(8); PG8_WAIT_L(0); PG8_BAR; PG8_MMA(0, 0, At, B0); PG8_MMA(0, 1, At, B1); PG8_BAR; PG8_SCHED;
            PG8_LDA(At, 1, 1); PG8_STAGE(PG8_SB(1, 0), b3, voffB); PG8_STAGE(PG8_SB(1, 1), b3 + hstep, voffB); PG8_STAGE_A(1, 0, a3);
            PG8_WAIT_V(8); PG8_WAIT_L(0); PG8_BAR; PG8_MMA(1, 0, At, B0); PG8_MMA(1, 1, At, B1); PG8_BAR; PG8_SCHED;
        }
#ifdef PROBE_GEMM
        if (var && PROBE_GEMM == 1) p_acc += __builtin_amdgcn_s_memrealtime() - pt0;
        if (var && PROBE_GEMM == 2) pt0 = __builtin_amdgcn_s_memrealtime();
#endif
        if (wr == 0) PG8_BAR;
        { const int l2 = lane_id(); E(acc, cur, wr, wc, l2 & 15, l2 >> 4, (const PG8_LAS float*)(lds + STAGE_BYTES + (ui & 1) * 2048)); }
#ifdef PROBE_GEMM
        if (var && PROBE_GEMM == 2) p_acc += __builtin_amdgcn_s_memrealtime() - pt0;
        if (var && PROBE_GEMM == 3) p_acc += 1000;
#endif
        if (!has_next) break;
#pragma unroll
        for (int a = 0; a < 2; ++a)
#pragma unroll
            for (int b = 0; b < 2; ++b)
#pragma unroll
                for (int m = 0; m < 4; ++m)
#pragma unroll
                    for (int n = 0; n < 2; ++n) acc[a][b][m][n] = (f32x4){0.f, 0.f, 0.f, 0.f};
        cur = nxt; cA = nA; cB = nB; ++ui;
        PG8_TABS(cur, ui & 1);
        if (wr == 1) PG8_BAR;
    }
    PG8_WAIT_V(0);
    PG8_BAR;
#ifdef PROBE_GEMM
    if (var && blockIdx.x == 0 && wid == 0) probe_spin(p_acc * 16);
#endif
#undef PG8_TABS
#undef PG8_STAGE_A
#undef PG8_SA
#undef PG8_SB
#undef PG8_STAGE
#undef PG8_LDA
#undef PG8_LDB
#undef PG8_MMA
#undef PG8_WAIT_V
#undef PG8_WAIT_L
#undef PG8_BAR
#undef PG8_SCHED
}
}

constexpr int BATCH = 16, SEQ = 2048, T = BATCH * SEQ, D = 1024;
constexpr int NPROJ = 6656;
constexpr int C_Z = 0, C_XBC = 1024, C_Q = 2560, C_K = 3584, C_V = 4608, C_O = 5632;
constexpr int WIN_LD = 6688;
constexpr int NE = 32, TOPK = 4;
constexpr int NASSIGN = T * TOPK, MAXBLK = NASSIGN / 256 + NE, MAXROWS = MAXBLK * 256;
constexpr float RMS_EPS = 1e-6f;
constexpr int NWAVES = 8, NTHR = 512;

constexpr size_t MiB = 1u << 20;
constexpr size_t WS_CTL = 0, CTL_ZERO_BYTES = 1 * MiB;
constexpr size_t WS_WIN = 1 * MiB, WS_WOUT = 14 * MiB, WS_WGU = 18 * MiB, WS_WDN = 146 * MiB;
constexpr size_t WS_XN = 210 * MiB, WS_H = 274 * MiB, WS_GATES = 402 * MiB, WS_ROUTE = 406 * MiB, WS_PROJ = 412 * MiB, WS_MIX = 828 * MiB, WS_END = 956 * MiB;
constexpr size_t WS_XBC = WS_H;
constexpr size_t WS_SSQ = WS_ROUTE + 3 * MiB;
constexpr size_t WS_XG = WS_PROJ, WS_ACT = WS_PROJ + 272 * MiB;
static_assert((size_t)MAXROWS * 1024 * 2 == 272 * MiB && WS_ACT + 272 * MiB == WS_END, "overlay map");
constexpr size_t R_TOPI = 0, R_TOPG = 512 * 1024, R_TOKROW = 1024 * 1024, R_ROWTOK = 1536 * 1024, R_ROWGATE = 2176 * 1024, R_BLKCNT = 2816 * 1024, R_BLKEXP = 2880 * 1024, R_NBLK = 2944 * 1024;
constexpr int CW_BAR = 4096;

constexpr int WL_LD = 36;
constexpr int WL_BYTES = 1024 * WL_LD * 4;
constexpr int MISC_OFF = 150528, LDS_BYTES = MISC_OFF + 1024;

#define GAS __attribute__((address_space(1)))
#define LAS __attribute__((address_space(3)))
typedef unsigned short bf16;
typedef unsigned v4u __attribute__((ext_vector_type(4)));
typedef unsigned v2u __attribute__((ext_vector_type(2)));
typedef float f32x4 __attribute__((ext_vector_type(4)));
#define LDS_WAIT() asm volatile("s_waitcnt lgkmcnt(0)" ::: "memory")
__device__ __forceinline__ unsigned f2bf(float f) { return (unsigned)__builtin_bit_cast(unsigned short, (__bf16)f); }
typedef __bf16 bf2_t __attribute__((ext_vector_type(2)));
__device__ __forceinline__ unsigned pk2(float lo, float hi) { const bf2_t v = {(__bf16)lo, (__bf16)hi}; return __builtin_bit_cast(unsigned, v); }
__device__ __forceinline__ float bf2f(unsigned short b) { return __builtin_bit_cast(float, (unsigned)b << 16); }
__device__ __forceinline__ float bflo(unsigned w) { return __builtin_bit_cast(float, w << 16); }
__device__ __forceinline__ float bfhi(unsigned w) { return __builtin_bit_cast(float, w & 0xffff0000u); }
__device__ __forceinline__ float wave_sum(float v) {
#pragma unroll
    for (int o = 1; o < 64; o <<= 1) v += __shfl_xor(v, o);
    return v;
}
__device__ __forceinline__ float silu_f(float x) { return x * __builtin_amdgcn_rcpf(1.0f + __expf(-x)); }
__device__ __forceinline__ float sigmoid_f(float x) { return __builtin_amdgcn_rcpf(1.0f + __expf(-x)); }
__device__ __forceinline__ float rsqrt_f(float x) { return __builtin_amdgcn_rsqf(x); }
__device__ __forceinline__ float softplus_f(float x) { return x > 20.0f ? x : log1pf(__expf(x)); }


#define XB_TMO      128
#define XB_XCNT(j)  (256  + 64 * (j))
#define XB_XSUB(j)  (1280 + 64 * (j))
#define XB_XGEN(j)  (2304 + 64 * (j))
#define XB_TOP      3328
#define XB_TOPGEN   3392
#define XCD_BAR_WORDS 3456
#define XB_SPIN_CAP (1u << 18)
__device__ __forceinline__ unsigned xb_ld(unsigned* p)              { return __hip_atomic_load(p, __ATOMIC_RELAXED, __HIP_MEMORY_SCOPE_AGENT); }
__device__ __forceinline__ unsigned xb_add(unsigned* p, unsigned v) { return __hip_atomic_fetch_add(p, v, __ATOMIC_RELAXED, __HIP_MEMORY_SCOPE_AGENT); }
__device__ __forceinline__ unsigned xb_xcc_id() { return (unsigned)__builtin_amdgcn_s_getreg((3 << 11) | 20) & 0xFu; }
#define XB_SPIN(cond, bar) do { unsigned _sp = 0; while (cond) { __builtin_amdgcn_s_sleep(1); \
    if ((++_sp & 255u) == 0u) { if (xb_ld(&(bar)[XB_TMO])) break; if (_sp > XB_SPIN_CAP) { atomicAdd(&(bar)[XB_TMO], 1u); break; } } } } while (0)
struct XcdBarrier { unsigned* bar; unsigned x; volatile LAS unsigned* st; };
__device__ __forceinline__ XcdBarrier xcd_barrier_post(unsigned* bar, volatile LAS unsigned* st, bool t0  ) {
    XcdBarrier b; b.bar = bar; b.x = xb_xcc_id(); b.st = st;
    if (t0) (void)xb_add(&bar[XB_XCNT(b.x)], 1u);
    return b;
}
__device__ __forceinline__ void xcd_barrier_complete(unsigned* bar, unsigned x, unsigned& nloc, unsigned& nx) {
    const unsigned G = gridDim.x * gridDim.y * gridDim.z;
    unsigned sum, cnt, mine, sp = 0u;
    for (;;) {
        sum = 0u; cnt = 0u; mine = 0u;
#pragma unroll
        for (unsigned j = 0; j < 16; ++j) { const unsigned c = xb_ld(&bar[XB_XCNT(j)]); sum += c; cnt += (c > 0u) ? 1u : 0u; mine = (j == x) ? c : mine; }
        if (sum == G) break;
        __builtin_amdgcn_s_sleep(1);
        if ((++sp & 255u) == 0u) { if (xb_ld(&bar[XB_TMO])) break; if (sp > XB_SPIN_CAP) { atomicAdd(&bar[XB_TMO], 1u); break; } }
    }
    nloc = mine > 0u ? mine : 1u; nx = cnt > 0u ? cnt : 1u;
}
__device__ __forceinline__ void xcd_barrier(const XcdBarrier& b, bool t0  ) {
    asm volatile("s_waitcnt vmcnt(0)" ::: "memory");
    __syncthreads();
    if (t0) {
        unsigned* bar = b.bar;
        __builtin_amdgcn_s_waitcnt(0);
        unsigned nloc = b.st[0], nx = b.st[1];
        if (nloc == 0u) { xcd_barrier_complete(bar, b.x, nloc, nx); b.st[0] = nloc; b.st[1] = nx; }
        const unsigned old = xb_add(&bar[XB_XSUB(b.x)], 1u);
        const unsigned gen = old / nloc;
        if (old + 1u == (gen + 1u) * nloc) {
            __builtin_amdgcn_fence(__ATOMIC_RELEASE, "agent");
            asm volatile("s_waitcnt vmcnt(0)" ::: "memory");
            const unsigned og = xb_add(&bar[XB_TOP], 1u);
            const unsigned tg = og / nx;
            if (og + 1u == (tg + 1u) * nx) xb_add(&bar[XB_TOPGEN], 1u);
            else XB_SPIN(xb_ld(&bar[XB_TOPGEN]) == tg, bar);
            __builtin_amdgcn_fence(__ATOMIC_ACQUIRE, "agent");
            xb_add(&bar[XB_XGEN(b.x)], 1u);
            asm volatile("s_waitcnt vmcnt(0)" ::: "memory");
        } else {
            XB_SPIN(xb_ld(&bar[XB_XGEN(b.x)]) == gen, bar);
            __builtin_amdgcn_fence(__ATOMIC_ACQUIRE, "agent");
            asm volatile("s_waitcnt vmcnt(0)" ::: "memory");
        }
    }
    __syncthreads();
}

__device__ __forceinline__ int fresh_tid(int wave) { int t = wave * 64 + lane_id(); asm volatile("" : "+v"(t)); return t; }
struct Args { const float* in[21]; float* out; unsigned char* ws; int ph_lo, ph_hi, variant, pad; };

__device__ __forceinline__ void transpose_item(const float* W, int ld_src, int n0s, int k0, bf16* WT, int K, int n0d, float cscale, const float* kscale, LAS float* scr, int lane) {
#pragma unroll
    for (int i = 0; i < 32; ++i) { const int kk = 2 * i + (lane >> 5); float v = W[(size_t)(k0 + kk) * ld_src + n0s + (lane & 31)] * cscale; if (kscale) v *= kscale[k0 + kk]; scr[kk * 33 + (lane & 31)] = v; }
    LDS_WAIT(); asm volatile("" ::: "memory");
    const int c = lane & 7;
#pragma unroll
    for (int j = 0; j < 4; ++j) { const int n = (lane >> 3) + 8 * j; const LAS float* s = scr + (8 * c) * 33 + n;
        v4u o; o.x = pk2(s[0 * 33], s[1 * 33]); o.y = pk2(s[2 * 33], s[3 * 33]); o.z = pk2(s[4 * 33], s[5 * 33]); o.w = pk2(s[6 * 33], s[7 * 33]);
        *(v4u*)(WT + (size_t)(n0d + n) * K + k0 + 8 * c) = o; }
    LDS_WAIT(); asm volatile("" ::: "memory");
}

__device__ __forceinline__ int pk4_fp8(float a, float b, float c, float d) { int w = 0; w = __builtin_amdgcn_cvt_pk_fp8_f32(a, b, w, false); w = __builtin_amdgcn_cvt_pk_fp8_f32(c, d, w, true); return w; }
__device__ __forceinline__ void transpose_item_f8(const float* W, int ld_src, int n0s, int k0, unsigned char* WT, int K, int n0d, float cscale, const float* kscale, LAS float* scr, int lane) {
#pragma unroll
    for (int i = 0; i < 32; ++i) { const int kk = 2 * i + (lane >> 5); float v = W[(size_t)(k0 + kk) * ld_src + n0s + (lane & 31)] * cscale; if (kscale) v *= kscale[k0 + kk]; scr[kk * 33 + (lane & 31)] = v; }
    LDS_WAIT(); asm volatile("" ::: "memory");
    const int c = lane & 3;
#pragma unroll
    for (int j = 0; j < 2; ++j) { const int n = (lane >> 2) + 16 * j; const LAS float* s = scr + (16 * c) * 33 + n;
        v4u o; o.x = (unsigned)pk4_fp8(s[0 * 33], s[1 * 33], s[2 * 33], s[3 * 33]); o.y = (unsigned)pk4_fp8(s[4 * 33], s[5 * 33], s[6 * 33], s[7 * 33]);
        o.z = (unsigned)pk4_fp8(s[8 * 33], s[9 * 33], s[10 * 33], s[11 * 33]); o.w = (unsigned)pk4_fp8(s[12 * 33], s[13 * 33], s[14 * 33], s[15 * 33]);
        *(v4u*)(WT + (size_t)(n0d + n) * K + k0 + 16 * c) = o; }
    LDS_WAIT(); asm volatile("" ::: "memory");
}

__device__ __forceinline__ void transpose_item_f8_128(const float* __restrict__ W, int ld_src, int n0s, int k0, unsigned char* __restrict__ WT, int K, int n0d, float cscale, LAS float* scr, int lane) {
#pragma unroll 1
    for (int i0 = 0; i0 < 64; i0 += 32) { float v[32];
#pragma unroll
        for (int i = 0; i < 32; ++i) v[i] = W[(size_t)(k0 + 2 * (i0 + i) + (lane >> 5)) * ld_src + n0s + (lane & 31)];
#pragma unroll
        for (int i = 0; i < 32; ++i) scr[(2 * (i0 + i) + (lane >> 5)) * 33 + (lane & 31)] = v[i] * cscale; }
    LDS_WAIT(); asm volatile("" ::: "memory");
    const int c = lane & 7;
#pragma unroll
    for (int j = 0; j < 4; ++j) { const int n = (lane >> 3) + 8 * j; const LAS float* s = scr + (16 * c) * 33 + n;
        v4u o; o.x = (unsigned)pk4_fp8(s[0 * 33], s[1 * 33], s[2 * 33], s[3 * 33]); o.y = (unsigned)pk4_fp8(s[4 * 33], s[5 * 33], s[6 * 33], s[7 * 33]);
        o.z = (unsigned)pk4_fp8(s[8 * 33], s[9 * 33], s[10 * 33], s[11 * 33]); o.w = (unsigned)pk4_fp8(s[12 * 33], s[13 * 33], s[14 * 33], s[15 * 33]);
        *(v4u*)(WT + (size_t)(n0d + n) * K + k0 + 16 * c) = o; }
    LDS_WAIT(); asm volatile("" ::: "memory");
}

struct MoeConv {
    static constexpr bool ACTIVE = true;
    const float* wgu; const float* wdn; unsigned char* gu8; unsigned char* dn8; int gw, ngw;
    __device__ __forceinline__ void run(LAS unsigned char* lds, int wave) const {
        const int lane = lane_id(); LAS float* scr = (LAS float*)(lds + wave * 17408);
        constexpr int I_GU = 8 * 64, I_DN = 8 * 32;
#pragma unroll 1
        for (int r0 = gw; r0 < NE * (I_GU + I_DN); r0 += ngw) { int r = r0;
            if (r < NE * I_GU) { const int e = r / I_GU, q = r % I_GU, nb = q % 64, kb = q / 64, rho = nb * 32; const int n0s = ((rho >> 7) & 1) * 1024 + (rho >> 8) * 128 + (rho & 127);
                transpose_item_f8_128(wgu + (size_t)e * 1024 * 2048, 2048, n0s, kb * 128, gu8 + (size_t)e * 2048 * 1024, 1024, rho, 64.0f, scr, lane); continue; } r -= NE * I_GU;
            { const int e = r / I_DN, q = r % I_DN, nb = q % 32, kb = q / 32;
                transpose_item_f8_128(wdn + (size_t)e * 1024 * 1024, 1024, nb * 32, kb * 128, dn8 + (size_t)e * 1024 * 1024, 1024, nb * 32, 64.0f, scr, lane); } }
    }
};

constexpr int PT_LD = 2064, PT_HALF = 32 * PT_LD;
typedef short s8v_t __attribute__((ext_vector_type(8)));
constexpr int PT_WN = 2 * PT_HALF;
__device__ __forceinline__ void pt_fill(LAS unsigned char* tab, const float* W, int ldw, int tid, bool gate_cols, const float* wn) {
    ((LAS float*)(tab + PT_WN))[tid] = wn[tid]; ((LAS float*)(tab + PT_WN))[512 + tid] = wn[512 + tid];
    const int c = tid & 31; const int sc = gate_cols ? (c < 16 ? 2560 + c : (c < 24 ? 6672 + (c - 16) : 6680 + (c - 24))) : c;
#pragma unroll 1
    for (int j0 = 0; j0 < 64; j0 += 32) { float v[32];
#pragma unroll
        for (int j = 0; j < 32; ++j) v[j] = W[(size_t)((tid >> 5) + 16 * (j0 + j)) * ldw + sc];
#pragma unroll
        for (int j = 0; j < 32; ++j) { const int k = (tid >> 5) + 16 * (j0 + j); const unsigned h = f2bf(v[j]); const float hf = __builtin_bit_cast(float, h << 16);
            *(LAS unsigned short*)(tab + c * PT_LD + k * 2) = (unsigned short)h; *(LAS unsigned short*)(tab + PT_HALF + c * PT_LD + k * 2) = (unsigned short)f2bf(v[j] - hf); } }
}
template <bool IN_BF16, bool OUT_F8>
__device__ __forceinline__ float rowproj16(const void* __restrict__ srcv, void* __restrict__ dstv, const float* __restrict__ wn, const LAS unsigned char* tab, int row0, int lane, f32x4 (&acc)[2]) {
    const int g = lane >> 4, c16 = lane & 15;
    acc[0] = (f32x4){0.f, 0.f, 0.f, 0.f}; acc[1] = acc[0]; float ss = 0.f;
    const LAS unsigned char* tb = tab + c16 * PT_LD + g * 16;
    v4u ra[4], rb[4];
#define RP_LOAD(dstA, dstB, s_) do { if constexpr (IN_BF16) { dstA = *(const v4u*)((const bf16*)srcv + (size_t)(row0 + c16) * 1024 + 32 * (s_) + 8 * g); } \
        else { const float* p_ = (const float*)srcv + (size_t)(row0 + c16) * 1024 + 32 * (s_) + 8 * g; dstA = *(const v4u*)p_; dstB = *(const v4u*)(p_ + 4); } } while (0)
#pragma unroll
    for (int i = 0; i < 4; ++i) RP_LOAD(ra[i], rb[i], i);
#pragma unroll 1
    for (int s0 = 0; s0 < 32; s0 += 4) {
        v4u na[4], nb[4];
#pragma unroll
        for (int i = 0; i < 4; ++i) { na[i] = ra[i]; nb[i] = rb[i]; }
        if (s0 + 4 < 32) {
#pragma unroll
            for (int i = 0; i < 4; ++i) RP_LOAD(na[i], nb[i], s0 + 4 + i);
        }
        f32x4 gw0[4], gw1[4];
#pragma unroll
        for (int i = 0; i < 4; ++i) { gw0[i] = *(const LAS f32x4*)(tab + PT_WN + (32 * (s0 + i) + 8 * g) * 4); gw1[i] = *(const LAS f32x4*)(tab + PT_WN + (32 * (s0 + i) + 8 * g) * 4 + 16); }
#pragma unroll
        for (int i = 0; i < 4; ++i) { const int s = s0 + i;
        f32x4 a, b;
        if constexpr (IN_BF16) { const v4u w = ra[i]; a = (f32x4){bflo(w.x), bfhi(w.x), bflo(w.y), bfhi(w.y)}; b = (f32x4){bflo(w.z), bfhi(w.z), bflo(w.w), bfhi(w.w)}; }
        else { a = __builtin_bit_cast(f32x4, ra[i]); b = __builtin_bit_cast(f32x4, rb[i]); }
        ss += (a[0] * a[0] + a[1] * a[1]) + (a[2] * a[2] + a[3] * a[3]) + (b[0] * b[0] + b[1] * b[1]) + (b[2] * b[2] + b[3] * b[3]);
        a = a * gw0[i]; b = b * gw1[i];
        v4u hw; hw.x = pk2(a[0], a[1]); hw.y = pk2(a[2], a[3]); hw.z = pk2(b[0], b[1]); hw.w = pk2(b[2], b[3]);
        v4u lw; lw.x = pk2(a[0] - bflo(hw.x), a[1] - bfhi(hw.x)); lw.y = pk2(a[2] - bflo(hw.y), a[3] - bfhi(hw.y)); lw.z = pk2(b[0] - bflo(hw.z), b[1] - bfhi(hw.z)); lw.w = pk2(b[2] - bflo(hw.w), b[3] - bfhi(hw.w));
        if constexpr (OUT_F8) { v2u o; o.x = (unsigned)pk4_fp8(a[0], a[1], a[2], a[3]); o.y = (unsigned)pk4_fp8(b[0], b[1], b[2], b[3]); *(v2u*)((unsigned char*)dstv + (size_t)(row0 + c16) * 1024 + 32 * s + 8 * g) = o; }
        else *(v4u*)((bf16*)dstv + (size_t)(row0 + c16) * 1024 + 32 * s + 8 * g) = hw;
        const s8v_t xh = __builtin_bit_cast(s8v_t, hw), xl = __builtin_bit_cast(s8v_t, lw);
#pragma unroll
        for (int nt = 0; nt < 2; ++nt) { const s8v_t wh = *(const LAS s8v_t*)(tb + nt * 16 * PT_LD + s * 64), wl = *(const LAS s8v_t*)(tb + PT_HALF + nt * 16 * PT_LD + s * 64);
            acc[nt] = __builtin_amdgcn_mfma_f32_16x16x32_bf16(xh, wh, acc[nt], 0, 0, 0); acc[nt] = __builtin_amdgcn_mfma_f32_16x16x32_bf16(xl, wh, acc[nt], 0, 0, 0); acc[nt] = __builtin_amdgcn_mfma_f32_16x16x32_bf16(xh, wl, acc[nt], 0, 0, 0); }
        }
#pragma unroll
        for (int i = 0; i < 4; ++i) { ra[i] = na[i]; rb[i] = nb[i]; }
    }
#undef RP_LOAD
    ss += __shfl_xor(ss, 16); ss += __shfl_xor(ss, 32);
    return 1.0f / sqrtf(ss * (1.0f / 1024.0f) + RMS_EPS);
}

namespace mx {
typedef short s8v __attribute__((ext_vector_type(8)));
typedef short s4v __attribute__((ext_vector_type(4)));
#define MX_MFMA(a, b, c) __builtin_amdgcn_mfma_f32_16x16x32_bf16(a, b, c, 0, 0, 0)
#define MX_SB() __builtin_amdgcn_sched_barrier(0)
#define MX_BAR() do { MX_SB(); asm volatile("s_waitcnt lgkmcnt(0)" ::: "memory"); __builtin_amdgcn_s_barrier(); asm volatile("" ::: "memory"); } while (0)
constexpr int TS = 288, TILE = 64 * TS, PS = 144, PTILE = 64 * PS, BUF = 3 * TILE;
struct LaneBase { unsigned row, perm, tr, prow; };
__device__ __forceinline__ LaneBase lane_base(int lane) { LaneBase L; const unsigned g = lane >> 4, i = lane & 15, q = i >> 2, p = lane & 3;
    L.row = i * TS + g * 16; L.perm = i * TS + g * 8; L.tr = (8 * g + q) * TS + p * 8; L.prow = i * PS + g * 16; return L; }
#define LD_ROW(t, L, rb, s) (*(const LAS mx::s8v*)((t) + (L).row + (rb) * 16 * mx::TS + (s) * 64))
#define LD_ROWP(t, L, rb, s) (*(const LAS mx::s8v*)((t) + (L).prow + (rb) * 16 * mx::PS + (s) * 64))
__device__ __forceinline__ s8v ld_perm2(const LAS unsigned char* p) { const s4v lo = *(const LAS s4v*)p, hi = *(const LAS s4v*)(p + 32); return (s8v){lo[0], lo[1], lo[2], lo[3], hi[0], hi[1], hi[2], hi[3]}; }
#define LD_PERM(t, L, rb, s) mx::ld_perm2((t) + (L).perm + (rb) * 16 * mx::TS + (s) * 64)
__device__ __forceinline__ s8v ld_tr2(const LAS unsigned char* p) {
    const s4v a = __builtin_amdgcn_ds_read_tr16_b64_v4i16((LAS s4v*)p), b = __builtin_amdgcn_ds_read_tr16_b64_v4i16((LAS s4v*)(p + 4 * TS));
    return (s8v){a[0], a[1], a[2], a[3], b[0], b[1], b[2], b[3]}; }
#define LD_TR(t, L, c, ks) mx::ld_tr2((t) + (L).tr + (ks) * 32 * mx::TS + (c) * 32)
__device__ __forceinline__ void dma_tiles(LAS unsigned char* buf, const bf16* g0, int gstride, int co0, int co1, int co2, int wave, int lane) {
#pragma unroll
    for (int pp = 0; pp < 7; ++pp) { const int piece = wave + 8 * pp; if (piece < 54) { const unsigned o = piece * 1024 + lane * 16, tl = o / TILE, ot = o - tl * TILE, row = ot / TS, wb = ot - row * TS;
        const int co = tl == 0 ? co0 : (tl == 1 ? co1 : co2);
        __builtin_amdgcn_global_load_lds((const unsigned*)(g0 + (size_t)row * gstride + co + (wb < 256 ? wb >> 1 : 0)), (LAS unsigned*)(buf + piece * 1024), 16, 0, 0); } }
}
#define MX_DPPF(old, src, ctrl, rm) __builtin_bit_cast(float, __builtin_amdgcn_update_dpp(__builtin_bit_cast(int, (float)(old)), __builtin_bit_cast(int, (float)(src)), ctrl, rm, 0xf, false))
__device__ __forceinline__ float scan_add(float x) {
    x += MX_DPPF(0.f, x, 0x111, 0xf); x += MX_DPPF(0.f, x, 0x112, 0xf); x += MX_DPPF(0.f, x, 0x114, 0xf); x += MX_DPPF(0.f, x, 0x118, 0xf);
    x += MX_DPPF(0.f, x, 0x142, 0xa); x += MX_DPPF(0.f, x, 0x143, 0xc); return x; }
__device__ __forceinline__ float scan_max(float x) { const float ninf = -INFINITY;
    x = fmaxf(x, MX_DPPF(ninf, x, 0x111, 0xf)); x = fmaxf(x, MX_DPPF(ninf, x, 0x112, 0xf)); x = fmaxf(x, MX_DPPF(ninf, x, 0x114, 0xf)); x = fmaxf(x, MX_DPPF(ninf, x, 0x118, 0xf));
    x = fmaxf(x, MX_DPPF(ninf, x, 0x142, 0xa)); x = fmaxf(x, MX_DPPF(ninf, x, 0x143, 0xc)); return x; }
__device__ __forceinline__ float lane63(float x) { return __builtin_bit_cast(float, __builtin_amdgcn_readlane(__builtin_bit_cast(int, x), 63)); }
__device__ __forceinline__ float softplus_fast(float x) { const float e = __expf(-fabsf(x)); return fmaxf(x, 0.f) + (e < 1e-6f ? e : __logf(1.0f + e)); }
__device__ __forceinline__ s8v pack_acc(const f32x4& a, const f32x4& b) {
    const unsigned w0 = pk2(a[0], a[1]), w1 = pk2(a[2], a[3]), w2 = pk2(b[0], b[1]), w3 = pk2(b[2], b[3]);
    v4u w = {w0, w1, w2, w3}; return __builtin_bit_cast(s8v, w);
}
__device__ __forceinline__ void unpack8(const v4u& w, float (&f)[8]) { f[0] = bflo(w.x); f[1] = bfhi(w.x); f[2] = bflo(w.y); f[3] = bfhi(w.y); f[4] = bflo(w.z); f[5] = bfhi(w.z); f[6] = bflo(w.w); f[7] = bfhi(w.w); }

__device__ __forceinline__ void mlstm_item(LAS unsigned char* lds, int item, int var, int wave, const bf16* __restrict__ PROJ, const float* __restrict__ GATES, const float* __restrict__ lnw, bf16* __restrict__ MIX) {
    const int lane = lane_id(), tid = wave * 64 + lane, g = lane >> 4, c16 = lane & 15;
    const int b = item >> 3, h = item & 7;
    const LaneBase L = lane_base(lane);
    LAS unsigned char* TP = lds + 2 * BUF; LAS unsigned char* TO = TP + PTILE;
    LAS float* denP = (LAS float*)(TO + TILE); LAS float* qnp = denP + 128; LAS float* nsh = qnp + 512;
    LAS float* Au = nsh + 128; LAS float* Avv = Au + 64; LAS float* Awi = Avv + 64; LAS float* Akw = Awi + 64; LAS float* Aid = Akw + 64;
    f32x4 Cst[8];
#pragma unroll
    for (int i = 0; i < 8; ++i) Cst[i] = (f32x4){0.f, 0.f, 0.f, 0.f};
    float nreg = 0.f, m_prev = 0.f;
    if (lane < 16) nsh[wave * 16 + lane] = 0.f;
    const int srow = tid >> 3, sch = tid & 7;
    const bf16* qbase = PROJ + (size_t)(b * SEQ) * NPROJ + h * 128;
    dma_tiles(lds, qbase, NPROJ, C_Q, C_K, C_V, wave, lane);
    float fnext = GATES[(size_t)(b * SEQ + lane) * 32 + 24 + h], inext = GATES[(size_t)(b * SEQ + lane) * 32 + 16 + h];
    asm volatile("s_waitcnt vmcnt(0)" ::: "memory"); MX_BAR();
#pragma unroll 1
    for (int c = 0; c < SEQ / 64; ++c) {
        const int cur = c & 1; const int t0 = b * SEQ + c * 64;
        LAS unsigned char* TQ = lds + cur * BUF; LAS unsigned char* TK = TQ + TILE; LAS unsigned char* TV = TQ + 2 * TILE;
        float fraw = fnext, iraw = inext; asm volatile("" : "+v"(fraw), "+v"(iraw));
        MX_SB();
        const v4u ov0 = *(const v4u*)(PROJ + (size_t)(t0 + srow) * NPROJ + C_O + h * 128 + 8 * sch), ov1 = *(const v4u*)(PROJ + (size_t)(t0 + srow) * NPROJ + C_O + h * 128 + 64 + 8 * sch);
        { const int tn = (c + 1 < SEQ / 64 ? t0 + 64 : t0) + lane; fnext = GATES[(size_t)tn * 32 + 24 + h]; inext = GATES[(size_t)tn * 32 + 16 + h]; }
        const float lf = -softplus_fast(-fraw), cf = scan_add(lf), chunk_f = lane63(cf);
        const float u = iraw - cf, Mx = scan_max(u);
        const float m_row = cf + fmaxf(m_prev, Mx), vv = cf - m_row;
        const float m_loc = chunk_f + lane63(Mx), m_new = fmaxf(chunk_f + m_prev, m_loc);
        const float w_inter = __expf(vv + m_prev), floorv = __expf(-m_row), kw = __expf(chunk_f + u - m_new), s_old = __expf(chunk_f + m_prev - m_new);
        Au[lane] = u; Avv[lane] = vv; Awi[lane] = w_inter; Akw[lane] = kw;
        if (!(var & 2)) { const int lt = wave & 3, jt0 = 2 * (wave >> 2); const float vv_l = Avv[16 * lt + c16]; float rsum = 0.f;
#pragma unroll
          for (int jj = 0; jj < 2; ++jj) { const int jt = jt0 + jj; float pv[4] = {0.f, 0.f, 0.f, 0.f};
            if (jt <= lt) { f32x4 acc = {0.f, 0.f, 0.f, 0.f};
#pragma unroll
                for (int ks = 0; ks < 4; ++ks) acc = MX_MFMA(LD_ROW(TK, L, jt, ks), LD_ROW(TQ, L, lt, ks), acc);
                const f32x4 uj = *(const LAS f32x4*)(Au + 16 * jt + 4 * g);
#pragma unroll
                for (int r = 0; r < 4; ++r) { const int j = 16 * jt + 4 * g + r, l = 16 * lt + c16; const float val = (j <= l) ? acc[r] * __expf(vv_l + uj[r]) : 0.f; rsum += val; pv[r] = val; } }
            v2u w; w.x = pk2(pv[0], pv[1]); w.y = pk2(pv[2], pv[3]);
            *(LAS v2u*)(TP + (16 * lt + c16) * PS + (16 * jt + 4 * g) * 2) = w; }
          rsum += __shfl_xor(rsum, 16); rsum += __shfl_xor(rsum, 32);
          if (g == 0) denP[(wave >> 2) * 64 + 16 * lt + c16] = rsum;
          v4u q0 = *(const LAS v4u*)(TQ + lane * TS + wave * 32), q1 = *(const LAS v4u*)(TQ + lane * TS + wave * 32 + 16); float qf[16]; { float t8[8]; unpack8(q0, t8);
#pragma unroll
            for (int e = 0; e < 8; ++e) qf[e] = t8[e]; unpack8(q1, t8);
#pragma unroll
            for (int e = 0; e < 8; ++e) qf[8 + e] = t8[e]; }
          float part = 0.f;
#pragma unroll
          for (int e4 = 0; e4 < 4; ++e4) { const f32x4 nv = *(const LAS f32x4*)(nsh + wave * 16 + 4 * e4); part += qf[4 * e4] * nv[0] + qf[4 * e4 + 1] * nv[1] + qf[4 * e4 + 2] * nv[2] + qf[4 * e4 + 3] * nv[3]; }
          qnp[wave * 64 + lane] = part; }
        if (c + 1 < SEQ / 64 && !(var & 1)) { int lv = lane; asm volatile("" : "+v"(lv)); dma_tiles(lds + (cur ^ 1) * BUF, qbase + (size_t)(c + 1) * 64 * NPROJ, NPROJ, C_Q, C_K, C_V, wave, lv); }
        MX_SB();
        f32x4 acc[4];
        { s8v sf[4];
#pragma unroll
          for (int ks = 0; ks < 4; ++ks) sf[ks] = pack_acc(Cst[2 * ks], Cst[2 * ks + 1]);
#pragma unroll
          for (int lt = 0; lt < 4; ++lt) acc[lt] = (f32x4){0.f, 0.f, 0.f, 0.f};
          if (!(var & 4)) {
#pragma unroll
            for (int ks = 0; ks < 4; ++ks)
#pragma unroll
                for (int lt = 0; lt < 4; ++lt) acc[lt] = MX_MFMA(sf[ks], LD_PERM(TQ, L, lt, ks), acc[lt]);
#pragma unroll
            for (int lt = 0; lt < 4; ++lt) acc[lt] = acc[lt] * Awi[16 * lt + c16]; } }
        const s8v vf0 = LD_TR(TV + wave * 32, L, 0, 0), vf1 = LD_TR(TV + wave * 32, L, 0, 1);
        {
#pragma unroll
          for (int i = 0; i < 8; ++i) Cst[i] = Cst[i] * s_old;
          if (!(var & 8))
#pragma unroll
          for (int ks = 0; ks < 2; ++ks) { const s8v vf = ks ? vf1 : vf0; const v4u vw = __builtin_bit_cast(v4u, vf); float f[8]; unpack8(vw, f);
            { const f32x4 k0 = *(const LAS f32x4*)(Akw + 32 * ks + 8 * g), k1 = *(const LAS f32x4*)(Akw + 32 * ks + 8 * g + 4);
#pragma unroll
              for (int e = 0; e < 4; ++e) { f[e] *= k0[e]; f[4 + e] *= k1[e]; } }
            v4u pw = {pk2(f[0], f[1]), pk2(f[2], f[3]), pk2(f[4], f[5]), pk2(f[6], f[7])}; const s8v vwf = __builtin_bit_cast(s8v, pw);
#pragma unroll
            for (int dkt = 0; dkt < 8; ++dkt) Cst[dkt] = MX_MFMA(LD_TR(TK, L, dkt, ks), vwf, Cst[dkt]); }
          float part = 0.f;
#pragma unroll
          for (int e4 = 0; e4 < 4; ++e4) { const f32x4 kk = *(const LAS f32x4*)(Akw + 16 * g + 4 * e4);
#pragma unroll
            for (int e = 0; e < 4; ++e) { const int j = 16 * g + 4 * e4 + e; part += bf2f(*(const LAS unsigned short*)(TK + j * TS + (16 * wave + c16) * 2)) * kk[e]; } }
          part += __shfl_xor(part, 16); part += __shfl_xor(part, 32);
          nreg = s_old * nreg + part; if (g == 0) nsh[wave * 16 + c16] = nreg;
        }
        MX_BAR();
        float inv_den; { float qn = 0.f;
#pragma unroll
          for (int w = 0; w < 8; ++w) qn += qnp[w * 64 + lane];
          float den = denP[lane] + denP[64 + lane] + w_inter * qn; den = fmaxf(fabsf(den), floorv); inv_den = __builtin_amdgcn_rcpf(den); Aid[lane] = inv_den; }
        { if (!(var & 4))
#pragma unroll
          for (int lt = 0; lt < 4; ++lt) { f32x4 a4 = MX_MFMA(vf0, LD_ROWP(TP, L, lt, 0), acc[lt]);
            if (lt >= 2) a4 = MX_MFMA(vf1, LD_ROWP(TP, L, lt, 1), a4);
            a4 = a4 * Aid[16 * lt + c16];
            v2u w; w.x = pk2(a4[0], a4[1]); w.y = pk2(a4[2], a4[3]);
            *(LAS v2u*)(TO + (16 * lt + c16) * TS + (16 * wave + 4 * g) * 2) = w; }
          m_prev = m_new; }
        asm volatile("s_waitcnt vmcnt(0)" ::: "memory"); MX_BAR();
        if (!(var & 16)) { const v4u a = *(const LAS v4u*)(TO + srow * TS + sch * 16), bq = *(const LAS v4u*)(TO + srow * TS + sch * 16 + 128); float f[16], of[16]; { float t8[8]; unpack8(a, t8);
#pragma unroll
            for (int e = 0; e < 8; ++e) f[e] = t8[e]; unpack8(bq, t8);
#pragma unroll
            for (int e = 0; e < 8; ++e) f[8 + e] = t8[e]; unpack8(ov0, t8);
#pragma unroll
            for (int e = 0; e < 8; ++e) of[e] = t8[e]; unpack8(ov1, t8);
#pragma unroll
            for (int e = 0; e < 8; ++e) of[8 + e] = t8[e]; }
          float ss = 0.f;
#pragma unroll
          for (int e = 0; e < 16; ++e) ss += f[e] * f[e];
          ss += __shfl_xor(ss, 1); ss += __shfl_xor(ss, 2); ss += __shfl_xor(ss, 4);
          const float rs = rsqrt_f(ss * (1.0f / 128.0f) + RMS_EPS);
          float wn[16]; { const f32x4 w0 = *(const f32x4*)(lnw + h * 128 + 8 * sch), w1 = *(const f32x4*)(lnw + h * 128 + 8 * sch + 4), w2 = *(const f32x4*)(lnw + h * 128 + 64 + 8 * sch), w3 = *(const f32x4*)(lnw + h * 128 + 64 + 8 * sch + 4);
#pragma unroll
            for (int e = 0; e < 4; ++e) { wn[e] = w0[e]; wn[4 + e] = w1[e]; wn[8 + e] = w2[e]; wn[12 + e] = w3[e]; } }
#pragma unroll
          for (int e = 0; e < 16; ++e) f[e] = f[e] * rs * wn[e] * sigmoid_f(of[e]);
          v4u o0 = {pk2(f[0], f[1]), pk2(f[2], f[3]), pk2(f[4], f[5]), pk2(f[6], f[7])}, o1 = {pk2(f[8], f[9]), pk2(f[10], f[11]), pk2(f[12], f[13]), pk2(f[14], f[15])};
          bf16* mp = MIX + (size_t)(t0 + srow) * 2048 + 1024 + h * 128 + 8 * sch; *(v4u*)mp = o0; *(v4u*)(mp + 64) = o1; }
    }
    MX_BAR();
}

__device__ __forceinline__ void ssd_item(LAS unsigned char* lds, int item, int var, int wave, const bf16* __restrict__ XBC, const bf16* __restrict__ PROJ, const float* __restrict__ GATES, const float* __restrict__ a_log,
                                         const float* __restrict__ d_skip, bf16* __restrict__ MIX, float* __restrict__ SSQ) {
    const int lane = lane_id(), tid = wave * 64 + lane, g = lane >> 4, c16 = lane & 15;
    const int b = item >> 3, hp = item & 7, grp = hp >> 2, hh = wave >> 2, ps = wave & 3;
    const LaneBase L = lane_base(lane);
    LAS unsigned char* TG = lds + 2 * BUF;
    LAS unsigned char* TO = TG + 2 * PTILE;
    LAS float* Aacs = (LAS float*)(TO + TILE); LAS float* Adinv = Aacs + 128; LAS float* Adt = Adinv + 128; LAS float* Awd = Adt + 128; LAS float* Aea = Awd + 128;
    f32x4 RT[8];
#pragma unroll
    for (int i = 0; i < 8; ++i) RT[i] = (f32x4){0.f, 0.f, 0.f, 0.f};
    const float an0 = -__expf(a_log[2 * hp]), an1 = -__expf(a_log[2 * hp + 1]), dk0 = d_skip[2 * hp], dk1 = d_skip[2 * hp + 1];
    const int srow = tid >> 3, sch = tid & 7;
    const bf16* xb = XBC + (size_t)(b * SEQ) * 1536;
    dma_tiles(lds, xb, 1536, 1280 + grp * 128, 1024 + grp * 128, hp * 128, wave, lane);
    float dn0 = GATES[(size_t)(b * SEQ + lane) * 32 + 2 * hp], dn1 = GATES[(size_t)(b * SEQ + lane) * 32 + 2 * hp + 1];
    asm volatile("s_waitcnt vmcnt(0)" ::: "memory"); MX_BAR();
#pragma unroll 1
    for (int c = 0; c < SEQ / 64; ++c) {
        const int cur = c & 1; const int t0 = b * SEQ + c * 64;
        LAS unsigned char* TC = lds + cur * BUF; LAS unsigned char* TB = TC + TILE; LAS unsigned char* TX = TC + 2 * TILE;
        float dr0 = dn0, dr1 = dn1; asm volatile("" : "+v"(dr0), "+v"(dr1));
        MX_SB();
        const v4u zv0 = *(const v4u*)(PROJ + (size_t)(t0 + srow) * NPROJ + C_Z + hp * 128 + 8 * sch), zv1 = *(const v4u*)(PROJ + (size_t)(t0 + srow) * NPROJ + C_Z + hp * 128 + 64 + 8 * sch);
        { const int tn = (c + 1 < SEQ / 64 ? t0 + 64 : t0) + lane; dn0 = GATES[(size_t)tn * 32 + 2 * hp]; dn1 = GATES[(size_t)tn * 32 + 2 * hp + 1]; }
        const float dt0 = softplus_fast(dr0), dt1 = softplus_fast(dr1);
        const float acs0 = scan_add(dt0 * an0), acs1 = scan_add(dt1 * an1);
        const float aend0 = lane63(acs0), aend1 = lane63(acs1);
        Aacs[lane] = acs0; Aacs[64 + lane] = acs1; Adinv[lane] = dk0 * __builtin_amdgcn_rcpf(dt0); Adinv[64 + lane] = dk1 * __builtin_amdgcn_rcpf(dt1); Adt[lane] = dt0; Adt[64 + lane] = dt1;
        Awd[lane] = __expf(aend0 - acs0); Awd[64 + lane] = __expf(aend1 - acs1); Aea[lane] = __expf(acs0); Aea[64 + lane] = __expf(acs1);
        const float aend = hh ? aend1 : aend0;
        if (!(var & 2)) { const int lt = wave & 3, st0 = 2 * (wave >> 2); const int l = 16 * lt + c16;
          const float al0 = Aacs[l], al1 = Aacs[64 + l], di0 = Adinv[l], di1 = Adinv[64 + l];
#pragma unroll
          for (int ss = 0; ss < 2; ++ss) { const int st = st0 + ss; float p0[4] = {0.f, 0.f, 0.f, 0.f}, p1[4] = {0.f, 0.f, 0.f, 0.f};
            if (st <= lt) { f32x4 acc = {0.f, 0.f, 0.f, 0.f};
#pragma unroll
                for (int ks = 0; ks < 4; ++ks) acc = MX_MFMA(LD_ROW(TB, L, st, ks), LD_ROW(TC, L, lt, ks), acc);
                const f32x4 as0 = *(const LAS f32x4*)(Aacs + 16 * st + 4 * g), as1 = *(const LAS f32x4*)(Aacs + 64 + 16 * st + 4 * g);
#pragma unroll
                for (int r = 0; r < 4; ++r) { const int sidx = 16 * st + 4 * g + r;
                    float v0 = (sidx <= l) ? acc[r] * __expf(al0 - as0[r]) : 0.f, v1 = (sidx <= l) ? acc[r] * __expf(al1 - as1[r]) : 0.f;
                    if (sidx == l) { v0 += di0; v1 += di1; } p0[r] = v0; p1[r] = v1; } }
            v2u w0, w1; w0.x = pk2(p0[0], p0[1]); w0.y = pk2(p0[2], p0[3]); w1.x = pk2(p1[0], p1[1]); w1.y = pk2(p1[2], p1[3]);
            const unsigned o = l * PS + (16 * st + 4 * g) * 2;
            *(LAS v2u*)(TG + o) = w0; *(LAS v2u*)(TG + PTILE + o) = w1; } }
        if (c + 1 < SEQ / 64 && !(var & 1)) { int lv = lane; asm volatile("" : "+v"(lv)); dma_tiles(lds + (cur ^ 1) * BUF, xb + (size_t)(c + 1) * 64 * 1536, 1536, 1280 + grp * 128, 1024 + grp * 128, hp * 128, wave, lv); }
        MX_SB();
        f32x4 acc[4];
        { s8v sf[4];
#pragma unroll
          for (int ks = 0; ks < 4; ++ks) sf[ks] = pack_acc(RT[2 * ks], RT[2 * ks + 1]);
#pragma unroll
          for (int lt = 0; lt < 4; ++lt) acc[lt] = (f32x4){0.f, 0.f, 0.f, 0.f};
          if (!(var & 4)) {
#pragma unroll
            for (int ks = 0; ks < 4; ++ks)
#pragma unroll
                for (int lt = 0; lt < 4; ++lt) acc[lt] = MX_MFMA(sf[ks], LD_PERM(TC, L, lt, ks), acc[lt]);
#pragma unroll
            for (int lt = 0; lt < 4; ++lt) acc[lt] = acc[lt] * Aea[64 * hh + 16 * lt + c16]; } }
          s8v xd[2], xw[2];
#pragma unroll
          for (int ks = 0; ks < 2; ++ks) { const s8v xf = LD_TR(TX + (4 * hh + ps) * 32, L, 0, ks); const v4u xv = __builtin_bit_cast(v4u, xf); float f[8], fw[8]; unpack8(xv, f);
            { const LAS float* pd = Adt + 64 * hh + 32 * ks + 8 * g; const LAS float* pw = Awd + 64 * hh + 32 * ks + 8 * g; const f32x4 d0 = *(const LAS f32x4*)pd, d1 = *(const LAS f32x4*)(pd + 4), w0 = *(const LAS f32x4*)pw, w1 = *(const LAS f32x4*)(pw + 4);
#pragma unroll
              for (int e = 0; e < 4; ++e) { f[e] *= d0[e]; fw[e] = f[e] * w0[e]; f[4 + e] *= d1[e]; fw[4 + e] = f[4 + e] * w1[e]; } }
            v4u a = {pk2(f[0], f[1]), pk2(f[2], f[3]), pk2(f[4], f[5]), pk2(f[6], f[7])}, bw = {pk2(fw[0], fw[1]), pk2(fw[2], fw[3]), pk2(fw[4], fw[5]), pk2(fw[6], fw[7])};
            xd[ks] = __builtin_bit_cast(s8v, a); xw[ks] = __builtin_bit_cast(s8v, bw); }
        {
          const float ea = __expf(aend);
#pragma unroll
          for (int i = 0; i < 8; ++i) RT[i] = RT[i] * ea;
          if (!(var & 8))
#pragma unroll
          for (int ks = 0; ks < 2; ++ks)
#pragma unroll
            for (int nt = 0; nt < 8; ++nt) RT[nt] = MX_MFMA(LD_TR(TB, L, nt, ks), xw[ks], RT[nt]);
        }
        MX_BAR();
        {
          const LAS unsigned char* TGm = TG + hh * PTILE;
          if (!(var & 4))
#pragma unroll
          for (int lt = 0; lt < 4; ++lt) { f32x4 a4 = MX_MFMA(xd[0], LD_ROWP(TGm, L, lt, 0), acc[lt]);
            if (lt >= 2) a4 = MX_MFMA(xd[1], LD_ROWP(TGm, L, lt, 1), a4);
            v2u w; w.x = pk2(a4[0], a4[1]); w.y = pk2(a4[2], a4[3]);
            *(LAS v2u*)(TO + (16 * lt + c16) * TS + (64 * hh + 16 * ps + 4 * g) * 2) = w; }
        }
        asm volatile("s_waitcnt vmcnt(0)" ::: "memory"); MX_BAR();
        if (!(var & 16)) { const v4u a = *(const LAS v4u*)(TO + srow * TS + sch * 16), bq = *(const LAS v4u*)(TO + srow * TS + sch * 16 + 128); float f[16], zf[16]; { float t8[8]; unpack8(a, t8);
#pragma unroll
            for (int e = 0; e < 8; ++e) f[e] = t8[e]; unpack8(bq, t8);
#pragma unroll
            for (int e = 0; e < 8; ++e) f[8 + e] = t8[e]; unpack8(zv0, t8);
#pragma unroll
            for (int e = 0; e < 8; ++e) zf[e] = t8[e]; unpack8(zv1, t8);
#pragma unroll
            for (int e = 0; e < 8; ++e) zf[8 + e] = t8[e]; }
          float ss = 0.f;
#pragma unroll
          for (int e = 0; e < 16; ++e) { f[e] = f[e] * silu_f(zf[e]); ss += f[e] * f[e]; }
          ss += __shfl_xor(ss, 1); ss += __shfl_xor(ss, 2); ss += __shfl_xor(ss, 4);
          if (sch == 0) SSQ[(size_t)(t0 + srow) * 8 + hp] = ss;
          v4u o0 = {pk2(f[0], f[1]), pk2(f[2], f[3]), pk2(f[4], f[5]), pk2(f[6], f[7])}, o1 = {pk2(f[8], f[9]), pk2(f[10], f[11]), pk2(f[12], f[13]), pk2(f[14], f[15])};
          bf16* mp = MIX + (size_t)(t0 + srow) * 2048 + hp * 128 + 8 * sch; *(v4u*)mp = o0; *(v4u*)(mp + 64) = o1; }
    }
    MX_BAR();
}
}

__global__ void __launch_bounds__(NTHR, 2) mega(Args args) {
    extern __shared__ __attribute__((aligned(16))) unsigned char lds_raw[];
    LAS unsigned char* lds = (LAS unsigned char*)lds_raw;
    const int wave = __builtin_amdgcn_readfirstlane((int)threadIdx.x >> 6);
    const int lane = lane_id(), tid = wave * 64 + lane;
    const int G = gridDim.x, bx = blockIdx.x;
    unsigned char* ws = args.ws;
#define INP(k) ({ int _k = (k); asm volatile("" : "+s"(_k)); args.in[_k]; })
#define XIN INP(0)
#define Win_t ((bf16*)(ws + WS_WIN))
#define Wout_t ((bf16*)(ws + WS_WOUT))
#define XN ((bf16*)(ws + WS_XN))
#define H ((bf16*)(ws + WS_H))
#define GATES ((float*)(ws + WS_GATES))
#define PROJ ((bf16*)(ws + WS_PROJ))
#define MIX ((bf16*)(ws + WS_MIX))
#define EO8 (ws + WS_XG + 136 * MiB)
#define TOPI ((int*)(ws + WS_ROUTE + R_TOPI))
#define TOPG ((float*)(ws + WS_ROUTE + R_TOPG))
#define TOKROW ((int*)(ws + WS_ROUTE + R_TOKROW))
#define ROWTOK ((int*)(ws + WS_ROUTE + R_ROWTOK))
#define ROWGATE ((float*)(ws + WS_ROUTE + R_ROWGATE))
#define BLKCNT ((int*)(ws + WS_ROUTE + R_BLKCNT))
#define BLKEXP ((int*)(ws + WS_ROUTE + R_BLKEXP))
#define NBLK ((int*)(ws + WS_ROUTE + R_NBLK))
#define XBC ((bf16*)(ws + WS_XBC))
#define SSQ ((float*)(ws + WS_SSQ))
#define RS1 ((float*)(ws + WS_SSQ + 1 * MiB))
#define RS2 ((float*)(ws + WS_SSQ + 1 * MiB + 128 * 1024))
#define ROWRS ((float*)(ws + WS_SSQ + 1 * MiB + 256 * 1024))
#define XN8 (ws + WS_XN)
#define XG8 (ws + WS_XG)
#define ACT8 (ws + WS_ACT)
#define Wgu8 (ws + WS_WGU)
#define Wdn8 (ws + WS_WDN)
    const int lo = args.ph_lo, hi = args.ph_hi;
    if (tid < 64) ((LAS unsigned*)(lds + MISC_OFF))[tid] = 0u;
    __syncthreads();
    XcdBarrier bar = xcd_barrier_post((unsigned*)(ws + WS_CTL) + CW_BAR, (volatile LAS unsigned*)(lds + MISC_OFF), tid == 0);
#define GRID_BAR(k) do { if (IN(k) && IN((k) + 1)) xcd_barrier(bar, wave == 0 && lane_id() == 0); } while (0)
#ifndef PH_MASK
#define PH_MASK 0xffff
#endif
#define IN(k) (((PH_MASK >> (k)) & 1) && lo <= (k) && (k) < hi)


    if (IN(0)) {
        const int tid = fresh_tid(wave), lane = tid & 63; (void)lane;
        LAS float* scr = (LAS float*)(lds + wave * 17408);
        const int gw = bx * NWAVES + wave, NGW = G * NWAVES;
        constexpr int I_IN = 16 * (NPROJ / 32), I_OUT = 32 * 32, I_GU = 8 * 64, I_DN = 8 * 32;
        constexpr int NITEMS = I_IN + I_OUT + NE * I_GU + NE * I_DN;
        if (!(args.variant & 32))
        for (int it = gw; it < I_IN + I_OUT; it += NGW) {
            int r = it;
            if (r < I_IN) { const int nb = r % (NPROJ / 32), kb = r / (NPROJ / 32), n0 = nb * 32; const int n0s = n0 + (n0 >= C_Q ? 16 : 0);
                const float cs = (n0 >= C_K && n0 < C_V) ? 0.08838834764831845f : 1.0f;
                transpose_item(INP(2), WIN_LD, n0s, kb * 64, Win_t, 1024, n0, cs, nullptr, scr, lane); continue; } r -= I_IN;
            if (r < I_OUT) { const int nb = r % 32, kb = r / 32; transpose_item(INP(12), 1024, nb * 32, kb * 64, Wout_t, 2048, nb * 32, 1.0f, kb < 16 ? INP(8) : nullptr, scr, lane); continue; } r -= I_OUT;
            if (r < NE * I_GU) { const int e = r / I_GU, q = r % I_GU, nb = q % 64, kb = q / 64, rho = nb * 32; const int n0s = ((rho >> 7) & 1) * 1024 + (rho >> 8) * 128 + (rho & 127);
                transpose_item_f8_128(INP(16) + (size_t)e * 1024 * 2048, 2048, n0s, kb * 128, Wgu8 + (size_t)e * 2048 * 1024, 1024, rho, 64.0f, scr, lane); continue; } r -= NE * I_GU;
            { const int e = r / I_DN, q = r % I_DN, nb = q % 32, kb = q / 32;
                transpose_item_f8_128(INP(18) + (size_t)e * 1024 * 1024, 1024, nb * 32, kb * 128, Wdn8 + (size_t)e * 1024 * 1024, 1024, nb * 32, 64.0f, scr, lane); }
        }
        __syncthreads();
        pt_fill(lds, INP(2), WIN_LD, tid, true, INP(1));
        __syncthreads();
        { const int c16 = lane & 15, g = lane >> 4;
          const float* wnp = INP(1); const float* bi_ = INP(9); const float* bf_ = INP(10); const float gb0 = INP(5)[c16], gb1 = *(c16 < 8 ? bi_ + c16 : bf_ + (c16 - 8));
          if (!(args.variant & 64))
#pragma unroll 1
          for (int task = gw; task < T / 16; task += NGW) { const int row0 = task * 16; f32x4 acc[2];
            const float rs = rowproj16<false, false>(XIN, XN, wnp, lds, row0, lane, acc);
            if (g == 0) RS1[row0 + c16] = rs;
#pragma unroll
            for (int r = 0; r < 4; ++r) { const float rr = __shfl(rs, 4 * g + r); float* gp = GATES + (size_t)(row0 + 4 * g + r) * 32; gp[c16] = rr * acc[0][r] + gb0; gp[16 + c16] = rr * acc[1][r] + gb1; } } }
        __syncthreads();
    }
    GRID_BAR(0);

    if (IN(1)) {
        pg8::Gemm g{XN, Win_t, T, NPROJ, 1024}; pg8::StaticOrder S; S.init(T, NPROJ, G, bx);
        pg8::EpiBf16 E{PROJ, NPROJ, RS1};
        MoeConv conv{INP(16), INP(18), Wgu8, Wdn8, bx * NWAVES + wave, G * NWAVES};
        pg8::gemm_phase<pg8::EpiBf16, pg8::StaticOrder, MoeConv>(lds, g, S, E, wave, conv, bx % 12);
    }
    GRID_BAR(1);

    if (IN(2)) {
        const int tid = fresh_tid(wave), lane = tid & 63; (void)lane;
        const float* cw = INP(3); const float* cb = INP(4);
#pragma unroll 1
        for (int it = bx * NTHR + tid; it < (T / 16) * 192; it += G * NTHR) {
            const int ch = it % 192, t0 = (it / 192) * 16, c0 = ch * 8;
            float w[4][8], bs[8], r0[8], r1[8], r2[8];
#pragma unroll
            for (int k = 0; k < 4; ++k) { const f32x4 a = *(const f32x4*)(cw + k * 1536 + c0), b2 = *(const f32x4*)(cw + k * 1536 + c0 + 4);
#pragma unroll
                for (int e = 0; e < 4; ++e) { w[k][e] = a[e]; w[k][4 + e] = b2[e]; } }
            { const f32x4 a = *(const f32x4*)(cb + c0), b2 = *(const f32x4*)(cb + c0 + 4);
#pragma unroll
              for (int e = 0; e < 4; ++e) { bs[e] = a[e]; bs[4 + e] = b2[e]; } }
            const bf16* src = PROJ + (size_t)t0 * NPROJ + C_XBC + c0;
            if ((t0 & (SEQ - 1)) == 0) {
#pragma unroll
                for (int e = 0; e < 8; ++e) { r0[e] = 0.f; r1[e] = 0.f; r2[e] = 0.f; }
            } else { mx::unpack8(*(const v4u*)(src - 3 * (size_t)NPROJ), r0); mx::unpack8(*(const v4u*)(src - 2 * (size_t)NPROJ), r1); mx::unpack8(*(const v4u*)(src - (size_t)NPROJ), r2); }
            v4u raw[16];
#pragma unroll
            for (int i = 0; i < 16; ++i) raw[i] = *(const v4u*)(src + (size_t)i * NPROJ);
#pragma unroll
            for (int i = 0; i < 16; ++i) { float cu[8], o[8]; mx::unpack8(raw[i], cu);
#pragma unroll
                for (int e = 0; e < 8; ++e) { o[e] = silu_f(bs[e] + w[0][e] * r0[e] + w[1][e] * r1[e] + w[2][e] * r2[e] + w[3][e] * cu[e]); r0[e] = r1[e]; r1[e] = r2[e]; r2[e] = cu[e]; }
                v4u ov = {pk2(o[0], o[1]), pk2(o[2], o[3]), pk2(o[4], o[5]), pk2(o[6], o[7])};
                *(v4u*)(XBC + (size_t)(t0 + i) * 1536 + c0) = ov; }
        }
    }
    GRID_BAR(2);

    if (IN(3)) {
#pragma unroll 1
        for (int it = bx; it < 256; it += G) if ((it >> 3) & 1) mx::mlstm_item(lds, ((it >> 4) << 3) | (it & 7), args.variant, wave, PROJ, GATES, INP(11), MIX);
#pragma unroll 1
        for (int it = bx; it < 256; it += G) if (!((it >> 3) & 1)) mx::ssd_item(lds, ((it >> 4) << 3) | (it & 7), args.variant, wave, XBC, PROJ, GATES, INP(6), INP(7), MIX, SSQ);
    }
    GRID_BAR(3);
    if (IN(4)) {
        pg8::Gemm g{MIX, Wout_t, T, 1024, 2048}; pg8::StaticOrder S; S.init(T, 1024, G, bx);
        pg8::EpiResF32 E{XIN, H, 1024, SSQ};
        pg8::gemm_phase<pg8::EpiResF32, pg8::StaticOrder>(lds, g, S, E, wave);
    }

    GRID_BAR(4);
    if (IN(5)) {
        const int tid = fresh_tid(wave), lane = tid & 63; (void)lane;
        LAS int* hist = (LAS int*)(lds + MISC_OFF + 256);
        pt_fill(lds, INP(14), 32, tid, false, INP(13));
        if (tid < 32) hist[tid] = 0;
        __syncthreads();
        const int c16 = lane & 15, g = lane >> 4; const float* wnp = INP(13); const float rb0 = INP(15)[c16], rb1 = INP(15)[16 + c16];
        for (int blk = bx; blk < T / 128; blk += G) {
            const int row0 = blk * 128 + wave * 16; f32x4 acc[2];
            const float rs = rowproj16<true, true>(H, XN8, wnp, lds, row0, lane, acc);
            if (g == 0) RS2[row0 + c16] = rs;
#pragma unroll
            for (int r = 0; r < 4; ++r) { const float rr = __shfl(rs, 4 * g + r); float v0 = rr * acc[0][r] + rb0, v1 = rr * acc[1][r] + rb1; float tv[4]; int ti[4];
#pragma unroll
                for (int k = 0; k < 4; ++k) { float bv = v0 >= v1 ? v0 : v1; int bi = v0 >= v1 ? c16 : c16 + 16;
#define TK_STEP(ctrl) do { const float ov = __builtin_bit_cast(float, __builtin_amdgcn_update_dpp(0, __builtin_bit_cast(int, bv), ctrl, 0xf, 0xf, false)); const int oi = __builtin_amdgcn_update_dpp(0, bi, ctrl, 0xf, 0xf, false); \
                        if (ov > bv || (ov == bv && oi < bi)) { bv = ov; bi = oi; } } while (0)
                    TK_STEP(0xB1); TK_STEP(0x4E); TK_STEP(0x141); TK_STEP(0x140);
#undef TK_STEP
                    tv[k] = bv; ti[k] = bi; if (bi == c16) v0 = -INFINITY; if (bi == c16 + 16) v1 = -INFINITY; }
                const float e1 = __expf(tv[1] - tv[0]), e2 = __expf(tv[2] - tv[0]), e3 = __expf(tv[3] - tv[0]); const float inv = 1.0f / (1.0f + e1 + e2 + e3);
                if (c16 == 0) { const size_t o = (size_t)(row0 + 4 * g + r) * 4; TOPI[o] = ti[0]; TOPI[o + 1] = ti[1]; TOPI[o + 2] = ti[2]; TOPI[o + 3] = ti[3];
                    TOPG[o] = inv; TOPG[o + 1] = e1 * inv; TOPG[o + 2] = e2 * inv; TOPG[o + 3] = e3 * inv;
                    __hip_atomic_fetch_add(hist + ti[0], 1, __ATOMIC_RELAXED, __HIP_MEMORY_SCOPE_WORKGROUP); __hip_atomic_fetch_add(hist + ti[1], 1, __ATOMIC_RELAXED, __HIP_MEMORY_SCOPE_WORKGROUP); __hip_atomic_fetch_add(hist + ti[2], 1, __ATOMIC_RELAXED, __HIP_MEMORY_SCOPE_WORKGROUP); __hip_atomic_fetch_add(hist + ti[3], 1, __ATOMIC_RELAXED, __HIP_MEMORY_SCOPE_WORKGROUP); } }
            __syncthreads();
            if (tid < 32) { BLKCNT[blk * 32 + tid] = hist[tid]; hist[tid] = 0; }
            __syncthreads();
        }
    }
    GRID_BAR(5);
    if (IN(6)) {
        const int tid = fresh_tid(wave), lane = tid & 63; (void)lane;
        LAS int* tot = (LAS int*)lds; LAS int* base = tot + 32; LAS int* pstart = base + 32; LAS int* wcnt = pstart + 33;
        LAS int* arow = wcnt + 256;
        LAS int* psum = arow + 512;
        for (int blk = bx; blk < T / 128; blk += G) {
            { const int e = tid & 31, part = tid >> 5; int v[16], t = 0, b = 0;
#pragma unroll
              for (int j = 0; j < 16; ++j) v[j] = BLKCNT[(part * 16 + j) * 32 + e];
#pragma unroll
              for (int j = 0; j < 16; ++j) { t += v[j]; if (part * 16 + j < blk) b += v[j]; }
              psum[part * 32 + e] = t; psum[512 + part * 32 + e] = b; }
            __syncthreads();
            if (tid < 32) { int t = 0, b = 0;
#pragma unroll
              for (int p = 0; p < 16; ++p) { t += psum[p * 32 + tid]; b += psum[512 + p * 32 + tid]; } tot[tid] = t; base[tid] = b; }
            __syncthreads();
            if (tid == 0) { int s = 0; for (int e = 0; e < 32; ++e) { pstart[e] = s; s += (tot[e] + 255) / 256 * 256; } pstart[32] = s; }
            __syncthreads();
            const int token = blk * 128 + (tid >> 2), k = tid & 3; const int e = TOPI[(size_t)token * 4 + k];
            int rank = 0;
#pragma unroll 1
            for (int ee = 0; ee < 32; ++ee) { const unsigned long long m = __ballot(e == ee); if (e == ee) rank = __popcll(m & ((1ull << lane) - 1ull)); if (lane == 0) wcnt[wave * 32 + ee] = __popcll(m); }
            __syncthreads();
            int off = 0; for (int w = 0; w < wave; ++w) off += wcnt[w * 32 + e];
            const int row = pstart[e] + base[e] + off + rank;
            ROWTOK[row] = token; ROWGATE[row] = TOPG[(size_t)token * 4 + k]; ROWRS[row] = RS2[token]; TOKROW[(size_t)token * 4 + k] = row; arow[tid] = row;
            __syncthreads();
            if (blk < 32) { const int ps = pstart[blk] + tot[blk], pe = pstart[blk + 1];
                for (int r = ps + tid; r < pe; r += NTHR) { ROWTOK[r] = 0; ROWGATE[r] = 0.f; ROWRS[r] = 0.f; } }
            if (blk == 0) { const int nb = pstart[32] / 256; if (tid == 0) NBLK[0] = nb;
                for (int b = tid; b < nb; b += NTHR) { int e2 = 0; while (e2 < 31 && b * 256 >= pstart[e2 + 1]) ++e2; BLKEXP[b] = e2; } }
            __syncthreads();
        }
    }

    GRID_BAR(6);
    if (IN(7)) {
        pg8::Gemm g{(const bf16*)XN8, (const bf16*)Wgu8, MAXROWS, 2048, 512}; pg8::MoeOrder S{BLKEXP, __builtin_amdgcn_readfirstlane(NBLK[0]), 8, G, bx};
        pg8::EpiSwiglu E{ROWTOK, ACT8, INP(17), ROWRS};
        pg8::gemm_phase_f8<pg8::EpiSwiglu, pg8::MoeOrder>(lds, g, S, E, wave, args.variant);
    }
    GRID_BAR(7);
    if (IN(8)) {
        pg8::Gemm g{(const bf16*)ACT8, (const bf16*)Wdn8, MAXROWS, 1024, 512}; pg8::MoeOrder S{BLKEXP, __builtin_amdgcn_readfirstlane(NBLK[0]), 4, G, bx};
        pg8::EpiDown E{nullptr, EO8, INP(19), ROWGATE};
        pg8::gemm_phase_f8<pg8::EpiDown, pg8::MoeOrder>(lds, g, S, E, wave);
    }
    GRID_BAR(8);
    if (IN(9)) {
        const int tid = fresh_tid(wave), lane = tid & 63; (void)lane;
        const int gw = bx * NWAVES + wave, NGW = G * NWAVES;
        f32x4 wf[4];
#pragma unroll
        for (int j = 0; j < 4; ++j) wf[j] = *(const f32x4*)(INP(20) + 4 * lane + 256 * j);
#pragma unroll 1
        for (int row = gw; row < T; row += 2 * NGW) {
            int er[2][4];
#pragma unroll
            for (int q = 0; q < 2; ++q) { const typeof(*(const v4u*)0) t4 = *(const v4u*)(TOKROW + (size_t)(row + q * NGW) * 4); er[q][0] = (int)t4.x; er[q][1] = (int)t4.y; er[q][2] = (int)t4.z; er[q][3] = (int)t4.w; }
            v2u hw[2][4]; int ew[2][4][4];
#pragma unroll
            for (int q = 0; q < 2; ++q)
#pragma unroll
                for (int j = 0; j < 4; ++j) hw[q][j] = *(const v2u*)(H + (size_t)(row + q * NGW) * 1024 + 4 * lane + 256 * j);
#pragma unroll
            for (int q = 0; q < 2; ++q)
#pragma unroll
                for (int k = 0; k < 4; ++k)
#pragma unroll
                    for (int j = 0; j < 4; ++j) ew[q][k][j] = *(const int*)(EO8 + (size_t)er[q][k] * 1024 + 4 * lane + 256 * j);
#pragma unroll
            for (int q = 0; q < 2; ++q) { f32x4 v[4], ya[4]; typedef float f2v __attribute__((ext_vector_type(2)));
#pragma unroll
                for (int j = 0; j < 4; ++j) { v[j] = (f32x4){bflo(hw[q][j].x), bfhi(hw[q][j].x), bflo(hw[q][j].y), bfhi(hw[q][j].y)}; ya[j] = (f32x4){0.f, 0.f, 0.f, 0.f}; }
#pragma unroll
                for (int k = 0; k < 4; ++k)
#pragma unroll
                    for (int j = 0; j < 4; ++j) { const f2v lo = __builtin_amdgcn_cvt_pk_f32_fp8(ew[q][k][j], false), hi = __builtin_amdgcn_cvt_pk_f32_fp8(ew[q][k][j], true); ya[j][0] += lo[0]; ya[j][1] += lo[1]; ya[j][2] += hi[0]; ya[j][3] += hi[1]; }
                float ss = 0.f;
#pragma unroll
                for (int j = 0; j < 4; ++j) { v[j] = v[j] + ya[j] * 0.0625f; ss += (v[j][0] * v[j][0] + v[j][1] * v[j][1]) + (v[j][2] * v[j][2] + v[j][3] * v[j][3]); }
                ss = wave_sum(ss); const float rs = rsqrt_f(ss * (1.0f / 1024.0f) + RMS_EPS);
#pragma unroll
                for (int j = 0; j < 4; ++j) *(f32x4*)(args.out + (size_t)(row + q * NGW) * 1024 + 4 * lane + 256 * j) = v[j] * rs * wf[j]; }
        }
    }
#undef IN
}

extern "C" void kernel_launch(void* const* d_in, const int* in_sizes, int n_in, void* d_out, int out_size, void* d_ws, size_t ws_size, hipStream_t stream) {
    static int grid = 0;
    if (grid == 0) {
        if (n_in != 21 || in_sizes[0] != T * D || out_size != T * D || ws_size < WS_END) { fprintf(stderr, "kernel_launch: unexpected shapes/workspace (n_in %d, ws %zu, need %zu)\n", n_in, ws_size, (size_t)WS_END); grid = -1; return; }
        if (hipFuncSetAttribute((const void*)mega, hipFuncAttributeMaxDynamicSharedMemorySize, LDS_BYTES) != hipSuccess) { fprintf(stderr, "kernel_launch: hipFuncSetAttribute failed\n"); grid = -1; return; }
        int dev = 0, cus = 0, per_cu = 0;
        if (hipGetDevice(&dev) != hipSuccess || hipDeviceGetAttribute(&cus, hipDeviceAttributeMultiprocessorCount, dev) != hipSuccess) { grid = -1; return; }
        if (hipOccupancyMaxActiveBlocksPerMultiprocessor(&per_cu, (const void*)mega, NTHR, LDS_BYTES) != hipSuccess || per_cu < 1) { fprintf(stderr, "kernel_launch: occupancy query says %d blocks per CU\n", per_cu); grid = -1; return; }
        (void)hipGetLastError();
        grid = cus;
    }
    if (grid < 0) return;
    (void)hipMemsetAsync((char*)d_ws + WS_CTL + (size_t)CW_BAR * 4, 0, (size_t)XCD_BAR_WORDS * 4, stream);
    Args a{};
    for (int i = 0; i < 21; ++i) a.in[i] = (const float*)d_in[i];
    a.out = (float*)d_out; a.ws = (unsigned char*)d_ws;
    a.ph_lo = 0; a.ph_hi = 10;
    hipLaunchKernelGGL(mega, dim3(grid), dim3(NTHR), LDS_BYTES, stream, a);
#ifdef PROBE_PHASE
    a.ph_lo = PROBE_PHASE; a.ph_hi = PROBE_PHASE + 1;
#ifdef PROBE_VARIANT
    a.variant = PROBE_VARIANT;
#endif
    hipLaunchKernelGGL(mega, dim3(grid), dim3(NTHR), LDS_BYTES, stream, a);
#endif
}
```

```cpp
#define WGM_SET 2
#include <hip/hip_runtime.h>
#include <cstdio>
#include <cstdint>

__device__ __forceinline__ int lane_id() { int l; asm volatile("v_mbcnt_lo_u32_b32 %0, -1, 0\n\tv_mbcnt_hi_u32_b32 %0, -1, %0" : "=v"(l)); return l; }
__device__ __forceinline__ void probe_spin(unsigned long long ticks) { const unsigned long long t0 = __builtin_amdgcn_s_memrealtime(); while (__builtin_amdgcn_s_memrealtime() - t0 < ticks) __builtin_amdgcn_s_sleep(8); }
namespace pg8 {
#define PG8_LAS __attribute__((address_space(3)))
typedef unsigned short bf16_t;
typedef short bf16x8 __attribute__((ext_vector_type(8)));
typedef float f32x4 __attribute__((ext_vector_type(4)));
typedef unsigned u32x4 __attribute__((ext_vector_type(4)));
#ifndef WGM_SET
#define WGM_SET 8
#endif
constexpr int BM = 256, BK = 64, HALF = 128, HTB = HALF * BK * 2, STAGE_BYTES = 8 * HTB, NXCD = 8, WGM = WGM_SET;

__host__ __device__ __forceinline__ int lds_byte(int r, int c) { const int st = (r >> 4) * 2 + (c >> 5), rr = r & 15, cc = c & 31, ob = rr * 64 + cc * 2; return st * 1024 + (ob ^ (((ob >> 9) & 1) << 5)); }
__host__ __device__ __forceinline__ void stage_rc(int b, int& R, int& C) { const int st = b / 1024, sb = b % 1024, swz = sb ^ (((sb >> 9) & 1) << 5); R = (st >> 1) * 16 + swz / 64; C = (st & 1) * 32 + (swz % 64) / 2; }
__host__ __device__ __forceinline__ int perm32(int rho) { const int n = rho >> 4, i = rho & 15; return 8 * (i >> 2) + 4 * n + (i & 3); }

__device__ __forceinline__ const char* uni_ptr(const void* p) { const unsigned long long v = (unsigned long long)p; const unsigned lo = __builtin_amdgcn_readfirstlane((unsigned)v), hi = __builtin_amdgcn_readfirstlane((unsigned)(v >> 32)); return (const char*)(((unsigned long long)hi << 32) | lo); }
struct Unit { int pm, pn, pb, e; };
struct Gemm { const bf16_t* A; const bf16_t* Bt; int M, N, K; };

struct StaticOrder {
    int nM, nN, nwg, G, c;
    __host__ __device__ void init(int M, int N, int G_, int c_) { nM = M / BM; nN = N / BM; nwg = nM * nN; G = G_; c = c_; }
    __host__ __device__ bool next(int i, Unit& u) const {
        const long L = (long)i * G + c; if (L >= nwg) return false;
        int wgid = (int)L; { const int q = nwg / NXCD, r = nwg % NXCD, xcd = wgid % NXCD, off = wgid / NXCD; wgid = (xcd < r ? xcd * (q + 1) : r * (q + 1) + (xcd - r) * q) + off; }
        const int nig = WGM * nN, gid = wgid / nig, fm = gid * WGM, gsz = (nM - fm) < WGM ? (nM - fm) : WGM;
        u.pm = fm + ((wgid % nig) % gsz); u.pn = (wgid % nig) / gsz; u.pb = u.pn; u.e = 0; return true;
    }
};
struct MoeOrder {
    const int* blk_expert; int nblk, ntn, G, c;
    __device__ bool next(int i, Unit& u) const {
        const int xcd = c % NXCD, s = i * (G / NXCD) + c / NXCD;
        const int rb = (s / ntn) * NXCD + xcd; if (rb >= nblk) return false;
        u.pm = rb; u.pn = s % ntn; u.e = __builtin_amdgcn_readfirstlane(blk_expert[rb]); u.pb = u.e * ntn + u.pn; return true;
    }
};

__device__ __forceinline__ unsigned cvt_pk_bf16(float lo, float hi) { unsigned r; asm volatile("v_cvt_pk_bf16_f32 %0, %1, %2" : "=v"(r) : "v"(lo), "v"(hi)); return r; }

struct EpiBf16 {
    static constexpr bool PERM = true; static constexpr int MIDT = -1;
    __device__ __forceinline__ void mid(f32x4 (&)[2][2][4][2], const Unit&, int, int) const {}
    bf16_t* O; int ldc; const float* rs;
    static constexpr bool HAS_ROWTAB = true;
    __device__ __forceinline__ const float* rowtab(const Unit& u) const { return rs + (size_t)u.pm * BM; }
    __device__ __forceinline__ void operator()(const f32x4 (&acc)[2][2][4][2], const Unit& u, int wr, int wc, int fr, int fq, const PG8_LAS float* rt) const {
        const int row0 = u.pm * BM + wr * 64 + fr, col0 = u.pn * BM + wc * 32 + 8 * fq;
#pragma unroll
        for (int ai = 0; ai < 2; ++ai)
#pragma unroll
            for (int m = 0; m < 4; ++m) { const int row = row0 + ai * HALF + m * 16; const float rr = rt[ai * HALF + wr * 64 + m * 16 + fr]; bf16_t* rowp = O + (size_t)row * ldc + col0;
#pragma unroll
                for (int bj = 0; bj < 2; ++bj) { const f32x4 v0 = acc[ai][bj][m][0] * rr, v1 = acc[ai][bj][m][1] * rr;
                    u32x4 w; w.x = cvt_pk_bf16(v0[0], v0[1]); w.y = cvt_pk_bf16(v0[2], v0[3]); w.z = cvt_pk_bf16(v1[0], v1[1]); w.w = cvt_pk_bf16(v1[2], v1[3]);
                    *(u32x4*)(rowp + bj * HALF) = w; } }
    }
};
struct EpiResF32 {
    static constexpr bool PERM = true; static constexpr int MIDT = 16;
    const float* base; bf16_t* C; int ldc; const float* ssq;
    __device__ __forceinline__ void mid(f32x4 (&acc)[2][2][4][2], const Unit& u, int wr, int fr) const {
#pragma unroll
        for (int ai = 0; ai < 2; ++ai)
#pragma unroll
            for (int m = 0; m < 4; ++m) { const int row = u.pm * BM + ai * HALF + wr * 64 + m * 16 + fr; const f32x4 a = *(const f32x4*)(ssq + (size_t)row * 8), b = *(const f32x4*)(ssq + (size_t)row * 8 + 4);
                const float rs = 1.0f / sqrtf(((a[0] + a[1]) + (a[2] + a[3]) + (b[0] + b[1]) + (b[2] + b[3])) * (1.0f / 1024.0f) + 1e-6f);
#pragma unroll
                for (int bj = 0; bj < 2; ++bj)
#pragma unroll
                    for (int n = 0; n < 2; ++n) acc[ai][bj][m][n] = acc[ai][bj][m][n] * rs;
                asm volatile("" ::: "memory"); }
    }
    static constexpr bool HAS_ROWTAB = false;
    __device__ __forceinline__ const float* rowtab(const Unit&) const { return nullptr; }
    __device__ __forceinline__ void operator()(const f32x4 (&acc)[2][2][4][2], const Unit& u, int wr, int wc, int fr, int fq, const PG8_LAS float*) const {
        const int row0 = u.pm * BM + wr * 64 + fr, col0 = u.pn * BM + wc * 32 + 8 * fq;
#pragma unroll
        for (int ai = 0; ai < 2; ++ai)
#pragma unroll
            for (int m = 0; m < 4; ++m) { const size_t off = (size_t)(row0 + ai * HALF + m * 16) * ldc + col0;
#pragma unroll
                for (int bj = 0; bj < 2; ++bj) { const f32x4 b0 = *(const f32x4*)(base + off + bj * HALF), b1 = *(const f32x4*)(base + off + bj * HALF + 4);
                    const f32x4 v0 = acc[ai][bj][m][0] + b0, v1 = acc[ai][bj][m][1] + b1;
                    u32x4 w; w.x = cvt_pk_bf16(v0[0], v0[1]); w.y = cvt_pk_bf16(v0[2], v0[3]); w.z = cvt_pk_bf16(v1[0], v1[1]); w.w = cvt_pk_bf16(v1[2], v1[3]);
                    *(u32x4*)(C + off + bj * HALF) = w; } }
    }
};
struct EpiSwiglu {
    static constexpr bool PERM = true; static constexpr int MIDT = -1;
    __device__ __forceinline__ void mid(f32x4 (&)[2][2][4][2], const Unit&, int, int) const {}
    static constexpr bool GATHER = true; const int* rowtok;
    unsigned char* act; const float* bgu; const float* rs;
    __device__ __forceinline__ const float* rowtab(const Unit& u) const { return rs + (size_t)u.pm * BM; }
    __device__ __forceinline__ const float* coltab(const Unit& u, int q) const { return bgu + (size_t)u.e * 2048 + u.pn * HALF + (q >> 1) * 1024 + (q & 1) * 64; }
    __device__ __forceinline__ void operator()(const f32x4 (&acc)[2][2][4][2], const Unit& u, int wr, int wc, int fr, int fq, const PG8_LAS float* tab) const {
        const int row0 = u.pm * BM + wr * 64 + fr, col0 = u.pn * HALF + wc * 32 + 8 * fq;
        const PG8_LAS float* ct = tab + 256 + wc * 32 + 8 * fq;
        f32x4 bgv[2], buv[2];
#pragma unroll
        for (int n = 0; n < 2; ++n) { bgv[n] = *(const PG8_LAS f32x4*)(ct + 4 * n); buv[n] = *(const PG8_LAS f32x4*)(ct + 128 + 4 * n); }
#pragma unroll
        for (int ai = 0; ai < 2; ++ai)
#pragma unroll
            for (int m = 0; m < 4; ++m) { const int row = row0 + ai * HALF + m * 16; const float rr = tab[ai * HALF + wr * 64 + m * 16 + fr]; unsigned char* rowp = act + (size_t)row * 1024 + col0;
                float o[8];
#pragma unroll
                for (int n = 0; n < 2; ++n) { typedef float f2 __attribute__((ext_vector_type(2)));
#pragma unroll
                    for (int h = 0; h < 2; ++h) { const f2 ag = {acc[ai][0][m][n][2 * h], acc[ai][0][m][n][2 * h + 1]}, au = {acc[ai][1][m][n][2 * h], acc[ai][1][m][n][2 * h + 1]};
                        const f2 bg2 = {bgv[n][2 * h], bgv[n][2 * h + 1]}, bu2 = {buv[n][2 * h], buv[n][2 * h + 1]};
                        f2 gv = ag * rr + bg2, uv = au * rr + bu2;
                        gv.x = fminf(gv.x, 7.0f); gv.y = fminf(gv.y, 7.0f); uv.x = __builtin_amdgcn_fmed3f(uv.x, -7.0f, 7.0f); uv.y = __builtin_amdgcn_fmed3f(uv.y, -7.0f, 7.0f);
                        const f2 t = gv * (-1.702f * 1.44269504f); f2 e; e.x = __builtin_amdgcn_exp2f(t.x); e.y = __builtin_amdgcn_exp2f(t.y);
                        const f2 d = e + 1.0f; f2 r; r.x = __builtin_amdgcn_rcpf(d.x); r.y = __builtin_amdgcn_rcpf(d.y);
                        const f2 res = ((uv + 1.0f) * gv) * r; o[4 * n + 2 * h] = res.x; o[4 * n + 2 * h + 1] = res.y; } }
                int w0 = 0, w1 = 0; w0 = __builtin_amdgcn_cvt_pk_fp8_f32(o[0], o[1], w0, false); w0 = __builtin_amdgcn_cvt_pk_fp8_f32(o[2], o[3], w0, true); w1 = __builtin_amdgcn_cvt_pk_fp8_f32(o[4], o[5], w1, false); w1 = __builtin_amdgcn_cvt_pk_fp8_f32(o[6], o[7], w1, true);
                typedef int i2v __attribute__((ext_vector_type(2))); *(i2v*)rowp = (i2v){w0, w1}; }
    }
};
struct EpiDown {
    static constexpr bool PERM = true; static constexpr int MIDT = -1;
    __device__ __forceinline__ void mid(f32x4 (&)[2][2][4][2], const Unit&, int, int) const {}
    static constexpr bool GATHER = false; const int* rowtok;
    unsigned char* eo; const float* bdn; const float* row_gate;
    __device__ __forceinline__ const float* rowtab(const Unit& u) const { return row_gate + (size_t)u.pm * BM; }
    __device__ __forceinline__ const float* coltab(const Unit& u, int q) const { return bdn + (size_t)u.e * 1024 + u.pn * BM + q * 64; }
    __device__ __forceinline__ void operator()(const f32x4 (&acc)[2][2][4][2], const Unit& u, int wr, int wc, int fr, int fq, const PG8_LAS float* tab) const {
        const int row0 = u.pm * BM + wr * 64 + fr, col0 = u.pn * BM + wc * 32 + 8 * fq;
        const PG8_LAS float* ct = tab + 256 + wc * 32 + 8 * fq;
        f32x4 bv[2][2];
#pragma unroll
        for (int bj = 0; bj < 2; ++bj)
#pragma unroll
            for (int n = 0; n < 2; ++n) bv[bj][n] = *(const PG8_LAS f32x4*)(ct + bj * HALF + 4 * n);
#pragma unroll
        for (int ai = 0; ai < 2; ++ai)
#pragma unroll
            for (int m = 0; m < 4; ++m) { const int row = row0 + ai * HALF + m * 16; const float gt = tab[ai * HALF + wr * 64 + m * 16 + fr] * 16.0f; unsigned char* rowp = eo + (size_t)row * 1024 + col0;
#pragma unroll
                for (int bj = 0; bj < 2; ++bj) { f32x4 v0 = (acc[ai][bj][m][0] + bv[bj][0]) * gt, v1 = (acc[ai][bj][m][1] + bv[bj][1]) * gt;
#pragma unroll
                    for (int i = 0; i < 4; ++i) { v0[i] = __builtin_amdgcn_fmed3f(v0[i], -448.0f, 448.0f); v1[i] = __builtin_amdgcn_fmed3f(v1[i], -448.0f, 448.0f); }
                    int w0 = 0, w1 = 0; w0 = __builtin_amdgcn_cvt_pk_fp8_f32(v0[0], v0[1], w0, false); w0 = __builtin_amdgcn_cvt_pk_fp8_f32(v0[2], v0[3], w0, true); w1 = __builtin_amdgcn_cvt_pk_fp8_f32(v1[0], v1[1], w1, false); w1 = __builtin_amdgcn_cvt_pk_fp8_f32(v1[2], v1[3], w1, true);
                    typedef int i2v __attribute__((ext_vector_type(2))); *(i2v*)(rowp + bj * HALF) = (i2v){w0, w1}; } }
    }
};

struct NoBetween { static constexpr bool ACTIVE = false; __device__ __forceinline__ void run(PG8_LAS unsigned char*, int) const {} };
typedef int v8i_t __attribute__((ext_vector_type(8)));
typedef int v4i_t __attribute__((ext_vector_type(4)));
template <class Epi, class Sched, class Between = NoBetween>
__device__ __forceinline__ void gemm_phase(PG8_LAS unsigned char* lds, const Gemm g, const Sched& S, const Epi& E, int wid, const Between& B = Between(), int bslot = 0) {
    bool between_done = false, restage = false; (void)between_done; (void)restage;
    const int lane = lane_id(), tid = wid * 64 + lane, wr = wid >> 2, wc = wid & 3, fr = lane & 15, fq = lane >> 4;
    const int K = g.K, nt = K / BK;
    unsigned voffA[2], voffB[2];
#pragma unroll
    for (int i = 0; i < 2; ++i) { int R, C; stage_rc(tid * 16 + i * 8192, R, C); const int Rb = Epi::PERM ? ((R & ~31) + perm32(R & 31)) : R;
        voffA[i] = (unsigned)(R * K + C) * 2u; voffB[i] = (unsigned)(Rb * K + C) * 2u; }
    const size_t kstep = (size_t)(BK * 2);
    const size_t hstep = (size_t)HALF * K * 2;
    const size_t tstep = 2 * hstep;
    const unsigned ldsw = (unsigned)wid * 1024u;
    const int aoff = lds_byte(wr * 64 + fr, fq * 8), boff = lds_byte(wc * 32 + fr, fq * 8);
#define PG8_SA(b, h) (((b) * 2 + (h)) * HTB)
#define PG8_SB(b, h) ((4 + (b) * 2 + (h)) * HTB)
#define PG8_STAGE(bufoff, gbase, voff) do { _Pragma("unroll") for (int _i = 0; _i < 2; ++_i) \
        __builtin_amdgcn_global_load_lds((const unsigned*)((const char*)(gbase) + (voff)[_i]), (PG8_LAS unsigned*)(lds + (bufoff) + ldsw + _i * 8192), 16, 0, 0); } while (0)
#define PG8_LDA(dst, b, h) do { _Pragma("unroll") for (int m = 0; m < 4; ++m) _Pragma("unroll") for (int k = 0; k < 2; ++k) dst[m][k] = *(const PG8_LAS bf16x8*)(lds + PG8_SA(b, h) + aoff + m * 2048 + k * 1024); } while (0)
#define PG8_LDB(dst, b, h) do { _Pragma("unroll") for (int n = 0; n < 2; ++n) _Pragma("unroll") for (int k = 0; k < 2; ++k) dst[n][k] = *(const PG8_LAS bf16x8*)(lds + PG8_SB(b, h) + boff + n * 2048 + k * 1024); } while (0)
#define PG8_MMA(ai, bj, At, Bt) do { __builtin_amdgcn_s_setprio(1); _Pragma("unroll") for (int m = 0; m < 4; ++m) _Pragma("unroll") for (int n = 0; n < 2; ++n) _Pragma("unroll") for (int k = 0; k < 2; ++k) \
        acc[ai][bj][m][n] = __builtin_amdgcn_mfma_f32_16x16x32_bf16(Bt[n][k], At[m][k], acc[ai][bj][m][n], 0, 0, 0); __builtin_amdgcn_s_setprio(0); } while (0)
#define PG8_WAIT_V(n) asm volatile("s_waitcnt vmcnt(" #n ")" ::: "memory")
#define PG8_WAIT_L(n) asm volatile("s_waitcnt lgkmcnt(" #n ")" ::: "memory")
#define PG8_BAR __builtin_amdgcn_s_barrier()
#define PG8_SCHED __builtin_amdgcn_sched_barrier(0)
    Unit cur, nxt; int ui = 0;
    if (!S.next(0, cur)) return;
    f32x4 acc[2][2][4][2];
#pragma unroll
    for (int a = 0; a < 2; ++a)
#pragma unroll
        for (int b = 0; b < 2; ++b)
#pragma unroll
            for (int m = 0; m < 4; ++m)
#pragma unroll
                for (int n = 0; n < 2; ++n) acc[a][b][m][n] = (f32x4){0.f, 0.f, 0.f, 0.f};
    bf16x8 At[4][2], B0[2][2], B1[2][2];
    const char* cA = uni_ptr((const char*)g.A + (size_t)cur.pm * tstep); const char* cB = uni_ptr((const char*)g.Bt + (size_t)cur.pb * tstep);
#define PG8_ROWTAB(u_, slot_) do { if (Epi::HAS_ROWTAB && wid < 4) __builtin_amdgcn_global_load_lds((const unsigned*)(E.rowtab(u_) + wid * 64 + lane), (PG8_LAS unsigned*)(lds + STAGE_BYTES + (slot_) * 1024 + wid * 256), 4, 0, 0); } while (0)
    PG8_ROWTAB(cur, 0);
#define PG8_PROLOGUE do { PG8_STAGE(PG8_SB(0, 0), cB, voffB); PG8_STAGE(PG8_SB(0, 1), cB + hstep, voffB); PG8_STAGE(PG8_SA(0, 0), cA, voffA); PG8_STAGE(PG8_SA(0, 1), cA + hstep, voffA); \
    if (wr == 1) PG8_BAR; \
    PG8_WAIT_V(2); PG8_BAR; \
    PG8_STAGE(PG8_SB(1, 0), cB + kstep, voffB); PG8_STAGE(PG8_SA(1, 0), cA + kstep, voffA); PG8_STAGE(PG8_SB(1, 1), cB + hstep + kstep, voffB); \
    PG8_WAIT_V(6); PG8_BAR; } while (0)
    PG8_PROLOGUE;
    for (;;) {
        const bool has_next = S.next(ui + 1, nxt);
        const char* nA = uni_ptr(has_next ? (const char*)g.A + (size_t)nxt.pm * tstep : cA); const char* nB = uni_ptr(has_next ? (const char*)g.Bt + (size_t)nxt.pb * tstep : cB);
        for (int t = 0; t < nt; t += 2) {
            const bool last = (t == nt - 2);
            const char* a1 = cA + (size_t)(t + 1) * kstep;
            const char* a2 = last ? nA : cA + (size_t)(t + 2) * kstep; const char* b2 = last ? nB : cB + (size_t)(t + 2) * kstep;
            const char* a3 = a2 + kstep; const char* b3 = b2 + kstep;
            if constexpr (Epi::MIDT >= 0) { if (t == Epi::MIDT) E.mid(acc, cur, wr, fr); }
            PG8_LDB(B0, 0, 0); PG8_LDB(B1, 0, 1); PG8_SCHED; PG8_LDA(At, 0, 0); PG8_STAGE(PG8_SA(1, 1), a1 + hstep, voffA);
            PG8_WAIT_V(8); PG8_WAIT_L(0); PG8_BAR; PG8_MMA(0, 0, At, B0); PG8_MMA(0, 1, At, B1); PG8_BAR; PG8_SCHED;
            PG8_LDA(At, 0, 1); PG8_STAGE(PG8_SB(0, 0), b2, voffB); PG8_STAGE(PG8_SB(0, 1), b2 + hstep, voffB); PG8_STAGE(PG8_SA(0, 0), a2, voffA);
            PG8_WAIT_V(8); PG8_WAIT_L(0); PG8_BAR; PG8_MMA(1, 0, At, B0); PG8_MMA(1, 1, At, B1); PG8_BAR; PG8_SCHED;
            PG8_LDB(B0, 1, 0); PG8_LDB(B1, 1, 1); PG8_SCHED; PG8_LDA(At, 1, 0); PG8_STAGE(PG8_SA(0, 1), a2 + hstep, voffA);
            PG8_WAIT_V(8); PG8_WAIT_L(0); PG8_BAR; PG8_MMA(0, 0, At, B0); PG8_MMA(0, 1, At, B1); PG8_BAR; PG8_SCHED;
            PG8_LDA(At, 1, 1); PG8_STAGE(PG8_SB(1, 0), b3, voffB); PG8_STAGE(PG8_SB(1, 1), b3 + hstep, voffB); PG8_STAGE(PG8_SA(1, 0), a3, voffA);
            PG8_WAIT_V(8); PG8_WAIT_L(0); PG8_BAR; PG8_MMA(1, 0, At, B0); PG8_MMA(1, 1, At, B1); PG8_BAR; PG8_SCHED;
        }
        if (wr == 0) PG8_BAR;
        E(acc, cur, wr, wc, fr, fq, (const PG8_LAS float*)(lds + STAGE_BYTES + (ui & 1) * 1024));
        if constexpr (Between::ACTIVE) { if (!between_done && (ui == bslot || !has_next)) {
            between_done = true; restage = has_next;
            PG8_WAIT_V(0); PG8_BAR;
            B.run(lds, wid);
            PG8_WAIT_L(0); PG8_BAR; } }
        if (!has_next) break;
#pragma unroll
        for (int a = 0; a < 2; ++a)
#pragma unroll
            for (int b = 0; b < 2; ++b)
#pragma unroll
                for (int m = 0; m < 4; ++m)
#pragma unroll
                    for (int n = 0; n < 2; ++n) acc[a][b][m][n] = (f32x4){0.f, 0.f, 0.f, 0.f};
        cur = nxt; cA = nA; cB = nB; ++ui;
        PG8_ROWTAB(cur, ui & 1);
        if (Between::ACTIVE && restage) { restage = false; PG8_PROLOGUE; }
        else if (wr == 1) PG8_BAR;
    }
    PG8_WAIT_V(0);
    PG8_BAR;
#undef PG8_ROWTAB
#undef PG8_PROLOGUE
#undef PG8_SA
#undef PG8_SB
#undef PG8_STAGE
#undef PG8_LDA
#undef PG8_LDB
#undef PG8_MMA
#undef PG8_WAIT_V
#undef PG8_WAIT_L
#undef PG8_BAR
#undef PG8_SCHED
}
template <class Epi, class Sched>
__device__ __forceinline__ void gemm_phase_f8(PG8_LAS unsigned char* lds, const Gemm g, const Sched& S, const Epi& E, int wid, int var = 0) {
    const int lane = lane_id(), tid = wid * 64 + lane, wr = wid >> 2, wc = wid & 3, fr = lane & 15, fq = lane >> 4;
    int Kq = g.K; asm volatile("" : "+s"(Kq));
    const int K = Kq, nt = K / BK;
    unsigned voffA[2], voffB[2];
#pragma unroll
    for (int i = 0; i < 2; ++i) { int R, C; stage_rc(tid * 16 + i * 8192, R, C); const int Rb = Epi::PERM ? ((R & ~31) + perm32(R & 31)) : R;
        voffA[i] = (unsigned)(R * K + C) * 2u; voffB[i] = (unsigned)(Rb * K + C) * 2u; }
    const size_t kstep = (size_t)(BK * 2);
    const size_t hstep = (size_t)HALF * K * 2;
    const size_t tstep = 2 * hstep;
    const unsigned ldsw = (unsigned)wid * 1024u;
    const unsigned ldsb = (unsigned)__builtin_amdgcn_readfirstlane((int)((unsigned)(size_t)lds + ldsw));
    const int aoff = lds_byte(wr * 64 + fr, fq * 8), boff = lds_byte(wc * 32 + fr, fq * 8);
#define PG8_SA(b, h) (((b) * 2 + (h)) * HTB)
#define PG8_SB(b, h) ((4 + (b) * 2 + (h)) * HTB)
#define PG8_STAGE(bufoff, gbase, voff) do { _Pragma("unroll") for (int _i = 0; _i < 2; ++_i) { unsigned _keep; \
        asm volatile("s_mov_b32 %0, m0\n\ts_mov_b32 m0, %3\n\ts_nop 0\n\tglobal_load_lds_dwordx4 %1, %2\n\ts_mov_b32 m0, %0" : "=&s"(_keep) : "v"((voff)[_i]), "s"((const char*)(gbase)), "s"(ldsb + (unsigned)((bufoff) + _i * 8192)) : "memory"); } } while (0)
#define PG8_STAGE_A(b, h, ka) do { if constexpr (Epi::GATHER) { _Pragma("unroll") for (int _i = 0; _i < 2; ++_i) { unsigned _keep; const unsigned _vo = (((voffA[_i] >> (16 * (h))) & 0xffffu) << 10) + cbA; \
        asm volatile("s_mov_b32 %0, m0\n\ts_mov_b32 m0, %3\n\ts_nop 0\n\tglobal_load_lds_dwordx4 %1, %2\n\ts_mov_b32 m0, %0" : "=&s"(_keep) : "v"(_vo), "s"((const char*)(ka)), "s"(ldsb + (unsigned)(PG8_SA(b, h) + _i * 8192)) : "memory"); } } \
    else PG8_STAGE(PG8_SA(b, h), (ka) + (h) * hstep, voffA); } while (0)
#define PG8_LDA(dst, b, h) do { _Pragma("unroll") for (int m = 0; m < 4; ++m) { const v4i_t _lo = *(const PG8_LAS v4i_t*)(lds + PG8_SA(b, h) + aoff + m * 2048), _hi = *(const PG8_LAS v4i_t*)(lds + PG8_SA(b, h) + aoff + m * 2048 + 1024); dst[m] = __builtin_shufflevector(_lo, _hi, 0, 1, 2, 3, 4, 5, 6, 7); } } while (0)
#define PG8_LDB(dst, b, h) do { _Pragma("unroll") for (int n = 0; n < 2; ++n) { const v4i_t _lo = *(const PG8_LAS v4i_t*)(lds + PG8_SB(b, h) + boff + n * 2048), _hi = *(const PG8_LAS v4i_t*)(lds + PG8_SB(b, h) + boff + n * 2048 + 1024); dst[n] = __builtin_shufflevector(_lo, _hi, 0, 1, 2, 3, 4, 5, 6, 7); } } while (0)
#define PG8_MMA(ai, bj, At, Bt) do { __builtin_amdgcn_s_setprio(1); _Pragma("unroll") for (int m = 0; m < 4; ++m) _Pragma("unroll") for (int n = 0; n < 2; ++n) \
        acc[ai][bj][m][n] = __builtin_amdgcn_mfma_scale_f32_16x16x128_f8f6f4(Bt[n], At[m], acc[ai][bj][m][n], 0, 0, 0, 0x79797979, 0, 0x7f7f7f7f); __builtin_amdgcn_s_setprio(0); } while (0)
#define PG8_WAIT_V(n) asm volatile("s_waitcnt vmcnt(" #n ")" ::: "memory")
#define PG8_WAIT_L(n) asm volatile("s_waitcnt lgkmcnt(" #n ")" ::: "memory")
#define PG8_BAR __builtin_amdgcn_s_barrier()
#define PG8_SCHED __builtin_amdgcn_sched_barrier(0)
#ifdef PROBE_GEMM
    unsigned long long p_acc = 0;
#endif
    Unit cur, nxt; int ui = 0;
    if (!S.next(0, cur)) return;
    f32x4 acc[2][2][4][2];
#pragma unroll
    for (int a = 0; a < 2; ++a)
#pragma unroll
        for (int b = 0; b < 2; ++b)
#pragma unroll
            for (int m = 0; m < 4; ++m)
#pragma unroll
                for (int n = 0; n < 2; ++n) acc[a][b][m][n] = (f32x4){0.f, 0.f, 0.f, 0.f};
    v8i_t At[4], B0[2], B1[2];
    const char* cA = uni_ptr((const char*)g.A + (Epi::GATHER ? (size_t)0 : (size_t)cur.pm * tstep)); const char* cB = uni_ptr((const char*)g.Bt + (size_t)cur.pb * tstep);
    unsigned cbA = 0;
    if constexpr (Epi::GATHER) { int R, C; stage_rc(tid * 16, R, C); cbA = (unsigned)C * 2u; const int* rt = E.rowtok + (size_t)cur.pm * BM + R;
        const int t00 = rt[0], t01 = rt[64], t10 = rt[128], t11 = rt[192]; voffA[0] = (unsigned)t00 | ((unsigned)t10 << 16); voffA[1] = (unsigned)t01 | ((unsigned)t11 << 16); }
#define PG8_TABS(u_, slot_) do { const char* _src = uni_ptr(wid < 4 ? E.rowtab(u_) + wid * 64 : E.coltab(u_, wid - 4)); unsigned _keep; \
        asm volatile("s_mov_b32 %0, m0\n\ts_mov_b32 m0, %3\n\ts_nop 0\n\tglobal_load_lds_dword %1, %2\n\ts_mov_b32 m0, %0" : "=&s"(_keep) : "v"(lane_id() * 4), "s"(_src), "s"(ldsb - ldsw + (unsigned)(STAGE_BYTES + (slot_) * 2048) + (unsigned)wid * 256u) : "memory"); } while (0)
    PG8_TABS(cur, 0);
    PG8_STAGE(PG8_SB(0, 0), cB, voffB); PG8_STAGE(PG8_SB(0, 1), cB + hstep, voffB); PG8_STAGE_A(0, 0, cA); PG8_STAGE_A(0, 1, cA);
    if (wr == 1) PG8_BAR;
    PG8_WAIT_V(2); PG8_BAR;
    PG8_STAGE(PG8_SB(1, 0), cB + kstep, voffB); PG8_STAGE_A(1, 0, cA + kstep); PG8_STAGE(PG8_SB(1, 1), cB + hstep + kstep, voffB);
    PG8_WAIT_V(6); PG8_BAR;
    for (;;) {
        const bool has_next = S.next(ui + 1, nxt);
        const char* nA = uni_ptr(has_next && !Epi::GATHER ? (const char*)g.A + (size_t)nxt.pm * tstep : cA); const char* nB = uni_ptr(has_next ? (const char*)g.Bt + (size_t)nxt.pb * tstep : cB);
        if constexpr (Epi::GATHER) { if (has_next && wid < 4) { const char* _src = uni_ptr(E.rowtok + (size_t)nxt.pm * BM + wid * 64); unsigned _keep;
            asm volatile("s_mov_b32 %0, m0\n\ts_mov_b32 m0, %3\n\ts_nop 0\n\tglobal_load_lds_dword %1, %2\n\ts_mov_b32 m0, %0" : "=&s"(_keep) : "v"(lane_id() * 4), "s"(_src), "s"(ldsb - ldsw + (unsigned)(STAGE_BYTES + 4096) + (unsigned)wid * 256u) : "memory"); } }
#ifdef PROBE_GEMM
        unsigned long long pt0 = 0; if (var && PROBE_GEMM == 1) pt0 = __builtin_amdgcn_s_memrealtime();
#endif
        for (int t = 0; t < nt; t += 2) {
            const bool last = (t == nt - 2);
            const char* a1 = cA + (size_t)(t + 1) * kstep;
            const char* a2 = last ? nA : cA + (size_t)(t + 2) * kstep; const char* b2 = last ? nB : cB + (size_t)(t + 2) * kstep;
            const char* a3 = a2 + kstep; const char* b3 = b2 + kstep;
            if constexpr (Epi::MIDT >= 0) { if (t == Epi::MIDT) E.mid(acc, cur, wr, fr); }
            PG8_LDB(B0, 0, 0); PG8_LDB(B1, 0, 1); PG8_SCHED; PG8_LDA(At, 0, 0); PG8_STAGE_A(1, 1, a1);
            PG8_WAIT_V(8); PG8_WAIT_L(0); PG8_BAR; PG8_MMA(0, 0, At, B0); PG8_MMA(0, 1, At, B1); PG8_BAR; PG8_SCHED;
            if constexpr (Epi::GATHER) { if (last && has_next) {
                const PG8_LAS int* tk = (const PG8_LAS int*)(lds + STAGE_BYTES + 4096) + (wid >> 1) * 16 + (lane_id() >> 2);
                const int t00 = tk[0], t01 = tk[64], t10 = tk[128], t11 = tk[192]; voffA[0] = (unsigned)t00 | ((unsigned)t10 << 16); voffA[1] = (unsigned)t01 | ((unsigned)t11 << 16); } }
            PG8_LDA(At, 0, 1); PG8_STAGE(PG8_SB(0, 0), b2, voffB); PG8_STAGE(PG8_SB(0, 1), b2 + hstep, voffB); PG8_STAGE_A(0, 0, a2);
            PG8_WAIT_V(8); PG8_WAIT_L(0); PG8_BAR; PG8_MMA(1, 0, At, B0); PG8_MMA(1, 1, At, B1); PG8_BAR; PG8_SCHED;
            PG8_LDB(B0, 1, 0); PG8_LDB(B1, 1, 1); PG8_SCHED; PG8_LDA(At, 1, 0); PG8_STAGE_A(0, 1, a2);
            PG8_WAIT_V(8); PG8_WAIT_L(0); PG8_BAR; PG8_MMA(0, 0, At, B0); PG8_MMA(0, 1, At, B1); PG8_BAR; PG8_SCHED;
            PG8_LDA(At, 1, 1); PG8_STAGE(PG8_SB(1, 0), b3, voffB); PG8_STAGE(PG8_SB(1, 1), b3 + hstep, voffB); PG8_STAGE_A(1, 0, a3);
            PG8_WAIT_V(8); PG8_WAIT_L(0); PG8_BAR; PG8_MMA(1, 0, At, B0); PG8_MMA(1, 1, At, B1); PG8_BAR; PG8_SCHED;
        }
#ifdef PROBE_GEMM
        if (var && PROBE_GEMM == 1) p_acc += __builtin_amdgcn_s_memrealtime() - pt0;
        if (var && PROBE_GEMM == 2) pt0 = __builtin_amdgcn_s_memrealtime();
#endif
        if (wr == 0) PG8_BAR;
        { const int l2 = lane_id(); E(acc, cur, wr, wc, l2 & 15, l2 >> 4, (const PG8_LAS float*)(lds + STAGE_BYTES + (ui & 1) * 2048)); }
#ifdef PROBE_GEMM
        if (var && PROBE_GEMM == 2) p_acc += __builtin_amdgcn_s_memrealtime() - pt0;
        if (var && PROBE_GEMM == 3) p_acc += 1000;
#endif
        if (!has_next) break;
#pragma unroll
        for (int a = 0; a < 2; ++a)
#pragma unroll
            for (int b = 0; b < 2; ++b)
#pragma unroll
                for (int m = 0; m < 4; ++m)
#pragma unroll
                    for (int n = 0; n < 2; ++n) acc[a][b][m][n] = (f32x4){0.f, 0.f, 0.f, 0.f};
        cur = nxt; cA = nA; cB = nB; ++ui;
        PG8_TABS(cur, ui & 1);
        if (wr == 1) PG8_BAR;
    }
    PG8_WAIT_V(0);
    PG8_BAR;
#ifdef PROBE_GEMM
    if (var && blockIdx.x == 0 && wid == 0) probe_spin(p_acc * 16);
#endif
#undef PG8_TABS
#undef PG8_STAGE_A
#undef PG8_SA
#undef PG8_SB
#undef PG8_STAGE
#undef PG8_LDA
#undef PG8_LDB
#undef PG8_MMA
#undef PG8_WAIT_V
#undef PG8_WAIT_L
#undef PG8_BAR
#undef PG8_SCHED
}
}

constexpr int BATCH = 16, SEQ = 2048, T = BATCH * SEQ, D = 1024;
constexpr int NPROJ = 6656;
constexpr int C_Z = 0, C_XBC = 1024, C_Q = 2560, C_K = 3584, C_V = 4608, C_O = 5632;
constexpr int WIN_LD = 6688;
constexpr int NE = 32, TOPK = 4;
constexpr int NASSIGN = T * TOPK, MAXBLK = NASSIGN / 256 + NE, MAXROWS = MAXBLK * 256;
constexpr float RMS_EPS = 1e-6f;
constexpr int NWAVES = 8, NTHR = 512;

constexpr size_t MiB = 1u << 20;
constexpr size_t WS_CTL = 0, CTL_ZERO_BYTES = 1 * MiB;
constexpr size_t WS_WIN = 1 * MiB, WS_WOUT = 14 * MiB, WS_WGU = 18 * MiB, WS_WDN = 146 * MiB;
constexpr size_t WS_XN = 210 * MiB, WS_H = 274 * MiB, WS_GATES = 402 * MiB, WS_ROUTE = 406 * MiB, WS_PROJ = 412 * MiB, WS_MIX = 828 * MiB, WS_END = 956 * MiB;
constexpr size_t WS_XBC = WS_H;
constexpr size_t WS_SSQ = WS_ROUTE + 3 * MiB;
constexpr size_t WS_XG = WS_PROJ, WS_ACT = WS_PROJ + 272 * MiB;
static_assert((size_t)MAXROWS * 1024 * 2 == 272 * MiB && WS_ACT + 272 * MiB == WS_END, "overlay map");
constexpr size_t R_TOPI = 0, R_TOPG = 512 * 1024, R_TOKROW = 1024 * 1024, R_ROWTOK = 1536 * 1024, R_ROWGATE = 2176 * 1024, R_BLKCNT = 2816 * 1024, R_BLKEXP = 2880 * 1024, R_NBLK = 2944 * 1024;
constexpr int CW_BAR = 4096;

constexpr int WL_LD = 36;
constexpr int WL_BYTES = 1024 * WL_LD * 4;
constexpr int MISC_OFF = 150528, LDS_BYTES = MISC_OFF + 1024;

#define GAS __attribute__((address_space(1)))
#define LAS __attribute__((address_space(3)))
typedef unsigned short bf16;
typedef unsigned v4u __attribute__((ext_vector_type(4)));
typedef unsigned v2u __attribute__((ext_vector_type(2)));
typedef float f32x4 __attribute__((ext_vector_type(4)));
#define LDS_WAIT() asm volatile("s_waitcnt lgkmcnt(0)" ::: "memory")
__device__ __forceinline__ unsigned f2bf(float f) { return (unsigned)__builtin_bit_cast(unsigned short, (__bf16)f); }
typedef __bf16 bf2_t __attribute__((ext_vector_type(2)));
__device__ __forceinline__ unsigned pk2(float lo, float hi) { const bf2_t v = {(__bf16)lo, (__bf16)hi}; return __builtin_bit_cast(unsigned, v); }
__device__ __forceinline__ float bf2f(unsigned short b) { return __builtin_bit_cast(float, (unsigned)b << 16); }
__device__ __forceinline__ float bflo(unsigned w) { return __builtin_bit_cast(float, w << 16); }
__device__ __forceinline__ float bfhi(unsigned w) { return __builtin_bit_cast(float, w & 0xffff0000u); }
__device__ __forceinline__ float wave_sum(float v) {
#pragma unroll
    for (int o = 1; o < 64; o <<= 1) v += __shfl_xor(v, o);
    return v;
}
__device__ __forceinline__ float silu_f(float x) { return x * __builtin_amdgcn_rcpf(1.0f + __expf(-x)); }
__device__ __forceinline__ float sigmoid_f(float x) { return __builtin_amdgcn_rcpf(1.0f + __expf(-x)); }
__device__ __forceinline__ float rsqrt_f(float x) { return __builtin_amdgcn_rsqf(x); }
__device__ __forceinline__ float softplus_f(float x) { return x > 20.0f ? x : log1pf(__expf(x)); }


#define XB_TMO      128
#define XB_XCNT(j)  (256  + 64 * (j))
#define XB_XSUB(j)  (1280 + 64 * (j))
#define XB_XGEN(j)  (2304 + 64 * (j))
#define XB_TOP      3328
#define XB_TOPGEN   3392
#define XCD_BAR_WORDS 3456
#define XB_SPIN_CAP (1u << 18)
__device__ __forceinline__ unsigned xb_ld(unsigned* p)              { return __hip_atomic_load(p, __ATOMIC_RELAXED, __HIP_MEMORY_SCOPE_AGENT); }
__device__ __forceinline__ unsigned xb_add(unsigned* p, unsigned v) { return __hip_atomic_fetch_add(p, v, __ATOMIC_RELAXED, __HIP_MEMORY_SCOPE_AGENT); }
__device__ __forceinline__ unsigned xb_xcc_id() { return (unsigned)__builtin_amdgcn_s_getreg((3 << 11) | 20) & 0xFu; }
#define XB_SPIN(cond, bar) do { unsigned _sp = 0; while (cond) { __builtin_amdgcn_s_sleep(1); \
    if ((++_sp & 255u) == 0u) { if (xb_ld(&(bar)[XB_TMO])) break; if (_sp > XB_SPIN_CAP) { atomicAdd(&(bar)[XB_TMO], 1u); break; } } } } while (0)
struct XcdBarrier { unsigned* bar; unsigned x; volatile LAS unsigned* st; };
__device__ __forceinline__ XcdBarrier xcd_barrier_post(unsigned* bar, volatile LAS unsigned* st, bool t0  ) {
    XcdBarrier b; b.bar = bar; b.x = xb_xcc_id(); b.st = st;
    if (t0) (void)xb_add(&bar[XB_XCNT(b.x)], 1u);
    return b;
}
__device__ __forceinline__ void xcd_barrier_complete(unsigned* bar, unsigned x, unsigned& nloc, unsigned& nx) {
    const unsigned G = gridDim.x * gridDim.y * gridDim.z;
    unsigned sum, cnt, mine, sp = 0u;
    for (;;) {
        sum = 0u; cnt = 0u; mine = 0u;
#pragma unroll
        for (unsigned j = 0; j < 16; ++j) { const unsigned c = xb_ld(&bar[XB_XCNT(j)]); sum += c; cnt += (c > 0u) ? 1u : 0u; mine = (j == x) ? c : mine; }
        if (sum == G) break;
        __builtin_amdgcn_s_sleep(1);
        if ((++sp & 255u) == 0u) { if (xb_ld(&bar[XB_TMO])) break; if (sp > XB_SPIN_CAP) { atomicAdd(&bar[XB_TMO], 1u); break; } }
    }
    nloc = mine > 0u ? mine : 1u; nx = cnt > 0u ? cnt : 1u;
}
__device__ __forceinline__ void xcd_barrier(const XcdBarrier& b, bool t0  ) {
    asm volatile("s_waitcnt vmcnt(0)" ::: "memory");
    __syncthreads();
    if (t0) {
        unsigned* bar = b.bar;
        __builtin_amdgcn_s_waitcnt(0);
        unsigned nloc = b.st[0], nx = b.st[1];
        if (nloc == 0u) { xcd_barrier_complete(bar, b.x, nloc, nx); b.st[0] = nloc; b.st[1] = nx; }
        const unsigned old = xb_add(&bar[XB_XSUB(b.x)], 1u);
        const unsigned gen = old / nloc;
        if (old + 1u == (gen + 1u) * nloc) {
            __builtin_amdgcn_fence(__ATOMIC_RELEASE, "agent");
            asm volatile("s_waitcnt vmcnt(0)" ::: "memory");
            const unsigned og = xb_add(&bar[XB_TOP], 1u);
            const unsigned tg = og / nx;
            if (og + 1u == (tg + 1u) * nx) xb_add(&bar[XB_TOPGEN], 1u);
            else XB_SPIN(xb_ld(&bar[XB_TOPGEN]) == tg, bar);
            __builtin_amdgcn_fence(__ATOMIC_ACQUIRE, "agent");
            xb_add(&bar[XB_XGEN(b.x)], 1u);
            asm volatile("s_waitcnt vmcnt(0)" ::: "memory");
        } else {
            XB_SPIN(xb_ld(&bar[XB_XGEN(b.x)]) == gen, bar);
            __builtin_amdgcn_fence(__ATOMIC_ACQUIRE, "agent");
            asm volatile("s_waitcnt vmcnt(0)" ::: "memory");
        }
    }
    __syncthreads();
}

__device__ __forceinline__ int fresh_tid(int wave) { int t = wave * 64 + lane_id(); asm volatile("" : "+v"(t)); return t; }
struct Args { const float* in[21]; float* out; unsigned char* ws; int ph_lo, ph_hi, variant, pad; };

__device__ __forceinline__ void transpose_item(const float* W, int ld_src, int n0s, int k0, bf16* WT, int K, int n0d, float cscale, const float* kscale, LAS float* scr, int lane) {
#pragma unroll
    for (int i = 0; i < 32; ++i) { const int kk = 2 * i + (lane >> 5); float v = W[(size_t)(k0 + kk) * ld_src + n0s + (lane & 31)] * cscale; if (kscale) v *= kscale[k0 + kk]; scr[kk * 33 + (lane & 31)] = v; }
    LDS_WAIT(); asm volatile("" ::: "memory");
    const int c = lane & 7;
#pragma unroll
    for (int j = 0; j < 4; ++j) { const int n = (lane >> 3) + 8 * j; const LAS float* s = scr + (8 * c) * 33 + n;
        v4u o; o.x = pk2(s[0 * 33], s[1 * 33]); o.y = pk2(s[2 * 33], s[3 * 33]); o.z = pk2(s[4 * 33], s[5 * 33]); o.w = pk2(s[6 * 33], s[7 * 33]);
        *(v4u*)(WT + (size_t)(n0d + n) * K + k0 + 8 * c) = o; }
    LDS_WAIT(); asm volatile("" ::: "memory");
}

__device__ __forceinline__ int pk4_fp8(float a, float b, float c, float d) { int w = 0; w = __builtin_amdgcn_cvt_pk_fp8_f32(a, b, w, false); w = __builtin_amdgcn_cvt_pk_fp8_f32(c, d, w, true); return w; }
__device__ __forceinline__ void transpose_item_f8(const float* W, int ld_src, int n0s, int k0, unsigned char* WT, int K, int n0d, float cscale, const float* kscale, LAS float* scr, int lane) {
#pragma unroll
    for (int i = 0; i < 32; ++i) { const int kk = 2 * i + (lane >> 5); float v = W[(size_t)(k0 + kk) * ld_src + n0s + (lane & 31)] * cscale; if (kscale) v *= kscale[k0 + kk]; scr[kk * 33 + (lane & 31)] = v; }
    LDS_WAIT(); asm volatile("" ::: "memory");
    const int c = lane & 3;
#pragma unroll
    for (int j = 0; j < 2; ++j) { const int n = (lane >> 2) + 16 * j; const LAS float* s = scr + (16 * c) * 33 + n;
        v4u o; o.x = (unsigned)pk4_fp8(s[0 * 33], s[1 * 33], s[2 * 33], s[3 * 33]); o.y = (unsigned)pk4_fp8(s[4 * 33], s[5 * 33], s[6 * 33], s[7 * 33]);
        o.z = (unsigned)pk4_fp8(s[8 * 33], s[9 * 33], s[10 * 33], s[11 * 33]); o.w = (unsigned)pk4_fp8(s[12 * 33], s[13 * 33], s[14 * 33], s[15 * 33]);
        *(v4u*)(WT + (size_t)(n0d + n) * K + k0 + 16 * c) = o; }
    LDS_WAIT(); asm volatile("" ::: "memory");
}

__device__ __forceinline__ void transpose_item_f8_128(const float* __restrict__ W, int ld_src, int n0s, int k0, unsigned char* __restrict__ WT, int K, int n0d, float cscale, LAS float* scr, int lane) {
#pragma unroll 1
    for (int i0 = 0; i0 < 64; i0 += 32) { float v[32];
#pragma unroll
        for (int i = 0; i < 32; ++i) v[i] = W[(size_t)(k0 + 2 * (i0 + i) + (lane >> 5)) * ld_src + n0s + (lane & 31)];
#pragma unroll
        for (int i = 0; i < 32; ++i) scr[(2 * (i0 + i) + (lane >> 5)) * 33 + (lane & 31)] = v[i] * cscale; }
    LDS_WAIT(); asm volatile("" ::: "memory");
    const int c = lane & 7;
#pragma unroll
    for (int j = 0; j < 4; ++j) { const int n = (lane >> 3) + 8 * j; const LAS float* s = scr + (16 * c) * 33 + n;
        v4u o; o.x = (unsigned)pk4_fp8(s[0 * 33], s[1 * 33], s[2 * 33], s[3 * 33]); o.y = (unsigned)pk4_fp8(s[4 * 33], s[5 * 33], s[6 * 33], s[7 * 33]);
        o.z = (unsigned)pk4_fp8(s[8 * 33], s[9 * 33], s[10 * 33], s[11 * 33]); o.w = (unsigned)pk4_fp8(s[12 * 33], s[13 * 33], s[14 * 33], s[15 * 33]);
        *(v4u*)(WT + (size_t)(n0d + n) * K + k0 + 16 * c) = o; }
    LDS_WAIT(); asm volatile("" ::: "memory");
}

struct MoeConv {
    static constexpr bool ACTIVE = true;
    const float* wgu; const float* wdn; unsigned char* gu8; unsigned char* dn8; int gw, ngw;
    struct Item { const float* src; unsigned char* dst; int ld; int pad; };
    __device__ __forceinline__ Item decode(int r) const {
        constexpr int I_GU = 8 * 64, I_DN = 8 * 32;
        if (r < NE * I_GU) { const int e = r / I_GU, q = r % I_GU, nb = q % 64, kb = q / 64, rho = nb * 32; const int n0s = ((rho >> 7) & 1) * 1024 + (rho >> 8) * 128 + (rho & 127);
            return Item{wgu + (size_t)e * 1024 * 2048 + (size_t)(kb * 128) * 2048 + n0s, gu8 + (size_t)e * 2048 * 1024 + (size_t)rho * 1024 + kb * 128, 2048, 0}; }
        r -= NE * I_GU; const int e = r / I_DN, q = r % I_DN, nb = q % 32, kb = q / 32;
        return Item{wdn + (size_t)e * 1024 * 1024 + (size_t)(kb * 128) * 1024 + nb * 32, dn8 + (size_t)e * 1024 * 1024 + (size_t)(nb * 32) * 1024 + kb * 128, 1024, 0}; }
    __device__ __forceinline__ void run(LAS unsigned char* lds, int wave) const {
        const int lane = lane_id(); LAS float* scr = (LAS float*)(lds + wave * 17408);
        constexpr int NMOE = NE * (8 * 64 + 8 * 32);
        const int lr = lane >> 3, lq = (lane & 7) * 4;
        if (gw >= NMOE) return;
        f32x4 v[16]; Item cur = decode(gw);
#pragma unroll
        for (int i = 0; i < 16; ++i) v[i] = *(const f32x4*)(cur.src + (size_t)(8 * i + lr) * cur.ld + lq);
#pragma unroll 1
        for (int r = gw; r < NMOE; r += ngw) {
            f32x4 nv[16]; Item nx = cur;
            if (r + ngw < NMOE) { nx = decode(r + ngw);
#pragma unroll
                for (int i = 0; i < 16; ++i) nv[i] = *(const f32x4*)(nx.src + (size_t)(8 * i + lr) * nx.ld + lq); }
            else {
#pragma unroll
                for (int i = 0; i < 16; ++i) nv[i] = v[i]; }
#pragma unroll
            for (int i = 0; i < 16; ++i)
#pragma unroll
                for (int e = 0; e < 4; ++e) scr[(8 * i + lr) * 33 + lq + e] = v[i][e] * 64.0f;
            LDS_WAIT(); asm volatile("" ::: "memory");
            { const int c = lane & 7;
#pragma unroll
              for (int j = 0; j < 4; ++j) { const int n = (lane >> 3) + 8 * j; const LAS float* sp = scr + (16 * c) * 33 + n;
                v4u o; o.x = (unsigned)pk4_fp8(sp[0 * 33], sp[1 * 33], sp[2 * 33], sp[3 * 33]); o.y = (unsigned)pk4_fp8(sp[4 * 33], sp[5 * 33], sp[6 * 33], sp[7 * 33]);
                o.z = (unsigned)pk4_fp8(sp[8 * 33], sp[9 * 33], sp[10 * 33], sp[11 * 33]); o.w = (unsigned)pk4_fp8(sp[12 * 33], sp[13 * 33], sp[14 * 33], sp[15 * 33]);
                *(v4u*)(cur.dst + (size_t)n * 1024 + 16 * c) = o; } }
            LDS_WAIT(); asm volatile("" ::: "memory");
#pragma unroll
            for (int i = 0; i < 16; ++i) v[i] = nv[i];
            cur = nx;
        }
    }
};

constexpr int PT_LD = 2064, PT_HALF = 32 * PT_LD;
typedef short s8v_t __attribute__((ext_vector_type(8)));
constexpr int PT_WN = 2 * PT_HALF;
__device__ __forceinline__ void pt_fill(LAS unsigned char* tab, const float* W, int ldw, int tid, bool gate_cols, const float* wn) {
    ((LAS float*)(tab + PT_WN))[tid] = wn[tid]; ((LAS float*)(tab + PT_WN))[512 + tid] = wn[512 + tid];
    const int c = tid & 31; const int sc = gate_cols ? (c < 16 ? 2560 + c : (c < 24 ? 6672 + (c - 16) : 6680 + (c - 24))) : c;
#pragma unroll 1
    for (int j0 = 0; j0 < 64; j0 += 32) { float v[32];
#pragma unroll
        for (int j = 0; j < 32; ++j) v[j] = W[(size_t)((tid >> 5) + 16 * (j0 + j)) * ldw + sc];
#pragma unroll
        for (int j = 0; j < 32; ++j) { const int k = (tid >> 5) + 16 * (j0 + j); const unsigned h = f2bf(v[j]); const float hf = __builtin_bit_cast(float, h << 16);
            *(LAS unsigned short*)(tab + c * PT_LD + k * 2) = (unsigned short)h; *(LAS unsigned short*)(tab + PT_HALF + c * PT_LD + k * 2) = (unsigned short)f2bf(v[j] - hf); } }
}
template <bool IN_BF16, bool OUT_F8>
__device__ __forceinline__ float rowproj16(const void* __restrict__ srcv, void* __restrict__ dstv, const float* __restrict__ wn, const LAS unsigned char* tab, int row0, int lane, f32x4 (&acc)[2]) {
    const int g = lane >> 4, c16 = lane & 15;
    acc[0] = (f32x4){0.f, 0.f, 0.f, 0.f}; acc[1] = acc[0]; float ss = 0.f;
    const LAS unsigned char* tb = tab + c16 * PT_LD + g * 16;
    v4u ra[4], rb[4];
#define RP_LOAD(dstA, dstB, s_) do { if constexpr (IN_BF16) { dstA = *(const v4u*)((const bf16*)srcv + (size_t)(row0 + c16) * 1024 + 32 * (s_) + 8 * g); } \
        else { const float* p_ = (const float*)srcv + (size_t)(row0 + c16) * 1024 + 32 * (s_) + 8 * g; dstA = *(const v4u*)p_; dstB = *(const v4u*)(p_ + 4); } } while (0)
#pragma unroll
    for (int i = 0; i < 4; ++i) RP_LOAD(ra[i], rb[i], i);
#pragma unroll 1
    for (int s0 = 0; s0 < 32; s0 += 4) {
        v4u na[4], nb[4];
#pragma unroll
        for (int i = 0; i < 4; ++i) { na[i] = ra[i]; nb[i] = rb[i]; }
        if (s0 + 4 < 32) {
#pragma unroll
            for (int i = 0; i < 4; ++i) RP_LOAD(na[i], nb[i], s0 + 4 + i);
        }
        f32x4 gw0[4], gw1[4];
#pragma unroll
        for (int i = 0; i < 4; ++i) { gw0[i] = *(const LAS f32x4*)(tab + PT_WN + (32 * (s0 + i) + 8 * g) * 4); gw1[i] = *(const LAS f32x4*)(tab + PT_WN + (32 * (s0 + i) + 8 * g) * 4 + 16); }
#pragma unroll
        for (int i = 0; i < 4; ++i) { const int s = s0 + i;
        f32x4 a, b;
        if constexpr (IN_BF16) { const v4u w = ra[i]; a = (f32x4){bflo(w.x), bfhi(w.x), bflo(w.y), bfhi(w.y)}; b = (f32x4){bflo(w.z), bfhi(w.z), bflo(w.w), bfhi(w.w)}; }
        else { a = __builtin_bit_cast(f32x4, ra[i]); b = __builtin_bit_cast(f32x4, rb[i]); }
        ss += (a[0] * a[0] + a[1] * a[1]) + (a[2] * a[2] + a[3] * a[3]) + (b[0] * b[0] + b[1] * b[1]) + (b[2] * b[2] + b[3] * b[3]);
        a = a * gw0[i]; b = b * gw1[i];
        v4u hw; hw.x = pk2(a[0], a[1]); hw.y = pk2(a[2], a[3]); hw.z = pk2(b[0], b[1]); hw.w = pk2(b[2], b[3]);
        v4u lw; lw.x = pk2(a[0] - bflo(hw.x), a[1] - bfhi(hw.x)); lw.y = pk2(a[2] - bflo(hw.y), a[3] - bfhi(hw.y)); lw.z = pk2(b[0] - bflo(hw.z), b[1] - bfhi(hw.z)); lw.w = pk2(b[2] - bflo(hw.w), b[3] - bfhi(hw.w));
        if constexpr (OUT_F8) { v2u o; o.x = (unsigned)pk4_fp8(a[0], a[1], a[2], a[3]); o.y = (unsigned)pk4_fp8(b[0], b[1], b[2], b[3]); *(v2u*)((unsigned char*)dstv + (size_t)(row0 + c16) * 1024 + 32 * s + 8 * g) = o; }
        else *(v4u*)((bf16*)dstv + (size_t)(row0 + c16) * 1024 + 32 * s + 8 * g) = hw;
        const s8v_t xh = __builtin_bit_cast(s8v_t, hw), xl = __builtin_bit_cast(s8v_t, lw);
#pragma unroll
        for (int nt = 0; nt < 2; ++nt) { const s8v_t wh = *(const LAS s8v_t*)(tb + nt * 16 * PT_LD + s * 64), wl = *(const LAS s8v_t*)(tb + PT_HALF + nt * 16 * PT_LD + s * 64);
            acc[nt] = __builtin_amdgcn_mfma_f32_16x16x32_bf16(xh, wh, acc[nt], 0, 0, 0); acc[nt] = __builtin_amdgcn_mfma_f32_16x16x32_bf16(xl, wh, acc[nt], 0, 0, 0); acc[nt] = __builtin_amdgcn_mfma_f32_16x16x32_bf16(xh, wl, acc[nt], 0, 0, 0); }
        }
#pragma unroll
        for (int i = 0; i < 4; ++i) { ra[i] = na[i]; rb[i] = nb[i]; }
    }
#undef RP_LOAD
    ss += __shfl_xor(ss, 16); ss += __shfl_xor(ss, 32);
    return 1.0f / sqrtf(ss * (1.0f / 1024.0f) + RMS_EPS);
}

namespace mx {
typedef short s8v __attribute__((ext_vector_type(8)));
typedef short s4v __attribute__((ext_vector_type(4)));
#define MX_MFMA(a, b, c) __builtin_amdgcn_mfma_f32_16x16x32_bf16(a, b, c, 0, 0, 0)
#define MX_SB() __builtin_amdgcn_sched_barrier(0)
#define MX_BAR() do { MX_SB(); asm volatile("s_waitcnt lgkmcnt(0)" ::: "memory"); __builtin_amdgcn_s_barrier(); asm volatile("" ::: "memory"); } while (0)
constexpr int TS = 288, TILE = 64 * TS, PS = 144, PTILE = 64 * PS, BUF = 3 * TILE;
struct LaneBase { unsigned row, perm, tr, prow; };
__device__ __forceinline__ LaneBase lane_base(int lane) { LaneBase L; const unsigned g = lane >> 4, i = lane & 15, q = i >> 2, p = lane & 3;
    L.row = i * TS + g * 16; L.perm = i * TS + g * 8; L.tr = (8 * g + q) * TS + p * 8; L.prow = i * PS + g * 16; return L; }
#define LD_ROW(t, L, rb, s) (*(const LAS mx::s8v*)((t) + (L).row + (rb) * 16 * mx::TS + (s) * 64))
#define LD_ROWP(t, L, rb, s) (*(const LAS mx::s8v*)((t) + (L).prow + (rb) * 16 * mx::PS + (s) * 64))
__device__ __forceinline__ s8v ld_perm2(const LAS unsigned char* p) { const s4v lo = *(const LAS s4v*)p, hi = *(const LAS s4v*)(p + 32); return (s8v){lo[0], lo[1], lo[2], lo[3], hi[0], hi[1], hi[2], hi[3]}; }
#define LD_PERM(t, L, rb, s) mx::ld_perm2((t) + (L).perm + (rb) * 16 * mx::TS + (s) * 64)
__device__ __forceinline__ s8v ld_tr2(const LAS unsigned char* p) {
    const s4v a = __builtin_amdgcn_ds_read_tr16_b64_v4i16((LAS s4v*)p), b = __builtin_amdgcn_ds_read_tr16_b64_v4i16((LAS s4v*)(p + 4 * TS));
    return (s8v){a[0], a[1], a[2], a[3], b[0], b[1], b[2], b[3]}; }
#define LD_TR(t, L, c, ks) mx::ld_tr2((t) + (L).tr + (ks) * 32 * mx::TS + (c) * 32)
__device__ __forceinline__ void dma_tiles(LAS unsigned char* buf, const bf16* g0, int gstride, int co0, int co1, int co2, int wave, int lane) {
#pragma unroll
    for (int pp = 0; pp < 7; ++pp) { const int piece = wave + 8 * pp; if (piece < 54) { const unsigned o = piece * 1024 + lane * 16, tl = o / TILE, ot = o - tl * TILE, row = ot / TS, wb = ot - row * TS;
        const int co = tl == 0 ? co0 : (tl == 1 ? co1 : co2);
        __builtin_amdgcn_global_load_lds((const unsigned*)(g0 + (size_t)row * gstride + co + (wb < 256 ? wb >> 1 : 0)), (LAS unsigned*)(buf + piece * 1024), 16, 0, 0); } }
}
#define MX_DPPF(old, src, ctrl, rm) __builtin_bit_cast(float, __builtin_amdgcn_update_dpp(__builtin_bit_cast(int, (float)(old)), __builtin_bit_cast(int, (float)(src)), ctrl, rm, 0xf, false))
__device__ __forceinline__ float scan_add(float x) {
    x += MX_DPPF(0.f, x, 0x111, 0xf); x += MX_DPPF(0.f, x, 0x112, 0xf); x += MX_DPPF(0.f, x, 0x114, 0xf); x += MX_DPPF(0.f, x, 0x118, 0xf);
    x += MX_DPPF(0.f, x, 0x142, 0xa); x += MX_DPPF(0.f, x, 0x143, 0xc); return x; }
__device__ __forceinline__ float scan_max(float x) { const float ninf = -INFINITY;
    x = fmaxf(x, MX_DPPF(ninf, x, 0x111, 0xf)); x = fmaxf(x, MX_DPPF(ninf, x, 0x112, 0xf)); x = fmaxf(x, MX_DPPF(ninf, x, 0x114, 0xf)); x = fmaxf(x, MX_DPPF(ninf, x, 0x118, 0xf));
    x = fmaxf(x, MX_DPPF(ninf, x, 0x142, 0xa)); x = fmaxf(x, MX_DPPF(ninf, x, 0x143, 0xc)); return x; }
__device__ __forceinline__ float lane63(float x) { return __builtin_bit_cast(float, __builtin_amdgcn_readlane(__builtin_bit_cast(int, x), 63)); }
__device__ __forceinline__ float softplus_fast(float x) { const float e = __expf(-fabsf(x)); return fmaxf(x, 0.f) + (e < 1e-6f ? e : __logf(1.0f + e)); }
__device__ __forceinline__ s8v pack_acc(const f32x4& a, const f32x4& b) {
    const unsigned w0 = pk2(a[0], a[1]), w1 = pk2(a[2], a[3]), w2 = pk2(b[0], b[1]), w3 = pk2(b[2], b[3]);
    v4u w = {w0, w1, w2, w3}; return __builtin_bit_cast(s8v, w);
}
__device__ __forceinline__ void unpack8(const v4u& w, float (&f)[8]) { f[0] = bflo(w.x); f[1] = bfhi(w.x); f[2] = bflo(w.y); f[3] = bfhi(w.y); f[4] = bflo(w.z); f[5] = bfhi(w.z); f[6] = bflo(w.w); f[7] = bfhi(w.w); }

__device__ __forceinline__ void mlstm_item(LAS unsigned char* lds, int item, int var, int wave, const bf16* __restrict__ PROJ, const float* __restrict__ GATES, const float* __restrict__ lnw, bf16* __restrict__ MIX) {
    const int lane = lane_id(), tid = wave * 64 + lane, g = lane >> 4, c16 = lane & 15;
    const int b = item >> 3, h = item & 7;
    const LaneBase L = lane_base(lane);
    LAS unsigned char* TP = lds + 2 * BUF; LAS unsigned char* TO = TP + PTILE;
    LAS float* denP = (LAS float*)(TO + TILE); LAS float* qnp = denP + 128; LAS float* nsh = qnp + 512;
    LAS float* Au = nsh + 128; LAS float* Avv = Au + 64; LAS float* Awi = Avv + 64; LAS float* Akw = Awi + 64; LAS float* Aid = Akw + 64;
    f32x4 Cst[8];
#pragma unroll
    for (int i = 0; i < 8; ++i) Cst[i] = (f32x4){0.f, 0.f, 0.f, 0.f};
    float nreg = 0.f, m_prev = 0.f;
    if (lane < 16) nsh[wave * 16 + lane] = 0.f;
    const int srow = tid >> 3, sch = tid & 7;
    const bf16* qbase = PROJ + (size_t)(b * SEQ) * NPROJ + h * 128;
    dma_tiles(lds, qbase, NPROJ, C_Q, C_K, C_V, wave, lane);
    float fnext = GATES[(size_t)(b * SEQ + lane) * 32 + 24 + h], inext = GATES[(size_t)(b * SEQ + lane) * 32 + 16 + h];
    asm volatile("s_waitcnt vmcnt(0)" ::: "memory"); MX_BAR();
#pragma unroll 1
    for (int c = 0; c < SEQ / 64; ++c) {
        const int cur = c & 1; const int t0 = b * SEQ + c * 64;
        LAS unsigned char* TQ = lds + cur * BUF; LAS unsigned char* TK = TQ + TILE; LAS unsigned char* TV = TQ + 2 * TILE;
        float fraw = fnext, iraw = inext; asm volatile("" : "+v"(fraw), "+v"(iraw));
        MX_SB();
        const v4u ov0 = *(const v4u*)(PROJ + (size_t)(t0 + srow) * NPROJ + C_O + h * 128 + 8 * sch), ov1 = *(const v4u*)(PROJ + (size_t)(t0 + srow) * NPROJ + C_O + h * 128 + 64 + 8 * sch);
        { const int tn = (c + 1 < SEQ / 64 ? t0 + 64 : t0) + lane; fnext = GATES[(size_t)tn * 32 + 24 + h]; inext = GATES[(size_t)tn * 32 + 16 + h]; }
        const float lf = -softplus_fast(-fraw), cf = scan_add(lf), chunk_f = lane63(cf);
        const float u = iraw - cf, Mx = scan_max(u);
        const float m_row = cf + fmaxf(m_prev, Mx), vv = cf - m_row;
        const float m_loc = chunk_f + lane63(Mx), m_new = fmaxf(chunk_f + m_prev, m_loc);
        const float w_inter = __expf(vv + m_prev), floorv = __expf(-m_row), kw = __expf(chunk_f + u - m_new), s_old = __expf(chunk_f + m_prev - m_new);
        Au[lane] = u; Avv[lane] = vv; Awi[lane] = w_inter; Akw[lane] = kw;
        if (!(var & 2)) { const int lt = wave & 3, jt0 = 2 * (wave >> 2); const float vv_l = Avv[16 * lt + c16]; float rsum = 0.f;
#pragma unroll
          for (int jj = 0; jj < 2; ++jj) { const int jt = jt0 + jj; float pv[4] = {0.f, 0.f, 0.f, 0.f};
            if (jt <= lt) { f32x4 acc = {0.f, 0.f, 0.f, 0.f};
#pragma unroll
                for (int ks = 0; ks < 4; ++ks) acc = MX_MFMA(LD_ROW(TK, L, jt, ks), LD_ROW(TQ, L, lt, ks), acc);
                const f32x4 uj = *(const LAS f32x4*)(Au + 16 * jt + 4 * g);
#pragma unroll
                for (int r = 0; r < 4; ++r) { const int j = 16 * jt + 4 * g + r, l = 16 * lt + c16; const float val = (j <= l) ? acc[r] * __expf(vv_l + uj[r]) : 0.f; rsum += val; pv[r] = val; } }
            v2u w; w.x = pk2(pv[0], pv[1]); w.y = pk2(pv[2], pv[3]);
            *(LAS v2u*)(TP + (16 * lt + c16) * PS + (16 * jt + 4 * g) * 2) = w; }
          rsum += __shfl_xor(rsum, 16); rsum += __shfl_xor(rsum, 32);
          if (g == 0) denP[(wave >> 2) * 64 + 16 * lt + c16] = rsum;
          v4u q0 = *(const LAS v4u*)(TQ + lane * TS + wave * 32), q1 = *(const LAS v4u*)(TQ + lane * TS + wave * 32 + 16); float qf[16]; { float t8[8]; unpack8(q0, t8);
#pragma unroll
            for (int e = 0; e < 8; ++e) qf[e] = t8[e]; unpack8(q1, t8);
#pragma unroll
            for (int e = 0; e < 8; ++e) qf[8 + e] = t8[e]; }
          float part = 0.f;
#pragma unroll
          for (int e4 = 0; e4 < 4; ++e4) { const f32x4 nv = *(const LAS f32x4*)(nsh + wave * 16 + 4 * e4); part += qf[4 * e4] * nv[0] + qf[4 * e4 + 1] * nv[1] + qf[4 * e4 + 2] * nv[2] + qf[4 * e4 + 3] * nv[3]; }
          qnp[wave * 64 + lane] = part; }
        if (c + 1 < SEQ / 64 && !(var & 1)) { int lv = lane; asm volatile("" : "+v"(lv)); dma_tiles(lds + (cur ^ 1) * BUF, qbase + (size_t)(c + 1) * 64 * NPROJ, NPROJ, C_Q, C_K, C_V, wave, lv); }
        MX_SB();
        f32x4 acc[4];
        { s8v sf[4];
#pragma unroll
          for (int ks = 0; ks < 4; ++ks) sf[ks] = pack_acc(Cst[2 * ks], Cst[2 * ks + 1]);
#pragma unroll
          for (int lt = 0; lt < 4; ++lt) acc[lt] = (f32x4){0.f, 0.f, 0.f, 0.f};
          if (!(var & 4)) {
#pragma unroll
            for (int ks = 0; ks < 4; ++ks)
#pragma unroll
                for (int lt = 0; lt < 4; ++lt) acc[lt] = MX_MFMA(sf[ks], LD_PERM(TQ, L, lt, ks), acc[lt]);
#pragma unroll
            for (int lt = 0; lt < 4; ++lt) acc[lt] = acc[lt] * Awi[16 * lt + c16]; } }
        const s8v vf0 = LD_TR(TV + wave * 32, L, 0, 0), vf1 = LD_TR(TV + wave * 32, L, 0, 1);
        {
#pragma unroll
          for (int i = 0; i < 8; ++i) Cst[i] = Cst[i] * s_old;
          if (!(var & 8))
#pragma unroll
          for (int ks = 0; ks < 2; ++ks) { const s8v vf = ks ? vf1 : vf0; const v4u vw = __builtin_bit_cast(v4u, vf); float f[8]; unpack8(vw, f);
            { const f32x4 k0 = *(const LAS f32x4*)(Akw + 32 * ks + 8 * g), k1 = *(const LAS f32x4*)(Akw + 32 * ks + 8 * g + 4);
#pragma unroll
              for (int e = 0; e < 4; ++e) { f[e] *= k0[e]; f[4 + e] *= k1[e]; } }
            v4u pw = {pk2(f[0], f[1]), pk2(f[2], f[3]), pk2(f[4], f[5]), pk2(f[6], f[7])}; const s8v vwf = __builtin_bit_cast(s8v, pw);
#pragma unroll
            for (int dkt = 0; dkt < 8; ++dkt) Cst[dkt] = MX_MFMA(LD_TR(TK, L, dkt, ks), vwf, Cst[dkt]); }
          float part = 0.f;
#pragma unroll
          for (int e4 = 0; e4 < 4; ++e4) { const f32x4 kk = *(const LAS f32x4*)(Akw + 16 * g + 4 * e4);
#pragma unroll
            for (int e = 0; e < 4; ++e) { const int j = 16 * g + 4 * e4 + e; part += bf2f(*(const LAS unsigned short*)(TK + j * TS + (16 * wave + c16) * 2)) * kk[e]; } }
          part += __shfl_xor(part, 16); part += __shfl_xor(part, 32);
          nreg = s_old * nreg + part; if (g == 0) nsh[wave * 16 + c16] = nreg;
        }
        MX_BAR();
        float inv_den; { float qn = 0.f;
#pragma unroll
          for (int w = 0; w < 8; ++w) qn += qnp[w * 64 + lane];
          float den = denP[lane] + denP[64 + lane] + w_inter * qn; den = fmaxf(fabsf(den), floorv); inv_den = __builtin_amdgcn_rcpf(den); Aid[lane] = inv_den; }
        { if (!(var & 4))
#pragma unroll
          for (int lt = 0; lt < 4; ++lt) { f32x4 a4 = MX_MFMA(vf0, LD_ROWP(TP, L, lt, 0), acc[lt]);
            if (lt >= 2) a4 = MX_MFMA(vf1, LD_ROWP(TP, L, lt, 1), a4);
            a4 = a4 * Aid[16 * lt + c16];
            v2u w; w.x = pk2(a4[0], a4[1]); w.y = pk2(a4[2], a4[3]);
            *(LAS v2u*)(TO + (16 * lt + c16) * TS + (16 * wave + 4 * g) * 2) = w; }
          m_prev = m_new; }
        asm volatile("s_waitcnt vmcnt(0)" ::: "memory"); MX_BAR();
        if (!(var & 16)) { const v4u a = *(const LAS v4u*)(TO + srow * TS + sch * 16), bq = *(const LAS v4u*)(TO + srow * TS + sch * 16 + 128); float f[16], of[16]; { float t8[8]; unpack8(a, t8);
#pragma unroll
            for (int e = 0; e < 8; ++e) f[e] = t8[e]; unpack8(bq, t8);
#pragma unroll
            for (int e = 0; e < 8; ++e) f[8 + e] = t8[e]; unpack8(ov0, t8);
#pragma unroll
            for (int e = 0; e < 8; ++e) of[e] = t8[e]; unpack8(ov1, t8);
#pragma unroll
            for (int e = 0; e < 8; ++e) of[8 + e] = t8[e]; }
          float ss = 0.f;
#pragma unroll
          for (int e = 0; e < 16; ++e) ss += f[e] * f[e];
          ss += __shfl_xor(ss, 1); ss += __shfl_xor(ss, 2); ss += __shfl_xor(ss, 4);
          const float rs = rsqrt_f(ss * (1.0f / 128.0f) + RMS_EPS);
          float wn[16]; { const f32x4 w0 = *(const f32x4*)(lnw + h * 128 + 8 * sch), w1 = *(const f32x4*)(lnw + h * 128 + 8 * sch + 4), w2 = *(const f32x4*)(lnw + h * 128 + 64 + 8 * sch), w3 = *(const f32x4*)(lnw + h * 128 + 64 + 8 * sch + 4);
#pragma unroll
            for (int e = 0; e < 4; ++e) { wn[e] = w0[e]; wn[4 + e] = w1[e]; wn[8 + e] = w2[e]; wn[12 + e] = w3[e]; } }
#pragma unroll
          for (int e = 0; e < 16; ++e) f[e] = f[e] * rs * wn[e] * sigmoid_f(of[e]);
          v4u o0 = {pk2(f[0], f[1]), pk2(f[2], f[3]), pk2(f[4], f[5]), pk2(f[6], f[7])}, o1 = {pk2(f[8], f[9]), pk2(f[10], f[11]), pk2(f[12], f[13]), pk2(f[14], f[15])};
          bf16* mp = MIX + (size_t)(t0 + srow) * 2048 + 1024 + h * 128 + 8 * sch; *(v4u*)mp = o0; *(v4u*)(mp + 64) = o1; }
    }
    MX_BAR();
}

__device__ __forceinline__ void ssd_item(LAS unsigned char* lds, int item, int var, int wave, const bf16* __restrict__ XBC, const bf16* __restrict__ PROJ, const float* __restrict__ GATES, const float* __restrict__ a_log,
                                         const float* __restrict__ d_skip, bf16* __restrict__ MIX, float* __restrict__ SSQ) {
    const int lane = lane_id(), tid = wave * 64 + lane, g = lane >> 4, c16 = lane & 15;
    const int b = item >> 3, hp = item & 7, grp = hp >> 2, hh = wave >> 2, ps = wave & 3;
    const LaneBase L = lane_base(lane);
    LAS unsigned char* TG = lds + 2 * BUF;
    LAS unsigned char* TO = TG + 2 * PTILE;
    LAS float* Aacs = (LAS float*)(TO + TILE); LAS float* Adinv = Aacs + 128; LAS float* Adt = Adinv + 128; LAS float* Awd = Adt + 128; LAS float* Aea = Awd + 128;
    f32x4 RT[8];
#pragma unroll
    for (int i = 0; i < 8; ++i) RT[i] = (f32x4){0.f, 0.f, 0.f, 0.f};
    const float an0 = -__expf(a_log[2 * hp]), an1 = -__expf(a_log[2 * hp + 1]), dk0 = d_skip[2 * hp], dk1 = d_skip[2 * hp + 1];
    const int srow = tid >> 3, sch = tid & 7;
    const bf16* xb = XBC + (size_t)(b * SEQ) * 1536;
    dma_tiles(lds, xb, 1536, 1280 + grp * 128, 1024 + grp * 128, hp * 128, wave, lane);
    float dn0 = GATES[(size_t)(b * SEQ + lane) * 32 + 2 * hp], dn1 = GATES[(size_t)(b * SEQ + lane) * 32 + 2 * hp + 1];
    asm volatile("s_waitcnt vmcnt(0)" ::: "memory"); MX_BAR();
#pragma unroll 1
    for (int c = 0; c < SEQ / 64; ++c) {
        const int cur = c & 1; const int t0 = b * SEQ + c * 64;
        LAS unsigned char* TC = lds + cur * BUF; LAS unsigned char* TB = TC + TILE; LAS unsigned char* TX = TC + 2 * TILE;
        float dr0 = dn0, dr1 = dn1; asm volatile("" : "+v"(dr0), "+v"(dr1));
        MX_SB();
        const v4u zv0 = *(const v4u*)(PROJ + (size_t)(t0 + srow) * NPROJ + C_Z + hp * 128 + 8 * sch), zv1 = *(const v4u*)(PROJ + (size_t)(t0 + srow) * NPROJ + C_Z + hp * 128 + 64 + 8 * sch);
        { const int tn = (c + 1 < SEQ / 64 ? t0 + 64 : t0) + lane; dn0 = GATES[(size_t)tn * 32 + 2 * hp]; dn1 = GATES[(size_t)tn * 32 + 2 * hp + 1]; }
        const float dt0 = softplus_fast(dr0), dt1 = softplus_fast(dr1);
        const float acs0 = scan_add(dt0 * an0), acs1 = scan_add(dt1 * an1);
        const float aend0 = lane63(acs0), aend1 = lane63(acs1);
        Aacs[lane] = acs0; Aacs[64 + lane] = acs1; Adinv[lane] = dk0 * __builtin_amdgcn_rcpf(dt0); Adinv[64 + lane] = dk1 * __builtin_amdgcn_rcpf(dt1); Adt[lane] = dt0; Adt[64 + lane] = dt1;
        Awd[lane] = __expf(aend0 - acs0); Awd[64 + lane] = __expf(aend1 - acs1); Aea[lane] = __expf(acs0); Aea[64 + lane] = __expf(acs1);
        const float aend = hh ? aend1 : aend0;
        if (!(var & 2)) { const int lt = wave & 3, st0 = 2 * (wave >> 2); const int l = 16 * lt + c16;
          const float al0 = Aacs[l], al1 = Aacs[64 + l], di0 = Adinv[l], di1 = Adinv[64 + l];
#pragma unroll
          for (int ss = 0; ss < 2; ++ss) { const int st = st0 + ss; float p0[4] = {0.f, 0.f, 0.f, 0.f}, p1[4] = {0.f, 0.f, 0.f, 0.f};
            if (st <= lt) { f32x4 acc = {0.f, 0.f, 0.f, 0.f};
#pragma unroll
                for (int ks = 0; ks < 4; ++ks) acc = MX_MFMA(LD_ROW(TB, L, st, ks), LD_ROW(TC, L, lt, ks), acc);
                const f32x4 as0 = *(const LAS f32x4*)(Aacs + 16 * st + 4 * g), as1 = *(const LAS f32x4*)(Aacs + 64 + 16 * st + 4 * g);
#pragma unroll
                for (int r = 0; r < 4; ++r) { const int sidx = 16 * st + 4 * g + r;
                    float v0 = (sidx <= l) ? acc[r] * __expf(al0 - as0[r]) : 0.f, v1 = (sidx <= l) ? acc[r] * __expf(al1 - as1[r]) : 0.f;
                    if (sidx == l) { v0 += di0; v1 += di1; } p0[r] = v0; p1[r] = v1; } }
            v2u w0, w1; w0.x = pk2(p0[0], p0[1]); w0.y = pk2(p0[2], p0[3]); w1.x = pk2(p1[0], p1[1]); w1.y = pk2(p1[2], p1[3]);
            const unsigned o = l * PS + (16 * st + 4 * g) * 2;
            *(LAS v2u*)(TG + o) = w0; *(LAS v2u*)(TG + PTILE + o) = w1; } }
        if (c + 1 < SEQ / 64 && !(var & 1)) { int lv = lane; asm volatile("" : "+v"(lv)); dma_tiles(lds + (cur ^ 1) * BUF, xb + (size_t)(c + 1) * 64 * 1536, 1536, 1280 + grp * 128, 1024 + grp * 128, hp * 128, wave, lv); }
        MX_SB();
        f32x4 acc[4];
        { s8v sf[4];
#pragma unroll
          for (int ks = 0; ks < 4; ++ks) sf[ks] = pack_acc(RT[2 * ks], RT[2 * ks + 1]);
#pragma unroll
          for (int lt = 0; lt < 4; ++lt) acc[lt] = (f32x4){0.f, 0.f, 0.f, 0.f};
          if (!(var & 4)) {
#pragma unroll
            for (int ks = 0; ks < 4; ++ks)
#pragma unroll
                for (int lt = 0; lt < 4; ++lt) acc[lt] = MX_MFMA(sf[ks], LD_PERM(TC, L, lt, ks), acc[lt]);
#pragma unroll
            for (int lt = 0; lt < 4; ++lt) acc[lt] = acc[lt] * Aea[64 * hh + 16 * lt + c16]; } }
          s8v xd[2], xw[2];
#pragma unroll
          for (int ks = 0; ks < 2; ++ks) { const s8v xf = LD_TR(TX + (4 * hh + ps) * 32, L, 0, ks); const v4u xv = __builtin_bit_cast(v4u, xf); float f[8], fw[8]; unpack8(xv, f);
            { const LAS float* pd = Adt + 64 * hh + 32 * ks + 8 * g; const LAS float* pw = Awd + 64 * hh + 32 * ks + 8 * g; const f32x4 d0 = *(const LAS f32x4*)pd, d1 = *(const LAS f32x4*)(pd + 4), w0 = *(const LAS f32x4*)pw, w1 = *(const LAS f32x4*)(pw + 4);
#pragma unroll
              for (int e = 0; e < 4; ++e) { f[e] *= d0[e]; fw[e] = f[e] * w0[e]; f[4 + e] *= d1[e]; fw[4 + e] = f[4 + e] * w1[e]; } }
            v4u a = {pk2(f[0], f[1]), pk2(f[2], f[3]), pk2(f[4], f[5]), pk2(f[6], f[7])}, bw = {pk2(fw[0], fw[1]), pk2(fw[2], fw[3]), pk2(fw[4], fw[5]), pk2(fw[6], fw[7])};
            xd[ks] = __builtin_bit_cast(s8v, a); xw[ks] = __builtin_bit_cast(s8v, bw); }
        {
          const float ea = __expf(aend);
#pragma unroll
          for (int i = 0; i < 8; ++i) RT[i] = RT[i] * ea;
          if (!(var & 8))
#pragma unroll
          for (int ks = 0; ks < 2; ++ks)
#pragma unroll
            for (int nt = 0; nt < 8; ++nt) RT[nt] = MX_MFMA(LD_TR(TB, L, nt, ks), xw[ks], RT[nt]);
        }
        MX_BAR();
        {
          const LAS unsigned char* TGm = TG + hh * PTILE;
          if (!(var & 4))
#pragma unroll
          for (int lt = 0; lt < 4; ++lt) { f32x4 a4 = MX_MFMA(xd[0], LD_ROWP(TGm, L, lt, 0), acc[lt]);
            if (lt >= 2) a4 = MX_MFMA(xd[1], LD_ROWP(TGm, L, lt, 1), a4);
            v2u w; w.x = pk2(a4[0], a4[1]); w.y = pk2(a4[2], a4[3]);
            *(LAS v2u*)(TO + (16 * lt + c16) * TS + (64 * hh + 16 * ps + 4 * g) * 2) = w; }
        }
        asm volatile("s_waitcnt vmcnt(0)" ::: "memory"); MX_BAR();
        if (!(var & 16)) { const v4u a = *(const LAS v4u*)(TO + srow * TS + sch * 16), bq = *(const LAS v4u*)(TO + srow * TS + sch * 16 + 128); float f[16], zf[16]; { float t8[8]; unpack8(a, t8);
#pragma unroll
            for (int e = 0; e < 8; ++e) f[e] = t8[e]; unpack8(bq, t8);
#pragma unroll
            for (int e = 0; e < 8; ++e) f[8 + e] = t8[e]; unpack8(zv0, t8);
#pragma unroll
            for (int e = 0; e < 8; ++e) zf[e] = t8[e]; unpack8(zv1, t8);
#pragma unroll
            for (int e = 0; e < 8; ++e) zf[8 + e] = t8[e]; }
          float ss = 0.f;
#pragma unroll
          for (int e = 0; e < 16; ++e) { f[e] = f[e] * silu_f(zf[e]); ss += f[e] * f[e]; }
          ss += __shfl_xor(ss, 1); ss += __shfl_xor(ss, 2); ss += __shfl_xor(ss, 4);
          if (sch == 0) SSQ[(size_t)(t0 + srow) * 8 + hp] = ss;
          v4u o0 = {pk2(f[0], f[1]), pk2(f[2], f[3]), pk2(f[4], f[5]), pk2(f[6], f[7])}, o1 = {pk2(f[8], f[9]), pk2(f[10], f[11]), pk2(f[12], f[13]), pk2(f[14], f[15])};
          bf16* mp = MIX + (size_t)(t0 + srow) * 2048 + hp * 128 + 8 * sch; *(v4u*)mp = o0; *(v4u*)(mp + 64) = o1; }
    }
    MX_BAR();
}
}

__global__ void __launch_bounds__(NTHR, 2) mega(Args args) {
    extern __shared__ __attribute__((aligned(16))) unsigned char lds_raw[];
    LAS unsigned char* lds = (LAS unsigned char*)lds_raw;
    const int wave = __builtin_amdgcn_readfirstlane((int)threadIdx.x >> 6);
    const int lane = lane_id(), tid = wave * 64 + lane;
    const int G = gridDim.x, bx = blockIdx.x;
    unsigned char* ws = args.ws;
#define INP(k) ({ int _k = (k); asm volatile("" : "+s"(_k)); args.in[_k]; })
#define XIN INP(0)
#define Win_t ((bf16*)(ws + WS_WIN))
#define Wout_t ((bf16*)(ws + WS_WOUT))
#define XN ((bf16*)(ws + WS_XN))
#define H ((bf16*)(ws + WS_H))
#define GATES ((float*)(ws + WS_GATES))
#define PROJ ((bf16*)(ws + WS_PROJ))
#define MIX ((bf16*)(ws + WS_MIX))
#define EO8 (ws + WS_XG + 136 * MiB)
#define TOPI ((int*)(ws + WS_ROUTE + R_TOPI))
#define TOPG ((float*)(ws + WS_ROUTE + R_TOPG))
#define TOKROW ((int*)(ws + WS_ROUTE + R_TOKROW))
#define ROWTOK ((int*)(ws + WS_ROUTE + R_ROWTOK))
#define ROWGATE ((float*)(ws + WS_ROUTE + R_ROWGATE))
#define BLKCNT ((int*)(ws + WS_ROUTE + R_BLKCNT))
#define BLKEXP ((int*)(ws + WS_ROUTE + R_BLKEXP))
#define NBLK ((int*)(ws + WS_ROUTE + R_NBLK))
#define XBC ((bf16*)(ws + WS_XBC))
#define SSQ ((float*)(ws + WS_SSQ))
#define RS1 ((float*)(ws + WS_SSQ + 1 * MiB))
#define RS2 ((float*)(ws + WS_SSQ + 1 * MiB + 128 * 1024))
#define ROWRS ((float*)(ws + WS_SSQ + 1 * MiB + 256 * 1024))
#define XN8 (ws + WS_XN)
#define XG8 (ws + WS_XG)
#define ACT8 (ws + WS_ACT)
#define Wgu8 (ws + WS_WGU)
#define Wdn8 (ws + WS_WDN)
    const int lo = args.ph_lo, hi = args.ph_hi;
    if (tid < 64) ((LAS unsigned*)(lds + MISC_OFF))[tid] = 0u;
    __syncthreads();
    XcdBarrier bar = xcd_barrier_post((unsigned*)(ws + WS_CTL) + CW_BAR, (volatile LAS unsigned*)(lds + MISC_OFF), tid == 0);
#define GRID_BAR(k) do { if (IN(k) && IN((k) + 1)) xcd_barrier(bar, wave == 0 && lane_id() == 0); } while (0)
#ifndef PH_MASK
#define PH_MASK 0xffff
#endif
#define IN(k) (((PH_MASK >> (k)) & 1) && lo <= (k) && (k) < hi)


    if (IN(0)) {
        const int tid = fresh_tid(wave), lane = tid & 63; (void)lane;
        LAS float* scr = (LAS float*)(lds + wave * 17408);
        const int gw = bx * NWAVES + wave, NGW = G * NWAVES;
        constexpr int I_IN = 16 * (NPROJ / 32), I_OUT = 32 * 32, I_GU = 8 * 64, I_DN = 8 * 32;
        constexpr int NITEMS = I_IN + I_OUT + NE * I_GU + NE * I_DN;
        if (!(args.variant & 32))
        for (int it = gw; it < I_IN + I_OUT; it += NGW) {
            int r = it;
            if (r < I_IN) { const int nb = r % (NPROJ / 32), kb = r / (NPROJ / 32), n0 = nb * 32; const int n0s = n0 + (n0 >= C_Q ? 16 : 0);
                const float cs = (n0 >= C_K && n0 < C_V) ? 0.08838834764831845f : 1.0f;
                transpose_item(INP(2), WIN_LD, n0s, kb * 64, Win_t, 1024, n0, cs, nullptr, scr, lane); continue; } r -= I_IN;
            if (r < I_OUT) { const int nb = r % 32, kb = r / 32; transpose_item(INP(12), 1024, nb * 32, kb * 64, Wout_t, 2048, nb * 32, 1.0f, kb < 16 ? INP(8) : nullptr, scr, lane); continue; } r -= I_OUT;
            if (r < NE * I_GU) { const int e = r / I_GU, q = r % I_GU, nb = q % 64, kb = q / 64, rho = nb * 32; const int n0s = ((rho >> 7) & 1) * 1024 + (rho >> 8) * 128 + (rho & 127);
                transpose_item_f8_128(INP(16) + (size_t)e * 1024 * 2048, 2048, n0s, kb * 128, Wgu8 + (size_t)e * 2048 * 1024, 1024, rho, 64.0f, scr, lane); continue; } r -= NE * I_GU;
            { const int e = r / I_DN, q = r % I_DN, nb = q % 32, kb = q / 32;
                transpose_item_f8_128(INP(18) + (size_t)e * 1024 * 1024, 1024, nb * 32, kb * 128, Wdn8 + (size_t)e * 1024 * 1024, 1024, nb * 32, 64.0f, scr, lane); }
        }
        __syncthreads();
        pt_fill(lds, INP(2), WIN_LD, tid, true, INP(1));
        __syncthreads();
        { const int c16 = lane & 15, g = lane >> 4;
          const float* wnp = INP(1); const float* bi_ = INP(9); const float* bf_ = INP(10); const float gb0 = INP(5)[c16], gb1 = *(c16 < 8 ? bi_ + c16 : bf_ + (c16 - 8));
          if (!(args.variant & 64))
#pragma unroll 1
          for (int task = gw; task < T / 16; task += NGW) { const int row0 = task * 16; f32x4 acc[2];
            const float rs = rowproj16<false, false>(XIN, XN, wnp, lds, row0, lane, acc);
            if (g == 0) RS1[row0 + c16] = rs;
#pragma unroll
            for (int r = 0; r < 4; ++r) { const float rr = __shfl(rs, 4 * g + r); float* gp = GATES + (size_t)(row0 + 4 * g + r) * 32; gp[c16] = rr * acc[0][r] + gb0; gp[16 + c16] = rr * acc[1][r] + gb1; } } }
        __syncthreads();
    }
    GRID_BAR(0);

    if (IN(1)) {
        pg8::Gemm g{XN, Win_t, T, NPROJ, 1024}; pg8::StaticOrder S; S.init(T, NPROJ, G, bx);
        pg8::EpiBf16 E{PROJ, NPROJ, RS1};
        MoeConv conv{INP(16), INP(18), Wgu8, Wdn8, bx * NWAVES + wave, G * NWAVES};
        pg8::gemm_phase<pg8::EpiBf16, pg8::StaticOrder, MoeConv>(lds, g, S, E, wave, conv, ((bx % 8) * 3) >> 1);
    }
    GRID_BAR(1);

    if (IN(2)) {
        const int tid = fresh_tid(wave), lane = tid & 63; (void)lane;
        const float* cw = INP(3); const float* cb = INP(4);
#pragma unroll 1
        for (int it = bx * NTHR + tid; it < (T / 16) * 192; it += G * NTHR) {
            const int ch = it % 192, t0 = (it / 192) * 16, c0 = ch * 8;
            float w[4][8], bs[8], r0[8], r1[8], r2[8];
#pragma unroll
            for (int k = 0; k < 4; ++k) { const f32x4 a = *(const f32x4*)(cw + k * 1536 + c0), b2 = *(const f32x4*)(cw + k * 1536 + c0 + 4);
#pragma unroll
                for (int e = 0; e < 4; ++e) { w[k][e] = a[e]; w[k][4 + e] = b2[e]; } }
            { const f32x4 a = *(const f32x4*)(cb + c0), b2 = *(const f32x4*)(cb + c0 + 4);
#pragma unroll
              for (int e = 0; e < 4; ++e) { bs[e] = a[e]; bs[4 + e] = b2[e]; } }
            const bf16* src = PROJ + (size_t)t0 * NPROJ + C_XBC + c0;
            if ((t0 & (SEQ - 1)) == 0) {
#pragma unroll
                for (int e = 0; e < 8; ++e) { r0[e] = 0.f; r1[e] = 0.f; r2[e] = 0.f; }
            } else { mx::unpack8(*(const v4u*)(src - 3 * (size_t)NPROJ), r0); mx::unpack8(*(const v4u*)(src - 2 * (size_t)NPROJ), r1); mx::unpack8(*(const v4u*)(src - (size_t)NPROJ), r2); }
            v4u raw[16];
#pragma unroll
            for (int i = 0; i < 16; ++i) raw[i] = *(const v4u*)(src + (size_t)i * NPROJ);
#pragma unroll
            for (int i = 0; i < 16; ++i) { float cu[8], o[8]; mx::unpack8(raw[i], cu);
#pragma unroll
                for (int e = 0; e < 8; ++e) { o[e] = silu_f(bs[e] + w[0][e] * r0[e] + w[1][e] * r1[e] + w[2][e] * r2[e] + w[3][e] * cu[e]); r0[e] = r1[e]; r1[e] = r2[e]; r2[e] = cu[e]; }
                v4u ov = {pk2(o[0], o[1]), pk2(o[2], o[3]), pk2(o[4], o[5]), pk2(o[6], o[7])};
                *(v4u*)(XBC + (size_t)(t0 + i) * 1536 + c0) = ov; }
        }
    }
    GRID_BAR(2);

    if (IN(3)) {
#pragma unroll 1
        for (int it = bx; it < 256; it += G) if ((it >> 3) & 1) mx::mlstm_item(lds, ((it >> 4) << 3) | (it & 7), args.variant, wave, PROJ, GATES, INP(11), MIX);
#pragma unroll 1
        for (int it = bx; it < 256; it += G) if (!((it >> 3) & 1)) mx::ssd_item(lds, ((it >> 4) << 3) | (it & 7), args.variant, wave, XBC, PROJ, GATES, INP(6), INP(7), MIX, SSQ);
    }
    GRID_BAR(3);
    if (IN(4)) {
        pg8::Gemm g{MIX, Wout_t, T, 1024, 2048}; pg8::StaticOrder S; S.init(T, 1024, G, bx);
        pg8::EpiResF32 E{XIN, H, 1024, SSQ};
        pg8::gemm_phase<pg8::EpiResF32, pg8::StaticOrder>(lds, g, S, E, wave);
    }

    GRID_BAR(4);
    if (IN(5)) {
        const int tid = fresh_tid(wave), lane = tid & 63; (void)lane;
        LAS int* hist = (LAS int*)(lds + MISC_OFF + 256);
        pt_fill(lds, INP(14), 32, tid, false, INP(13));
        if (tid < 32) hist[tid] = 0;
        __syncthreads();
        const int c16 = lane & 15, g = lane >> 4; const float* wnp = INP(13); const float rb0 = INP(15)[c16], rb1 = INP(15)[16 + c16];
        for (int blk = bx; blk < T / 128; blk += G) {
            const int row0 = blk * 128 + wave * 16; f32x4 acc[2];
            const float rs = rowproj16<true, true>(H, XN8, wnp, lds, row0, lane, acc);
            if (g == 0) RS2[row0 + c16] = rs;
#pragma unroll
            for (int r = 0; r < 4; ++r) { const float rr = __shfl(rs, 4 * g + r); float v0 = rr * acc[0][r] + rb0, v1 = rr * acc[1][r] + rb1; float tv[4]; int ti[4];
#pragma unroll
                for (int k = 0; k < 4; ++k) { float bv = v0 >= v1 ? v0 : v1; int bi = v0 >= v1 ? c16 : c16 + 16;
#define TK_STEP(ctrl) do { const float ov = __builtin_bit_cast(float, __builtin_amdgcn_update_dpp(0, __builtin_bit_cast(int, bv), ctrl, 0xf, 0xf, false)); const int oi = __builtin_amdgcn_update_dpp(0, bi, ctrl, 0xf, 0xf, false); \
                        if (ov > bv || (ov == bv && oi < bi)) { bv = ov; bi = oi; } } while (0)
                    TK_STEP(0xB1); TK_STEP(0x4E); TK_STEP(0x141); TK_STEP(0x140);
#undef TK_STEP
                    tv[k] = bv; ti[k] = bi; if (bi == c16) v0 = -INFINITY; if (bi == c16 + 16) v1 = -INFINITY; }
                const float e1 = __expf(tv[1] - tv[0]), e2 = __expf(tv[2] - tv[0]), e3 = __expf(tv[3] - tv[0]); const float inv = 1.0f / (1.0f + e1 + e2 + e3);
                if (c16 == 0) { const size_t o = (size_t)(row0 + 4 * g + r) * 4; TOPI[o] = ti[0]; TOPI[o + 1] = ti[1]; TOPI[o + 2] = ti[2]; TOPI[o + 3] = ti[3];
                    TOPG[o] = inv; TOPG[o + 1] = e1 * inv; TOPG[o + 2] = e2 * inv; TOPG[o + 3] = e3 * inv;
                    __hip_atomic_fetch_add(hist + ti[0], 1, __ATOMIC_RELAXED, __HIP_MEMORY_SCOPE_WORKGROUP); __hip_atomic_fetch_add(hist + ti[1], 1, __ATOMIC_RELAXED, __HIP_MEMORY_SCOPE_WORKGROUP); __hip_atomic_fetch_add(hist + ti[2], 1, __ATOMIC_RELAXED, __HIP_MEMORY_SCOPE_WORKGROUP); __hip_atomic_fetch_add(hist + ti[3], 1, __ATOMIC_RELAXED, __HIP_MEMORY_SCOPE_WORKGROUP); } }
            __syncthreads();
            if (tid < 32) { BLKCNT[blk * 32 + tid] = hist[tid]; hist[tid] = 0; }
            __syncthreads();
        }
    }
    GRID_BAR(5);
    if (IN(6)) {
        const int tid = fresh_tid(wave), lane = tid & 63; (void)lane;
        LAS int* tot = (LAS int*)lds; LAS int* base = tot + 32; LAS int* pstart = base + 32; LAS int* wcnt = pstart + 33;
        LAS int* arow = wcnt + 256;
        LAS int* psum = arow + 512;
        for (int blk = bx; blk < T / 128; blk += G) {
            { const int e = tid & 31, part = tid >> 5; int v[16], t = 0, b = 0;
#pragma unroll
              for (int j = 0; j < 16; ++j) v[j] = BLKCNT[(part * 16 + j) * 32 + e];
#pragma unroll
              for (int j = 0; j < 16; ++j) { t += v[j]; if (part * 16 + j < blk) b += v[j]; }
              psum[part * 32 + e] = t; psum[512 + part * 32 + e] = b; }
            __syncthreads();
            if (tid < 32) { int t = 0, b = 0;
#pragma unroll
              for (int p = 0; p < 16; ++p) { t += psum[p * 32 + tid]; b += psum[512 + p * 32 + tid]; } tot[tid] = t; base[tid] = b; }
            __syncthreads();
            if (tid == 0) { int s = 0; for (int e = 0; e < 32; ++e) { pstart[e] = s; s += (tot[e] + 255) / 256 * 256; } pstart[32] = s; }
            __syncthreads();
            const int token = blk * 128 + (tid >> 2), k = tid & 3; const int e = TOPI[(size_t)token * 4 + k];
            int rank = 0;
#pragma unroll 1
            for (int ee = 0; ee < 32; ++ee) { const unsigned long long m = __ballot(e == ee); if (e == ee) rank = __popcll(m & ((1ull << lane) - 1ull)); if (lane == 0) wcnt[wave * 32 + ee] = __popcll(m); }
            __syncthreads();
            int off = 0; for (int w = 0; w < wave; ++w) off += wcnt[w * 32 + e];
            const int row = pstart[e] + base[e] + off + rank;
            ROWTOK[row] = token; ROWGATE[row] = TOPG[(size_t)token * 4 + k]; ROWRS[row] = RS2[token]; TOKROW[(size_t)token * 4 + k] = row; arow[tid] = row;
            __syncthreads();
            if (blk < 32) { const int ps = pstart[blk] + tot[blk], pe = pstart[blk + 1];
                for (int r = ps + tid; r < pe; r += NTHR) { ROWTOK[r] = 0; ROWGATE[r] = 0.f; ROWRS[r] = 0.f; } }
            if (blk == 0) { const int nb = pstart[32] / 256; if (tid == 0) NBLK[0] = nb;
                for (int b = tid; b < nb; b += NTHR) { int e2 = 0; while (e2 < 31 && b * 256 >= pstart[e2 + 1]) ++e2; BLKEXP[b] = e2; } }
            __syncthreads();
        }
    }

    GRID_BAR(6);
    if (IN(7)) {
        pg8::Gemm g{(const bf16*)XN8, (const bf16*)Wgu8, MAXROWS, 2048, 512}; pg8::MoeOrder S{BLKEXP, __builtin_amdgcn_readfirstlane(NBLK[0]), 8, G, bx};
        pg8::EpiSwiglu E{ROWTOK, ACT8, INP(17), ROWRS};
        pg8::gemm_phase_f8<pg8::EpiSwiglu, pg8::MoeOrder>(lds, g, S, E, wave, args.variant);
    }
    GRID_BAR(7);
    if (IN(8)) {
        pg8::Gemm g{(const bf16*)ACT8, (const bf16*)Wdn8, MAXROWS, 1024, 512}; pg8::MoeOrder S{BLKEXP, __builtin_amdgcn_readfirstlane(NBLK[0]), 4, G, bx};
        pg8::EpiDown E{nullptr, EO8, INP(19), ROWGATE};
        pg8::gemm_phase_f8<pg8::EpiDown, pg8::MoeOrder>(lds, g, S, E, wave);
    }
    GRID_BAR(8);
    if (IN(9)) {
        const int tid = fresh_tid(wave), lane = tid & 63; (void)lane;
        const int gw = bx * NWAVES + wave, NGW = G * NWAVES;
        f32x4 wf[4];
#pragma unroll
        for (int j = 0; j < 4; ++j) wf[j] = *(const f32x4*)(INP(20) + 4 * lane + 256 * j);
#pragma unroll 1
        for (int row = gw; row < T; row += 2 * NGW) {
            int er[2][4];
#pragma unroll
            for (int q = 0; q < 2; ++q) { const typeof(*(const v4u*)0) t4 = *(const v4u*)(TOKROW + (size_t)(row + q * NGW) * 4); er[q][0] = (int)t4.x; er[q][1] = (int)t4.y; er[q][2] = (int)t4.z; er[q][3] = (int)t4.w; }
            v2u hw[2][4]; int ew[2][4][4];
#pragma unroll
            for (int q = 0; q < 2; ++q)
#pragma unroll
                for (int j = 0; j < 4; ++j) hw[q][j] = *(const v2u*)(H + (size_t)(row + q * NGW) * 1024 + 4 * lane + 256 * j);
#pragma unroll
            for (int q = 0; q < 2; ++q)
#pragma unroll
                for (int k = 0; k < 4; ++k)
#pragma unroll
                    for (int j = 0; j < 4; ++j) ew[q][k][j] = *(const int*)(EO8 + (size_t)er[q][k] * 1024 + 4 * lane + 256 * j);
#pragma unroll
            for (int q = 0; q < 2; ++q) { f32x4 v[4], ya[4]; typedef float f2v __attribute__((ext_vector_type(2)));
#pragma unroll
                for (int j = 0; j < 4; ++j) { v[j] = (f32x4){bflo(hw[q][j].x), bfhi(hw[q][j].x), bflo(hw[q][j].y), bfhi(hw[q][j].y)}; ya[j] = (f32x4){0.f, 0.f, 0.f, 0.f}; }
#pragma unroll
                for (int k = 0; k < 4; ++k)
#pragma unroll
                    for (int j = 0; j < 4; ++j) { const f2v lo = __builtin_amdgcn_cvt_pk_f32_fp8(ew[q][k][j], false), hi = __builtin_amdgcn_cvt_pk_f32_fp8(ew[q][k][j], true); ya[j][0] += lo[0]; ya[j][1] += lo[1]; ya[j][2] += hi[0]; ya[j][3] += hi[1]; }
                float ss = 0.f;
#pragma unroll
                for (int j = 0; j < 4; ++j) { v[j] = v[j] + ya[j] * 0.0625f; ss += (v[j][0] * v[j][0] + v[j][1] * v[j][1]) + (v[j][2] * v[j][2] + v[j][3] * v[j][3]); }
                ss = wave_sum(ss); const float rs = rsqrt_f(ss * (1.0f / 1024.0f) + RMS_EPS);
#pragma unroll
                for (int j = 0; j < 4; ++j) *(f32x4*)(args.out + (size_t)(row + q * NGW) * 1024 + 4 * lane + 256 * j) = v[j] * rs * wf[j]; }
        }
    }
#undef IN
}

extern "C" void kernel_launch(void* const* d_in, const int* in_sizes, int n_in, void* d_out, int out_size, void* d_ws, size_t ws_size, hipStream_t stream) {
    static int grid = 0;
    if (grid == 0) {
        if (n_in != 21 || in_sizes[0] != T * D || out_size != T * D || ws_size < WS_END) { fprintf(stderr, "kernel_launch: unexpected shapes/workspace (n_in %d, ws %zu, need %zu)\n", n_in, ws_size, (size_t)WS_END); grid = -1; return; }
        if (hipFuncSetAttribute((const void*)mega, hipFuncAttributeMaxDynamicSharedMemorySize, LDS_BYTES) != hipSuccess) { fprintf(stderr, "kernel_launch: hipFuncSetAttribute failed\n"); grid = -1; return; }
        int dev = 0, cus = 0, per_cu = 0;
        if (hipGetDevice(&dev) != hipSuccess || hipDeviceGetAttribute(&cus, hipDeviceAttributeMultiprocessorCount, dev) != hipSuccess) { grid = -1; return; }
        if (hipOccupancyMaxActiveBlocksPerMultiprocessor(&per_cu, (const void*)mega, NTHR, LDS_BYTES) != hipSuccess || per_cu < 1) { fprintf(stderr, "kernel_launch: occupancy query says %d blocks per CU\n", per_cu); grid = -1; return; }
        (void)hipGetLastError();
        grid = cus;
    }
    if (grid < 0) return;
    (void)hipMemsetAsync((char*)d_ws + WS_CTL + (size_t)CW_BAR * 4, 0, (size_t)XCD_BAR_WORDS * 4, stream);
    Args a{};
    for (int i = 0; i < 21; ++i) a.in[i] = (const float*)d_in[i];
    a.out = (float*)d_out; a.ws = (unsigned char*)d_ws;
    a.ph_lo = 0; a.ph_hi = 10;
    hipLaunchKernelGGL(mega, dim3(grid), dim3(NTHR), LDS_BYTES, stream, a);
#ifdef PROBE_PHASE
    a.ph_lo = PROBE_PHASE; a.ph_hi = PROBE_PHASE + 1;
#ifdef PROBE_VARIANT
    a.variant = PROBE_VARIANT;
#endif
    hipLaunchKernelGGL(mega, dim3(grid), dim3(NTHR), LDS_BYTES, stream, a);
#endif
}
```
